# Optimizing an MI355X kernel written in HIP

```python
import math
import jax, jax.numpy as jnp
from jax import lax
import numpy as np

D_MODEL = 1024
BATCH = 2
SEQ = 8192
DEPTH = 2
DEC_BATCH = 32
DEC_SEQ = 1
PAST_LEN = 8192
PAGE_SIZE = 128

D_RNN = D_MODEL
N_LRU_BLOCKS = 16
LRU_BLOCK = D_RNN // N_LRU_BLOCKS
CONV_WIDTH = 4
LRU_C = 8.0
HEAD_DIM = 64
HEADS_PER_GROUP = 8
DILATED_GROUPS = ((128, 1), (512, 4), (2048, 16))
N_GROUPS = len(DILATED_GROUPS)
N_ATT_HEADS = N_GROUPS * HEADS_PER_GROUP
ATT_WIDTH = N_ATT_HEADS * HEAD_DIM
ATT_OUT = HEADS_PER_GROUP * HEAD_DIM
BAND_BLOCK = 128
NUM_BUCKETS = 32
MAX_DISTANCE = 2048
D_FF = -(-8 * D_MODEL // (3 * 256)) * 256
EPS = 1e-6
D_IN = 2 * D_RNN + 3 * ATT_WIDTH
SPLITS = (D_RNN, 2 * D_RNN, 2 * D_RNN + ATT_WIDTH, 2 * D_RNN + 2 * ATT_WIDTH)

kernel_name = "hawk_dilated_hybrid_step"


def rmsnorm(x, g):
    xf = x.astype(jnp.float32)
    y = xf * lax.rsqrt(jnp.mean(xf * xf, axis=-1, keepdims=True) + EPS)
    return (y * g.astype(jnp.float32)).astype(x.dtype)


def t5_bucket(dist):
    max_exact = NUM_BUCKETS // 2
    d_f = jnp.maximum(dist, 1).astype(jnp.float32)
    large = max_exact + (jnp.log(d_f / max_exact) / math.log(MAX_DISTANCE / max_exact)
                         * (NUM_BUCKETS - max_exact)).astype(jnp.int32)
    large = jnp.minimum(large, NUM_BUCKETS - 1)
    return jnp.where(dist < max_exact, dist, large)


def causal_conv(x_ext, w, b):
    T = x_ext.shape[1] - (CONV_WIDTH - 1)
    out = b
    for k in range(CONV_WIDTH):
        out = out + w[k] * x_ext[:, k:k + T]
    return out


def rg_lru(x, pos, h0, w_a, b_a, w_x, b_x, lam):
    B, T, _ = x.shape
    xb = x.reshape(B, T, N_LRU_BLOCKS, LRU_BLOCK)
    gate_a = jnp.einsum('btni,nij->btnj', xb, w_a).reshape(B, T, D_RNN) + b_a
    gate_x = jnp.einsum('btni,nij->btnj', xb, w_x).reshape(B, T, D_RNN) + b_x
    r = jax.nn.sigmoid(gate_a.astype(jnp.float32))
    i = jax.nn.sigmoid(gate_x.astype(jnp.float32))
    log_a = -LRU_C * r * jax.nn.softplus(-lam.astype(jnp.float32))
    a = jnp.exp(log_a)
    mult = jnp.sqrt(-jnp.expm1(2.0 * log_a))
    mult = jnp.where((pos == 0)[None, :, None], 1.0, mult)
    u = mult * i * x.astype(jnp.float32)

    def step(h, au):
        a_t, u_t = au
        h = a_t * h + u_t
        return h, h

    h_T, hs = lax.scan(step, h0.astype(jnp.float32),
                       (jnp.swapaxes(a, 0, 1), jnp.swapaxes(u, 0, 1)))
    return jnp.swapaxes(hs, 0, 1).astype(x.dtype), h_T


def dilated_attn_prompt(q, k, v, tab, window, dil):
    B, S, H, E = q.shape
    BB = BAND_BLOCK
    band = window // dil
    n = S // dil
    nb = -(-n // BB)
    n_pad = nb * BB

    def to_res(t):
        t = jnp.swapaxes(t.reshape(B, n, dil, H, E), 1, 2)
        return jnp.pad(t, ((0, 0), (0, 0), (0, n_pad - n), (0, 0), (0, 0)))

    def key_blocks(t):
        tp = jnp.pad(t, ((0, 0), (0, 0), (BB, 0), (0, 0), (0, 0))).reshape(B, dil, nb + 1, BB, H, E)
        return jnp.concatenate([tp[:, :, :-1], tp[:, :, 1:]], axis=3)

    qb = to_res(q).reshape(B, dil, nb, BB, H, E)
    kb = key_blocks(to_res(k))
    vb = key_blocks(to_res(v))
    s = jnp.einsum('brcqhe,brckhe->brchqk', qb, kb,
                   preferred_element_type=jnp.float32) * (HEAD_DIM ** -0.5)
    qi = jnp.arange(BB)[:, None]
    ki = jnp.arange(2 * BB)[None, :]
    sub_dist = qi + BB - ki
    in_band = (sub_dist >= 0) & (sub_dist <= band)
    bias = tab[t5_bucket(jnp.clip(sub_dist, 0, band) * dil)].astype(jnp.float32)
    bias = jnp.transpose(bias, (2, 0, 1))
    key_sub = jnp.arange(nb)[:, None, None] * BB - BB + ki[None]
    valid = in_band[None] & (key_sub >= 0)
    s = jnp.where(valid[:, None], s + bias, -jnp.inf)
    m = jnp.max(s, axis=-1)
    p = jnp.exp(s - m[..., None])
    l = jnp.sum(p, axis=-1)
    o = jnp.einsum('brchqk,brckhe->brcqhe', p, vb.astype(jnp.float32))
    m = jnp.swapaxes(m, 3, 4)
    l = jnp.swapaxes(l, 3, 4)
    o = o / l[..., None]

    def from_res(t):
        t = t.reshape((B, dil, n_pad) + t.shape[4:])[:, :, :n]
        t = jnp.swapaxes(t, 1, 2)
        return t.reshape((B, S) + t.shape[3:])

    return from_res(o), from_res(m), from_res(l)


def dilated_attn_sample(q, k_all, v_all, tab, window, dil):
    B, T, H, E = q.shape
    L = k_all.shape[1] - T
    kk = jnp.arange(window // dil + 1)
    idx = L + jnp.arange(T)[:, None] - kk[None, :] * dil
    valid = idx >= 0
    idx_c = jnp.maximum(idx, 0)
    kg = k_all[:, idx_c]
    vg = v_all[:, idx_c]
    s = jnp.einsum('bthe,btkhe->bthk', q, kg,
                   preferred_element_type=jnp.float32) * (HEAD_DIM ** -0.5)
    bias = tab[t5_bucket(kk * dil)].astype(jnp.float32).T
    s = jnp.where(valid[:, None, :], s + bias, -jnp.inf)
    m = jnp.max(s, axis=-1)
    p = jnp.exp(s - m[..., None])
    l = jnp.sum(p, axis=-1)
    o = jnp.einsum('bthk,btkhe->bthe', p, vg.astype(jnp.float32)) / l[..., None]
    return o, m, l


def combine_groups(outs):
    m_max = jnp.max(jnp.stack([m for _, m, _ in outs]), axis=0)
    num = 0.0
    den = 0.0
    for o, m, l in outs:
        z = l * jnp.exp(m - m_max)
        num = num + z[..., None] * o
        den = den + z
    return num / den[..., None]


def trunk_layer(x, pos, conv_prefix, h0, kv_bufs, rel_bias, norm_mix, w_in, w_conv, b_conv,
                w_rg_a, b_rg_a, w_rg_x, b_rg_x, lru_lambda, q_gain, k_gain, w_merge, b_merge,
                w_branch_lru, w_branch_att, w_o, norm_ffn, w_ffn_in, w_ffn_out):
    B, T, _ = x.shape
    xn = rmsnorm(x, norm_mix)
    lru_x, lru_g, q, k, v = jnp.split(xn @ w_in, SPLITS, axis=-1)

    if conv_prefix is None:
        conv_prefix = jnp.zeros((B, CONV_WIDTH - 1, D_RNN), lru_x.dtype)
    x_ext = jnp.concatenate([conv_prefix.astype(lru_x.dtype), lru_x], axis=1)
    new_conv = x_ext[:, -(CONV_WIDTH - 1):]
    xc = causal_conv(x_ext, w_conv, b_conv)
    hs, h_T = rg_lru(xc, pos, h0, w_rg_a, b_rg_a, w_rg_x, b_rg_x, lru_lambda)
    y_lru = (hs * jax.nn.gelu(lru_g)) @ w_branch_lru

    q = rmsnorm(q.reshape(B, T, N_ATT_HEADS, HEAD_DIM), q_gain)
    k = rmsnorm(k.reshape(B, T, N_ATT_HEADS, HEAD_DIM), k_gain)
    v = v.reshape(B, T, N_ATT_HEADS, HEAD_DIM)
    outs, new_kv = [], []
    for g, (window, dil) in enumerate(DILATED_GROUPS):
        hsl = slice(g * HEADS_PER_GROUP, (g + 1) * HEADS_PER_GROUP)
        qg, kg, vg = q[:, :, hsl], k[:, :, hsl], v[:, :, hsl]
        tab = rel_bias[:, hsl]
        if kv_bufs is None:
            outs.append(dilated_attn_prompt(qg, kg, vg, tab, window, dil))
            keep = min(window, T)
            new_kv.append(jnp.stack([kg[:, T - keep:], vg[:, T - keep:]], axis=2))
        else:
            buf = kv_bufs[g].astype(kg.dtype)
            k_all = jnp.concatenate([buf[:, :, 0], kg], axis=1)
            v_all = jnp.concatenate([buf[:, :, 1], vg], axis=1)
            outs.append(dilated_attn_sample(qg, k_all, v_all, tab, window, dil))
            new_kv.append(jnp.stack([kg, vg], axis=2))
    o = combine_groups(outs).astype(x.dtype).reshape(B, T, ATT_OUT)
    y_att = o @ w_branch_att

    g_lru, g_att = jnp.split(jax.nn.sigmoid(xn @ w_merge + b_merge), 2, axis=-1)
    x = x + (g_lru * y_lru + g_att * y_att) @ w_o

    gate, up = jnp.split(rmsnorm(x, norm_ffn) @ w_ffn_in, 2, axis=-1)
    x = x + (jax.nn.silu(gate) * up) @ w_ffn_out
    return x, new_conv, h_T, new_kv


def setup_inputs(seed: int = 0) -> dict:
    key = jax.random.key(seed)
    ks = iter(jax.random.split(key, 40))
    nrm = lambda shape, scale: jax.random.normal(next(ks), shape, jnp.float32) * scale
    inp = {}
    inp["x_prompt"] = nrm((BATCH, SEQ, D_MODEL), 1.0)
    inp["x_sample"] = nrm((DEC_BATCH, DEC_SEQ, D_MODEL), 1.0)
    for g, (window, dil) in enumerate(DILATED_GROUPS):
        L = min(window, PAST_LEN)
        inp["cache_kv_g%d" % g] = nrm((DEPTH, DEC_BATCH, L, 2, HEADS_PER_GROUP, HEAD_DIM), 1.0)
    inp["state_conv"] = nrm((DEPTH, DEC_BATCH, CONV_WIDTH - 1, D_RNN), 1.0)
    inp["state_h"] = nrm((DEPTH, DEC_BATCH, D_RNN), 0.5)
    inp["rel_bias"] = nrm((NUM_BUCKETS, N_ATT_HEADS), 0.5)
    inp["norm_mix"] = 1.0 + nrm((DEPTH, D_MODEL), 0.01)
    inp["w_in"] = nrm((DEPTH, D_MODEL, D_IN), D_MODEL ** -0.5)
    inp["w_conv"] = nrm((DEPTH, CONV_WIDTH, D_RNN), CONV_WIDTH ** -0.5)
    inp["b_conv"] = nrm((DEPTH, D_RNN), 0.01)
    inp["w_rg_a"] = nrm((DEPTH, N_LRU_BLOCKS, LRU_BLOCK, LRU_BLOCK), LRU_BLOCK ** -0.5)
    inp["b_rg_a"] = nrm((DEPTH, D_RNN), 0.01)
    inp["w_rg_x"] = nrm((DEPTH, N_LRU_BLOCKS, LRU_BLOCK, LRU_BLOCK), LRU_BLOCK ** -0.5)
    inp["b_rg_x"] = nrm((DEPTH, D_RNN), 0.01)
    a_c = jax.random.uniform(next(ks), (DEPTH, D_RNN), jnp.float32, 0.9, 0.999)
    a = a_c ** (1.0 / LRU_C)
    inp["lru_lambda"] = jnp.log(a) - jnp.log1p(-a)
    inp["q_gain"] = 1.0 + nrm((DEPTH, HEAD_DIM), 0.01)
    inp["k_gain"] = 1.0 + nrm((DEPTH, HEAD_DIM), 0.01)
    inp["w_merge"] = nrm((DEPTH, D_MODEL, 2 * D_MODEL), D_MODEL ** -0.5)
    inp["b_merge"] = nrm((DEPTH, 2 * D_MODEL), 0.01)
    inp["w_branch_lru"] = nrm((DEPTH, D_RNN, D_MODEL), D_RNN ** -0.5)
    inp["w_branch_att"] = nrm((DEPTH, ATT_OUT, D_MODEL), ATT_OUT ** -0.5)
    inp["w_o"] = nrm((DEPTH, D_MODEL, D_MODEL), D_MODEL ** -0.5)
    inp["norm_ffn"] = 1.0 + nrm((DEPTH, D_MODEL), 0.01)
    inp["w_ffn_in"] = nrm((DEPTH, D_MODEL, 2 * D_FF), D_MODEL ** -0.5)
    inp["w_ffn_out"] = nrm((DEPTH, D_FF, D_MODEL), D_FF ** -0.5)
    return inp


def reference(x_prompt, x_sample, cache_kv_g0, cache_kv_g1, cache_kv_g2, state_conv, state_h,
              rel_bias, norm_mix, w_in, w_conv, b_conv, w_rg_a, b_rg_a, w_rg_x, b_rg_x, lru_lambda,
              q_gain, k_gain, w_merge, b_merge, w_branch_lru, w_branch_att, w_o, norm_ffn,
              w_ffn_in, w_ffn_out):
    pos_p = jnp.arange(x_prompt.shape[1])
    pos_s = PAST_LEN + jnp.arange(x_sample.shape[1])

    def layer_weights(l):
        return (norm_mix[l], w_in[l], w_conv[l], b_conv[l], w_rg_a[l], b_rg_a[l], w_rg_x[l],
                b_rg_x[l], lru_lambda[l], q_gain[l], k_gain[l], w_merge[l], b_merge[l],
                w_branch_lru[l], w_branch_att[l], w_o[l], norm_ffn[l], w_ffn_in[l], w_ffn_out[l])

    yp, ys = x_prompt, x_sample
    kvp = [[], [], []]
    kvs = [[], [], []]
    conv_p, h_p, conv_s, h_s = [], [], [], []
    for l in range(DEPTH):
        lw = layer_weights(l)
        h0 = jnp.zeros((x_prompt.shape[0], D_RNN), jnp.float32)
        yp, c_p, hp_l, kv_p = trunk_layer(yp, pos_p, None, h0, None, rel_bias, *lw)
        ys, c_s, hs_l, kv_s = trunk_layer(ys, pos_s, state_conv[l], state_h[l],
                                          (cache_kv_g0[l], cache_kv_g1[l], cache_kv_g2[l]),
                                          rel_bias, *lw)
        for g in range(N_GROUPS):
            kvp[g].append(kv_p[g])
            kvs[g].append(kv_s[g])
        conv_p.append(c_p)
        h_p.append(hp_l)
        conv_s.append(c_s)
        h_s.append(hs_l)
    kv_g0_p, kv_g1_p, kv_g2_p = (jnp.stack(kvp[0]), jnp.stack(kvp[1]), jnp.stack(kvp[2]))
    kv_g0_s, kv_g1_s, kv_g2_s = (jnp.stack(kvs[0]), jnp.stack(kvs[1]), jnp.stack(kvs[2]))
    conv_p_out = jnp.stack(conv_p)
    h_p_out = jnp.stack(h_p)
    conv_s_out = jnp.stack(conv_s)
    h_s_out = jnp.stack(h_s)
    return (yp, ys, kv_g0_p, kv_g1_p, kv_g2_p, conv_p_out, h_p_out,
            kv_g0_s, kv_g1_s, kv_g2_s, conv_s_out, h_s_out)
```

```cpp
#include <hip/hip_runtime.h>
#include <stdint.h>
#include <stdio.h>

typedef unsigned short bf16_t;
typedef short bf16x8 __attribute__((ext_vector_type(8)));
typedef float f32x4 __attribute__((ext_vector_type(4)));

constexpr int DM = 1024, NB = 2, SEQ = 8192, DEPTH = 2, SB = 32, PAST = 8192;
constexpr int MP = NB * SEQ;
constexpr int MT = MP + SB;
constexpr int DR = 1024, NBLK = 16, CW = 4;
constexpr int HD = 64, HPG = 8, NG = 3, NH = 24, AW = 1536, AO = 512;
constexpr int DFF = 2816;
constexpr int N1 = 2 * DR + 3 * AW + 2 * DM;
constexpr float EPS = 1e-6f;
constexpr int NKEY = 129;

__host__ __device__ constexpr int g_dil(int g) { return g == 0 ? 1 : (g == 1 ? 4 : 16); }
__host__ __device__ constexpr int g_win(int g) { return g == 0 ? 128 : (g == 1 ? 512 : 2048); }

constexpr size_t O_Y = 0;
constexpr size_t O_KVP0 = (size_t)MT * DM;
constexpr size_t O_KVP1 = O_KVP0 + (size_t)DEPTH * NB * 128 * 1024;
constexpr size_t O_KVP2 = O_KVP1 + (size_t)DEPTH * NB * 512 * 1024;
constexpr size_t O_CONVP = O_KVP2 + (size_t)DEPTH * NB * 2048 * 1024;
constexpr size_t O_HP = O_CONVP + (size_t)DEPTH * NB * 3 * DR;
constexpr size_t O_KVS0 = O_HP + (size_t)DEPTH * NB * DR;
constexpr size_t O_KVS1 = O_KVS0 + (size_t)DEPTH * SB * 1024;
constexpr size_t O_KVS2 = O_KVS1 + (size_t)DEPTH * SB * 1024;
constexpr size_t O_CONVS = O_KVS2 + (size_t)DEPTH * SB * 1024;
constexpr size_t O_HS = O_CONVS + (size_t)DEPTH * SB * 3 * DR;
constexpr size_t O_END = O_HS + (size_t)DEPTH * SB * DR;
__host__ __device__ constexpr size_t o_kvp(int g) { return g == 0 ? O_KVP0 : (g == 1 ? O_KVP1 : O_KVP2); }
__host__ __device__ constexpr size_t o_kvs(int g) { return g == 0 ? O_KVS0 : (g == 1 ? O_KVS1 : O_KVS2); }

constexpr size_t MiB = 1u << 20;
constexpr size_t rup(size_t x) { return (x + MiB - 1) / MiB * MiB; }
constexpr size_t WS_CTL = 0;
constexpr size_t WS_BIAS = 1 * MiB;
constexpr size_t WS_SSQ = 2 * MiB;
constexpr size_t WS_SUM = 3 * MiB;
constexpr size_t WS_W = 8 * MiB;
constexpr size_t LW_W1 = 0;
constexpr size_t LW_W3A = LW_W1 + (size_t)N1 * DM * 2;
constexpr size_t LW_W3B = LW_W3A + (size_t)DM * DR * 2;
constexpr size_t LW_W4 = LW_W3B + (size_t)DM * AO * 2;
constexpr size_t LW_W5 = LW_W4 + (size_t)DM * DM * 2;
constexpr size_t LW_W6 = LW_W5 + (size_t)2 * DFF * DM * 2;
constexpr size_t LW_BYTES = rup(LW_W6 + (size_t)DM * DFF * 2);
constexpr size_t WS_XB = WS_W + DEPTH * LW_BYTES;
constexpr size_t ROWS_PAD = 16640;
constexpr size_t WS_LX = WS_XB + rup(ROWS_PAD * DM * 2);
constexpr size_t WS_GG = WS_LX + rup(ROWS_PAD * DM * 2);
constexpr size_t WS_Q = WS_GG + rup(ROWS_PAD * DM * 2);
constexpr size_t WS_K = WS_Q + rup(ROWS_PAD * AW * 2);
constexpr size_t WS_V = WS_K + rup(ROWS_PAD * AW * 2);
constexpr size_t WS_GM = WS_V + rup(ROWS_PAD * AW * 2);
constexpr size_t WS_OG = WS_GM + rup(ROWS_PAD * 2048 * 2);
constexpr size_t WS_ML = WS_OG + rup(3 * ROWS_PAD * AO * 2);
constexpr size_t WS_ALRU = WS_ML + rup(3 * ROWS_PAD * 16 * 4);
constexpr size_t WS_AATT = WS_ALRU + rup(ROWS_PAD * DM * 2);
constexpr size_t WS_MRG = WS_AATT + rup(ROWS_PAD * AO * 2);
constexpr size_t WS_H = WS_MRG + rup(ROWS_PAD * DM * 2);
constexpr size_t WS_SIMPLE = WS_H + rup(ROWS_PAD * DFF * 2);
constexpr size_t WS_C = WS_SIMPLE;
constexpr size_t WS_C2 = WS_C + rup(ROWS_PAD * (size_t)N1 * 4);
constexpr size_t WS_XC = WS_C2 + rup(ROWS_PAD * DM * 4);
constexpr size_t WS_AA = WS_XC + rup(ROWS_PAD * DM * 4);
constexpr size_t WS_UU = WS_AA + rup(ROWS_PAD * DM * 4);
constexpr size_t WS_END = WS_UU + rup(ROWS_PAD * DM * 4);

__device__ __forceinline__ float bf2f(bf16_t v) { return __uint_as_float(((unsigned)v) << 16); }
__device__ __forceinline__ bf16_t f2bf(float f) { unsigned u = __float_as_uint(f); u += 0x7fffu + ((u >> 16) & 1u); return (bf16_t)(u >> 16); }
__device__ __forceinline__ float wave_sum(float v) {
#pragma unroll
    for (int o = 1; o < 64; o <<= 1) v += __shfl_xor(v, o);
    return v;
}
__device__ __forceinline__ float wave_max(float v) {
#pragma unroll
    for (int o = 1; o < 64; o <<= 1) v = fmaxf(v, __shfl_xor(v, o));
    return v;
}
__device__ __forceinline__ float sigmoidf_(float x) { return 1.0f / (1.0f + __expf(-x)); }
__device__ __forceinline__ float gelu_tanh(float x) { const float u = 0.7978845608028654f * (x + 0.044715f * x * x * x); return 0.5f * x * (1.0f + tanhf(u)); }

__host__ __device__ __forceinline__ int w1_src_col(int nt) {
    if (nt < 2048 || nt >= 6656) return nt;
    const int pn = nt >> 8, tc = nt & 255, bj = tc >> 7, wc = (tc >> 5) & 3, i = tc & 31;
    return 2048 + (pn - 8) * 256 + wc * 64 + bj * 32 + i;
}
__host__ __device__ __forceinline__ int w1_qkv_tilecol(int L) {
    const int pn = 8 + (L >> 8), w = L & 255, wc = w >> 6, d = w & 63, bj = d >> 5, i = d & 31;
    return pn * 256 + bj * 128 + wc * 32 + i;
}
__host__ __device__ __forceinline__ int w5_src_col(int nt) { const int pn = nt >> 8, tc = nt & 255, bj = tc >> 7, j = tc & 127; return bj * DFF + pn * 128 + j; }

struct Ptrs {
    const float* x_prompt; const float* x_sample; const float* cache[3]; const float* state_conv; const float* state_h; const float* rel_bias;
    const float* norm_mix; const float* w_in; const float* w_conv; const float* b_conv; const float* w_rg_a; const float* b_rg_a; const float* w_rg_x; const float* b_rg_x;
    const float* lru_lambda; const float* q_gain; const float* k_gain; const float* w_merge; const float* b_merge; const float* w_branch_lru; const float* w_branch_att;
    const float* w_o; const float* norm_ffn; const float* w_ffn_in; const float* w_ffn_out;
    float* out; unsigned char* ws;
};

__global__ void k_convert(Ptrs P) {
    const size_t tid = (size_t)blockIdx.x * blockDim.x + threadIdx.x, nth = (size_t)gridDim.x * blockDim.x;
    for (int l = 0; l < DEPTH; ++l) {
        unsigned char* wb = P.ws + WS_W + l * LW_BYTES;
        bf16_t* W1 = (bf16_t*)(wb + LW_W1); bf16_t* W3A = (bf16_t*)(wb + LW_W3A); bf16_t* W3B = (bf16_t*)(wb + LW_W3B);
        bf16_t* W4 = (bf16_t*)(wb + LW_W4); bf16_t* W5 = (bf16_t*)(wb + LW_W5); bf16_t* W6 = (bf16_t*)(wb + LW_W6);
        const float* w_in = P.w_in + (size_t)l * DM * 6656; const float* w_merge = P.w_merge + (size_t)l * DM * 2048;
        const float* nm = P.norm_mix + l * DM; const float* nf = P.norm_ffn + l * DM;
        for (size_t e = tid; e < (size_t)N1 * DM; e += nth) { const int n = (int)(e % N1), k = (int)(e / N1); const int c = w1_src_col(n);
            const float v = (c < 6656 ? w_in[(size_t)k * 6656 + c] : w_merge[(size_t)k * 2048 + (c - 6656)]) * nm[k]; W1[(size_t)n * DM + k] = f2bf(v); }
        const float* wl = P.w_branch_lru + (size_t)l * DR * DM;
        for (size_t e = tid; e < (size_t)DM * DR; e += nth) { const int n = (int)(e % DM), k = (int)(e / DM); W3A[(size_t)n * DR + k] = f2bf(wl[(size_t)k * DM + n]); }
        const float* wa = P.w_branch_att + (size_t)l * AO * DM;
        for (size_t e = tid; e < (size_t)DM * AO; e += nth) { const int n = (int)(e % DM), k = (int)(e / DM); W3B[(size_t)n * AO + k] = f2bf(wa[(size_t)k * DM + n]); }
        const float* wo = P.w_o + (size_t)l * DM * DM;
        for (size_t e = tid; e < (size_t)DM * DM; e += nth) { const int n = (int)(e % DM), k = (int)(e / DM); W4[(size_t)n * DM + k] = f2bf(wo[(size_t)k * DM + n]); }
        const float* wf = P.w_ffn_in + (size_t)l * DM * 2 * DFF;
        for (size_t e = tid; e < (size_t)2 * DFF * DM; e += nth) { const int n = (int)(e % (2 * DFF)), k = (int)(e / (2 * DFF)); W5[(size_t)n * DM + k] = f2bf(wf[(size_t)k * 2 * DFF + w5_src_col(n)] * nf[k]); }
        const float* wf2 = P.w_ffn_out + (size_t)l * DFF * DM;
        for (size_t e = tid; e < (size_t)DM * DFF; e += nth) { const int n = (int)(e % DM), k = (int)(e / DM); W6[(size_t)n * DFF + k] = f2bf(wf2[(size_t)k * DM + n]); }
    }
    float* BIAS = (float*)(P.ws + WS_BIAS);
    for (size_t e = tid; e < (size_t)NG * HPG * NKEY; e += nth) {
        const int kk = (int)(e % NKEY), hh = (int)((e / NKEY) % HPG), g = (int)(e / (NKEY * HPG));
        const int d = kk * g_dil(g); int bkt;
        if (d < 16) bkt = d; else { const float df = (float)d; int lg = 16 + (int)(logf(df / 16.0f) / logf(128.0f) * 16.0f); bkt = lg < 31 ? lg : 31; }
        BIAS[e] = P.rel_bias[bkt * NH + 8 * g + hh];
    }
}

__device__ __forceinline__ const float* xin_row(const Ptrs& P, int row) { return row < MP ? P.x_prompt + (size_t)row * DM : P.x_sample + (size_t)(row - MP) * DM; }

__global__ void k_prep(Ptrs P) {
    const int wave = (blockIdx.x * blockDim.x + threadIdx.x) >> 6, lane = threadIdx.x & 63;
    if (wave >= MT) return;
    const float* xr = xin_row(P, wave); bf16_t* xb = (bf16_t*)(P.ws + WS_XB) + (size_t)wave * DM; float* ssq = (float*)(P.ws + WS_SSQ) + (size_t)wave * 4;
    float s = 0.f;
    for (int c = lane; c < DM; c += 64) { const float v = xr[c]; s += v * v; xb[c] = f2bf(v); }
    s = wave_sum(s);
    if (lane == 0) { ssq[0] = s; ssq[1] = 0.f; ssq[2] = 0.f; ssq[3] = 0.f; }
}

__global__ void __launch_bounds__(256) k_gemm(const bf16_t* __restrict__ A, const bf16_t* __restrict__ Bt, float* __restrict__ C, int M, int N, int K) {
    const int lane = threadIdx.x & 63, wave = threadIdx.x >> 6, wr = wave >> 1, wc = wave & 1;
    const int m0 = blockIdx.y * 128 + wr * 64, n0 = blockIdx.x * 128 + wc * 64;
    const int fr = lane & 15, fq = lane >> 4;
    f32x4 acc[4][4];
#pragma unroll
    for (int i = 0; i < 4; ++i)
#pragma unroll
        for (int j = 0; j < 4; ++j) acc[i][j] = (f32x4){0.f, 0.f, 0.f, 0.f};
    const bf16_t* ap[4]; const bf16_t* bp[4];
#pragma unroll
    for (int i = 0; i < 4; ++i) { int r = m0 + i * 16 + fr; if (r > M - 1) r = M - 1; ap[i] = A + (size_t)r * K + fq * 8; bp[i] = Bt + (size_t)(n0 + i * 16 + fr) * K + fq * 8; }
    for (int k0 = 0; k0 < K; k0 += 32) {
        bf16x8 a[4], b[4];
#pragma unroll
        for (int i = 0; i < 4; ++i) { a[i] = *(const bf16x8*)(ap[i] + k0); b[i] = *(const bf16x8*)(bp[i] + k0); }
#pragma unroll
        for (int i = 0; i < 4; ++i)
#pragma unroll
            for (int j = 0; j < 4; ++j) acc[i][j] = __builtin_amdgcn_mfma_f32_16x16x32_bf16(a[i], b[j], acc[i][j], 0, 0, 0);
    }
#pragma unroll
    for (int i = 0; i < 4; ++i)
#pragma unroll
        for (int j = 0; j < 4; ++j)
#pragma unroll
            for (int r = 0; r < 4; ++r) { const int row = m0 + i * 16 + fq * 4 + r, col = n0 + j * 16 + fr; if (row < M) C[(size_t)row * N + col] = acc[i][j][r]; }
}

__global__ void __launch_bounds__(256) k_epi1(Ptrs P, int l) {
    const int row = blockIdx.x, tid = threadIdx.x, lane = tid & 63, wave = tid >> 6;
    const float* C = (const float*)(P.ws + WS_C) + (size_t)row * N1;
    const float* ssq = (const float*)(P.ws + WS_SSQ) + (size_t)row * 4;
    const float r = rsqrtf((ssq[0] + ssq[1] + ssq[2] + ssq[3]) * (1.0f / DM) + EPS);
    bf16_t* LX = (bf16_t*)(P.ws + WS_LX) + (size_t)row * DR; bf16_t* GG = (bf16_t*)(P.ws + WS_GG) + (size_t)row * DR;
    const bool samp = row >= MP; const int b = samp ? row - MP : row / SEQ, t = samp ? 0 : row % SEQ;
    for (int c = tid; c < DR; c += 256) {
        const float v = C[c] * r; LX[c] = f2bf(v);
        GG[c] = f2bf(gelu_tanh(C[DR + c] * r));
        if (!samp) { if (t >= SEQ - 3) P.out[O_CONVP + ((size_t)(l * NB + b) * 3 + (t - (SEQ - 3))) * DR + c] = v; }
        else { float* cs = P.out + O_CONVS + (size_t)(l * SB + b) * 3 * DR; const float* sc = P.state_conv + (size_t)(l * SB + b) * 3 * DR;
            cs[c] = sc[DR + c]; cs[DR + c] = sc[2 * DR + c]; cs[2 * DR + c] = v; }
    }
    bf16_t* Q = (bf16_t*)(P.ws + WS_Q) + (size_t)row * AW; bf16_t* K = (bf16_t*)(P.ws + WS_K) + (size_t)row * AW; bf16_t* V = (bf16_t*)(P.ws + WS_V) + (size_t)row * AW;
    for (int idx = wave; idx < 3 * NH; idx += 4) {
        const int type = idx / NH, head = idx % NH, g = head / HPG, hh = head % HPG;
        const int L = type * AW + head * HD + lane;
        float v = C[w1_qkv_tilecol(L)] * r;
        if (type < 2) { const float ss = wave_sum(v * v); const float* gain = (type == 0 ? P.q_gain : P.k_gain) + l * HD; v = v * rsqrtf(ss * (1.0f / HD) + EPS) * gain[lane]; }
        (type == 0 ? Q : (type == 1 ? K : V))[head * HD + lane] = f2bf(v);
        if (type >= 1) {
            if (!samp) { const int W = g_win(g); if (t >= SEQ - W) P.out[o_kvp(g) + ((((size_t)(l * NB + b) * W + (t - (SEQ - W))) * 2 + (type - 1)) * HPG + hh) * HD + lane] = v; }
            else P.out[o_kvs(g) + (((size_t)(l * SB + b) * 2 + (type - 1)) * HPG + hh) * HD + lane] = v;
        }
    }
    bf16_t* GM = (bf16_t*)(P.ws + WS_GM) + (size_t)row * 2048; const float* bm = P.b_merge + (size_t)l * 2048;
    for (int c = tid; c < 2048; c += 256) GM[c] = f2bf(sigmoidf_(C[6656 + c] * r + bm[c]));
}

__global__ void k_conv(Ptrs P, int l) {
    const size_t e = (size_t)blockIdx.x * blockDim.x + threadIdx.x; if (e >= (size_t)MT * DR) return;
    const int row = (int)(e / DR), ch = (int)(e % DR);
    const bf16_t* LX = (const bf16_t*)(P.ws + WS_LX);
    const float* wc = P.w_conv + (size_t)l * CW * DR; float acc = P.b_conv[l * DR + ch];
    if (row < MP) { const int t = row % SEQ;
#pragma unroll
        for (int k = 0; k < CW; ++k) { const int tt = t + k - 3; if (tt >= 0) acc += wc[k * DR + ch] * bf2f(LX[(size_t)(row + k - 3) * DR + ch]); } }
    else { const int b = row - MP; const float* sc = P.state_conv + (size_t)(l * SB + b) * 3 * DR;
        acc += wc[0 * DR + ch] * sc[ch] + wc[1 * DR + ch] * sc[DR + ch] + wc[2 * DR + ch] * sc[2 * DR + ch] + wc[3 * DR + ch] * bf2f(LX[(size_t)row * DR + ch]); }
    ((float*)(P.ws + WS_XC))[e] = acc;
}
__global__ void k_gates(Ptrs P, int l) {
    const size_t e = (size_t)blockIdx.x * blockDim.x + threadIdx.x; if (e >= (size_t)MT * DR) return;
    const int row = (int)(e / DR), ch = (int)(e % DR), n = ch >> 6, j = ch & 63;
    const float* XC = (const float*)(P.ws + WS_XC) + (size_t)row * DR + n * 64;
    const float* wa = P.w_rg_a + ((size_t)(l * NBLK + n) * 64) * 64 + j; const float* wx = P.w_rg_x + ((size_t)(l * NBLK + n) * 64) * 64 + j;
    float ga = P.b_rg_a[l * DR + ch], gx = P.b_rg_x[l * DR + ch];
    for (int i = 0; i < 64; ++i) { const float x = XC[i]; ga += x * wa[i * 64]; gx += x * wx[i * 64]; }
    const float rr = sigmoidf_(ga), ii = sigmoidf_(gx);
    const float lam = P.lru_lambda[l * DR + ch]; const float sp = log1pf(expf(-lam));
    const float log_a = -8.0f * rr * sp; const float a = expf(log_a);
    const bool pos0 = (row < MP) && (row % SEQ == 0);
    const float mult = pos0 ? 1.0f : sqrtf(-expm1f(2.0f * log_a));
    ((float*)(P.ws + WS_AA))[e] = a; ((float*)(P.ws + WS_UU))[e] = mult * ii * XC[j];
}
__global__ void k_scan(Ptrs P, int l) {
    const int e = blockIdx.x * blockDim.x + threadIdx.x; if (e >= (NB + SB) * DR) return;
    const int s = e / DR, ch = e % DR;
    const float* AA = (const float*)(P.ws + WS_AA); const float* UU = (const float*)(P.ws + WS_UU);
    const bf16_t* GG = (const bf16_t*)(P.ws + WS_GG); bf16_t* AL = (bf16_t*)(P.ws + WS_ALRU);
    if (s < NB) { float h = 0.f; const size_t base = (size_t)s * SEQ * DR + ch;
        for (int t = 0; t < SEQ; t += 8) { float a[8], u[8], g[8];
#pragma unroll
            for (int i = 0; i < 8; ++i) { const size_t o = base + (size_t)(t + i) * DR; a[i] = AA[o]; u[i] = UU[o]; g[i] = bf2f(GG[o]); }
#pragma unroll
            for (int i = 0; i < 8; ++i) { h = a[i] * h + u[i]; AL[base + (size_t)(t + i) * DR] = f2bf(h * g[i]); } }
        P.out[O_HP + (size_t)(l * NB + s) * DR + ch] = h;
    } else { const int b = s - NB; const size_t o = (size_t)(MP + b) * DR + ch; float h = P.state_h[(size_t)(l * SB + b) * DR + ch];
        h = AA[o] * h + UU[o]; AL[o] = f2bf(h * bf2f(GG[o])); P.out[O_HS + (size_t)(l * SB + b) * DR + ch] = h; }
}

__global__ void __launch_bounds__(256) k_attn(Ptrs P, int l) {
    const int gw = (blockIdx.x * blockDim.x + threadIdx.x) >> 6, lane = threadIdx.x & 63;
    if (gw >= MT * NH) return;
    const int row = gw / NH, head = gw % NH, g = head / HPG, hh = head % HPG, dil = g_dil(g);
    const bf16_t* Q = (const bf16_t*)(P.ws + WS_Q); const bf16_t* K = (const bf16_t*)(P.ws + WS_K); const bf16_t* V = (const bf16_t*)(P.ws + WS_V);
    const float* BIAS = (const float*)(P.ws + WS_BIAS) + (size_t)(g * HPG + hh) * NKEY;
    const bool samp = row >= MP; const int b = samp ? row - MP : row / SEQ, t = samp ? 0 : row % SEQ;
    const int nkeys = samp ? NKEY : ((t / dil) < 128 ? (t / dil) + 1 : NKEY);
    const float* cache = P.cache[g] + (size_t)(l * SB + (samp ? b : 0)) * g_win(g) * 1024;
    const int Lc = g_win(g);
    __shared__ float qs[4][HD];
    float* qw = qs[threadIdx.x >> 6];
    qw[lane] = bf2f(Q[(size_t)row * AW + head * HD + lane]);
    __syncthreads();
    float s[3];
#pragma unroll
    for (int j = 0; j < 3; ++j) { const int kk = lane + 64 * j; float acc = -INFINITY;
        if (kk < nkeys) { acc = 0.f;
            if (!samp || kk == 0) { const bf16_t* kr = K + (size_t)(row - kk * dil) * AW + head * HD;
                for (int d = 0; d < HD; ++d) acc += qw[d] * bf2f(kr[d]); }
            else { const float* kr = cache + ((size_t)(Lc - kk * dil) * 2 + 0) * 512 + hh * HD;
                for (int d = 0; d < HD; ++d) acc += qw[d] * kr[d]; }
            acc = acc * 0.125f + BIAS[kk]; }
        s[j] = acc; }
    const float m = wave_max(fmaxf(fmaxf(s[0], s[1]), s[2]));
    float p[3]; float lsum = 0.f;
#pragma unroll
    for (int j = 0; j < 3; ++j) { p[j] = (lane + 64 * j < nkeys) ? __expf(s[j] - m) : 0.f; lsum += p[j]; }
    lsum = wave_sum(lsum);
    float o = 0.f;
    for (int kk = 0; kk < nkeys; ++kk) { const float pk = __shfl(kk < 64 ? p[0] : (kk < 128 ? p[1] : p[2]), kk & 63);
        float vv;
        if (!samp || kk == 0) vv = bf2f(V[(size_t)(row - kk * dil) * AW + head * HD + lane]);
        else vv = cache[((size_t)(Lc - kk * dil) * 2 + 1) * 512 + hh * HD + lane];
        o += pk * vv; }
    bf16_t* OG = (bf16_t*)(P.ws + WS_OG) + ((size_t)g * MT + row) * AO; OG[hh * HD + lane] = f2bf(o / lsum);
    if (lane == 0) { float* ML = (float*)(P.ws + WS_ML) + (((size_t)g * MT + row) * HPG + hh) * 2; ML[0] = m; ML[1] = lsum; }
}
__global__ void k_combine(Ptrs P) {
    const size_t e = (size_t)blockIdx.x * blockDim.x + threadIdx.x; if (e >= (size_t)MT * AO) return;
    const int row = (int)(e / AO), c = (int)(e % AO), hh = c >> 6;
    const bf16_t* OG = (const bf16_t*)(P.ws + WS_OG); const float* ML = (const float*)(P.ws + WS_ML);
    float m[3], lz[3], mm = -INFINITY;
#pragma unroll
    for (int g = 0; g < 3; ++g) { const float* q = ML + (((size_t)g * MT + row) * HPG + hh) * 2; m[g] = q[0]; lz[g] = q[1]; mm = fmaxf(mm, m[g]); }
    float num = 0.f, den = 0.f;
#pragma unroll
    for (int g = 0; g < 3; ++g) { const float z = lz[g] * __expf(m[g] - mm); num += z * bf2f(OG[((size_t)g * MT + row) * AO + c]); den += z; }
    ((bf16_t*)(P.ws + WS_AATT))[e] = f2bf(num / den);
}
__global__ void k_merge(Ptrs P) {
    const size_t e = (size_t)blockIdx.x * blockDim.x + threadIdx.x; if (e >= (size_t)MT * DM) return;
    const int row = (int)(e / DM), c = (int)(e % DM);
    const float y1 = ((const float*)(P.ws + WS_C))[e], y2 = ((const float*)(P.ws + WS_C2))[e];
    const bf16_t* GM = (const bf16_t*)(P.ws + WS_GM) + (size_t)row * 2048;
    ((bf16_t*)(P.ws + WS_MRG))[e] = f2bf(bf2f(GM[c]) * y1 + bf2f(GM[1024 + c]) * y2);
}
__global__ void __launch_bounds__(256) k_resid(Ptrs P, int first) {
    __shared__ float red[4];
    const int row = blockIdx.x, tid = threadIdx.x;
    const float* C = (const float*)(P.ws + WS_C) + (size_t)row * DM; float* Y = P.out + O_Y + (size_t)row * DM;
    const float* base = first ? xin_row(P, row) : Y; bf16_t* xb = (bf16_t*)(P.ws + WS_XB) + (size_t)row * DM;
    float s = 0.f;
    for (int c = tid; c < DM; c += 256) { const float v = base[c] + C[c]; Y[c] = v; xb[c] = f2bf(v); s += v * v; }
    s = wave_sum(s); if ((tid & 63) == 0) red[tid >> 6] = s; __syncthreads();
    if (tid == 0) { float* ssq = (float*)(P.ws + WS_SSQ) + (size_t)row * 4; ssq[0] = red[0] + red[1] + red[2] + red[3]; ssq[1] = 0.f; ssq[2] = 0.f; ssq[3] = 0.f; }
}
__global__ void k_ffn(Ptrs P) {
    const size_t e = (size_t)blockIdx.x * blockDim.x + threadIdx.x; if (e >= (size_t)MT * DFF) return;
    const int row = (int)(e / DFF), j = (int)(e % DFF), pn = j >> 7, jj = j & 127;
    const float* ssq = (const float*)(P.ws + WS_SSQ) + (size_t)row * 4; const float r = rsqrtf((ssq[0] + ssq[1] + ssq[2] + ssq[3]) * (1.0f / DM) + EPS);
    const float* C = (const float*)(P.ws + WS_C) + (size_t)row * 2 * DFF + pn * 256;
    const float gt = C[jj] * r, up = C[128 + jj] * r;
    ((bf16_t*)(P.ws + WS_H))[e] = f2bf(gt * sigmoidf_(gt) * up);
}

static inline void gemm(hipStream_t st, const bf16_t* A, const bf16_t* Bt, float* C, int M, int N, int K) {
    hipLaunchKernelGGL(k_gemm, dim3(N / 128, (M + 127) / 128), dim3(256), 0, st, A, Bt, C, M, N, K);
}

extern "C" void kernel_launch(void* const* d_in, const int* in_sizes, int n_in, void* d_out, int out_size, void* d_ws, size_t ws_size, hipStream_t stream) {
    if (n_in != 27 || (size_t)out_size != O_END || ws_size < WS_END) { fprintf(stderr, "kernel_launch: unexpected sizes n_in %d out %d (want %zu) ws %zu (want %zu)\n", n_in, out_size, (size_t)O_END, ws_size, (size_t)WS_END); return; }
    Ptrs P{};
    const float* const* in = (const float* const*)d_in;
    P.x_prompt = in[0]; P.x_sample = in[1]; P.cache[0] = in[2]; P.cache[1] = in[3]; P.cache[2] = in[4]; P.state_conv = in[5]; P.state_h = in[6]; P.rel_bias = in[7];
    P.norm_mix = in[8]; P.w_in = in[9]; P.w_conv = in[10]; P.b_conv = in[11]; P.w_rg_a = in[12]; P.b_rg_a = in[13]; P.w_rg_x = in[14]; P.b_rg_x = in[15];
    P.lru_lambda = in[16]; P.q_gain = in[17]; P.k_gain = in[18]; P.w_merge = in[19]; P.b_merge = in[20]; P.w_branch_lru = in[21]; P.w_branch_att = in[22];
    P.w_o = in[23]; P.norm_ffn = in[24]; P.w_ffn_in = in[25]; P.w_ffn_out = in[26];
    P.out = (float*)d_out; P.ws = (unsigned char*)d_ws;
    unsigned char* ws = P.ws;
    hipLaunchKernelGGL(k_convert, dim3(2048), dim3(256), 0, stream, P);
    hipLaunchKernelGGL(k_prep, dim3((MT * 64 + 255) / 256), dim3(256), 0, stream, P);
    const unsigned EB = 256;
    for (int l = 0; l < DEPTH; ++l) {
        unsigned char* wb = ws + WS_W + l * LW_BYTES;
        gemm(stream, (const bf16_t*)(ws + WS_XB), (const bf16_t*)(wb + LW_W1), (float*)(ws + WS_C), MT, N1, DM);
        hipLaunchKernelGGL(k_epi1, dim3(MT), dim3(256), 0, stream, P, l);
        hipLaunchKernelGGL(k_conv, dim3((unsigned)(((size_t)MT * DR + EB - 1) / EB)), dim3(EB), 0, stream, P, l);
        hipLaunchKernelGGL(k_gates, dim3((unsigned)(((size_t)MT * DR + EB - 1) / EB)), dim3(EB), 0, stream, P, l);
        hipLaunchKernelGGL(k_scan, dim3(((NB + SB) * DR + EB - 1) / EB), dim3(EB), 0, stream, P, l);
        hipLaunchKernelGGL(k_attn, dim3((unsigned)(((size_t)MT * NH * 64 + 255) / 256)), dim3(256), 0, stream, P, l);
        hipLaunchKernelGGL(k_combine, dim3((unsigned)(((size_t)MT * AO + EB - 1) / EB)), dim3(EB), 0, stream, P);
        gemm(stream, (const bf16_t*)(ws + WS_ALRU), (const bf16_t*)(wb + LW_W3A), (float*)(ws + WS_C), MT, DM, DR);
        gemm(stream, (const bf16_t*)(ws + WS_AATT), (const bf16_t*)(wb + LW_W3B), (float*)(ws + WS_C2), MT, DM, AO);
        hipLaunchKernelGGL(k_merge, dim3((unsigned)(((size_t)MT * DM + EB - 1) / EB)), dim3(EB), 0, stream, P);
        gemm(stream, (const bf16_t*)(ws + WS_MRG), (const bf16_t*)(wb + LW_W4), (float*)(ws + WS_C), MT, DM, DM);
        hipLaunchKernelGGL(k_resid, dim3(MT), dim3(256), 0, stream, P, l == 0 ? 1 : 0);
        gemm(stream, (const bf16_t*)(ws + WS_XB), (const bf16_t*)(wb + LW_W5), (float*)(ws + WS_C), MT, 2 * DFF, DM);
        hipLaunchKernelGGL(k_ffn, dim3((unsigned)(((size_t)MT * DFF + EB - 1) / EB)), dim3(EB), 0, stream, P);
        gemm(stream, (const bf16_t*)(ws + WS_H), (const bf16_t*)(wb + LW_W6), (float*)(ws + WS_C), MT, DM, DFF);
        hipLaunchKernelGGL(k_resid, dim3(MT), dim3(256), 0, stream, P, 0);
    }
}
```

```cpp
#include <hip/hip_runtime.h>
#include <stdint.h>
#include <stdio.h>

typedef unsigned short bf16_t;
typedef short bf16x8 __attribute__((ext_vector_type(8)));
typedef float f32x4 __attribute__((ext_vector_type(4)));
typedef unsigned u32x4 __attribute__((ext_vector_type(4)));
typedef unsigned u32x2 __attribute__((ext_vector_type(2)));

constexpr int DM = 1024, NB = 2, SEQ = 8192, DEPTH = 2, SB = 32, PAST = 8192;
constexpr int MP = NB * SEQ;
constexpr int MT = MP + SB;
constexpr int MPAD = 16640;
constexpr int DR = 1024, NBLK = 16, CW = 4;
constexpr int HD = 64, HPG = 8, NG = 3, NH = 24, AW = 1536, AO = 512;
constexpr int DFF = 2816;
constexpr int N1 = 2 * DR + 3 * AW + 2 * DM;
constexpr int K3 = DR + AO;
constexpr float EPS = 1e-6f;
constexpr int NKEY = 129;

__host__ __device__ constexpr int g_dil(int g) { return g == 0 ? 1 : (g == 1 ? 4 : 16); }
__host__ __device__ constexpr int g_win(int g) { return g == 0 ? 128 : (g == 1 ? 512 : 2048); }

constexpr size_t O_Y = 0;
constexpr size_t O_KVP0 = (size_t)MT * DM;
constexpr size_t O_KVP1 = O_KVP0 + (size_t)DEPTH * NB * 128 * 1024;
constexpr size_t O_KVP2 = O_KVP1 + (size_t)DEPTH * NB * 512 * 1024;
constexpr size_t O_CONVP = O_KVP2 + (size_t)DEPTH * NB * 2048 * 1024;
constexpr size_t O_HP = O_CONVP + (size_t)DEPTH * NB * 3 * DR;
constexpr size_t O_KVS0 = O_HP + (size_t)DEPTH * NB * DR;
constexpr size_t O_KVS1 = O_KVS0 + (size_t)DEPTH * SB * 1024;
constexpr size_t O_KVS2 = O_KVS1 + (size_t)DEPTH * SB * 1024;
constexpr size_t O_CONVS = O_KVS2 + (size_t)DEPTH * SB * 1024;
constexpr size_t O_HS = O_CONVS + (size_t)DEPTH * SB * 3 * DR;
constexpr size_t O_END = O_HS + (size_t)DEPTH * SB * DR;
__host__ __device__ constexpr size_t o_kvp(int g) { return g == 0 ? O_KVP0 : (g == 1 ? O_KVP1 : O_KVP2); }
__host__ __device__ constexpr size_t o_kvs(int g) { return g == 0 ? O_KVS0 : (g == 1 ? O_KVS1 : O_KVS2); }

constexpr size_t MiB = 1u << 20;
constexpr size_t rup(size_t x) { return (x + MiB - 1) / MiB * MiB; }
constexpr size_t WS_CTL = 0, CTL_ZERO_BYTES = 1 * MiB;
constexpr size_t WS_BIAS = 1 * MiB;
constexpr size_t WS_SSQ = 2 * MiB;
constexpr size_t WS_SUM = 4 * MiB;
constexpr size_t WS_W = 8 * MiB;
constexpr size_t LW_W1 = 0;
constexpr size_t LW_W3 = LW_W1 + (size_t)N1 * DM * 2;
constexpr size_t LW_W4 = LW_W3 + (size_t)DM * K3 * 2;
constexpr size_t LW_W5 = LW_W4 + (size_t)DM * DM * 2;
constexpr size_t LW_W6 = LW_W5 + (size_t)2 * DFF * DM * 2;
constexpr size_t LW_BYTES = rup(LW_W6 + (size_t)DM * DFF * 2);
constexpr size_t WS_XB = WS_W + DEPTH * LW_BYTES;
constexpr size_t WS_LX = WS_XB + rup((size_t)MPAD * DM * 2);
constexpr size_t WS_GG = WS_LX + rup((size_t)MPAD * DM * 2);
constexpr size_t WS_Q = WS_GG + rup((size_t)MPAD * DM * 2);
constexpr size_t WS_K = WS_Q + rup((size_t)MPAD * AW * 2);
constexpr size_t WS_V = WS_K + rup((size_t)MPAD * AW * 2);
constexpr size_t WS_GM = WS_V + rup((size_t)MPAD * AW * 2);
constexpr size_t WS_OG = WS_GM + rup((size_t)MPAD * 2048 * 2);
constexpr size_t WS_ML = WS_OG + rup((size_t)3 * MPAD * AO * 2);
constexpr size_t WS_A3 = WS_ML + rup((size_t)3 * MPAD * 16 * 4);
constexpr size_t WS_MRG = WS_A3 + rup((size_t)MPAD * K3 * 2);
constexpr size_t WS_H = WS_MRG + rup((size_t)MPAD * DM * 2);
constexpr size_t WS_SIMPLE = WS_H + rup((size_t)MPAD * DFF * 2);
constexpr size_t WS_XC = WS_SIMPLE;
constexpr size_t WS_AA = WS_XC + rup((size_t)MPAD * DM * 4);
constexpr size_t WS_UU = WS_AA + rup((size_t)MPAD * DM * 4);
constexpr size_t WS_END = WS_UU + rup((size_t)MPAD * DM * 4);

__device__ __forceinline__ float bf2f(bf16_t v) { return __uint_as_float(((unsigned)v) << 16); }
__device__ __forceinline__ bf16_t f2b(float f) { unsigned u = __float_as_uint(f); u += 0x7fffu + ((u >> 16) & 1u); return (bf16_t)(u >> 16); }
__device__ __forceinline__ float wave_sum(float v) {
#pragma unroll
    for (int o = 1; o < 64; o <<= 1) v += __shfl_xor(v, o);
    return v;
}
__device__ __forceinline__ float wave_max(float v) {
#pragma unroll
    for (int o = 1; o < 64; o <<= 1) v = fmaxf(v, __shfl_xor(v, o));
    return v;
}
__device__ __forceinline__ float sigmoidf_(float x) { return 1.0f / (1.0f + __expf(-x)); }
__device__ __forceinline__ float gelu_tanh(float x) { const float u = 0.7978845608028654f * (x + 0.044715f * x * x * x); return 0.5f * x * (1.0f + tanhf(u)); }

__host__ __device__ __forceinline__ int w1_src_col(int nt) {
    if (nt < 2048) return nt;
    const int pn = nt >> 8, tc = nt & 255, bj = tc >> 7;
    if (nt >= 6656) return 6656 + bj * 1024 + (pn - 26) * 128 + (tc & 127);
    const int wc = (tc >> 5) & 3, i = tc & 31;
    return 2048 + (pn - 8) * 256 + wc * 64 + bj * 32 + i;
}
__host__ __device__ __forceinline__ int w5_src_col(int nt) { const int pn = nt >> 8, tc = nt & 255, bj = tc >> 7, j = tc & 127; return bj * DFF + pn * 128 + j; }

struct Ptrs {
    const float* x_prompt; const float* x_sample; const float* cache[3]; const float* state_conv; const float* state_h; const float* rel_bias;
    const float* norm_mix; const float* w_in; const float* w_conv; const float* b_conv; const float* w_rg_a; const float* b_rg_a; const float* w_rg_x; const float* b_rg_x;
    const float* lru_lambda; const float* q_gain; const float* k_gain; const float* w_merge; const float* b_merge; const float* w_branch_lru; const float* w_branch_att;
    const float* w_o; const float* norm_ffn; const float* w_ffn_in; const float* w_ffn_out;
    float* out; unsigned char* ws;
};
__device__ __forceinline__ const float* xin_row(const Ptrs& P, int row) { return row < MP ? P.x_prompt + (size_t)row * DM : P.x_sample + (size_t)(row - MP) * DM; }

namespace pg8 {
#define PG8_LAS __attribute__((address_space(3)))
typedef unsigned short bf16_t;
typedef short bf16x8 __attribute__((ext_vector_type(8)));
typedef float f32x4 __attribute__((ext_vector_type(4)));
typedef unsigned u32x4 __attribute__((ext_vector_type(4)));
constexpr int BM = 256, BK = 64, HALF = 128, HTB = HALF * BK * 2  , STAGE_BYTES = 8 * HTB, NXCD = 8, WGM = 8;

__host__ __device__ __forceinline__ int lds_byte(int r, int c) { const int st = (r >> 4) * 2 + (c >> 5), rr = r & 15, cc = c & 31, ob = rr * 64 + cc * 2; return st * 1024 + (ob ^ (((ob >> 9) & 1) << 5)); }
__host__ __device__ __forceinline__ void stage_rc(int b, int& R, int& C) { const int st = b / 1024, sb = b % 1024, swz = sb ^ (((sb >> 9) & 1) << 5); R = (st >> 1) * 16 + swz / 64; C = (st & 1) * 32 + (swz % 64) / 2; }
__host__ __device__ __forceinline__ int perm32(int rho) { const int n = rho >> 4, i = rho & 15; return 8 * (i >> 2) + 4 * n + (i & 3); }

struct Unit { int pm, pn; };
struct Gemm { const bf16_t* A; const bf16_t* Bt; int M, N, K; int wv; };

struct StaticOrder {
    int nM, nN, nwg, G, c;
    __host__ __device__ void init(int M, int N, int G_, int c_) { nM = M / BM; nN = N / BM; nwg = nM * nN; G = G_; c = c_; }
    __host__ __device__ bool next(int i, Unit& u) const {
        const long L = (long)i * G + c; if (L >= nwg) return false;
        int wgid = (int)L; { const int q = nwg / NXCD, r = nwg % NXCD, xcd = wgid % NXCD, off = wgid / NXCD; wgid = (xcd < r ? xcd * (q + 1) : r * (q + 1) + (xcd - r) * q) + off; }
        const int nig = WGM * nN, gid = wgid / nig, fm = gid * WGM, gsz = (nM - fm) < WGM ? (nM - fm) : WGM;
        u.pm = fm + ((wgid % nig) % gsz); u.pn = (wgid % nig) / gsz; return true;
    }
    __device__ __forceinline__ void a_ready(const Unit&) const {}
    __device__ __forceinline__ void done(const Unit&) const {}
};

template <class Epi, class Sched, bool ALIGN_EPI = false, bool SP2 = false>
__device__ __forceinline__ void gemm_phase(PG8_LAS unsigned char* lds, const Gemm g, const Sched& S, const Epi& E) {
    int tid_ = (g.wv << 6) | (int)__builtin_amdgcn_mbcnt_hi(~0u, __builtin_amdgcn_mbcnt_lo(~0u, 0u)); asm volatile("" : "+v"(tid_));
    const int tid = tid_, wid = __builtin_amdgcn_readfirstlane(tid >> 6), lane = tid & 63, wr = wid >> 2, wc = wid & 3, fr = lane & 15, fq = lane >> 4;
    const int K = g.K, nt = K / BK;
    unsigned voffA[2], voffB[2];
#pragma unroll
    for (int i = 0; i < 2; ++i) { int R, C; stage_rc(tid * 16 + i * 8192, R, C); const int Rb = Epi::PERM ? ((R & ~31) + perm32(R & 31)) : R;
        voffA[i] = (unsigned)(R * K + C) * 2u; voffB[i] = (unsigned)(Rb * K + C) * 2u; }
    const size_t kstep = (size_t)(BK * 2);
    const size_t hstep = (size_t)HALF * K * 2;
    const size_t tstep = 2 * hstep;
    const unsigned ldsw = (unsigned)wid * 1024u;
    const int aoff = lds_byte(wr * 64 + fr, fq * 8), boff = lds_byte(wc * 32 + fr, fq * 8);
#define PG8_SA(b, h) (((b) * 2 + (h)) * HTB)
#define PG8_SB(b, h) ((4 + (b) * 2 + (h)) * HTB)
#define PG8_STAGE(bufoff, gbase, voff) do { _Pragma("unroll") for (int _i = 0; _i < 2; ++_i) \
        __builtin_amdgcn_global_load_lds((const unsigned*)((const char*)(gbase) + (voff)[_i]), (PG8_LAS unsigned*)(lds + (bufoff) + ldsw + _i * 8192), 16, 0, 0); } while (0)
#define PG8_LDA(dst, b, h) do { _Pragma("unroll") for (int m = 0; m < 4; ++m) _Pragma("unroll") for (int k = 0; k < 2; ++k) dst[m][k] = *(const PG8_LAS bf16x8*)(lds + PG8_SA(b, h) + aoff + m * 2048 + k * 1024); } while (0)
#define PG8_LDB(dst, b, h) do { _Pragma("unroll") for (int n = 0; n < 2; ++n) _Pragma("unroll") for (int k = 0; k < 2; ++k) dst[n][k] = *(const PG8_LAS bf16x8*)(lds + PG8_SB(b, h) + boff + n * 2048 + k * 1024); } while (0)
#define PG8_MMA(ai, bj, At, Bt) do { __builtin_amdgcn_s_setprio(1); _Pragma("unroll") for (int m = 0; m < 4; ++m) _Pragma("unroll") for (int n = 0; n < 2; ++n) _Pragma("unroll") for (int k = 0; k < 2; ++k) \
        acc[ai][bj][m][n] = __builtin_amdgcn_mfma_f32_16x16x32_bf16(Bt[n][k], At[m][k], acc[ai][bj][m][n], 0, 0, 0); __builtin_amdgcn_s_setprio(0); } while (0)
#define PG8_WAIT_V(n) asm volatile("s_waitcnt vmcnt(" #n ")" ::: "memory")
#define PG8_WAIT_L(n) asm volatile("s_waitcnt lgkmcnt(" #n ")" ::: "memory")
#define PG8_BAR __builtin_amdgcn_s_barrier()
#define PG8_SCHED __builtin_amdgcn_sched_barrier(0)
    Unit cur, nxt; int ui = 0;
    if (!S.next(0, cur)) return;
    f32x4 acc[2][2][4][2];
#pragma unroll
    for (int a = 0; a < 2; ++a)
#pragma unroll
        for (int b = 0; b < 2; ++b)
#pragma unroll
            for (int m = 0; m < 4; ++m)
#pragma unroll
                for (int n = 0; n < 2; ++n) acc[a][b][m][n] = (f32x4){0.f, 0.f, 0.f, 0.f};
    bf16x8 At[4][2], B0[2][2], B1[2][2];
    const char* cA = (const char*)g.A + (size_t)cur.pm * tstep; const char* cB = (const char*)g.Bt + (size_t)cur.pn * tstep;
    S.a_ready(cur);
    if constexpr (SP2) {
        PG8_STAGE(PG8_SB(0, 0), cB, voffB); PG8_STAGE(PG8_SB(0, 1), cB + hstep, voffB); PG8_STAGE(PG8_SA(0, 0), cA, voffA); PG8_STAGE(PG8_SA(0, 1), cA + hstep, voffA);
        if (wr == 1) PG8_BAR;
        PG8_WAIT_V(2); PG8_BAR;
        PG8_STAGE(PG8_SB(1, 0), cB + kstep, voffB); PG8_STAGE(PG8_SA(1, 0), cA + kstep, voffA); PG8_STAGE(PG8_SB(1, 1), cB + hstep + kstep, voffB);
        PG8_WAIT_V(6); PG8_BAR;
    } else {
        PG8_STAGE(PG8_SB(0, 0), cB, voffB); PG8_STAGE(PG8_SA(0, 0), cA, voffA); PG8_STAGE(PG8_SB(0, 1), cB + hstep, voffB); PG8_STAGE(PG8_SA(0, 1), cA + hstep, voffA);
        if (wr == 1) PG8_BAR;
        PG8_WAIT_V(4); PG8_BAR;
        PG8_STAGE(PG8_SB(1, 0), cB + kstep, voffB); PG8_STAGE(PG8_SA(1, 0), cA + kstep, voffA); PG8_STAGE(PG8_SB(1, 1), cB + hstep + kstep, voffB);
        PG8_WAIT_V(6); PG8_BAR;
    }
    for (;;) {
        const bool has_next = S.next(ui + 1, nxt);
        const char* nA = has_next ? (const char*)g.A + (size_t)nxt.pm * tstep : cA; const char* nB = has_next ? (const char*)g.Bt + (size_t)nxt.pn * tstep : cB;
        for (int t = 0; t < nt; t += 2) {
            if constexpr (Epi::HAS_MID) { if (t == E.mid_t) E.mid(acc, cur, wr, wc, fr, fq); }
            const bool last = (t == nt - 2);
            const char* a1 = cA + (size_t)(t + 1) * kstep;
            const char* a2 = last ? nA : cA + (size_t)(t + 2) * kstep; const char* b2 = last ? nB : cB + (size_t)(t + 2) * kstep;
            const char* a3 = a2 + kstep; const char* b3 = b2 + kstep;
            if (last && has_next) S.a_ready(nxt);
            if constexpr (SP2) {
            PG8_LDB(B0, 0, 0); PG8_LDB(B1, 0, 1); PG8_SCHED; PG8_LDA(At, 0, 0); PG8_STAGE(PG8_SA(1, 1), a1 + hstep, voffA);
            PG8_WAIT_V(8); PG8_WAIT_L(0); PG8_BAR; PG8_MMA(0, 0, At, B0); PG8_MMA(0, 1, At, B1); PG8_BAR; PG8_SCHED;
            PG8_LDA(At, 0, 1); PG8_STAGE(PG8_SB(0, 0), b2, voffB); PG8_STAGE(PG8_SB(0, 1), b2 + hstep, voffB); PG8_STAGE(PG8_SA(0, 0), a2, voffA);
            PG8_WAIT_V(8); PG8_WAIT_L(0); PG8_BAR; PG8_MMA(1, 0, At, B0); PG8_MMA(1, 1, At, B1); PG8_BAR; PG8_SCHED;
            PG8_LDB(B0, 1, 0); PG8_LDB(B1, 1, 1); PG8_SCHED; PG8_LDA(At, 1, 0); PG8_STAGE(PG8_SA(0, 1), a2 + hstep, voffA);
            PG8_WAIT_V(8); PG8_WAIT_L(0); PG8_BAR; PG8_MMA(0, 0, At, B0); PG8_MMA(0, 1, At, B1); PG8_BAR; PG8_SCHED;
            PG8_LDA(At, 1, 1); PG8_STAGE(PG8_SB(1, 0), b3, voffB); PG8_STAGE(PG8_SB(1, 1), b3 + hstep, voffB); PG8_STAGE(PG8_SA(1, 0), a3, voffA);
            PG8_WAIT_V(8); PG8_WAIT_L(0); PG8_BAR; PG8_MMA(1, 0, At, B0); PG8_MMA(1, 1, At, B1); PG8_BAR; PG8_SCHED;
            } else {
            PG8_LDB(B0, 0, 0); PG8_SCHED; PG8_LDA(At, 0, 0); PG8_STAGE(PG8_SA(1, 1), a1 + hstep, voffA);
            PG8_WAIT_L(8); PG8_BAR; PG8_WAIT_L(0); PG8_MMA(0, 0, At, B0); PG8_BAR; PG8_SCHED;
            PG8_LDB(B1, 0, 1); PG8_STAGE(PG8_SB(0, 0), b2, voffB);
            PG8_BAR; PG8_WAIT_L(0); PG8_MMA(0, 1, At, B1); PG8_BAR;
            PG8_LDA(At, 0, 1); PG8_STAGE(PG8_SA(0, 0), a2, voffA);
            PG8_BAR; PG8_WAIT_L(0); PG8_MMA(1, 0, At, B0); PG8_BAR; PG8_SCHED;
            PG8_STAGE(PG8_SB(0, 1), b2 + hstep, voffB);
            PG8_WAIT_V(6); PG8_BAR; PG8_MMA(1, 1, At, B1); PG8_BAR;
            PG8_LDB(B0, 1, 0); PG8_SCHED; PG8_LDA(At, 1, 0); PG8_STAGE(PG8_SA(0, 1), a2 + hstep, voffA);
            PG8_WAIT_L(8); PG8_BAR; PG8_WAIT_L(0); PG8_MMA(0, 0, At, B0); PG8_BAR; PG8_SCHED;
            PG8_LDB(B1, 1, 1); PG8_STAGE(PG8_SB(1, 0), b3, voffB);
            PG8_BAR; PG8_WAIT_L(0); PG8_MMA(0, 1, At, B1); PG8_BAR;
            PG8_LDA(At, 1, 1); PG8_STAGE(PG8_SA(1, 0), a3, voffA);
            PG8_BAR; PG8_WAIT_L(0); PG8_MMA(1, 0, At, B0); PG8_BAR; PG8_SCHED;
            PG8_STAGE(PG8_SB(1, 1), b3 + hstep, voffB);
            PG8_WAIT_V(6); PG8_BAR; PG8_MMA(1, 1, At, B1); PG8_BAR;
            }
        }
        if constexpr (ALIGN_EPI) { if (wr == 0) PG8_BAR; }
        if constexpr (!Epi::AFTER_DRAIN) { E(acc, cur, wr, wc, fr, fq); S.done(cur); }
        if (!has_next) break;
#pragma unroll
        for (int a = 0; a < 2; ++a)
#pragma unroll
            for (int b = 0; b < 2; ++b)
#pragma unroll
                for (int m = 0; m < 4; ++m)
#pragma unroll
                    for (int n = 0; n < 2; ++n) acc[a][b][m][n] = (f32x4){0.f, 0.f, 0.f, 0.f};
        cur = nxt; cA = nA; cB = nB; ++ui;
        if constexpr (ALIGN_EPI) { if (wr == 1) PG8_BAR; }
    }
    PG8_WAIT_V(0);
    if constexpr (!ALIGN_EPI) { if (wr == 0) PG8_BAR; }
    PG8_BAR;
    if constexpr (Epi::AFTER_DRAIN) { E.fused(acc, cur, wr, wc, fr, fq, lds, wid, lane); S.done(cur); }
#undef PG8_SA
#undef PG8_SB
#undef PG8_STAGE
#undef PG8_LDA
#undef PG8_LDB
#undef PG8_MMA
#undef PG8_WAIT_V
#undef PG8_WAIT_L
#undef PG8_BAR
#undef PG8_SCHED
}
}
#define GAS __attribute__((address_space(1)))
#define LAS __attribute__((address_space(3)))
typedef unsigned short bf16;
typedef unsigned v4u __attribute__((ext_vector_type(4)));
typedef float f32x4 __attribute__((ext_vector_type(4)));
typedef short bf16x8 __attribute__((ext_vector_type(8)));
typedef GAS unsigned gu32;
typedef GAS unsigned long long gu64;
#define RLX_AGENT __ATOMIC_RELAXED, __HIP_MEMORY_SCOPE_AGENT
#define LDS_WAIT() asm volatile("s_waitcnt lgkmcnt(0)" ::: "memory")
#define VM_WAIT() asm volatile("s_waitcnt vmcnt(0)" ::: "memory")
__device__ __forceinline__ unsigned long long rt() { return __builtin_amdgcn_s_memrealtime(); }
__device__ __forceinline__ unsigned f2bf(float f) { unsigned u = __builtin_bit_cast(unsigned, f); return (u + 0x7fffu + ((u >> 16) & 1u)) >> 16; }
__device__ __forceinline__ unsigned pk2(float lo, float hi) { return f2bf(lo) | (f2bf(hi) << 16); }

#define XB_TMO      128
#define XB_XCNT(j)  (256  + 64 * (j))
#define XB_XSUB(j)  (1280 + 64 * (j))
#define XB_XGEN(j)  (2304 + 64 * (j))
#define XB_TOP      3328
#define XB_TOPGEN   3392
#define XCD_BAR_WORDS 3456
#define XB_SPIN_CAP (1u << 18)

__device__ __forceinline__ unsigned xb_ld(unsigned* p)              { return __hip_atomic_load(p, __ATOMIC_RELAXED, __HIP_MEMORY_SCOPE_AGENT); }
__device__ __forceinline__ unsigned xb_add(unsigned* p, unsigned v) { return __hip_atomic_fetch_add(p, v, __ATOMIC_RELAXED, __HIP_MEMORY_SCOPE_AGENT); }
__device__ __forceinline__ unsigned xb_xcc_id() { return (unsigned)__builtin_amdgcn_s_getreg((3 << 11) | 20) & 0xFu; }
#define XB_SPIN(cond, bar) do { unsigned _sp = 0; while (cond) { __builtin_amdgcn_s_sleep(1); \
    if ((++_sp & 255u) == 0u) { if (xb_ld(&(bar)[XB_TMO])) break; if (_sp > XB_SPIN_CAP) { atomicAdd(&(bar)[XB_TMO], 1u); break; } } } } while (0)

struct XcdBarrier {
    unsigned* bar; unsigned x; int wv;
    volatile LAS unsigned* st;
};

__device__ __forceinline__ XcdBarrier xcd_barrier_post(unsigned* bar, volatile LAS unsigned* st) {
    XcdBarrier b; b.bar = bar; b.x = xb_xcc_id(); b.st = st;
    if (threadIdx.x == 0) (void)xb_add(&bar[XB_XCNT(b.x)], 1u);
    return b;
}
__device__ __forceinline__ void xcd_barrier_complete(unsigned* bar, unsigned x, unsigned& nloc, unsigned& nx) {
    const unsigned G = gridDim.x * gridDim.y * gridDim.z;
    unsigned sum, cnt, mine, sp = 0u;
    for (;;) {
        sum = 0u; cnt = 0u; mine = 0u;
#pragma unroll
        for (unsigned j = 0; j < 16; ++j) { const unsigned c = xb_ld(&bar[XB_XCNT(j)]); sum += c; cnt += (c > 0u) ? 1u : 0u; mine = (j == x) ? c : mine; }
        if (sum == G) break;
        __builtin_amdgcn_s_sleep(1);
        if ((++sp & 255u) == 0u) { if (xb_ld(&bar[XB_TMO])) break; if (sp > XB_SPIN_CAP) { atomicAdd(&bar[XB_TMO], 1u); break; } }
    }
    nloc = mine > 0u ? mine : 1u; nx = cnt > 0u ? cnt : 1u;
}

__device__ __forceinline__ void xcd_barrier(const XcdBarrier& b) {
    asm volatile("s_waitcnt vmcnt(0)" ::: "memory");
    __syncthreads();
    if (b.wv == 0 && __builtin_amdgcn_mbcnt_hi(~0u, __builtin_amdgcn_mbcnt_lo(~0u, 0u)) == 0u) {
        unsigned* bar = b.bar; asm volatile("" : "+s"(bar));
        __builtin_amdgcn_s_waitcnt(0);
        unsigned nloc = b.st[0], nx = b.st[1];
        if (nloc == 0u) { xcd_barrier_complete(bar, b.x, nloc, nx); b.st[0] = nloc; b.st[1] = nx; }
        const unsigned old = xb_add(&bar[XB_XSUB(b.x)], 1u);
        const unsigned gen = old / nloc;
        if (old + 1u == (gen + 1u) * nloc) {
            __builtin_amdgcn_fence(__ATOMIC_RELEASE, "agent");
            asm volatile("s_waitcnt vmcnt(0)" ::: "memory");
            const unsigned og = xb_add(&bar[XB_TOP], 1u);
            const unsigned tg = og / nx;
            if (og + 1u == (tg + 1u) * nx) xb_add(&bar[XB_TOPGEN], 1u);
            else XB_SPIN(xb_ld(&bar[XB_TOPGEN]) == tg, bar);
            __builtin_amdgcn_fence(__ATOMIC_ACQUIRE, "agent");
            xb_add(&bar[XB_XGEN(b.x)], 1u);
            asm volatile("s_waitcnt vmcnt(0)" ::: "memory");
        } else {
            XB_SPIN(xb_ld(&bar[XB_XGEN(b.x)]) == gen, bar);
            __builtin_amdgcn_fence(__ATOMIC_ACQUIRE, "agent");
            asm volatile("s_waitcnt vmcnt(0)" ::: "memory");
        }
    }
    __syncthreads();
}

using pg8::Unit;
#define ROW_FENCE() asm volatile("" ::: "memory")
__device__ __forceinline__ float row_rs(const float* ssq, int row) {
    const f32x4* p = (const f32x4*)(ssq + (size_t)row * 16);
    const f32x4 a = p[0], b = p[1], c = p[2], d = p[3];
    const float s = (((a[0] + a[1]) + (a[2] + a[3])) + ((b[0] + b[1]) + (b[2] + b[3]))) + (((c[0] + c[1]) + (c[2] + c[3])) + ((d[0] + d[1]) + (d[2] + d[3])));
    return rsqrtf(s * (1.0f / DM) + EPS);
}
__device__ __forceinline__ unsigned pkbf(float lo, float hi) { return (unsigned)f2b(lo) | ((unsigned)f2b(hi) << 16); }
__device__ __forceinline__ u32x4 pack8(const f32x4 a, const f32x4 b) { u32x4 w; w.x = pkbf(a[0], a[1]); w.y = pkbf(a[2], a[3]); w.z = pkbf(b[0], b[1]); w.w = pkbf(b[2], b[3]); return w; }
__device__ __forceinline__ float bflo(unsigned w) { return __uint_as_float(w << 16); }
__device__ __forceinline__ float bfhi(unsigned w) { return __uint_as_float(w & 0xffff0000u); }

struct Epi1 {
    static constexpr bool PERM = true, AFTER_DRAIN = false, HAS_MID = false;
    int mid_t; Ptrs P; int l;
    __device__ __forceinline__ void operator()(const f32x4 (&acc)[2][2][4][2], const Unit& u, int wr, int wc, int fr, int fq) const {
        const float* ssq = (const float*)(P.ws + WS_SSQ);
        const int pn = u.pn, c8 = wc * 32 + 8 * fq, row0 = u.pm * 256 + wr * 64 + fr;
        if (pn < 8) {
            bf16_t* dst = (bf16_t*)(P.ws + (pn < 4 ? WS_LX : WS_GG));
            const int colb = (pn & 3) * 256 + c8;
#pragma unroll
            for (int ai = 0; ai < 2; ++ai)
#pragma unroll
                for (int m = 0; m < 4; ++m) {
                    const int row = row0 + ai * 128 + m * 16; const float rs = row_rs(ssq, row);
#pragma unroll
                    for (int bj = 0; bj < 2; ++bj) {
                        f32x4 v0 = acc[ai][bj][m][0] * rs, v1 = acc[ai][bj][m][1] * rs; const int col = colb + bj * 128;
                        if (pn >= 4) {
#pragma unroll
                            for (int e = 0; e < 4; ++e) { v0[e] = gelu_tanh(v0[e]); v1[e] = gelu_tanh(v1[e]); }
                        }
                        *(u32x4*)(dst + (size_t)row * DR + col) = pack8(v0, v1);
                        if (pn < 4) {
                            if (row < MP) { const int t = row & (SEQ - 1); if (t >= SEQ - 3) { const int b = row >> 13; float* o = P.out + O_CONVP + ((size_t)(l * NB + b) * 3 + (t - (SEQ - 3))) * DR + col; *(f32x4*)o = v0; *(f32x4*)(o + 4) = v1; } }
                            else if (row < MT) { const int b = row - MP; float* cs = P.out + O_CONVS + (size_t)(l * SB + b) * 3 * DR + col; const float* sc = P.state_conv + (size_t)(l * SB + b) * 3 * DR + col;
                                *(f32x4*)cs = *(const f32x4*)(sc + DR); *(f32x4*)(cs + 4) = *(const f32x4*)(sc + DR + 4); *(f32x4*)(cs + DR) = *(const f32x4*)(sc + 2 * DR); *(f32x4*)(cs + DR + 4) = *(const f32x4*)(sc + 2 * DR + 4);
                                *(f32x4*)(cs + 2 * DR) = v0; *(f32x4*)(cs + 2 * DR + 4) = v1; }
                        }
                    }
                    ROW_FENCE();
                }
        } else if (pn < 26) {
            const int tq = pn - 8, type = tq / 6, head = 4 * (tq % 6) + wc, g = head >> 3, hh = head & 7;
            bf16_t* dst = (bf16_t*)(P.ws + (type == 0 ? WS_Q : (type == 1 ? WS_K : WS_V)));
            f32x4 gn[2][2];
#pragma unroll
            for (int bj = 0; bj < 2; ++bj)
#pragma unroll
                for (int n = 0; n < 2; ++n) gn[bj][n] = (f32x4){1.f, 1.f, 1.f, 1.f};
            if (type < 2) { const float* gp = (type == 0 ? P.q_gain : P.k_gain) + l * HD;
#pragma unroll
                for (int bj = 0; bj < 2; ++bj)
#pragma unroll
                    for (int n = 0; n < 2; ++n) gn[bj][n] = *(const f32x4*)(gp + 32 * bj + 8 * fq + 4 * n); }
            const int W = g_win(g);
#pragma unroll
            for (int ai = 0; ai < 2; ++ai)
#pragma unroll
                for (int m = 0; m < 4; ++m) {
                    const int row = row0 + ai * 128 + m * 16; const float rs = row_rs(ssq, row);
                    f32x4 v[2][2]; float ss = 0.f;
#pragma unroll
                    for (int bj = 0; bj < 2; ++bj)
#pragma unroll
                        for (int n = 0; n < 2; ++n) { v[bj][n] = acc[ai][bj][m][n] * rs; const f32x4 q = v[bj][n] * v[bj][n]; ss += (q[0] + q[1]) + (q[2] + q[3]); }
                    ss += __shfl_xor(ss, 16); ss += __shfl_xor(ss, 32);
                    const float inv = (type < 2) ? rsqrtf(ss * (1.0f / HD) + EPS) : 1.0f;
#pragma unroll
                    for (int bj = 0; bj < 2; ++bj) {
                        v[bj][0] = v[bj][0] * inv * gn[bj][0]; v[bj][1] = v[bj][1] * inv * gn[bj][1];
                        *(u32x4*)(dst + (size_t)row * AW + head * HD + 32 * bj + 8 * fq) = pack8(v[bj][0], v[bj][1]);
                    }
                    if (type >= 1) {
                        float* o = nullptr;
                        if (row < MP) { const int t = row & (SEQ - 1), b = row >> 13; if (t >= SEQ - W) o = P.out + o_kvp(g) + ((((size_t)(l * NB + b) * W + (t - (SEQ - W))) * 2 + (type - 1)) * HPG + hh) * HD + 8 * fq; }
                        else if (row < MT) { const int b = row - MP; o = P.out + o_kvs(g) + (((size_t)(l * SB + b) * 2 + (type - 1)) * HPG + hh) * HD + 8 * fq; }
                        if (o) {
#pragma unroll
                            for (int bj = 0; bj < 2; ++bj) { *(f32x4*)(o + 32 * bj) = v[bj][0]; *(f32x4*)(o + 32 * bj + 4) = v[bj][1]; } }
                    }
                    ROW_FENCE();
                }
        } else {
            bf16_t* GM = (bf16_t*)(P.ws + WS_GM); const float* bm = P.b_merge + (size_t)l * 2048;
            const int colb = (pn - 26) * 128 + c8;
            f32x4 bv[2][2];
#pragma unroll
            for (int bj = 0; bj < 2; ++bj)
#pragma unroll
                for (int n = 0; n < 2; ++n) bv[bj][n] = *(const f32x4*)(bm + bj * 1024 + colb + 4 * n);
#pragma unroll
            for (int ai = 0; ai < 2; ++ai)
#pragma unroll
                for (int m = 0; m < 4; ++m) {
                    const int row = row0 + ai * 128 + m * 16; const float rs = row_rs(ssq, row);
                    f32x4 rho[2], gav[2];
#pragma unroll
                    for (int n = 0; n < 2; ++n) {
                        const f32x4 xl = acc[ai][0][m][n] * rs + bv[0][n], xa = acc[ai][1][m][n] * rs + bv[1][n];
#pragma unroll
                        for (int e = 0; e < 4; ++e) { const float el = __expf(-xl[e]), ea = fminf(__expf(-xa[e]), 1e30f); gav[n][e] = __builtin_amdgcn_rcpf(1.0f + ea); rho[n][e] = (1.0f + ea) * __builtin_amdgcn_rcpf(1.0f + el); }
                    }
                    *(u32x4*)(GM + (size_t)row * 2048 + colb) = pack8(rho[0], rho[1]);
                    *(u32x4*)(GM + (size_t)row * 2048 + 1024 + colb) = pack8(gav[0], gav[1]);
                    ROW_FENCE();
                }
        }
    }
};

struct Epi3 {
    static constexpr bool PERM = true, AFTER_DRAIN = false, HAS_MID = true;
    int mid_t; Ptrs P;
    __device__ __forceinline__ void mid(f32x4 (&acc)[2][2][4][2], const Unit& u, int wr, int wc, int fr, int fq) const {
        const bf16_t* GM = (const bf16_t*)(P.ws + WS_GM);
        int fr_ = fr; asm volatile("" : "+v"(fr_));
        const int colb = u.pn * 256 + wc * 32 + 8 * fq, row0 = u.pm * 256 + wr * 64 + fr_;
#pragma unroll
        for (int ai = 0; ai < 2; ++ai)
#pragma unroll
            for (int m = 0; m < 4; ++m) {
                const int row = row0 + ai * 128 + m * 16;
#pragma unroll
                for (int bj = 0; bj < 2; ++bj) {
                    const u32x4 gl = *(const u32x4*)(GM + (size_t)row * 2048 + colb + bj * 128);
                    const f32x4 r0 = (f32x4){bflo(gl.x), bfhi(gl.x), bflo(gl.y), bfhi(gl.y)}, r1 = (f32x4){bflo(gl.z), bfhi(gl.z), bflo(gl.w), bfhi(gl.w)};
                    acc[ai][bj][m][0] = acc[ai][bj][m][0] * r0; acc[ai][bj][m][1] = acc[ai][bj][m][1] * r1;
                }
                ROW_FENCE();
            }
    }
    __device__ __forceinline__ void operator()(const f32x4 (&acc)[2][2][4][2], const Unit& u, int wr, int wc, int fr, int fq) const {
        const bf16_t* GM = (const bf16_t*)(P.ws + WS_GM); bf16_t* MRG = (bf16_t*)(P.ws + WS_MRG);
        const int colb = u.pn * 256 + wc * 32 + 8 * fq, row0 = u.pm * 256 + wr * 64 + fr;
#pragma unroll
        for (int ai = 0; ai < 2; ++ai)
#pragma unroll
            for (int m = 0; m < 4; ++m) {
                const int row = row0 + ai * 128 + m * 16;
#pragma unroll
                for (int bj = 0; bj < 2; ++bj) {
                    const u32x4 ga = *(const u32x4*)(GM + (size_t)row * 2048 + 1024 + colb + bj * 128);
                    const f32x4 g0 = (f32x4){bflo(ga.x), bfhi(ga.x), bflo(ga.y), bfhi(ga.y)}, g1 = (f32x4){bflo(ga.z), bfhi(ga.z), bflo(ga.w), bfhi(ga.w)};
                    *(u32x4*)(MRG + (size_t)row * DM + colb + bj * 128) = pack8(acc[ai][bj][m][0] * g0, acc[ai][bj][m][1] * g1);
                }
                ROW_FENCE();
            }
    }
};

struct EpiRes {
    static constexpr bool PERM = false, AFTER_DRAIN = false, HAS_MID = false;
    int mid_t; Ptrs P; int first;
    __device__ __forceinline__ void operator()(const f32x4 (&acc)[2][2][4][2], const Unit& u, int wr, int wc, int fr, int fq) const {
        float* Y = P.out + O_Y; bf16_t* XB = (bf16_t*)(P.ws + WS_XB); float* ssq = (float*)(P.ws + WS_SSQ);
        const int colb = u.pn * 256 + wc * 32 + 4 * fq, row0 = u.pm * 256 + wr * 64 + fr;
#pragma unroll
        for (int ai = 0; ai < 2; ++ai)
#pragma unroll
            for (int m = 0; m < 4; ++m) {
                const int row = row0 + ai * 128 + m * 16; const bool live = row < MT;
                const float* base = first ? xin_row(P, live ? row : 0) : Y + (size_t)(live ? row : 0) * DM;
                float ss = 0.f;
#pragma unroll
                for (int bj = 0; bj < 2; ++bj)
#pragma unroll
                    for (int n = 0; n < 2; ++n) {
                        const int col = colb + bj * 128 + n * 16;
                        f32x4 v = acc[ai][bj][m][n];
                        if (live) { v = v + *(const f32x4*)(base + col); *(f32x4*)(Y + (size_t)row * DM + col) = v; }
                        u32x2 w; w.x = pkbf(v[0], v[1]); w.y = pkbf(v[2], v[3]);
                        *(u32x2*)(XB + (size_t)row * DM + col) = w;
                        ss += (v[0] * v[0] + v[1] * v[1]) + (v[2] * v[2] + v[3] * v[3]);
                    }
                ss += __shfl_xor(ss, 16); ss += __shfl_xor(ss, 32);
                if (fq == 0) ssq[(size_t)row * 16 + u.pn * 4 + wc] = ss;
                ROW_FENCE();
            }
    }
};

struct Epi5 {
    static constexpr bool PERM = true, AFTER_DRAIN = false, HAS_MID = false;
    int mid_t; Ptrs P;
    __device__ __forceinline__ void operator()(const f32x4 (&acc)[2][2][4][2], const Unit& u, int wr, int wc, int fr, int fq) const {
        const float* ssq = (const float*)(P.ws + WS_SSQ); bf16_t* H = (bf16_t*)(P.ws + WS_H);
        const int colb = u.pn * 128 + wc * 32 + 8 * fq, row0 = u.pm * 256 + wr * 64 + fr;
#pragma unroll
        for (int ai = 0; ai < 2; ++ai)
#pragma unroll
            for (int m = 0; m < 4; ++m) {
                const int row = row0 + ai * 128 + m * 16; const float rs = row_rs(ssq, row);
                f32x4 h[2];
#pragma unroll
                for (int n = 0; n < 2; ++n)
#pragma unroll
                    for (int e = 0; e < 4; ++e) { const float gt = acc[ai][0][m][n][e] * rs, up = acc[ai][1][m][n][e] * rs; h[n][e] = gt * sigmoidf_(gt) * up; }
                *(u32x4*)(H + (size_t)row * DFF + colb) = pack8(h[0], h[1]);
                ROW_FENCE();
            }
    }
};

__device__ __forceinline__ void p0_prologue(const Ptrs& P, size_t tid, size_t nth) {
    for (int l = 0; l < DEPTH; ++l) {
        unsigned char* wb = P.ws + WS_W + l * LW_BYTES;
        bf16_t* W1 = (bf16_t*)(wb + LW_W1); bf16_t* W3 = (bf16_t*)(wb + LW_W3);
        bf16_t* W4 = (bf16_t*)(wb + LW_W4); bf16_t* W5 = (bf16_t*)(wb + LW_W5); bf16_t* W6 = (bf16_t*)(wb + LW_W6);
        const float* w_in = P.w_in + (size_t)l * DM * 6656; const float* w_merge = P.w_merge + (size_t)l * DM * 2048;
        const float* nm = P.norm_mix + l * DM; const float* nf = P.norm_ffn + l * DM;
        for (size_t e = tid; e < (size_t)N1 * DM; e += nth) { const int n = (int)(e % N1), k = (int)(e / N1); const int c = w1_src_col(n);
            const float v = (c < 6656 ? w_in[(size_t)k * 6656 + c] : w_merge[(size_t)k * 2048 + (c - 6656)]) * nm[k]; W1[(size_t)n * DM + k] = f2b(v); }
        const float* wl = P.w_branch_lru + (size_t)l * DR * DM;
        for (size_t e = tid; e < (size_t)DM * DR; e += nth) { const int n = (int)(e % DM), k = (int)(e / DM); W3[(size_t)n * K3 + k] = f2b(wl[(size_t)k * DM + n]); }
        const float* wa = P.w_branch_att + (size_t)l * AO * DM;
        for (size_t e = tid; e < (size_t)DM * AO; e += nth) { const int n = (int)(e % DM), k = (int)(e / DM); W3[(size_t)n * K3 + DR + k] = f2b(wa[(size_t)k * DM + n]); }
        const float* wo = P.w_o + (size_t)l * DM * DM;
        for (size_t e = tid; e < (size_t)DM * DM; e += nth) { const int n = (int)(e % DM), k = (int)(e / DM); W4[(size_t)n * DM + k] = f2b(wo[(size_t)k * DM + n]); }
        const float* wf = P.w_ffn_in + (size_t)l * DM * 2 * DFF;
        for (size_t e = tid; e < (size_t)2 * DFF * DM; e += nth) { const int n = (int)(e % (2 * DFF)), k = (int)(e / (2 * DFF)); W5[(size_t)n * DM + k] = f2b(wf[(size_t)k * 2 * DFF + w5_src_col(n)] * nf[k]); }
        const float* wf2 = P.w_ffn_out + (size_t)l * DFF * DM;
        for (size_t e = tid; e < (size_t)DM * DFF; e += nth) { const int n = (int)(e % DM), k = (int)(e / DM); W6[(size_t)n * DFF + k] = f2b(wf2[(size_t)k * DM + n]); }
    }
    float* BIAS = (float*)(P.ws + WS_BIAS);
    for (size_t e = tid; e < (size_t)NG * HPG * NKEY; e += nth) {
        const int kk = (int)(e % NKEY), hh = (int)((e / NKEY) % HPG), g = (int)(e / (NKEY * HPG));
        const int d = kk * g_dil(g); int bkt;
        if (d < 16) bkt = d; else { const float df = (float)d; int lg = 16 + (int)(logf(df / 16.0f) / logf(128.0f) * 16.0f); bkt = lg < 31 ? lg : 31; }
        BIAS[e] = P.rel_bias[bkt * NH + 8 * g + hh];
    }
    const int lane = (int)(tid & 63);
    for (size_t row = tid >> 6; row < (size_t)MT; row += nth >> 6) {
        const float* xr = xin_row(P, (int)row); bf16_t* xb = (bf16_t*)(P.ws + WS_XB) + row * DM; float* ssq = (float*)(P.ws + WS_SSQ) + row * 16;
        float s = 0.f;
        for (int c = lane; c < DM; c += 64) { const float v = xr[c]; s += v * v; xb[c] = f2b(v); }
        s = wave_sum(s);
        if (lane < 16) ssq[lane] = (lane == 0) ? s : 0.f;
    }
}

constexpr int RING_BYTES = 131072, LDSCTL_OFF = RING_BYTES, MISC_OFF = LDSCTL_OFF + 320, LDS_BYTES = 147456;
constexpr int CW_BAR = 4096;
constexpr int NPH = 1 + 8 * DEPTH;
#ifndef PHMASK
#define PHMASK 63
#endif
struct Args { Ptrs P; int ph_lo, ph_hi, pad0, pad1; };

__global__ void __launch_bounds__(512, 2) mega(Args a) {
    extern __shared__ __attribute__((aligned(16))) unsigned char lds_raw[];
    LAS unsigned char* lds = (LAS unsigned char*)lds_raw;
    const int wv = __builtin_amdgcn_readfirstlane(threadIdx.x >> 6);
#define TID() ((wv << 6) | (int)__builtin_amdgcn_mbcnt_hi(~0u, __builtin_amdgcn_mbcnt_lo(~0u, 0u)))
    { const int tid = TID(); for (int u = tid; u < (LDS_BYTES - LDSCTL_OFF) / 4; u += 512) ((LAS unsigned*)(lds + LDSCTL_OFF))[u] = 0u; }
    __syncthreads();
    unsigned char* ws0 = a.P.ws;
    XcdBarrier bar; bar.bar = (unsigned*)(ws0 + WS_CTL) + CW_BAR; bar.x = 0; bar.st = nullptr; bar.wv = wv;
    if (a.ph_hi - a.ph_lo > 1) bar = xcd_barrier_post((unsigned*)(ws0 + WS_CTL) + CW_BAR, (volatile LAS unsigned*)(lds + MISC_OFF) + 8);
    bar.wv = wv;
    const int G = gridDim.x;
    for (int ph = a.ph_lo; ph < a.ph_hi; ++ph) {
        Ptrs P = a.P;
        { unsigned char* w_ = P.ws; float* o_ = P.out; asm volatile("" : "+s"(w_), "+s"(o_)); P.ws = w_; P.out = o_; }
        unsigned char* ws = P.ws;
        if (ph == 0 && (PHMASK & 32)) {
            int t_ = TID(); asm volatile("" : "+v"(t_));
            p0_prologue(P, (size_t)blockIdx.x * 512 + t_, (size_t)G * 512);
        } else {
            const int l = (ph - 1) >> 3, p = (ph - 1) & 7;
            unsigned char* wb = ws + WS_W + l * LW_BYTES;
            if (p == 0 && (PHMASK & 1)) {
                pg8::Gemm g{(const bf16_t*)(ws + WS_XB), (const bf16_t*)(wb + LW_W1), MPAD, N1, DM, wv}; pg8::StaticOrder S; S.init(MPAD, N1, G, (int)blockIdx.x);
                Epi1 E{0, P, l}; pg8::gemm_phase<Epi1, pg8::StaticOrder, true, true>(lds, g, S, E);
            } else if (p == 3 && (PHMASK & 2)) {
                pg8::Gemm g{(const bf16_t*)(ws + WS_A3), (const bf16_t*)(wb + LW_W3), MPAD, DM, K3, wv}; pg8::StaticOrder S; S.init(MPAD, DM, G, (int)blockIdx.x);
                Epi3 E{DR / 64, P}; pg8::gemm_phase<Epi3, pg8::StaticOrder, true, true>(lds, g, S, E);
            } else if (p == 4 && (PHMASK & 4)) {
                pg8::Gemm g{(const bf16_t*)(ws + WS_MRG), (const bf16_t*)(wb + LW_W4), MPAD, DM, DM, wv}; pg8::StaticOrder S; S.init(MPAD, DM, G, (int)blockIdx.x);
                EpiRes E{0, P, l == 0 ? 1 : 0}; pg8::gemm_phase<EpiRes, pg8::StaticOrder, true, true>(lds, g, S, E);
            } else if (p == 5 && (PHMASK & 8)) {
                pg8::Gemm g{(const bf16_t*)(ws + WS_XB), (const bf16_t*)(wb + LW_W5), MPAD, 2 * DFF, DM, wv}; pg8::StaticOrder S; S.init(MPAD, 2 * DFF, G, (int)blockIdx.x);
                Epi5 E{0, P}; pg8::gemm_phase<Epi5, pg8::StaticOrder, true, true>(lds, g, S, E);
            } else if (p == 6 && (PHMASK & 16)) {
                pg8::Gemm g{(const bf16_t*)(ws + WS_H), (const bf16_t*)(wb + LW_W6), MPAD, DM, DFF, wv}; pg8::StaticOrder S; S.init(MPAD, DM, G, (int)blockIdx.x);
                EpiRes E{0, P, 0}; pg8::gemm_phase<EpiRes, pg8::StaticOrder, true, true>(lds, g, S, E);
            }
        }
        if (ph + 1 < a.ph_hi) xcd_barrier(bar);
    }
}

__global__ void k_conv(Ptrs P, int l) {
    const size_t e = (size_t)blockIdx.x * blockDim.x + threadIdx.x; if (e >= (size_t)MT * DR) return;
    const int row = (int)(e / DR), ch = (int)(e % DR);
    const bf16_t* LX = (const bf16_t*)(P.ws + WS_LX);
    const float* wc = P.w_conv + (size_t)l * CW * DR; float acc = P.b_conv[l * DR + ch];
    if (row < MP) { const int t = row % SEQ;
#pragma unroll
        for (int k = 0; k < CW; ++k) { const int tt = t + k - 3; if (tt >= 0) acc += wc[k * DR + ch] * bf2f(LX[(size_t)(row + k - 3) * DR + ch]); } }
    else { const int b = row - MP; const float* sc = P.state_conv + (size_t)(l * SB + b) * 3 * DR;
        acc += wc[0 * DR + ch] * sc[ch] + wc[1 * DR + ch] * sc[DR + ch] + wc[2 * DR + ch] * sc[2 * DR + ch] + wc[3 * DR + ch] * bf2f(LX[(size_t)row * DR + ch]); }
    ((float*)(P.ws + WS_XC))[e] = acc;
}
__global__ void k_gates(Ptrs P, int l) {
    const size_t e = (size_t)blockIdx.x * blockDim.x + threadIdx.x; if (e >= (size_t)MT * DR) return;
    const int row = (int)(e / DR), ch = (int)(e % DR), n = ch >> 6, j = ch & 63;
    const float* XC = (const float*)(P.ws + WS_XC) + (size_t)row * DR + n * 64;
    const float* wa = P.w_rg_a + ((size_t)(l * NBLK + n) * 64) * 64 + j; const float* wx = P.w_rg_x + ((size_t)(l * NBLK + n) * 64) * 64 + j;
    float ga = P.b_rg_a[l * DR + ch], gx = P.b_rg_x[l * DR + ch];
    for (int i = 0; i < 64; ++i) { const float x = XC[i]; ga += x * wa[i * 64]; gx += x * wx[i * 64]; }
    const float rr = sigmoidf_(ga), ii = sigmoidf_(gx);
    const float lam = P.lru_lambda[l * DR + ch]; const float sp = log1pf(expf(-lam));
    const float log_a = -8.0f * rr * sp; const float av = expf(log_a);
    const bool pos0 = (row < MP) && (row % SEQ == 0);
    const float mult = pos0 ? 1.0f : sqrtf(-expm1f(2.0f * log_a));
    ((float*)(P.ws + WS_AA))[e] = av; ((float*)(P.ws + WS_UU))[e] = mult * ii * XC[j];
}
__global__ void k_scan(Ptrs P, int l) {
    const int e = blockIdx.x * blockDim.x + threadIdx.x; if (e >= (NB + SB) * DR) return;
    const int s = e / DR, ch = e % DR;
    const float* AA = (const float*)(P.ws + WS_AA); const float* UU = (const float*)(P.ws + WS_UU);
    const bf16_t* GG = (const bf16_t*)(P.ws + WS_GG); bf16_t* A3 = (bf16_t*)(P.ws + WS_A3);
    if (s < NB) { float h = 0.f; const size_t r0 = (size_t)s * SEQ;
        for (int t = 0; t < SEQ; t += 8) { float av[8], u[8], g[8];
#pragma unroll
            for (int i = 0; i < 8; ++i) { const size_t o = (r0 + t + i) * DR + ch; av[i] = AA[o]; u[i] = UU[o]; g[i] = bf2f(GG[o]); }
#pragma unroll
            for (int i = 0; i < 8; ++i) { h = av[i] * h + u[i]; A3[(r0 + t + i) * K3 + ch] = f2b(h * g[i]); } }
        P.out[O_HP + (size_t)(l * NB + s) * DR + ch] = h;
    } else { const int b = s - NB; const size_t o = (size_t)(MP + b) * DR + ch; float h = P.state_h[(size_t)(l * SB + b) * DR + ch];
        h = AA[o] * h + UU[o]; A3[(size_t)(MP + b) * K3 + ch] = f2b(h * bf2f(GG[o])); P.out[O_HS + (size_t)(l * SB + b) * DR + ch] = h; }
}
__global__ void __launch_bounds__(256) k_attn(Ptrs P, int l) {
    const int gw = (blockIdx.x * blockDim.x + threadIdx.x) >> 6, lane = threadIdx.x & 63;
    if (gw >= MT * NH) return;
    const int row = gw / NH, head = gw % NH, g = head / HPG, hh = head % HPG, dil = g_dil(g);
    const bf16_t* Q = (const bf16_t*)(P.ws + WS_Q); const bf16_t* K = (const bf16_t*)(P.ws + WS_K); const bf16_t* V = (const bf16_t*)(P.ws + WS_V);
    const float* BIAS = (const float*)(P.ws + WS_BIAS) + (size_t)(g * HPG + hh) * NKEY;
    const bool samp = row >= MP; const int b = samp ? row - MP : row / SEQ, t = samp ? 0 : row % SEQ;
    const int nkeys = samp ? NKEY : ((t / dil) < 128 ? (t / dil) + 1 : NKEY);
    const float* cache = P.cache[g] + (size_t)(l * SB + (samp ? b : 0)) * g_win(g) * 1024;
    const int Lc = g_win(g);
    __shared__ float qs[4][HD];
    float* qw = qs[threadIdx.x >> 6];
    qw[lane] = bf2f(Q[(size_t)row * AW + head * HD + lane]);
    __syncthreads();
    float s[3];
#pragma unroll
    for (int j = 0; j < 3; ++j) { const int kk = lane + 64 * j; float acc = -INFINITY;
        if (kk < nkeys) { acc = 0.f;
            if (!samp || kk == 0) { const bf16_t* kr = K + (size_t)(row - kk * dil) * AW + head * HD;
                for (int d = 0; d < HD; ++d) acc += qw[d] * bf2f(kr[d]); }
            else { const float* kr = cache + ((size_t)(Lc - kk * dil) * 2 + 0) * 512 + hh * HD;
                for (int d = 0; d < HD; ++d) acc += qw[d] * kr[d]; }
            acc = acc * 0.125f + BIAS[kk]; }
        s[j] = acc; }
    const float m = wave_max(fmaxf(fmaxf(s[0], s[1]), s[2]));
    float p[3]; float lsum = 0.f;
#pragma unroll
    for (int j = 0; j < 3; ++j) { p[j] = (lane + 64 * j < nkeys) ? __expf(s[j] - m) : 0.f; lsum += p[j]; }
    lsum = wave_sum(lsum);
    float o = 0.f;
    for (int kk = 0; kk < nkeys; ++kk) { const float pk = __shfl(kk < 64 ? p[0] : (kk < 128 ? p[1] : p[2]), kk & 63);
        float vv;
        if (!samp || kk == 0) vv = bf2f(V[(size_t)(row - kk * dil) * AW + head * HD + lane]);
        else vv = cache[((size_t)(Lc - kk * dil) * 2 + 1) * 512 + hh * HD + lane];
        o += pk * vv; }
    bf16_t* OG = (bf16_t*)(P.ws + WS_OG) + ((size_t)g * MT + row) * AO; OG[hh * HD + lane] = f2b(o / lsum);
    if (lane == 0) { float* ML = (float*)(P.ws + WS_ML) + (((size_t)g * MT + row) * HPG + hh) * 2; ML[0] = m; ML[1] = lsum; }
}
__global__ void k_combine(Ptrs P) {
    const size_t e = (size_t)blockIdx.x * blockDim.x + threadIdx.x; if (e >= (size_t)MT * AO) return;
    const int row = (int)(e / AO), c = (int)(e % AO), hh = c >> 6;
    const bf16_t* OG = (const bf16_t*)(P.ws + WS_OG); const float* ML = (const float*)(P.ws + WS_ML);
    float m[3], lz[3], mm = -INFINITY;
#pragma unroll
    for (int g = 0; g < 3; ++g) { const float* q = ML + (((size_t)g * MT + row) * HPG + hh) * 2; m[g] = q[0]; lz[g] = q[1]; mm = fmaxf(mm, m[g]); }
    float num = 0.f, den = 0.f;
#pragma unroll
    for (int g = 0; g < 3; ++g) { const float z = lz[g] * __expf(m[g] - mm); num += z * bf2f(OG[((size_t)g * MT + row) * AO + c]); den += z; }
    ((bf16_t*)(P.ws + WS_A3))[(size_t)row * K3 + DR + c] = f2b(num / den);
}

extern "C" void kernel_launch(void* const* d_in, const int* in_sizes, int n_in, void* d_out, int out_size, void* d_ws, size_t ws_size, hipStream_t stream) {
    static int grid = 0;
    if (grid == 0) {
        if (n_in != 27 || (size_t)out_size != O_END || ws_size < WS_END) { fprintf(stderr, "kernel_launch: unexpected sizes n_in %d out %d (want %zu) ws %zu (want %zu)\n", n_in, out_size, (size_t)O_END, ws_size, (size_t)WS_END); grid = -1; return; }
        int dev = 0, cus = 0;
        if (hipGetDevice(&dev) != hipSuccess || hipDeviceGetAttribute(&cus, hipDeviceAttributeMultiprocessorCount, dev) != hipSuccess) { grid = -1; return; }
        if (hipFuncSetAttribute((const void*)mega, hipFuncAttributeMaxDynamicSharedMemorySize, LDS_BYTES) != hipSuccess) { fprintf(stderr, "kernel_launch: hipFuncSetAttribute failed\n"); grid = -1; return; }
        grid = cus;
    }
    if (grid < 0) return;
    Args a{};
    Ptrs& P = a.P;
    const float* const* in = (const float* const*)d_in;
    P.x_prompt = in[0]; P.x_sample = in[1]; P.cache[0] = in[2]; P.cache[1] = in[3]; P.cache[2] = in[4]; P.state_conv = in[5]; P.state_h = in[6]; P.rel_bias = in[7];
    P.norm_mix = in[8]; P.w_in = in[9]; P.w_conv = in[10]; P.b_conv = in[11]; P.w_rg_a = in[12]; P.b_rg_a = in[13]; P.w_rg_x = in[14]; P.b_rg_x = in[15];
    P.lru_lambda = in[16]; P.q_gain = in[17]; P.k_gain = in[18]; P.w_merge = in[19]; P.b_merge = in[20]; P.w_branch_lru = in[21]; P.w_branch_att = in[22];
    P.w_o = in[23]; P.norm_ffn = in[24]; P.w_ffn_in = in[25]; P.w_ffn_out = in[26];
    P.out = (float*)d_out; P.ws = (unsigned char*)d_ws;
    (void)hipMemsetAsync((char*)d_ws + WS_CTL, 0, CTL_ZERO_BYTES, stream);
    auto run = [&](int lo, int hi) { a.ph_lo = lo; a.ph_hi = hi; hipLaunchKernelGGL(mega, dim3(grid), dim3(512), LDS_BYTES, stream, a); };
    const unsigned EB = 256;
    run(0, 1);
    for (int l = 0; l < DEPTH; ++l) {
        const int base = 1 + 8 * l;
        run(base + 0, base + 1);
        hipLaunchKernelGGL(k_conv, dim3((unsigned)(((size_t)MT * DR + EB - 1) / EB)), dim3(EB), 0, stream, P, l);
        hipLaunchKernelGGL(k_gates, dim3((unsigned)(((size_t)MT * DR + EB - 1) / EB)), dim3(EB), 0, stream, P, l);
        hipLaunchKernelGGL(k_scan, dim3(((NB + SB) * DR + EB - 1) / EB), dim3(EB), 0, stream, P, l);
        hipLaunchKernelGGL(k_attn, dim3((unsigned)(((size_t)MT * NH * 64 + 255) / 256)), dim3(256), 0, stream, P, l);
        hipLaunchKernelGGL(k_combine, dim3((unsigned)(((size_t)MT * AO + EB - 1) / EB)), dim3(EB), 0, stream, P);
        run(base + 3, base + 4); run(base + 4, base + 5); run(base + 5, base + 6); run(base + 6, base + 7);
    }
}
```

```cpp
#include <hip/hip_runtime.h>
#include <stdint.h>
#include <stdio.h>

typedef unsigned short bf16_t;
typedef short bf16x8 __attribute__((ext_vector_type(8)));
typedef float f32x4 __attribute__((ext_vector_type(4)));
typedef unsigned u32x4 __attribute__((ext_vector_type(4)));
typedef unsigned u32x2 __attribute__((ext_vector_type(2)));

constexpr int DM = 1024, NB = 2, SEQ = 8192, DEPTH = 2, SB = 32, PAST = 8192;
constexpr int MP = NB * SEQ;
constexpr int MT = MP + SB;
constexpr int MPAD = 16640;
constexpr int DR = 1024, NBLK = 16, CW = 4;
constexpr int HD = 64, HPG = 8, NG = 3, NH = 24, AW = 1536, AO = 512;
constexpr int DFF = 2816;
constexpr int N1 = 2 * DR + 3 * AW + 2 * DM;
constexpr int K3 = DR + AO;
constexpr float EPS = 1e-6f;
constexpr int NKEY = 129;

__host__ __device__ constexpr int g_dil(int g) { return g == 0 ? 1 : (g == 1 ? 4 : 16); }
__host__ __device__ constexpr int g_win(int g) { return g == 0 ? 128 : (g == 1 ? 512 : 2048); }

constexpr size_t O_Y = 0;
constexpr size_t O_KVP0 = (size_t)MT * DM;
constexpr size_t O_KVP1 = O_KVP0 + (size_t)DEPTH * NB * 128 * 1024;
constexpr size_t O_KVP2 = O_KVP1 + (size_t)DEPTH * NB * 512 * 1024;
constexpr size_t O_CONVP = O_KVP2 + (size_t)DEPTH * NB * 2048 * 1024;
constexpr size_t O_HP = O_CONVP + (size_t)DEPTH * NB * 3 * DR;
constexpr size_t O_KVS0 = O_HP + (size_t)DEPTH * NB * DR;
constexpr size_t O_KVS1 = O_KVS0 + (size_t)DEPTH * SB * 1024;
constexpr size_t O_KVS2 = O_KVS1 + (size_t)DEPTH * SB * 1024;
constexpr size_t O_CONVS = O_KVS2 + (size_t)DEPTH * SB * 1024;
constexpr size_t O_HS = O_CONVS + (size_t)DEPTH * SB * 3 * DR;
constexpr size_t O_END = O_HS + (size_t)DEPTH * SB * DR;
__host__ __device__ constexpr size_t o_kvp(int g) { return g == 0 ? O_KVP0 : (g == 1 ? O_KVP1 : O_KVP2); }
__host__ __device__ constexpr size_t o_kvs(int g) { return g == 0 ? O_KVS0 : (g == 1 ? O_KVS1 : O_KVS2); }

constexpr size_t MiB = 1u << 20;
constexpr size_t rup(size_t x) { return (x + MiB - 1) / MiB * MiB; }
constexpr size_t WS_CTL = 0, CTL_ZERO_BYTES = 1 * MiB;
constexpr size_t WS_BIAS = 1 * MiB;
constexpr size_t WS_SSQ = 2 * MiB;
constexpr size_t WS_SUM = 4 * MiB;
constexpr size_t WS_W = 8 * MiB;
constexpr size_t LW_W1 = 0;
constexpr size_t LW_W3 = LW_W1 + (size_t)N1 * DM * 2;
constexpr size_t LW_W4 = LW_W3 + (size_t)DM * K3 * 2;
constexpr size_t LW_W5 = LW_W4 + (size_t)DM * DM * 2;
constexpr size_t LW_W6 = LW_W5 + (size_t)2 * DFF * DM * 2;
constexpr size_t LW_BYTES = rup(LW_W6 + (size_t)DM * DFF * 2);
constexpr size_t WS_XB = WS_W + DEPTH * LW_BYTES;
constexpr size_t WS_LX = WS_XB + rup((size_t)MPAD * DM * 2);
constexpr size_t WS_GG = WS_LX + rup((size_t)MPAD * DM * 2);
constexpr size_t WS_Q = WS_GG + rup((size_t)MPAD * DM * 2);
constexpr size_t WS_K = WS_Q + rup((size_t)MPAD * AW * 2);
constexpr size_t WS_V = WS_K + rup((size_t)MPAD * AW * 2);
constexpr size_t WS_GM = WS_V + rup((size_t)MPAD * AW * 2);
constexpr size_t WS_OG = WS_GM + rup((size_t)MPAD * 2048 * 2);
constexpr size_t WS_ML = WS_OG + rup((size_t)3 * MPAD * AO * 2);
constexpr size_t WS_A3 = WS_ML + rup((size_t)3 * MPAD * 16 * 4);
constexpr size_t WS_MRG = WS_A3 + rup((size_t)MPAD * K3 * 2);
constexpr size_t WS_H = WS_MRG + rup((size_t)MPAD * DM * 2);
constexpr size_t WS_SIMPLE = WS_H + rup((size_t)MPAD * DFF * 2);
constexpr size_t WS_XC = WS_SIMPLE;
constexpr size_t WS_AA = WS_XC + rup((size_t)MPAD * DM * 4);
constexpr size_t WS_UU = WS_AA + rup((size_t)MPAD * DM * 4);
constexpr size_t WS_END = WS_UU + rup((size_t)MPAD * DM * 4);

__device__ __forceinline__ float bf2f(bf16_t v) { return __uint_as_float(((unsigned)v) << 16); }
__device__ __forceinline__ bf16_t f2b(float f) { unsigned u = __float_as_uint(f); u += 0x7fffu + ((u >> 16) & 1u); return (bf16_t)(u >> 16); }
__device__ __forceinline__ float wave_sum(float v) {
#pragma unroll
    for (int o = 1; o < 64; o <<= 1) v += __shfl_xor(v, o);
    return v;
}
__device__ __forceinline__ float wave_max(float v) {
#pragma unroll
    for (int o = 1; o < 64; o <<= 1) v = fmaxf(v, __shfl_xor(v, o));
    return v;
}
__device__ __forceinline__ float sigmoidf_(float x) { return 1.0f / (1.0f + __expf(-x)); }
__device__ __forceinline__ float gelu_tanh(float x) { const float u = 0.7978845608028654f * (x + 0.044715f * x * x * x); return 0.5f * x * (1.0f + tanhf(u)); }

__host__ __device__ __forceinline__ int w1_src_col(int nt) {
    if (nt < 2048) return nt;
    const int pn = nt >> 8, tc = nt & 255, bj = tc >> 7;
    if (nt >= 6656) return 6656 + bj * 1024 + (pn - 26) * 128 + (tc & 127);
    const int wc = (tc >> 5) & 3, i = tc & 31;
    return 2048 + (pn - 8) * 256 + wc * 64 + bj * 32 + i;
}
__host__ __device__ __forceinline__ int w5_src_col(int nt) { const int pn = nt >> 8, tc = nt & 255, bj = tc >> 7, j = tc & 127; return bj * DFF + pn * 128 + j; }

struct Ptrs {
    const float* x_prompt; const float* x_sample; const float* cache[3]; const float* state_conv; const float* state_h; const float* rel_bias;
    const float* norm_mix; const float* w_in; const float* w_conv; const float* b_conv; const float* w_rg_a; const float* b_rg_a; const float* w_rg_x; const float* b_rg_x;
    const float* lru_lambda; const float* q_gain; const float* k_gain; const float* w_merge; const float* b_merge; const float* w_branch_lru; const float* w_branch_att;
    const float* w_o; const float* norm_ffn; const float* w_ffn_in; const float* w_ffn_out;
    float* out; unsigned char* ws;
};
__device__ __forceinline__ const float* xin_row(const Ptrs& P, int row) { return row < MP ? P.x_prompt + (size_t)row * DM : P.x_sample + (size_t)(row - MP) * DM; }

namespace pg8 {
#define PG8_LAS __attribute__((address_space(3)))
typedef unsigned short bf16_t;
typedef short bf16x8 __attribute__((ext_vector_type(8)));
typedef float f32x4 __attribute__((ext_vector_type(4)));
typedef unsigned u32x4 __attribute__((ext_vector_type(4)));
constexpr int BM = 256, BK = 64, HALF = 128, HTB = HALF * BK * 2  , STAGE_BYTES = 8 * HTB, NXCD = 8, WGM = 8;

__host__ __device__ __forceinline__ int lds_byte(int r, int c) { const int st = (r >> 4) * 2 + (c >> 5), rr = r & 15, cc = c & 31, ob = rr * 64 + cc * 2; return st * 1024 + (ob ^ (((ob >> 9) & 1) << 5)); }
__host__ __device__ __forceinline__ void stage_rc(int b, int& R, int& C) { const int st = b / 1024, sb = b % 1024, swz = sb ^ (((sb >> 9) & 1) << 5); R = (st >> 1) * 16 + swz / 64; C = (st & 1) * 32 + (swz % 64) / 2; }
__host__ __device__ __forceinline__ int perm32(int rho) { const int n = rho >> 4, i = rho & 15; return 8 * (i >> 2) + 4 * n + (i & 3); }

struct Unit { int pm, pn; };
struct Gemm { const bf16_t* A; const bf16_t* Bt; int M, N, K; int wv; };

struct StaticOrder {
    int nM, nN, nwg, G, c;
    __host__ __device__ void init(int M, int N, int G_, int c_) { nM = M / BM; nN = N / BM; nwg = nM * nN; G = G_; c = c_; }
    __host__ __device__ bool next(int i, Unit& u) const {
        const long L = (long)i * G + c; if (L >= nwg) return false;
        int wgid = (int)L; { const int q = nwg / NXCD, r = nwg % NXCD, xcd = wgid % NXCD, off = wgid / NXCD; wgid = (xcd < r ? xcd * (q + 1) : r * (q + 1) + (xcd - r) * q) + off; }
        const int nig = WGM * nN, gid = wgid / nig, fm = gid * WGM, gsz = (nM - fm) < WGM ? (nM - fm) : WGM;
        u.pm = fm + ((wgid % nig) % gsz); u.pn = (wgid % nig) / gsz; return true;
    }
    __device__ __forceinline__ void a_ready(const Unit&) const {}
    __device__ __forceinline__ void done(const Unit&) const {}
};

template <class Epi, class Sched, bool ALIGN_EPI = false, bool SP2 = false>
__device__ __forceinline__ void gemm_phase(PG8_LAS unsigned char* lds, const Gemm g, const Sched& S, const Epi& E) {
    int tid_ = (g.wv << 6) | (int)__builtin_amdgcn_mbcnt_hi(~0u, __builtin_amdgcn_mbcnt_lo(~0u, 0u)); asm volatile("" : "+v"(tid_));
    const int tid = tid_, wid = __builtin_amdgcn_readfirstlane(tid >> 6), lane = tid & 63, wr = wid >> 2, wc = wid & 3, fr = lane & 15, fq = lane >> 4;
    const int K = g.K, nt = K / BK;
    unsigned voffA[2], voffB[2];
#pragma unroll
    for (int i = 0; i < 2; ++i) { int R, C; stage_rc(tid * 16 + i * 8192, R, C); const int Rb = Epi::PERM ? ((R & ~31) + perm32(R & 31)) : R;
        voffA[i] = (unsigned)(R * K + C) * 2u; voffB[i] = (unsigned)(Rb * K + C) * 2u; }
    const size_t kstep = (size_t)(BK * 2);
    const size_t hstep = (size_t)HALF * K * 2;
    const size_t tstep = 2 * hstep;
    const unsigned ldsw = (unsigned)wid * 1024u;
    const int aoff = lds_byte(wr * 64 + fr, fq * 8), boff = lds_byte(wc * 32 + fr, fq * 8);
#define PG8_SA(b, h) (((b) * 2 + (h)) * HTB)
#define PG8_SB(b, h) ((4 + (b) * 2 + (h)) * HTB)
#define PG8_STAGE(bufoff, gbase, voff) do { _Pragma("unroll") for (int _i = 0; _i < 2; ++_i) \
        __builtin_amdgcn_global_load_lds((const unsigned*)((const char*)(gbase) + (voff)[_i]), (PG8_LAS unsigned*)(lds + (bufoff) + ldsw + _i * 8192), 16, 0, 0); } while (0)
#define PG8_LDA(dst, b, h) do { _Pragma("unroll") for (int m = 0; m < 4; ++m) _Pragma("unroll") for (int k = 0; k < 2; ++k) dst[m][k] = *(const PG8_LAS bf16x8*)(lds + PG8_SA(b, h) + aoff + m * 2048 + k * 1024); } while (0)
#define PG8_LDB(dst, b, h) do { _Pragma("unroll") for (int n = 0; n < 2; ++n) _Pragma("unroll") for (int k = 0; k < 2; ++k) dst[n][k] = *(const PG8_LAS bf16x8*)(lds + PG8_SB(b, h) + boff + n * 2048 + k * 1024); } while (0)
#define PG8_MMA(ai, bj, At, Bt) do { __builtin_amdgcn_s_setprio(1); _Pragma("unroll") for (int m = 0; m < 4; ++m) _Pragma("unroll") for (int n = 0; n < 2; ++n) _Pragma("unroll") for (int k = 0; k < 2; ++k) \
        acc[ai][bj][m][n] = __builtin_amdgcn_mfma_f32_16x16x32_bf16(Bt[n][k], At[m][k], acc[ai][bj][m][n], 0, 0, 0); __builtin_amdgcn_s_setprio(0); } while (0)
#define PG8_WAIT_V(n) asm volatile("s_waitcnt vmcnt(" #n ")" ::: "memory")
#define PG8_WAIT_L(n) asm volatile("s_waitcnt lgkmcnt(" #n ")" ::: "memory")
#define PG8_BAR __builtin_amdgcn_s_barrier()
#define PG8_SCHED __builtin_amdgcn_sched_barrier(0)
    Unit cur, nxt; int ui = 0;
    if (!S.next(0, cur)) return;
    f32x4 acc[2][2][4][2];
#pragma unroll
    for (int a = 0; a < 2; ++a)
#pragma unroll
        for (int b = 0; b < 2; ++b)
#pragma unroll
            for (int m = 0; m < 4; ++m)
#pragma unroll
                for (int n = 0; n < 2; ++n) acc[a][b][m][n] = (f32x4){0.f, 0.f, 0.f, 0.f};
    bf16x8 At[4][2], B0[2][2], B1[2][2];
    const char* cA = (const char*)g.A + (size_t)cur.pm * tstep; const char* cB = (const char*)g.Bt + (size_t)cur.pn * tstep;
    S.a_ready(cur);
    if constexpr (SP2) {
        PG8_STAGE(PG8_SB(0, 0), cB, voffB); PG8_STAGE(PG8_SB(0, 1), cB + hstep, voffB); PG8_STAGE(PG8_SA(0, 0), cA, voffA); PG8_STAGE(PG8_SA(0, 1), cA + hstep, voffA);
        if (wr == 1) PG8_BAR;
        PG8_WAIT_V(2); PG8_BAR;
        PG8_STAGE(PG8_SB(1, 0), cB + kstep, voffB); PG8_STAGE(PG8_SA(1, 0), cA + kstep, voffA); PG8_STAGE(PG8_SB(1, 1), cB + hstep + kstep, voffB);
        PG8_WAIT_V(6); PG8_BAR;
    } else {
        PG8_STAGE(PG8_SB(0, 0), cB, voffB); PG8_STAGE(PG8_SA(0, 0), cA, voffA); PG8_STAGE(PG8_SB(0, 1), cB + hstep, voffB); PG8_STAGE(PG8_SA(0, 1), cA + hstep, voffA);
        if (wr == 1) PG8_BAR;
        PG8_WAIT_V(4); PG8_BAR;
        PG8_STAGE(PG8_SB(1, 0), cB + kstep, voffB); PG8_STAGE(PG8_SA(1, 0), cA + kstep, voffA); PG8_STAGE(PG8_SB(1, 1), cB + hstep + kstep, voffB);
        PG8_WAIT_V(6); PG8_BAR;
    }
    for (;;) {
        const bool has_next = S.next(ui + 1, nxt);
        const char* nA = has_next ? (const char*)g.A + (size_t)nxt.pm * tstep : cA; const char* nB = has_next ? (const char*)g.Bt + (size_t)nxt.pn * tstep : cB;
        for (int t = 0; t < nt; t += 2) {
            if constexpr (Epi::HAS_MID) { if (t == E.mid_t) E.mid(acc, cur, wr, wc, fr, fq); }
            const bool last = (t == nt - 2);
            const char* a1 = cA + (size_t)(t + 1) * kstep;
            const char* a2 = last ? nA : cA + (size_t)(t + 2) * kstep; const char* b2 = last ? nB : cB + (size_t)(t + 2) * kstep;
            const char* a3 = a2 + kstep; const char* b3 = b2 + kstep;
            if (last && has_next) S.a_ready(nxt);
            if constexpr (SP2) {
            PG8_LDB(B0, 0, 0); PG8_LDB(B1, 0, 1); PG8_SCHED; PG8_LDA(At, 0, 0); PG8_STAGE(PG8_SA(1, 1), a1 + hstep, voffA);
            PG8_WAIT_V(8); PG8_WAIT_L(0); PG8_BAR; PG8_MMA(0, 0, At, B0); PG8_MMA(0, 1, At, B1); PG8_BAR; PG8_SCHED;
            PG8_LDA(At, 0, 1); PG8_STAGE(PG8_SB(0, 0), b2, voffB); PG8_STAGE(PG8_SB(0, 1), b2 + hstep, voffB); PG8_STAGE(PG8_SA(0, 0), a2, voffA);
            PG8_WAIT_V(8); PG8_WAIT_L(0); PG8_BAR; PG8_MMA(1, 0, At, B0); PG8_MMA(1, 1, At, B1); PG8_BAR; PG8_SCHED;
            PG8_LDB(B0, 1, 0); PG8_LDB(B1, 1, 1); PG8_SCHED; PG8_LDA(At, 1, 0); PG8_STAGE(PG8_SA(0, 1), a2 + hstep, voffA);
            PG8_WAIT_V(8); PG8_WAIT_L(0); PG8_BAR; PG8_MMA(0, 0, At, B0); PG8_MMA(0, 1, At, B1); PG8_BAR; PG8_SCHED;
            PG8_LDA(At, 1, 1); PG8_STAGE(PG8_SB(1, 0), b3, voffB); PG8_STAGE(PG8_SB(1, 1), b3 + hstep, voffB); PG8_STAGE(PG8_SA(1, 0), a3, voffA);
            PG8_WAIT_V(8); PG8_WAIT_L(0); PG8_BAR; PG8_MMA(1, 0, At, B0); PG8_MMA(1, 1, At, B1); PG8_BAR; PG8_SCHED;
            } else {
            PG8_LDB(B0, 0, 0); PG8_SCHED; PG8_LDA(At, 0, 0); PG8_STAGE(PG8_SA(1, 1), a1 + hstep, voffA);
            PG8_WAIT_L(8); PG8_BAR; PG8_WAIT_L(0); PG8_MMA(0, 0, At, B0); PG8_BAR; PG8_SCHED;
            PG8_LDB(B1, 0, 1); PG8_STAGE(PG8_SB(0, 0), b2, voffB);
            PG8_BAR; PG8_WAIT_L(0); PG8_MMA(0, 1, At, B1); PG8_BAR;
            PG8_LDA(At, 0, 1); PG8_STAGE(PG8_SA(0, 0), a2, voffA);
            PG8_BAR; PG8_WAIT_L(0); PG8_MMA(1, 0, At, B0); PG8_BAR; PG8_SCHED;
            PG8_STAGE(PG8_SB(0, 1), b2 + hstep, voffB);
            PG8_WAIT_V(6); PG8_BAR; PG8_MMA(1, 1, At, B1); PG8_BAR;
            PG8_LDB(B0, 1, 0); PG8_SCHED; PG8_LDA(At, 1, 0); PG8_STAGE(PG8_SA(0, 1), a2 + hstep, voffA);
            PG8_WAIT_L(8); PG8_BAR; PG8_WAIT_L(0); PG8_MMA(0, 0, At, B0); PG8_BAR; PG8_SCHED;
            PG8_LDB(B1, 1, 1); PG8_STAGE(PG8_SB(1, 0), b3, voffB);
            PG8_BAR; PG8_WAIT_L(0); PG8_MMA(0, 1, At, B1); PG8_BAR;
            PG8_LDA(At, 1, 1); PG8_STAGE(PG8_SA(1, 0), a3, voffA);
            PG8_BAR; PG8_WAIT_L(0); PG8_MMA(1, 0, At, B0); PG8_BAR; PG8_SCHED;
            PG8_STAGE(PG8_SB(1, 1), b3 + hstep, voffB);
            PG8_WAIT_V(6); PG8_BAR; PG8_MMA(1, 1, At, B1); PG8_BAR;
            }
        }
        if constexpr (ALIGN_EPI) { if (wr == 0) PG8_BAR; }
        if constexpr (!Epi::AFTER_DRAIN) { E(acc, cur, wr, wc, fr, fq); S.done(cur); }
        if (!has_next) break;
#pragma unroll
        for (int a = 0; a < 2; ++a)
#pragma unroll
            for (int b = 0; b < 2; ++b)
#pragma unroll
                for (int m = 0; m < 4; ++m)
#pragma unroll
                    for (int n = 0; n < 2; ++n) acc[a][b][m][n] = (f32x4){0.f, 0.f, 0.f, 0.f};
        cur = nxt; cA = nA; cB = nB; ++ui;
        if constexpr (ALIGN_EPI) { if (wr == 1) PG8_BAR; }
    }
    PG8_WAIT_V(0);
    if constexpr (!ALIGN_EPI) { if (wr == 0) PG8_BAR; }
    PG8_BAR;
    if constexpr (Epi::AFTER_DRAIN) { E.fused(acc, cur, wr, wc, fr, fq, lds, wid, lane); S.done(cur); }
#undef PG8_SA
#undef PG8_SB
#undef PG8_STAGE
#undef PG8_LDA
#undef PG8_LDB
#undef PG8_MMA
#undef PG8_WAIT_V
#undef PG8_WAIT_L
#undef PG8_BAR
#undef PG8_SCHED
}
}
#define GAS __attribute__((address_space(1)))
#define LAS __attribute__((address_space(3)))
typedef unsigned short bf16;
typedef unsigned v4u __attribute__((ext_vector_type(4)));
typedef float f32x4 __attribute__((ext_vector_type(4)));
typedef short bf16x8 __attribute__((ext_vector_type(8)));
typedef GAS unsigned gu32;
typedef GAS unsigned long long gu64;
#define RLX_AGENT __ATOMIC_RELAXED, __HIP_MEMORY_SCOPE_AGENT
#define LDS_WAIT() asm volatile("s_waitcnt lgkmcnt(0)" ::: "memory")
#define VM_WAIT() asm volatile("s_waitcnt vmcnt(0)" ::: "memory")
__device__ __forceinline__ unsigned long long rt() { return __builtin_amdgcn_s_memrealtime(); }
__device__ __forceinline__ unsigned f2bf(float f) { unsigned u = __builtin_bit_cast(unsigned, f); return (u + 0x7fffu + ((u >> 16) & 1u)) >> 16; }
__device__ __forceinline__ unsigned pk2(float lo, float hi) { return f2bf(lo) | (f2bf(hi) << 16); }

#define XB_TMO      128
#define XB_XCNT(j)  (256  + 64 * (j))
#define XB_XSUB(j)  (1280 + 64 * (j))
#define XB_XGEN(j)  (2304 + 64 * (j))
#define XB_TOP      3328
#define XB_TOPGEN   3392
#define XCD_BAR_WORDS 3456
#define XB_SPIN_CAP (1u << 18)

__device__ __forceinline__ unsigned xb_ld(unsigned* p)              { return __hip_atomic_load(p, __ATOMIC_RELAXED, __HIP_MEMORY_SCOPE_AGENT); }
__device__ __forceinline__ unsigned xb_add(unsigned* p, unsigned v) { return __hip_atomic_fetch_add(p, v, __ATOMIC_RELAXED, __HIP_MEMORY_SCOPE_AGENT); }
__device__ __forceinline__ unsigned xb_xcc_id() { return (unsigned)__builtin_amdgcn_s_getreg((3 << 11) | 20) & 0xFu; }
#define XB_SPIN(cond, bar) do { unsigned _sp = 0; while (cond) { __builtin_amdgcn_s_sleep(1); \
    if ((++_sp & 255u) == 0u) { if (xb_ld(&(bar)[XB_TMO])) break; if (_sp > XB_SPIN_CAP) { atomicAdd(&(bar)[XB_TMO], 1u); break; } } } } while (0)

struct XcdBarrier {
    unsigned* bar; unsigned x; int wv;
    volatile LAS unsigned* st;
};

__device__ __forceinline__ XcdBarrier xcd_barrier_post(unsigned* bar, volatile LAS unsigned* st) {
    XcdBarrier b; b.bar = bar; b.x = xb_xcc_id(); b.st = st;
    if (threadIdx.x == 0) (void)xb_add(&bar[XB_XCNT(b.x)], 1u);
    return b;
}
__device__ __forceinline__ void xcd_barrier_complete(unsigned* bar, unsigned x, unsigned& nloc, unsigned& nx) {
    const unsigned G = gridDim.x * gridDim.y * gridDim.z;
    unsigned sum, cnt, mine, sp = 0u;
    for (;;) {
        sum = 0u; cnt = 0u; mine = 0u;
#pragma unroll
        for (unsigned j = 0; j < 16; ++j) { const unsigned c = xb_ld(&bar[XB_XCNT(j)]); sum += c; cnt += (c > 0u) ? 1u : 0u; mine = (j == x) ? c : mine; }
        if (sum == G) break;
        __builtin_amdgcn_s_sleep(1);
        if ((++sp & 255u) == 0u) { if (xb_ld(&bar[XB_TMO])) break; if (sp > XB_SPIN_CAP) { atomicAdd(&bar[XB_TMO], 1u); break; } }
    }
    nloc = mine > 0u ? mine : 1u; nx = cnt > 0u ? cnt : 1u;
}

__device__ __forceinline__ void xcd_barrier(const XcdBarrier& b) {
    asm volatile("s_waitcnt vmcnt(0)" ::: "memory");
    __syncthreads();
    if (b.wv == 0 && __builtin_amdgcn_mbcnt_hi(~0u, __builtin_amdgcn_mbcnt_lo(~0u, 0u)) == 0u) {
        unsigned* bar = b.bar; asm volatile("" : "+s"(bar));
        __builtin_amdgcn_s_waitcnt(0);
        unsigned nloc = b.st[0], nx = b.st[1];
        if (nloc == 0u) { xcd_barrier_complete(bar, b.x, nloc, nx); b.st[0] = nloc; b.st[1] = nx; }
        const unsigned old = xb_add(&bar[XB_XSUB(b.x)], 1u);
        const unsigned gen = old / nloc;
        if (old + 1u == (gen + 1u) * nloc) {
            __builtin_amdgcn_fence(__ATOMIC_RELEASE, "agent");
            asm volatile("s_waitcnt vmcnt(0)" ::: "memory");
            const unsigned og = xb_add(&bar[XB_TOP], 1u);
            const unsigned tg = og / nx;
            if (og + 1u == (tg + 1u) * nx) xb_add(&bar[XB_TOPGEN], 1u);
            else XB_SPIN(xb_ld(&bar[XB_TOPGEN]) == tg, bar);
            __builtin_amdgcn_fence(__ATOMIC_ACQUIRE, "agent");
            xb_add(&bar[XB_XGEN(b.x)], 1u);
            asm volatile("s_waitcnt vmcnt(0)" ::: "memory");
        } else {
            XB_SPIN(xb_ld(&bar[XB_XGEN(b.x)]) == gen, bar);
            __builtin_amdgcn_fence(__ATOMIC_ACQUIRE, "agent");
            asm volatile("s_waitcnt vmcnt(0)" ::: "memory");
        }
    }
    __syncthreads();
}

using pg8::Unit;
#define ROW_FENCE() asm volatile("" ::: "memory")
__device__ __forceinline__ float row_rs(const float* ssq, int row) {
    const f32x4* p = (const f32x4*)(ssq + (size_t)row * 16);
    const f32x4 a = p[0], b = p[1], c = p[2], d = p[3];
    const float s = (((a[0] + a[1]) + (a[2] + a[3])) + ((b[0] + b[1]) + (b[2] + b[3]))) + (((c[0] + c[1]) + (c[2] + c[3])) + ((d[0] + d[1]) + (d[2] + d[3])));
    return rsqrtf(s * (1.0f / DM) + EPS);
}
__device__ __forceinline__ unsigned pkbf(float lo, float hi) { return (unsigned)f2b(lo) | ((unsigned)f2b(hi) << 16); }
__device__ __forceinline__ u32x4 pack8(const f32x4 a, const f32x4 b) { u32x4 w; w.x = pkbf(a[0], a[1]); w.y = pkbf(a[2], a[3]); w.z = pkbf(b[0], b[1]); w.w = pkbf(b[2], b[3]); return w; }
__device__ __forceinline__ float bflo(unsigned w) { return __uint_as_float(w << 16); }
__device__ __forceinline__ float bfhi(unsigned w) { return __uint_as_float(w & 0xffff0000u); }

struct Epi1 {
    static constexpr bool PERM = true, AFTER_DRAIN = false, HAS_MID = false;
    int mid_t; Ptrs P; int l;
    __device__ __forceinline__ void operator()(const f32x4 (&acc)[2][2][4][2], const Unit& u, int wr, int wc, int fr0, int fq) const {
        int fr = fr0; asm volatile("" : "+v"(fr));
        const float* ssq = (const float*)(P.ws + WS_SSQ);
        const int pn = u.pn, c8 = wc * 32 + 8 * fq, row0 = u.pm * 256 + wr * 64 + fr;
        if (pn < 8) {
            bf16_t* dst = (bf16_t*)(P.ws + (pn < 4 ? WS_LX : WS_GG));
            const int colb = (pn & 3) * 256 + c8;
#pragma unroll
            for (int ai = 0; ai < 2; ++ai)
#pragma unroll
                for (int m = 0; m < 4; ++m) {
                    const int row = row0 + ai * 128 + m * 16; const float rs = row_rs(ssq, row);
#pragma unroll
                    for (int bj = 0; bj < 2; ++bj) {
                        f32x4 v0 = acc[ai][bj][m][0] * rs, v1 = acc[ai][bj][m][1] * rs; const int col = colb + bj * 128;
                        if (pn >= 4) {
#pragma unroll
                            for (int e = 0; e < 4; ++e) { v0[e] = gelu_tanh(v0[e]); v1[e] = gelu_tanh(v1[e]); }
                        }
                        *(u32x4*)(dst + (size_t)row * DR + col) = pack8(v0, v1);
                        if (pn < 4) {
                            if (row < MP) { const int t = row & (SEQ - 1); if (t >= SEQ - 3) { const int b = row >> 13; float* o = P.out + O_CONVP + ((size_t)(l * NB + b) * 3 + (t - (SEQ - 3))) * DR + col; *(f32x4*)o = v0; *(f32x4*)(o + 4) = v1; } }
                            else if (row < MT) { const int b = row - MP; float* cs = P.out + O_CONVS + (size_t)(l * SB + b) * 3 * DR + col; const float* sc = P.state_conv + (size_t)(l * SB + b) * 3 * DR + col;
                                *(f32x4*)cs = *(const f32x4*)(sc + DR); *(f32x4*)(cs + 4) = *(const f32x4*)(sc + DR + 4); *(f32x4*)(cs + DR) = *(const f32x4*)(sc + 2 * DR); *(f32x4*)(cs + DR + 4) = *(const f32x4*)(sc + 2 * DR + 4);
                                *(f32x4*)(cs + 2 * DR) = v0; *(f32x4*)(cs + 2 * DR + 4) = v1; }
                        }
                    }
                    ROW_FENCE();
                }
        } else if (pn < 26) {
            const int tq = pn - 8, type = tq / 6, head = 4 * (tq % 6) + wc, g = head >> 3, hh = head & 7;
            bf16_t* dst = (bf16_t*)(P.ws + (type == 0 ? WS_Q : (type == 1 ? WS_K : WS_V)));
            f32x4 gn[2][2];
#pragma unroll
            for (int bj = 0; bj < 2; ++bj)
#pragma unroll
                for (int n = 0; n < 2; ++n) gn[bj][n] = (f32x4){1.f, 1.f, 1.f, 1.f};
            if (type < 2) { const float* gp = (type == 0 ? P.q_gain : P.k_gain) + l * HD;
#pragma unroll
                for (int bj = 0; bj < 2; ++bj)
#pragma unroll
                    for (int n = 0; n < 2; ++n) gn[bj][n] = *(const f32x4*)(gp + 32 * bj + 8 * fq + 4 * n); }
            const int W = g_win(g);
#pragma unroll
            for (int ai = 0; ai < 2; ++ai)
#pragma unroll
                for (int m = 0; m < 4; ++m) {
                    const int row = row0 + ai * 128 + m * 16; const float rs = row_rs(ssq, row);
                    f32x4 v[2][2]; float ss = 0.f;
#pragma unroll
                    for (int bj = 0; bj < 2; ++bj)
#pragma unroll
                        for (int n = 0; n < 2; ++n) { v[bj][n] = acc[ai][bj][m][n] * rs; const f32x4 q = v[bj][n] * v[bj][n]; ss += (q[0] + q[1]) + (q[2] + q[3]); }
                    ss += __shfl_xor(ss, 16); ss += __shfl_xor(ss, 32);
                    const float inv = (type < 2) ? rsqrtf(ss * (1.0f / HD) + EPS) : 1.0f;
#pragma unroll
                    for (int bj = 0; bj < 2; ++bj) {
                        v[bj][0] = v[bj][0] * inv * gn[bj][0]; v[bj][1] = v[bj][1] * inv * gn[bj][1];
                        *(u32x4*)(dst + (size_t)row * AW + head * HD + 32 * bj + 8 * fq) = pack8(v[bj][0], v[bj][1]);
                    }
                    if (type >= 1) {
                        float* o = nullptr;
                        if (row < MP) { const int t = row & (SEQ - 1), b = row >> 13; if (t >= SEQ - W) o = P.out + o_kvp(g) + ((((size_t)(l * NB + b) * W + (t - (SEQ - W))) * 2 + (type - 1)) * HPG + hh) * HD + 8 * fq; }
                        else if (row < MT) { const int b = row - MP; o = P.out + o_kvs(g) + (((size_t)(l * SB + b) * 2 + (type - 1)) * HPG + hh) * HD + 8 * fq; }
                        if (o) {
#pragma unroll
                            for (int bj = 0; bj < 2; ++bj) { *(f32x4*)(o + 32 * bj) = v[bj][0]; *(f32x4*)(o + 32 * bj + 4) = v[bj][1]; } }
                    }
                    ROW_FENCE();
                }
        } else {
            bf16_t* GM = (bf16_t*)(P.ws + WS_GM); const float* bm = P.b_merge + (size_t)l * 2048;
            const int colb = (pn - 26) * 128 + c8;
            f32x4 bv[2][2];
#pragma unroll
            for (int bj = 0; bj < 2; ++bj)
#pragma unroll
                for (int n = 0; n < 2; ++n) bv[bj][n] = *(const f32x4*)(bm + bj * 1024 + colb + 4 * n);
#pragma unroll
            for (int ai = 0; ai < 2; ++ai)
#pragma unroll
                for (int m = 0; m < 4; ++m) {
                    const int row = row0 + ai * 128 + m * 16; const float rs = row_rs(ssq, row);
                    f32x4 rho[2], gav[2];
#pragma unroll
                    for (int n = 0; n < 2; ++n) {
                        const f32x4 xl = acc[ai][0][m][n] * rs + bv[0][n], xa = acc[ai][1][m][n] * rs + bv[1][n];
#pragma unroll
                        for (int e = 0; e < 4; ++e) { const float el = __expf(-xl[e]), ea = fminf(__expf(-xa[e]), 1e30f); gav[n][e] = __builtin_amdgcn_rcpf(1.0f + ea); rho[n][e] = (1.0f + ea) * __builtin_amdgcn_rcpf(1.0f + el); }
                    }
                    *(u32x4*)(GM + (size_t)row * 2048 + colb) = pack8(rho[0], rho[1]);
                    *(u32x4*)(GM + (size_t)row * 2048 + 1024 + colb) = pack8(gav[0], gav[1]);
                    ROW_FENCE();
                }
        }
    }
};

struct Epi3 {
    static constexpr bool PERM = true, AFTER_DRAIN = false, HAS_MID = true;
    int mid_t; Ptrs P;
    __device__ __forceinline__ void mid(f32x4 (&acc)[2][2][4][2], const Unit& u, int wr, int wc, int fr, int fq) const {
        const bf16_t* GM = (const bf16_t*)(P.ws + WS_GM);
        int fr_ = fr; asm volatile("" : "+v"(fr_));
        const int colb = u.pn * 256 + wc * 32 + 8 * fq, row0 = u.pm * 256 + wr * 64 + fr_;
#pragma unroll
        for (int ai = 0; ai < 2; ++ai)
#pragma unroll
            for (int m = 0; m < 4; ++m) {
                const int row = row0 + ai * 128 + m * 16;
#pragma unroll
                for (int bj = 0; bj < 2; ++bj) {
                    const u32x4 gl = *(const u32x4*)(GM + (size_t)row * 2048 + colb + bj * 128);
                    const f32x4 r0 = (f32x4){bflo(gl.x), bfhi(gl.x), bflo(gl.y), bfhi(gl.y)}, r1 = (f32x4){bflo(gl.z), bfhi(gl.z), bflo(gl.w), bfhi(gl.w)};
                    acc[ai][bj][m][0] = acc[ai][bj][m][0] * r0; acc[ai][bj][m][1] = acc[ai][bj][m][1] * r1;
                }
                ROW_FENCE();
            }
    }
    __device__ __forceinline__ void operator()(const f32x4 (&acc)[2][2][4][2], const Unit& u, int wr, int wc, int fr0, int fq) const {
        int fr = fr0; asm volatile("" : "+v"(fr));
        const bf16_t* GM = (const bf16_t*)(P.ws + WS_GM); bf16_t* MRG = (bf16_t*)(P.ws + WS_MRG);
        const int colb = u.pn * 256 + wc * 32 + 8 * fq, row0 = u.pm * 256 + wr * 64 + fr;
#pragma unroll
        for (int ai = 0; ai < 2; ++ai)
#pragma unroll
            for (int m = 0; m < 4; ++m) {
                const int row = row0 + ai * 128 + m * 16;
#pragma unroll
                for (int bj = 0; bj < 2; ++bj) {
                    const u32x4 ga = *(const u32x4*)(GM + (size_t)row * 2048 + 1024 + colb + bj * 128);
                    const f32x4 g0 = (f32x4){bflo(ga.x), bfhi(ga.x), bflo(ga.y), bfhi(ga.y)}, g1 = (f32x4){bflo(ga.z), bfhi(ga.z), bflo(ga.w), bfhi(ga.w)};
                    *(u32x4*)(MRG + (size_t)row * DM + colb + bj * 128) = pack8(acc[ai][bj][m][0] * g0, acc[ai][bj][m][1] * g1);
                }
                ROW_FENCE();
            }
    }
};

struct EpiRes {
    static constexpr bool PERM = false, AFTER_DRAIN = false, HAS_MID = false;
    int mid_t; Ptrs P; int first;
    __device__ __forceinline__ void operator()(const f32x4 (&acc)[2][2][4][2], const Unit& u, int wr, int wc, int fr0, int fq) const {
        int fr = fr0; asm volatile("" : "+v"(fr));
        float* Y = P.out + O_Y; bf16_t* XB = (bf16_t*)(P.ws + WS_XB); float* ssq = (float*)(P.ws + WS_SSQ);
        const int colb = u.pn * 256 + wc * 32 + 4 * fq, row0 = u.pm * 256 + wr * 64 + fr;
#pragma unroll
        for (int ai = 0; ai < 2; ++ai)
#pragma unroll
            for (int m = 0; m < 4; ++m) {
                const int row = row0 + ai * 128 + m * 16; const bool live = row < MT;
                const float* base = first ? xin_row(P, live ? row : 0) : Y + (size_t)(live ? row : 0) * DM;
                float ss = 0.f;
#pragma unroll
                for (int bj = 0; bj < 2; ++bj)
#pragma unroll
                    for (int n = 0; n < 2; ++n) {
                        const int col = colb + bj * 128 + n * 16;
                        f32x4 v = acc[ai][bj][m][n];
                        if (live) { v = v + *(const f32x4*)(base + col); *(f32x4*)(Y + (size_t)row * DM + col) = v; }
                        u32x2 w; w.x = pkbf(v[0], v[1]); w.y = pkbf(v[2], v[3]);
                        *(u32x2*)(XB + (size_t)row * DM + col) = w;
                        ss += (v[0] * v[0] + v[1] * v[1]) + (v[2] * v[2] + v[3] * v[3]);
                    }
                ss += __shfl_xor(ss, 16); ss += __shfl_xor(ss, 32);
                if (fq == 0) ssq[(size_t)row * 16 + u.pn * 4 + wc] = ss;
                ROW_FENCE();
            }
    }
};

struct Epi5 {
    static constexpr bool PERM = true, AFTER_DRAIN = false, HAS_MID = false;
    int mid_t; Ptrs P;
    __device__ __forceinline__ void operator()(const f32x4 (&acc)[2][2][4][2], const Unit& u, int wr, int wc, int fr0, int fq) const {
        int fr = fr0; asm volatile("" : "+v"(fr));
        const float* ssq = (const float*)(P.ws + WS_SSQ); bf16_t* H = (bf16_t*)(P.ws + WS_H);
        const int colb = u.pn * 128 + wc * 32 + 8 * fq, row0 = u.pm * 256 + wr * 64 + fr;
#pragma unroll
        for (int ai = 0; ai < 2; ++ai)
#pragma unroll
            for (int m = 0; m < 4; ++m) {
                const int row = row0 + ai * 128 + m * 16; const float rs = row_rs(ssq, row);
                f32x4 h[2];
#pragma unroll
                for (int n = 0; n < 2; ++n)
#pragma unroll
                    for (int e = 0; e < 4; ++e) { const float gt = acc[ai][0][m][n][e] * rs, up = acc[ai][1][m][n][e] * rs; h[n][e] = gt * sigmoidf_(gt) * up; }
                *(u32x4*)(H + (size_t)row * DFF + colb) = pack8(h[0], h[1]);
                ROW_FENCE();
            }
    }
};

__device__ __forceinline__ void p0_prologue(const Ptrs& P, size_t tid, size_t nth) {
    for (int l = 0; l < DEPTH; ++l) {
        unsigned char* wb = P.ws + WS_W + l * LW_BYTES;
        bf16_t* W1 = (bf16_t*)(wb + LW_W1); bf16_t* W3 = (bf16_t*)(wb + LW_W3);
        bf16_t* W4 = (bf16_t*)(wb + LW_W4); bf16_t* W5 = (bf16_t*)(wb + LW_W5); bf16_t* W6 = (bf16_t*)(wb + LW_W6);
        const float* w_in = P.w_in + (size_t)l * DM * 6656; const float* w_merge = P.w_merge + (size_t)l * DM * 2048;
        const float* nm = P.norm_mix + l * DM; const float* nf = P.norm_ffn + l * DM;
        for (size_t e = tid; e < (size_t)N1 * DM; e += nth) { const int n = (int)(e % N1), k = (int)(e / N1); const int c = w1_src_col(n);
            const float v = (c < 6656 ? w_in[(size_t)k * 6656 + c] : w_merge[(size_t)k * 2048 + (c - 6656)]) * nm[k]; W1[(size_t)n * DM + k] = f2b(v); }
        const float* wl = P.w_branch_lru + (size_t)l * DR * DM;
        for (size_t e = tid; e < (size_t)DM * DR; e += nth) { const int n = (int)(e % DM), k = (int)(e / DM); W3[(size_t)n * K3 + k] = f2b(wl[(size_t)k * DM + n]); }
        const float* wa = P.w_branch_att + (size_t)l * AO * DM;
        for (size_t e = tid; e < (size_t)DM * AO; e += nth) { const int n = (int)(e % DM), k = (int)(e / DM); W3[(size_t)n * K3 + DR + k] = f2b(wa[(size_t)k * DM + n]); }
        const float* wo = P.w_o + (size_t)l * DM * DM;
        for (size_t e = tid; e < (size_t)DM * DM; e += nth) { const int n = (int)(e % DM), k = (int)(e / DM); W4[(size_t)n * DM + k] = f2b(wo[(size_t)k * DM + n]); }
        const float* wf = P.w_ffn_in + (size_t)l * DM * 2 * DFF;
        for (size_t e = tid; e < (size_t)2 * DFF * DM; e += nth) { const int n = (int)(e % (2 * DFF)), k = (int)(e / (2 * DFF)); W5[(size_t)n * DM + k] = f2b(wf[(size_t)k * 2 * DFF + w5_src_col(n)] * nf[k]); }
        const float* wf2 = P.w_ffn_out + (size_t)l * DFF * DM;
        for (size_t e = tid; e < (size_t)DM * DFF; e += nth) { const int n = (int)(e % DM), k = (int)(e / DM); W6[(size_t)n * DFF + k] = f2b(wf2[(size_t)k * DM + n]); }
    }
    float* BIAS = (float*)(P.ws + WS_BIAS);
    for (size_t e = tid; e < (size_t)NG * HPG * NKEY; e += nth) {
        const int kk = (int)(e % NKEY), hh = (int)((e / NKEY) % HPG), g = (int)(e / (NKEY * HPG));
        const int d = kk * g_dil(g); int bkt;
        if (d < 16) bkt = d; else { const float df = (float)d; int lg = 16 + (int)(logf(df / 16.0f) / logf(128.0f) * 16.0f); bkt = lg < 31 ? lg : 31; }
        BIAS[e] = P.rel_bias[bkt * NH + 8 * g + hh];
    }
    const int lane = (int)(tid & 63);
    for (size_t row = tid >> 6; row < (size_t)MT; row += nth >> 6) {
        const float* xr = xin_row(P, (int)row); bf16_t* xb = (bf16_t*)(P.ws + WS_XB) + row * DM; float* ssq = (float*)(P.ws + WS_SSQ) + row * 16;
        float s = 0.f;
        for (int c = lane; c < DM; c += 64) { const float v = xr[c]; s += v * v; xb[c] = f2b(v); }
        s = wave_sum(s);
        if (lane < 16) ssq[lane] = (lane == 0) ? s : 0.f;
    }
}

__device__ __forceinline__ void ph_conv(const Ptrs& P, int l, size_t gtid, size_t nth) {
    const bf16_t* LX = (const bf16_t*)(P.ws + WS_LX);
    const float* wc = P.w_conv + (size_t)l * CW * DR;
    for (size_t e = gtid; e < (size_t)MT * DR; e += nth) {
        const int row = (int)(e / DR), ch = (int)(e % DR);
        float acc = P.b_conv[l * DR + ch];
        if (row < MP) { const int t = row % SEQ;
#pragma unroll
            for (int k = 0; k < CW; ++k) { const int tt = t + k - 3; if (tt >= 0) acc += wc[k * DR + ch] * bf2f(LX[(size_t)(row + k - 3) * DR + ch]); } }
        else { const int b = row - MP; const float* sc = P.state_conv + (size_t)(l * SB + b) * 3 * DR;
            acc += wc[0 * DR + ch] * sc[ch] + wc[1 * DR + ch] * sc[DR + ch] + wc[2 * DR + ch] * sc[2 * DR + ch] + wc[3 * DR + ch] * bf2f(LX[(size_t)row * DR + ch]); }
        ((float*)(P.ws + WS_XC))[e] = acc;
    }
}
__device__ __forceinline__ void ph_gates(const Ptrs& P, int l, size_t gtid, size_t nth) {
    for (size_t e = gtid; e < (size_t)MT * DR; e += nth) {
        const int row = (int)(e / DR), ch = (int)(e % DR), n = ch >> 6, j = ch & 63;
        const float* XC = (const float*)(P.ws + WS_XC) + (size_t)row * DR + n * 64;
        const float* wa = P.w_rg_a + ((size_t)(l * NBLK + n) * 64) * 64 + j; const float* wx = P.w_rg_x + ((size_t)(l * NBLK + n) * 64) * 64 + j;
        float ga = P.b_rg_a[l * DR + ch], gx = P.b_rg_x[l * DR + ch];
        for (int i = 0; i < 64; ++i) { const float x = XC[i]; ga += x * wa[i * 64]; gx += x * wx[i * 64]; }
        const float rr = sigmoidf_(ga), ii = sigmoidf_(gx);
        const float lam = P.lru_lambda[l * DR + ch]; const float sp = log1pf(expf(-lam));
        const float log_a = -8.0f * rr * sp; const float av = expf(log_a);
        const bool pos0 = (row < MP) && (row % SEQ == 0);
        const float mult = pos0 ? 1.0f : sqrtf(-expm1f(2.0f * log_a));
        ((float*)(P.ws + WS_AA))[e] = av; ((float*)(P.ws + WS_UU))[e] = mult * ii * XC[j];
    }
}
__device__ __forceinline__ void ph_scan(const Ptrs& P, int l, size_t gtid, size_t nth) {
    const float* AA = (const float*)(P.ws + WS_AA); const float* UU = (const float*)(P.ws + WS_UU);
    const bf16_t* GG = (const bf16_t*)(P.ws + WS_GG); bf16_t* A3 = (bf16_t*)(P.ws + WS_A3);
    for (size_t e = gtid; e < (size_t)(NB + SB) * DR; e += nth) {
        const int s = (int)(e / DR), ch = (int)(e % DR);
        if (s < NB) { float h = 0.f; const size_t r0 = (size_t)s * SEQ;
            for (int t = 0; t < SEQ; t += 8) { float av[8], u[8], g[8];
#pragma unroll
                for (int i = 0; i < 8; ++i) { const size_t o = (r0 + t + i) * DR + ch; av[i] = AA[o]; u[i] = UU[o]; g[i] = bf2f(GG[o]); }
#pragma unroll
                for (int i = 0; i < 8; ++i) { h = av[i] * h + u[i]; A3[(r0 + t + i) * K3 + ch] = f2b(h * g[i]); } }
            P.out[O_HP + (size_t)(l * NB + s) * DR + ch] = h;
        } else { const int b = s - NB; const size_t o = (size_t)(MP + b) * DR + ch; float h = P.state_h[(size_t)(l * SB + b) * DR + ch];
            h = AA[o] * h + UU[o]; A3[(size_t)(MP + b) * K3 + ch] = f2b(h * bf2f(GG[o])); P.out[O_HS + (size_t)(l * SB + b) * DR + ch] = h; }
    }
}
__device__ __forceinline__ void ph_attn(const Ptrs& P, int l, int gwave, int nwaves, int lane, LAS float* qw) {
    const bf16_t* Q = (const bf16_t*)(P.ws + WS_Q); const bf16_t* K = (const bf16_t*)(P.ws + WS_K); const bf16_t* V = (const bf16_t*)(P.ws + WS_V);
    for (int gw = gwave; gw < MT * NH; gw += nwaves) {
        const int row = gw / NH, head = gw % NH, g = head / HPG, hh = head % HPG, dil = g_dil(g);
        const float* BIAS = (const float*)(P.ws + WS_BIAS) + (size_t)(g * HPG + hh) * NKEY;
        const bool samp = row >= MP; const int b = samp ? row - MP : row / SEQ, t = samp ? 0 : row % SEQ;
        const int nkeys = samp ? NKEY : ((t / dil) < 128 ? (t / dil) + 1 : NKEY);
        const float* cbase = (g == 0 ? P.cache[0] : (g == 1 ? P.cache[1] : P.cache[2]));
        const float* cache = cbase + (size_t)(l * SB + (samp ? b : 0)) * g_win(g) * 1024;
        const int Lc = g_win(g);
        asm volatile("" ::: "memory");
        qw[lane] = bf2f(Q[(size_t)row * AW + head * HD + lane]);
        asm volatile("s_waitcnt lgkmcnt(0)" ::: "memory");
        float s[3];
#pragma unroll
        for (int j = 0; j < 3; ++j) { const int kk = lane + 64 * j; float acc = -INFINITY;
            if (kk < nkeys) { acc = 0.f;
                if (!samp || kk == 0) { const bf16_t* kr = K + (size_t)(row - kk * dil) * AW + head * HD;
                    for (int d = 0; d < HD; ++d) acc += qw[d] * bf2f(kr[d]); }
                else { const float* kr = cache + ((size_t)(Lc - kk * dil) * 2 + 0) * 512 + hh * HD;
                    for (int d = 0; d < HD; ++d) acc += qw[d] * kr[d]; }
                acc = acc * 0.125f + BIAS[kk]; }
            s[j] = acc; }
        const float m = wave_max(fmaxf(fmaxf(s[0], s[1]), s[2]));
        float p[3]; float lsum = 0.f;
#pragma unroll
        for (int j = 0; j < 3; ++j) { p[j] = (lane + 64 * j < nkeys) ? __expf(s[j] - m) : 0.f; lsum += p[j]; }
        lsum = wave_sum(lsum);
        float o = 0.f;
        for (int kk = 0; kk < nkeys; ++kk) { const float pk = __shfl(kk < 64 ? p[0] : (kk < 128 ? p[1] : p[2]), kk & 63);
            float vv;
            if (!samp || kk == 0) vv = bf2f(V[(size_t)(row - kk * dil) * AW + head * HD + lane]);
            else vv = cache[((size_t)(Lc - kk * dil) * 2 + 1) * 512 + hh * HD + lane];
            o += pk * vv; }
        bf16_t* OG = (bf16_t*)(P.ws + WS_OG) + ((size_t)g * MT + row) * AO; OG[hh * HD + lane] = f2b(o / lsum);
        if (lane == 0) { float* ML = (float*)(P.ws + WS_ML) + (((size_t)g * MT + row) * HPG + hh) * 2; ML[0] = m; ML[1] = lsum; }
    }
}
__device__ __forceinline__ void ph_combine(const Ptrs& P, size_t gtid, size_t nth) {
    const bf16_t* OG = (const bf16_t*)(P.ws + WS_OG); const float* ML = (const float*)(P.ws + WS_ML);
    for (size_t e = gtid; e < (size_t)MT * AO; e += nth) {
        const int row = (int)(e / AO), c = (int)(e % AO), hh = c >> 6;
        float m[3], lz[3], mm = -INFINITY;
#pragma unroll
        for (int g = 0; g < 3; ++g) { const float* q = ML + (((size_t)g * MT + row) * HPG + hh) * 2; m[g] = q[0]; lz[g] = q[1]; mm = fmaxf(mm, m[g]); }
        float num = 0.f, den = 0.f;
#pragma unroll
        for (int g = 0; g < 3; ++g) { const float z = lz[g] * __expf(m[g] - mm); num += z * bf2f(OG[((size_t)g * MT + row) * AO + c]); den += z; }
        ((bf16_t*)(P.ws + WS_A3))[(size_t)row * K3 + DR + c] = f2b(num / den);
    }
}

constexpr int RING_BYTES = 131072, LDSCTL_OFF = RING_BYTES, MISC_OFF = LDSCTL_OFF + 320, LDS_BYTES = 147456;
constexpr int CW_BAR = 4096;
constexpr int NPH = 1 + 8 * DEPTH;
#ifndef PHMASK
#define PHMASK 63
#endif
struct Args { Ptrs P; int ph_lo, ph_hi, pad0, pad1; };

__global__ void __launch_bounds__(512, 2) mega(Args a) {
    extern __shared__ __attribute__((aligned(16))) unsigned char lds_raw[];
    LAS unsigned char* lds = (LAS unsigned char*)lds_raw;
    const int wv = __builtin_amdgcn_readfirstlane(threadIdx.x >> 6);
#define TID() ((wv << 6) | (int)__builtin_amdgcn_mbcnt_hi(~0u, __builtin_amdgcn_mbcnt_lo(~0u, 0u)))
    { const int tid = TID(); for (int u = tid; u < (LDS_BYTES - LDSCTL_OFF) / 4; u += 512) ((LAS unsigned*)(lds + LDSCTL_OFF))[u] = 0u; }
    __syncthreads();
    unsigned char* ws0 = a.P.ws;
    XcdBarrier bar; bar.bar = (unsigned*)(ws0 + WS_CTL) + CW_BAR; bar.x = 0; bar.st = nullptr; bar.wv = wv;
    if (a.ph_hi - a.ph_lo > 1) bar = xcd_barrier_post((unsigned*)(ws0 + WS_CTL) + CW_BAR, (volatile LAS unsigned*)(lds + MISC_OFF) + 8);
    bar.wv = wv;
    const int G = gridDim.x;
    for (int ph = a.ph_lo; ph < a.ph_hi; ++ph) {
        const Ptrs& P = a.P;
        unsigned char* ws = P.ws;
        if (ph == 0 && (PHMASK & 32)) {
            int t_ = TID(); asm volatile("" : "+v"(t_));
            p0_prologue(P, (size_t)blockIdx.x * 512 + t_, (size_t)G * 512);
        } else {
            const int l = __builtin_amdgcn_readfirstlane((ph - 1) >> 3), p = __builtin_amdgcn_readfirstlane((ph - 1) & 7);
            unsigned char* wb = ws + WS_W + l * LW_BYTES;
            if (p == 0 && (PHMASK & 1)) {
                pg8::Gemm g{(const bf16_t*)(ws + WS_XB), (const bf16_t*)(wb + LW_W1), MPAD, N1, DM, wv}; pg8::StaticOrder S; S.init(MPAD, N1, G, (int)blockIdx.x);
                Epi1 E{0, P, l}; pg8::gemm_phase<Epi1, pg8::StaticOrder, true, true>(lds, g, S, E);
            } else if (p == 4 && (PHMASK & 2)) {
                pg8::Gemm g{(const bf16_t*)(ws + WS_A3), (const bf16_t*)(wb + LW_W3), MPAD, DM, K3, wv}; pg8::StaticOrder S; S.init(MPAD, DM, G, (int)blockIdx.x);
                Epi3 E{DR / 64, P}; pg8::gemm_phase<Epi3, pg8::StaticOrder, true, true>(lds, g, S, E);
            } else if (p == 5 && (PHMASK & 4)) {
                pg8::Gemm g{(const bf16_t*)(ws + WS_MRG), (const bf16_t*)(wb + LW_W4), MPAD, DM, DM, wv}; pg8::StaticOrder S; S.init(MPAD, DM, G, (int)blockIdx.x);
                EpiRes E{0, P, l == 0 ? 1 : 0}; pg8::gemm_phase<EpiRes, pg8::StaticOrder, true, true>(lds, g, S, E);
            } else if (p == 6 && (PHMASK & 8)) {
                pg8::Gemm g{(const bf16_t*)(ws + WS_XB), (const bf16_t*)(wb + LW_W5), MPAD, 2 * DFF, DM, wv}; pg8::StaticOrder S; S.init(MPAD, 2 * DFF, G, (int)blockIdx.x);
                Epi5 E{0, P}; pg8::gemm_phase<Epi5, pg8::StaticOrder, true, true>(lds, g, S, E);
            } else if (p == 7 && (PHMASK & 16)) {
                pg8::Gemm g{(const bf16_t*)(ws + WS_H), (const bf16_t*)(wb + LW_W6), MPAD, DM, DFF, wv}; pg8::StaticOrder S; S.init(MPAD, DM, G, (int)blockIdx.x);
                EpiRes E{0, P, 0}; pg8::gemm_phase<EpiRes, pg8::StaticOrder, true, true>(lds, g, S, E);
            } else if (p >= 1 && p <= 3) {
                int t_ = TID(); asm volatile("" : "+v"(t_));
                const size_t gtid = (size_t)blockIdx.x * 512 + t_, nth = (size_t)G * 512;
                if (p == 1) { ph_conv(P, l, gtid, nth); ph_attn(P, l, (int)blockIdx.x * 8 + wv, G * 8, t_ & 63, (LAS float*)lds + wv * 64); }
                else if (p == 2) { ph_gates(P, l, gtid, nth); ph_combine(P, gtid, nth); }
                else ph_scan(P, l, gtid, nth);
            }
        }
        if (ph + 1 < a.ph_hi) xcd_barrier(bar);
    }
}

extern "C" void kernel_launch(void* const* d_in, const int* in_sizes, int n_in, void* d_out, int out_size, void* d_ws, size_t ws_size, hipStream_t stream) {
    static int grid = 0;
    if (grid == 0) {
        if (n_in != 27 || (size_t)out_size != O_END || ws_size < WS_END) { fprintf(stderr, "kernel_launch: unexpected sizes n_in %d out %d (want %zu) ws %zu (want %zu)\n", n_in, out_size, (size_t)O_END, ws_size, (size_t)WS_END); grid = -1; return; }
        int dev = 0, cus = 0;
        if (hipGetDevice(&dev) != hipSuccess || hipDeviceGetAttribute(&cus, hipDeviceAttributeMultiprocessorCount, dev) != hipSuccess) { grid = -1; return; }
        if (hipFuncSetAttribute((const void*)mega, hipFuncAttributeMaxDynamicSharedMemorySize, LDS_BYTES) != hipSuccess) { fprintf(stderr, "kernel_launch: hipFuncSetAttribute failed\n"); grid = -1; return; }
        grid = cus;
    }
    if (grid < 0) return;
    Args a{};
    Ptrs& P = a.P;
    const float* const* in = (const float* const*)d_in;
    P.x_prompt = in[0]; P.x_sample = in[1]; P.cache[0] = in[2]; P.cache[1] = in[3]; P.cache[2] = in[4]; P.state_conv = in[5]; P.state_h = in[6]; P.rel_bias = in[7];
    P.norm_mix = in[8]; P.w_in = in[9]; P.w_conv = in[10]; P.b_conv = in[11]; P.w_rg_a = in[12]; P.b_rg_a = in[13]; P.w_rg_x = in[14]; P.b_rg_x = in[15];
    P.lru_lambda = in[16]; P.q_gain = in[17]; P.k_gain = in[18]; P.w_merge = in[19]; P.b_merge = in[20]; P.w_branch_lru = in[21]; P.w_branch_att = in[22];
    P.w_o = in[23]; P.norm_ffn = in[24]; P.w_ffn_in = in[25]; P.w_ffn_out = in[26];
    P.out = (float*)d_out; P.ws = (unsigned char*)d_ws;
    (void)hipMemsetAsync((char*)d_ws + WS_CTL, 0, CTL_ZERO_BYTES, stream);
    a.ph_lo = 0; a.ph_hi = NPH;
    hipLaunchKernelGGL(mega, dim3(grid), dim3(512), LDS_BYTES, stream, a);
}
```

```cpp
#include <hip/hip_runtime.h>
#include <stdint.h>
#include <stdio.h>

typedef unsigned short bf16_t;
typedef short bf16x8 __attribute__((ext_vector_type(8)));
typedef float f32x4 __attribute__((ext_vector_type(4)));
typedef unsigned u32x4 __attribute__((ext_vector_type(4)));
typedef unsigned u32x2 __attribute__((ext_vector_type(2)));

constexpr int DM = 1024, NB = 2, SEQ = 8192, DEPTH = 2, SB = 32, PAST = 8192;
constexpr int MP = NB * SEQ;
constexpr int MT = MP + SB;
constexpr int MPAD = 16640;
constexpr int DR = 1024, NBLK = 16, CW = 4;
constexpr int HD = 64, HPG = 8, NG = 3, NH = 24, AW = 1536, AO = 512;
constexpr int DFF = 2816;
constexpr int N1 = 2 * DR + 3 * AW + 2 * DM;
constexpr int K3 = DR + AO;
constexpr float EPS = 1e-6f;
constexpr int NKEY = 129;

__host__ __device__ constexpr int g_dil(int g) { return g == 0 ? 1 : (g == 1 ? 4 : 16); }
__host__ __device__ constexpr int g_win(int g) { return g == 0 ? 128 : (g == 1 ? 512 : 2048); }

constexpr size_t O_Y = 0;
constexpr size_t O_KVP0 = (size_t)MT * DM;
constexpr size_t O_KVP1 = O_KVP0 + (size_t)DEPTH * NB * 128 * 1024;
constexpr size_t O_KVP2 = O_KVP1 + (size_t)DEPTH * NB * 512 * 1024;
constexpr size_t O_CONVP = O_KVP2 + (size_t)DEPTH * NB * 2048 * 1024;
constexpr size_t O_HP = O_CONVP + (size_t)DEPTH * NB * 3 * DR;
constexpr size_t O_KVS0 = O_HP + (size_t)DEPTH * NB * DR;
constexpr size_t O_KVS1 = O_KVS0 + (size_t)DEPTH * SB * 1024;
constexpr size_t O_KVS2 = O_KVS1 + (size_t)DEPTH * SB * 1024;
constexpr size_t O_CONVS = O_KVS2 + (size_t)DEPTH * SB * 1024;
constexpr size_t O_HS = O_CONVS + (size_t)DEPTH * SB * 3 * DR;
constexpr size_t O_END = O_HS + (size_t)DEPTH * SB * DR;
__host__ __device__ constexpr size_t o_kvp(int g) { return g == 0 ? O_KVP0 : (g == 1 ? O_KVP1 : O_KVP2); }
__host__ __device__ constexpr size_t o_kvs(int g) { return g == 0 ? O_KVS0 : (g == 1 ? O_KVS1 : O_KVS2); }

constexpr size_t MiB = 1u << 20;
constexpr size_t rup(size_t x) { return (x + MiB - 1) / MiB * MiB; }
constexpr size_t WS_CTL = 0, CTL_ZERO_BYTES = 1 * MiB;
constexpr size_t WS_BIAS = 1 * MiB;
constexpr size_t WS_SSQ = 2 * MiB;
constexpr size_t WS_SUM = 4 * MiB;
constexpr size_t WS_W = 8 * MiB;
constexpr size_t LW_W1 = 0;
constexpr size_t LW_W3 = LW_W1 + (size_t)N1 * DM * 2;
constexpr size_t LW_W4 = LW_W3 + (size_t)DM * K3 * 2;
constexpr size_t LW_W5 = LW_W4 + (size_t)DM * DM * 2;
constexpr size_t LW_W6 = LW_W5 + (size_t)2 * DFF * DM * 2;
constexpr size_t LW_BYTES = rup(LW_W6 + (size_t)DM * DFF * 2);
constexpr size_t WS_XB = WS_W + DEPTH * LW_BYTES;
constexpr size_t WS_LX = WS_XB + rup((size_t)MPAD * DM * 2);
constexpr size_t WS_GG = WS_LX + rup((size_t)MPAD * DM * 2);
constexpr size_t WS_Q = WS_GG + rup((size_t)MPAD * DM * 2);
constexpr size_t WS_K = WS_Q + rup((size_t)MPAD * AW * 2);
constexpr size_t WS_V = WS_K + rup((size_t)MPAD * AW * 2);
constexpr size_t WS_GM = WS_V + rup((size_t)MPAD * AW * 2);
constexpr size_t WS_OG = WS_GM + rup((size_t)MPAD * 2048 * 2);
constexpr size_t WS_ML = WS_OG + rup((size_t)3 * MPAD * AO * 2);
constexpr size_t WS_A3 = WS_ML + rup((size_t)3 * MPAD * 16 * 4);
constexpr size_t WS_MRG = WS_A3 + rup((size_t)MPAD * K3 * 2);
constexpr size_t WS_H = WS_MRG + rup((size_t)MPAD * DM * 2);
constexpr size_t WS_SIMPLE = WS_H + rup((size_t)MPAD * DFF * 2);
constexpr size_t WS_XC = WS_SIMPLE;
constexpr size_t WS_AA = WS_XC + rup((size_t)MPAD * DM * 4);
constexpr size_t WS_UU = WS_AA + rup((size_t)MPAD * DM * 4);
constexpr size_t WS_END = WS_UU + rup((size_t)MPAD * DM * 4);

__device__ __forceinline__ float bf2f(bf16_t v) { return __uint_as_float(((unsigned)v) << 16); }
__device__ __forceinline__ bf16_t f2b(float f) { unsigned u = __float_as_uint(f); u += 0x7fffu + ((u >> 16) & 1u); return (bf16_t)(u >> 16); }
__device__ __forceinline__ float wave_sum(float v) {
#pragma unroll
    for (int o = 1; o < 64; o <<= 1) v += __shfl_xor(v, o);
    return v;
}
__device__ __forceinline__ float wave_max(float v) {
#pragma unroll
    for (int o = 1; o < 64; o <<= 1) v = fmaxf(v, __shfl_xor(v, o));
    return v;
}
__device__ __forceinline__ float sigmoidf_(float x) { return 1.0f / (1.0f + __expf(-x)); }
__device__ __forceinline__ float gelu_tanh(float x) { const float u = 0.7978845608028654f * (x + 0.044715f * x * x * x); return 0.5f * x * (1.0f + tanhf(u)); }

__host__ __device__ __forceinline__ int w1_src_col(int nt) {
    if (nt < 2048) return nt;
    const int pn = nt >> 8, tc = nt & 255, bj = tc >> 7;
    if (nt >= 6656) return 6656 + bj * 1024 + (pn - 26) * 128 + (tc & 127);
    const int wc = (tc >> 5) & 3, i = tc & 31;
    return 2048 + (pn - 8) * 256 + wc * 64 + bj * 32 + i;
}
__host__ __device__ __forceinline__ int w5_src_col(int nt) { const int pn = nt >> 8, tc = nt & 255, bj = tc >> 7, j = tc & 127; return bj * DFF + pn * 128 + j; }

struct Ptrs {
    const float* x_prompt; const float* x_sample; const float* cache[3]; const float* state_conv; const float* state_h; const float* rel_bias;
    const float* norm_mix; const float* w_in; const float* w_conv; const float* b_conv; const float* w_rg_a; const float* b_rg_a; const float* w_rg_x; const float* b_rg_x;
    const float* lru_lambda; const float* q_gain; const float* k_gain; const float* w_merge; const float* b_merge; const float* w_branch_lru; const float* w_branch_att;
    const float* w_o; const float* norm_ffn; const float* w_ffn_in; const float* w_ffn_out;
    float* out; unsigned char* ws;
};
__device__ __forceinline__ const float* xin_row(const Ptrs& P, int row) { return row < MP ? P.x_prompt + (size_t)row * DM : P.x_sample + (size_t)(row - MP) * DM; }

namespace pg8 {
#define PG8_LAS __attribute__((address_space(3)))
typedef unsigned short bf16_t;
typedef short bf16x8 __attribute__((ext_vector_type(8)));
typedef float f32x4 __attribute__((ext_vector_type(4)));
typedef unsigned u32x4 __attribute__((ext_vector_type(4)));
constexpr int BM = 256, BK = 64, HALF = 128, HTB = HALF * BK * 2  , STAGE_BYTES = 8 * HTB, NXCD = 8, WGM = 8;

__host__ __device__ __forceinline__ int lds_byte(int r, int c) { const int st = (r >> 4) * 2 + (c >> 5), rr = r & 15, cc = c & 31, ob = rr * 64 + cc * 2; return st * 1024 + (ob ^ (((ob >> 9) & 1) << 5)); }
__host__ __device__ __forceinline__ void stage_rc(int b, int& R, int& C) { const int st = b / 1024, sb = b % 1024, swz = sb ^ (((sb >> 9) & 1) << 5); R = (st >> 1) * 16 + swz / 64; C = (st & 1) * 32 + (swz % 64) / 2; }
__host__ __device__ __forceinline__ int perm32(int rho) { const int n = rho >> 4, i = rho & 15; return 8 * (i >> 2) + 4 * n + (i & 3); }

struct Unit { int pm, pn; };
struct Gemm { const bf16_t* A; const bf16_t* Bt; int M, N, K; int wv; };

struct StaticOrder {
    int nM, nN, nwg, G, c;
    __host__ __device__ void init(int M, int N, int G_, int c_) { nM = M / BM; nN = N / BM; nwg = nM * nN; G = G_; c = c_; }
    __host__ __device__ bool next(int i, Unit& u) const {
        const long L = (long)i * G + c; if (L >= nwg) return false;
        int wgid = (int)L; { const int q = nwg / NXCD, r = nwg % NXCD, xcd = wgid % NXCD, off = wgid / NXCD; wgid = (xcd < r ? xcd * (q + 1) : r * (q + 1) + (xcd - r) * q) + off; }
        const int nig = WGM * nN, gid = wgid / nig, fm = gid * WGM, gsz = (nM - fm) < WGM ? (nM - fm) : WGM;
        u.pm = fm + ((wgid % nig) % gsz); u.pn = (wgid % nig) / gsz; return true;
    }
    __device__ __forceinline__ void a_ready(const Unit&) const {}
    __device__ __forceinline__ void done(const Unit&) const {}
};

template <class Epi, class Sched, bool ALIGN_EPI = false, bool SP2 = false>
__device__ __forceinline__ void gemm_phase(PG8_LAS unsigned char* lds, const Gemm g, const Sched& S, const Epi& E) {
    int tid_ = (g.wv << 6) | (int)__builtin_amdgcn_mbcnt_hi(~0u, __builtin_amdgcn_mbcnt_lo(~0u, 0u)); asm volatile("" : "+v"(tid_));
    const int tid = tid_, wid = __builtin_amdgcn_readfirstlane(tid >> 6), lane = tid & 63, wr = wid >> 2, wc = wid & 3, fr = lane & 15, fq = lane >> 4;
    const int K = g.K, nt = K / BK;
    unsigned voffA[2], voffB[2];
#pragma unroll
    for (int i = 0; i < 2; ++i) { int R, C; stage_rc(tid * 16 + i * 8192, R, C); const int Rb = Epi::PERM ? ((R & ~31) + perm32(R & 31)) : R;
        voffA[i] = (unsigned)(R * K + C) * 2u; voffB[i] = (unsigned)(Rb * K + C) * 2u; }
    const size_t kstep = (size_t)(BK * 2);
    const size_t hstep = (size_t)HALF * K * 2;
    const size_t tstep = 2 * hstep;
    const unsigned ldsw = (unsigned)wid * 1024u;
    const int aoff = lds_byte(wr * 64 + fr, fq * 8), boff = lds_byte(wc * 32 + fr, fq * 8);
#define PG8_SA(b, h) (((b) * 2 + (h)) * HTB)
#define PG8_SB(b, h) ((4 + (b) * 2 + (h)) * HTB)
#define PG8_STAGE(bufoff, gbase, voff) do { _Pragma("unroll") for (int _i = 0; _i < 2; ++_i) \
        __builtin_amdgcn_global_load_lds((const unsigned*)((const char*)(gbase) + (voff)[_i]), (PG8_LAS unsigned*)(lds + (bufoff) + ldsw + _i * 8192), 16, 0, 0); } while (0)
#define PG8_LDA(dst, b, h) do { _Pragma("unroll") for (int m = 0; m < 4; ++m) _Pragma("unroll") for (int k = 0; k < 2; ++k) dst[m][k] = *(const PG8_LAS bf16x8*)(lds + PG8_SA(b, h) + aoff + m * 2048 + k * 1024); } while (0)
#define PG8_LDB(dst, b, h) do { _Pragma("unroll") for (int n = 0; n < 2; ++n) _Pragma("unroll") for (int k = 0; k < 2; ++k) dst[n][k] = *(const PG8_LAS bf16x8*)(lds + PG8_SB(b, h) + boff + n * 2048 + k * 1024); } while (0)
#define PG8_MMA(ai, bj, At, Bt) do { __builtin_amdgcn_s_setprio(1); _Pragma("unroll") for (int m = 0; m < 4; ++m) _Pragma("unroll") for (int n = 0; n < 2; ++n) _Pragma("unroll") for (int k = 0; k < 2; ++k) \
        acc[ai][bj][m][n] = __builtin_amdgcn_mfma_f32_16x16x32_bf16(Bt[n][k], At[m][k], acc[ai][bj][m][n], 0, 0, 0); __builtin_amdgcn_s_setprio(0); } while (0)
#define PG8_WAIT_V(n) asm volatile("s_waitcnt vmcnt(" #n ")" ::: "memory")
#define PG8_WAIT_L(n) asm volatile("s_waitcnt lgkmcnt(" #n ")" ::: "memory")
#define PG8_BAR __builtin_amdgcn_s_barrier()
#define PG8_SCHED __builtin_amdgcn_sched_barrier(0)
    Unit cur, nxt; int ui = 0;
    if (!S.next(0, cur)) return;
    f32x4 acc[2][2][4][2];
#pragma unroll
    for (int a = 0; a < 2; ++a)
#pragma unroll
        for (int b = 0; b < 2; ++b)
#pragma unroll
            for (int m = 0; m < 4; ++m)
#pragma unroll
                for (int n = 0; n < 2; ++n) acc[a][b][m][n] = (f32x4){0.f, 0.f, 0.f, 0.f};
    bf16x8 At[4][2], B0[2][2], B1[2][2];
    const char* cA = (const char*)g.A + (size_t)cur.pm * tstep; const char* cB = (const char*)g.Bt + (size_t)cur.pn * tstep;
    S.a_ready(cur);
    if constexpr (SP2) {
        PG8_STAGE(PG8_SB(0, 0), cB, voffB); PG8_STAGE(PG8_SB(0, 1), cB + hstep, voffB); PG8_STAGE(PG8_SA(0, 0), cA, voffA); PG8_STAGE(PG8_SA(0, 1), cA + hstep, voffA);
        if (wr == 1) PG8_BAR;
        PG8_WAIT_V(2); PG8_BAR;
        PG8_STAGE(PG8_SB(1, 0), cB + kstep, voffB); PG8_STAGE(PG8_SA(1, 0), cA + kstep, voffA); PG8_STAGE(PG8_SB(1, 1), cB + hstep + kstep, voffB);
        PG8_WAIT_V(6); PG8_BAR;
    } else {
        PG8_STAGE(PG8_SB(0, 0), cB, voffB); PG8_STAGE(PG8_SA(0, 0), cA, voffA); PG8_STAGE(PG8_SB(0, 1), cB + hstep, voffB); PG8_STAGE(PG8_SA(0, 1), cA + hstep, voffA);
        if (wr == 1) PG8_BAR;
        PG8_WAIT_V(4); PG8_BAR;
        PG8_STAGE(PG8_SB(1, 0), cB + kstep, voffB); PG8_STAGE(PG8_SA(1, 0), cA + kstep, voffA); PG8_STAGE(PG8_SB(1, 1), cB + hstep + kstep, voffB);
        PG8_WAIT_V(6); PG8_BAR;
    }
    for (;;) {
        const bool has_next = S.next(ui + 1, nxt);
        const char* nA = has_next ? (const char*)g.A + (size_t)nxt.pm * tstep : cA; const char* nB = has_next ? (const char*)g.Bt + (size_t)nxt.pn * tstep : cB;
        for (int t = 0; t < nt; t += 2) {
            if constexpr (Epi::HAS_MID) { if (t == E.mid_t) E.mid(acc, cur, wr, wc, fr, fq); }
            const bool last = (t == nt - 2);
            const char* a1 = cA + (size_t)(t + 1) * kstep;
            const char* a2 = last ? nA : cA + (size_t)(t + 2) * kstep; const char* b2 = last ? nB : cB + (size_t)(t + 2) * kstep;
            const char* a3 = a2 + kstep; const char* b3 = b2 + kstep;
            if (last && has_next) S.a_ready(nxt);
            if constexpr (SP2) {
            PG8_LDB(B0, 0, 0); PG8_LDB(B1, 0, 1); PG8_SCHED; PG8_LDA(At, 0, 0); PG8_STAGE(PG8_SA(1, 1), a1 + hstep, voffA);
            PG8_WAIT_V(8); PG8_WAIT_L(0); PG8_BAR; PG8_MMA(0, 0, At, B0); PG8_MMA(0, 1, At, B1); PG8_BAR; PG8_SCHED;
            PG8_LDA(At, 0, 1); PG8_STAGE(PG8_SB(0, 0), b2, voffB); PG8_STAGE(PG8_SB(0, 1), b2 + hstep, voffB); PG8_STAGE(PG8_SA(0, 0), a2, voffA);
            PG8_WAIT_V(8); PG8_WAIT_L(0); PG8_BAR; PG8_MMA(1, 0, At, B0); PG8_MMA(1, 1, At, B1); PG8_BAR; PG8_SCHED;
            PG8_LDB(B0, 1, 0); PG8_LDB(B1, 1, 1); PG8_SCHED; PG8_LDA(At, 1, 0); PG8_STAGE(PG8_SA(0, 1), a2 + hstep, voffA);
            PG8_WAIT_V(8); PG8_WAIT_L(0); PG8_BAR; PG8_MMA(0, 0, At, B0); PG8_MMA(0, 1, At, B1); PG8_BAR; PG8_SCHED;
            PG8_LDA(At, 1, 1); PG8_STAGE(PG8_SB(1, 0), b3, voffB); PG8_STAGE(PG8_SB(1, 1), b3 + hstep, voffB); PG8_STAGE(PG8_SA(1, 0), a3, voffA);
            PG8_WAIT_V(8); PG8_WAIT_L(0); PG8_BAR; PG8_MMA(1, 0, At, B0); PG8_MMA(1, 1, At, B1); PG8_BAR; PG8_SCHED;
            } else {
            PG8_LDB(B0, 0, 0); PG8_SCHED; PG8_LDA(At, 0, 0); PG8_STAGE(PG8_SA(1, 1), a1 + hstep, voffA);
            PG8_WAIT_L(8); PG8_BAR; PG8_WAIT_L(0); PG8_MMA(0, 0, At, B0); PG8_BAR; PG8_SCHED;
            PG8_LDB(B1, 0, 1); PG8_STAGE(PG8_SB(0, 0), b2, voffB);
            PG8_BAR; PG8_WAIT_L(0); PG8_MMA(0, 1, At, B1); PG8_BAR;
            PG8_LDA(At, 0, 1); PG8_STAGE(PG8_SA(0, 0), a2, voffA);
            PG8_BAR; PG8_WAIT_L(0); PG8_MMA(1, 0, At, B0); PG8_BAR; PG8_SCHED;
            PG8_STAGE(PG8_SB(0, 1), b2 + hstep, voffB);
            PG8_WAIT_V(6); PG8_BAR; PG8_MMA(1, 1, At, B1); PG8_BAR;
            PG8_LDB(B0, 1, 0); PG8_SCHED; PG8_LDA(At, 1, 0); PG8_STAGE(PG8_SA(0, 1), a2 + hstep, voffA);
            PG8_WAIT_L(8); PG8_BAR; PG8_WAIT_L(0); PG8_MMA(0, 0, At, B0); PG8_BAR; PG8_SCHED;
            PG8_LDB(B1, 1, 1); PG8_STAGE(PG8_SB(1, 0), b3, voffB);
            PG8_BAR; PG8_WAIT_L(0); PG8_MMA(0, 1, At, B1); PG8_BAR;
            PG8_LDA(At, 1, 1); PG8_STAGE(PG8_SA(1, 0), a3, voffA);
            PG8_BAR; PG8_WAIT_L(0); PG8_MMA(1, 0, At, B0); PG8_BAR; PG8_SCHED;
            PG8_STAGE(PG8_SB(1, 1), b3 + hstep, voffB);
            PG8_WAIT_V(6); PG8_BAR; PG8_MMA(1, 1, At, B1); PG8_BAR;
            }
        }
        if constexpr (ALIGN_EPI) { if (wr == 0) PG8_BAR; }
        if constexpr (!Epi::AFTER_DRAIN) { E(acc, cur, wr, wc, fr, fq); S.done(cur); }
        if (!has_next) break;
#pragma unroll
        for (int a = 0; a < 2; ++a)
#pragma unroll
            for (int b = 0; b < 2; ++b)
#pragma unroll
                for (int m = 0; m < 4; ++m)
#pragma unroll
                    for (int n = 0; n < 2; ++n) acc[a][b][m][n] = (f32x4){0.f, 0.f, 0.f, 0.f};
        cur = nxt; cA = nA; cB = nB; ++ui;
        if constexpr (ALIGN_EPI) { if (wr == 1) PG8_BAR; }
    }
    PG8_WAIT_V(0);
    if constexpr (!ALIGN_EPI) { if (wr == 0) PG8_BAR; }
    PG8_BAR;
    if constexpr (Epi::AFTER_DRAIN) { E.fused(acc, cur, wr, wc, fr, fq, lds, wid, lane); S.done(cur); }
#undef PG8_SA
#undef PG8_SB
#undef PG8_STAGE
#undef PG8_LDA
#undef PG8_LDB
#undef PG8_MMA
#undef PG8_WAIT_V
#undef PG8_WAIT_L
#undef PG8_BAR
#undef PG8_SCHED
}
}
#define GAS __attribute__((address_space(1)))
#define LAS __attribute__((address_space(3)))
typedef unsigned short bf16;
typedef unsigned v4u __attribute__((ext_vector_type(4)));
typedef float f32x4 __attribute__((ext_vector_type(4)));
typedef short bf16x8 __attribute__((ext_vector_type(8)));
typedef GAS unsigned gu32;
typedef GAS unsigned long long gu64;
#define RLX_AGENT __ATOMIC_RELAXED, __HIP_MEMORY_SCOPE_AGENT
#define LDS_WAIT() asm volatile("s_waitcnt lgkmcnt(0)" ::: "memory")
#define VM_WAIT() asm volatile("s_waitcnt vmcnt(0)" ::: "memory")
__device__ __forceinline__ unsigned long long rt() { return __builtin_amdgcn_s_memrealtime(); }
__device__ __forceinline__ unsigned f2bf(float f) { unsigned u = __builtin_bit_cast(unsigned, f); return (u + 0x7fffu + ((u >> 16) & 1u)) >> 16; }
__device__ __forceinline__ unsigned pk2(float lo, float hi) { return f2bf(lo) | (f2bf(hi) << 16); }

#define XB_TMO      128
#define XB_XCNT(j)  (256  + 64 * (j))
#define XB_XSUB(j)  (1280 + 64 * (j))
#define XB_XGEN(j)  (2304 + 64 * (j))
#define XB_TOP      3328
#define XB_TOPGEN   3392
#define XCD_BAR_WORDS 3456
#define XB_SPIN_CAP (1u << 18)

__device__ __forceinline__ unsigned xb_ld(unsigned* p)              { return __hip_atomic_load(p, __ATOMIC_RELAXED, __HIP_MEMORY_SCOPE_AGENT); }
__device__ __forceinline__ unsigned xb_add(unsigned* p, unsigned v) { return __hip_atomic_fetch_add(p, v, __ATOMIC_RELAXED, __HIP_MEMORY_SCOPE_AGENT); }
__device__ __forceinline__ unsigned xb_xcc_id() { return (unsigned)__builtin_amdgcn_s_getreg((3 << 11) | 20) & 0xFu; }
#define XB_SPIN(cond, bar) do { unsigned _sp = 0; while (cond) { __builtin_amdgcn_s_sleep(1); \
    if ((++_sp & 255u) == 0u) { if (xb_ld(&(bar)[XB_TMO])) break; if (_sp > XB_SPIN_CAP) { atomicAdd(&(bar)[XB_TMO], 1u); break; } } } } while (0)

struct XcdBarrier {
    unsigned* bar; unsigned x; int wv;
    volatile LAS unsigned* st;
};

__device__ __forceinline__ XcdBarrier xcd_barrier_post(unsigned* bar, volatile LAS unsigned* st) {
    XcdBarrier b; b.bar = bar; b.x = xb_xcc_id(); b.st = st;
    if (threadIdx.x == 0) (void)xb_add(&bar[XB_XCNT(b.x)], 1u);
    return b;
}
__device__ __forceinline__ void xcd_barrier_complete(unsigned* bar, unsigned x, unsigned& nloc, unsigned& nx) {
    const unsigned G = gridDim.x * gridDim.y * gridDim.z;
    unsigned sum, cnt, mine, sp = 0u;
    for (;;) {
        sum = 0u; cnt = 0u; mine = 0u;
#pragma unroll
        for (unsigned j = 0; j < 16; ++j) { const unsigned c = xb_ld(&bar[XB_XCNT(j)]); sum += c; cnt += (c > 0u) ? 1u : 0u; mine = (j == x) ? c : mine; }
        if (sum == G) break;
        __builtin_amdgcn_s_sleep(1);
        if ((++sp & 255u) == 0u) { if (xb_ld(&bar[XB_TMO])) break; if (sp > XB_SPIN_CAP) { atomicAdd(&bar[XB_TMO], 1u); break; } }
    }
    nloc = mine > 0u ? mine : 1u; nx = cnt > 0u ? cnt : 1u;
}

__device__ __forceinline__ void xcd_barrier(const XcdBarrier& b) {
    asm volatile("s_waitcnt vmcnt(0)" ::: "memory");
    __syncthreads();
    if (b.wv == 0 && __builtin_amdgcn_mbcnt_hi(~0u, __builtin_amdgcn_mbcnt_lo(~0u, 0u)) == 0u) {
        unsigned* bar = b.bar; asm volatile("" : "+s"(bar));
        __builtin_amdgcn_s_waitcnt(0);
        unsigned nloc = b.st[0], nx = b.st[1];
        if (nloc == 0u) { xcd_barrier_complete(bar, b.x, nloc, nx); b.st[0] = nloc; b.st[1] = nx; }
        const unsigned old = xb_add(&bar[XB_XSUB(b.x)], 1u);
        const unsigned gen = old / nloc;
        if (old + 1u == (gen + 1u) * nloc) {
            __builtin_amdgcn_fence(__ATOMIC_RELEASE, "agent");
            asm volatile("s_waitcnt vmcnt(0)" ::: "memory");
            const unsigned og = xb_add(&bar[XB_TOP], 1u);
            const unsigned tg = og / nx;
            if (og + 1u == (tg + 1u) * nx) xb_add(&bar[XB_TOPGEN], 1u);
            else XB_SPIN(xb_ld(&bar[XB_TOPGEN]) == tg, bar);
            __builtin_amdgcn_fence(__ATOMIC_ACQUIRE, "agent");
            xb_add(&bar[XB_XGEN(b.x)], 1u);
            asm volatile("s_waitcnt vmcnt(0)" ::: "memory");
        } else {
            XB_SPIN(xb_ld(&bar[XB_XGEN(b.x)]) == gen, bar);
            __builtin_amdgcn_fence(__ATOMIC_ACQUIRE, "agent");
            asm volatile("s_waitcnt vmcnt(0)" ::: "memory");
        }
    }
    __syncthreads();
}

using pg8::Unit;
#define ROW_FENCE() asm volatile("" ::: "memory")
__device__ __forceinline__ float row_rs(const float* ssq, int row) {
    const f32x4* p = (const f32x4*)(ssq + (size_t)row * 16);
    const f32x4 a = p[0], b = p[1], c = p[2], d = p[3];
    const float s = (((a[0] + a[1]) + (a[2] + a[3])) + ((b[0] + b[1]) + (b[2] + b[3]))) + (((c[0] + c[1]) + (c[2] + c[3])) + ((d[0] + d[1]) + (d[2] + d[3])));
    return rsqrtf(s * (1.0f / DM) + EPS);
}
__device__ __forceinline__ unsigned pkbf(float lo, float hi) { return (unsigned)f2b(lo) | ((unsigned)f2b(hi) << 16); }
__device__ __forceinline__ u32x4 pack8(const f32x4 a, const f32x4 b) { u32x4 w; w.x = pkbf(a[0], a[1]); w.y = pkbf(a[2], a[3]); w.z = pkbf(b[0], b[1]); w.w = pkbf(b[2], b[3]); return w; }
__device__ __forceinline__ float bflo(unsigned w) { return __uint_as_float(w << 16); }
__device__ __forceinline__ float bfhi(unsigned w) { return __uint_as_float(w & 0xffff0000u); }

struct Epi1 {
    static constexpr bool PERM = true, AFTER_DRAIN = false, HAS_MID = false;
    int mid_t; Ptrs P; int l;
    __device__ __forceinline__ void operator()(const f32x4 (&acc)[2][2][4][2], const Unit& u, int wr, int wc, int fr0, int fq) const {
        int fr = fr0; asm volatile("" : "+v"(fr));
        const float* ssq = (const float*)(P.ws + WS_SSQ);
        const int pn = u.pn, c8 = wc * 32 + 8 * fq, row0 = u.pm * 256 + wr * 64 + fr;
        if (pn < 8) {
            bf16_t* dst = (bf16_t*)(P.ws + (pn < 4 ? WS_LX : WS_GG));
            const int colb = (pn & 3) * 256 + c8;
#pragma unroll
            for (int ai = 0; ai < 2; ++ai)
#pragma unroll
                for (int m = 0; m < 4; ++m) {
                    const int row = row0 + ai * 128 + m * 16; const float rs = row_rs(ssq, row);
#pragma unroll
                    for (int bj = 0; bj < 2; ++bj) {
                        f32x4 v0 = acc[ai][bj][m][0] * rs, v1 = acc[ai][bj][m][1] * rs; const int col = colb + bj * 128;
                        if (pn >= 4) {
#pragma unroll
                            for (int e = 0; e < 4; ++e) { v0[e] = gelu_tanh(v0[e]); v1[e] = gelu_tanh(v1[e]); }
                        }
                        *(u32x4*)(dst + (size_t)row * DR + col) = pack8(v0, v1);
                        if (pn < 4) {
                            if (row < MP) { const int t = row & (SEQ - 1); if (t >= SEQ - 3) { const int b = row >> 13; float* o = P.out + O_CONVP + ((size_t)(l * NB + b) * 3 + (t - (SEQ - 3))) * DR + col; *(f32x4*)o = v0; *(f32x4*)(o + 4) = v1; } }
                            else if (row < MT) { const int b = row - MP; float* cs = P.out + O_CONVS + (size_t)(l * SB + b) * 3 * DR + col; const float* sc = P.state_conv + (size_t)(l * SB + b) * 3 * DR + col;
                                *(f32x4*)cs = *(const f32x4*)(sc + DR); *(f32x4*)(cs + 4) = *(const f32x4*)(sc + DR + 4); *(f32x4*)(cs + DR) = *(const f32x4*)(sc + 2 * DR); *(f32x4*)(cs + DR + 4) = *(const f32x4*)(sc + 2 * DR + 4);
                                *(f32x4*)(cs + 2 * DR) = v0; *(f32x4*)(cs + 2 * DR + 4) = v1; }
                        }
                    }
                    ROW_FENCE();
                }
        } else if (pn < 26) {
            const int tq = pn - 8, type = tq / 6, head = 4 * (tq % 6) + wc, g = head >> 3, hh = head & 7;
            bf16_t* dst = (bf16_t*)(P.ws + (type == 0 ? WS_Q : (type == 1 ? WS_K : WS_V)));
            f32x4 gn[2][2];
#pragma unroll
            for (int bj = 0; bj < 2; ++bj)
#pragma unroll
                for (int n = 0; n < 2; ++n) gn[bj][n] = (f32x4){1.f, 1.f, 1.f, 1.f};
            if (type < 2) { const float* gp = (type == 0 ? P.q_gain : P.k_gain) + l * HD;
#pragma unroll
                for (int bj = 0; bj < 2; ++bj)
#pragma unroll
                    for (int n = 0; n < 2; ++n) gn[bj][n] = *(const f32x4*)(gp + 32 * bj + 8 * fq + 4 * n); }
            const int W = g_win(g);
#pragma unroll
            for (int ai = 0; ai < 2; ++ai)
#pragma unroll
                for (int m = 0; m < 4; ++m) {
                    const int row = row0 + ai * 128 + m * 16; const float rs = row_rs(ssq, row);
                    f32x4 v[2][2]; float ss = 0.f;
#pragma unroll
                    for (int bj = 0; bj < 2; ++bj)
#pragma unroll
                        for (int n = 0; n < 2; ++n) { v[bj][n] = acc[ai][bj][m][n] * rs; const f32x4 q = v[bj][n] * v[bj][n]; ss += (q[0] + q[1]) + (q[2] + q[3]); }
                    ss += __shfl_xor(ss, 16); ss += __shfl_xor(ss, 32);
                    const float inv = (type < 2) ? rsqrtf(ss * (1.0f / HD) + EPS) : 1.0f;
#pragma unroll
                    for (int bj = 0; bj < 2; ++bj) {
                        v[bj][0] = v[bj][0] * inv * gn[bj][0]; v[bj][1] = v[bj][1] * inv * gn[bj][1];
                        *(u32x4*)(dst + (size_t)row * AW + head * HD + 32 * bj + 8 * fq) = pack8(v[bj][0], v[bj][1]);
                    }
                    if (type >= 1) {
                        float* o = nullptr;
                        if (row < MP) { const int t = row & (SEQ - 1), b = row >> 13; if (t >= SEQ - W) o = P.out + o_kvp(g) + ((((size_t)(l * NB + b) * W + (t - (SEQ - W))) * 2 + (type - 1)) * HPG + hh) * HD + 8 * fq; }
                        else if (row < MT) { const int b = row - MP; o = P.out + o_kvs(g) + (((size_t)(l * SB + b) * 2 + (type - 1)) * HPG + hh) * HD + 8 * fq; }
                        if (o) {
#pragma unroll
                            for (int bj = 0; bj < 2; ++bj) { *(f32x4*)(o + 32 * bj) = v[bj][0]; *(f32x4*)(o + 32 * bj + 4) = v[bj][1]; } }
                    }
                    ROW_FENCE();
                }
        } else {
            bf16_t* GM = (bf16_t*)(P.ws + WS_GM); const float* bm = P.b_merge + (size_t)l * 2048;
            const int colb = (pn - 26) * 128 + c8;
            f32x4 bv[2][2];
#pragma unroll
            for (int bj = 0; bj < 2; ++bj)
#pragma unroll
                for (int n = 0; n < 2; ++n) bv[bj][n] = *(const f32x4*)(bm + bj * 1024 + colb + 4 * n);
#pragma unroll
            for (int ai = 0; ai < 2; ++ai)
#pragma unroll
                for (int m = 0; m < 4; ++m) {
                    const int row = row0 + ai * 128 + m * 16; const float rs = row_rs(ssq, row);
                    f32x4 rho[2], gav[2];
#pragma unroll
                    for (int n = 0; n < 2; ++n) {
                        const f32x4 xl = acc[ai][0][m][n] * rs + bv[0][n], xa = acc[ai][1][m][n] * rs + bv[1][n];
#pragma unroll
                        for (int e = 0; e < 4; ++e) { const float el = __expf(-xl[e]), ea = fminf(__expf(-xa[e]), 1e30f); gav[n][e] = __builtin_amdgcn_rcpf(1.0f + ea); rho[n][e] = (1.0f + ea) * __builtin_amdgcn_rcpf(1.0f + el); }
                    }
                    *(u32x4*)(GM + (size_t)row * 2048 + colb) = pack8(rho[0], rho[1]);
                    *(u32x4*)(GM + (size_t)row * 2048 + 1024 + colb) = pack8(gav[0], gav[1]);
                    ROW_FENCE();
                }
        }
    }
};

struct Epi3 {
    static constexpr bool PERM = true, AFTER_DRAIN = false, HAS_MID = true;
    int mid_t; Ptrs P;
    __device__ __forceinline__ void mid(f32x4 (&acc)[2][2][4][2], const Unit& u, int wr, int wc, int fr, int fq) const {
        const bf16_t* GM = (const bf16_t*)(P.ws + WS_GM);
        int fr_ = fr; asm volatile("" : "+v"(fr_));
        const int colb = u.pn * 256 + wc * 32 + 8 * fq, row0 = u.pm * 256 + wr * 64 + fr_;
#pragma unroll
        for (int ai = 0; ai < 2; ++ai)
#pragma unroll
            for (int m = 0; m < 4; ++m) {
                const int row = row0 + ai * 128 + m * 16;
#pragma unroll
                for (int bj = 0; bj < 2; ++bj) {
                    const u32x4 gl = *(const u32x4*)(GM + (size_t)row * 2048 + colb + bj * 128);
                    const f32x4 r0 = (f32x4){bflo(gl.x), bfhi(gl.x), bflo(gl.y), bfhi(gl.y)}, r1 = (f32x4){bflo(gl.z), bfhi(gl.z), bflo(gl.w), bfhi(gl.w)};
                    acc[ai][bj][m][0] = acc[ai][bj][m][0] * r0; acc[ai][bj][m][1] = acc[ai][bj][m][1] * r1;
                }
                ROW_FENCE();
            }
    }
    __device__ __forceinline__ void operator()(const f32x4 (&acc)[2][2][4][2], const Unit& u, int wr, int wc, int fr0, int fq) const {
        int fr = fr0; asm volatile("" : "+v"(fr));
        const bf16_t* GM = (const bf16_t*)(P.ws + WS_GM); bf16_t* MRG = (bf16_t*)(P.ws + WS_MRG);
        const int colb = u.pn * 256 + wc * 32 + 8 * fq, row0 = u.pm * 256 + wr * 64 + fr;
#pragma unroll
        for (int ai = 0; ai < 2; ++ai)
#pragma unroll
            for (int m = 0; m < 4; ++m) {
                const int row = row0 + ai * 128 + m * 16;
#pragma unroll
                for (int bj = 0; bj < 2; ++bj) {
                    const u32x4 ga = *(const u32x4*)(GM + (size_t)row * 2048 + 1024 + colb + bj * 128);
                    const f32x4 g0 = (f32x4){bflo(ga.x), bfhi(ga.x), bflo(ga.y), bfhi(ga.y)}, g1 = (f32x4){bflo(ga.z), bfhi(ga.z), bflo(ga.w), bfhi(ga.w)};
                    *(u32x4*)(MRG + (size_t)row * DM + colb + bj * 128) = pack8(acc[ai][bj][m][0] * g0, acc[ai][bj][m][1] * g1);
                }
                ROW_FENCE();
            }
    }
};

struct EpiRes {
    static constexpr bool PERM = false, AFTER_DRAIN = false, HAS_MID = false;
    int mid_t; Ptrs P; int first;
    __device__ __forceinline__ void operator()(const f32x4 (&acc)[2][2][4][2], const Unit& u, int wr, int wc, int fr0, int fq) const {
        int fr = fr0; asm volatile("" : "+v"(fr));
        float* Y = P.out + O_Y; bf16_t* XB = (bf16_t*)(P.ws + WS_XB); float* ssq = (float*)(P.ws + WS_SSQ);
        const int colb = u.pn * 256 + wc * 32 + 4 * fq, row0 = u.pm * 256 + wr * 64 + fr;
#pragma unroll
        for (int ai = 0; ai < 2; ++ai)
#pragma unroll
            for (int m = 0; m < 4; ++m) {
                const int row = row0 + ai * 128 + m * 16; const bool live = row < MT;
                const float* base = first ? xin_row(P, live ? row : 0) : Y + (size_t)(live ? row : 0) * DM;
                float ss = 0.f;
#pragma unroll
                for (int bj = 0; bj < 2; ++bj)
#pragma unroll
                    for (int n = 0; n < 2; ++n) {
                        const int col = colb + bj * 128 + n * 16;
                        f32x4 v = acc[ai][bj][m][n];
                        if (live) { v = v + *(const f32x4*)(base + col); *(f32x4*)(Y + (size_t)row * DM + col) = v; }
                        u32x2 w; w.x = pkbf(v[0], v[1]); w.y = pkbf(v[2], v[3]);
                        *(u32x2*)(XB + (size_t)row * DM + col) = w;
                        ss += (v[0] * v[0] + v[1] * v[1]) + (v[2] * v[2] + v[3] * v[3]);
                    }
                ss += __shfl_xor(ss, 16); ss += __shfl_xor(ss, 32);
                if (fq == 0) ssq[(size_t)row * 16 + u.pn * 4 + wc] = ss;
                ROW_FENCE();
            }
    }
};

struct Epi5 {
    static constexpr bool PERM = true, AFTER_DRAIN = false, HAS_MID = false;
    int mid_t; Ptrs P;
    __device__ __forceinline__ void operator()(const f32x4 (&acc)[2][2][4][2], const Unit& u, int wr, int wc, int fr0, int fq) const {
        int fr = fr0; asm volatile("" : "+v"(fr));
        const float* ssq = (const float*)(P.ws + WS_SSQ); bf16_t* H = (bf16_t*)(P.ws + WS_H);
        const int colb = u.pn * 128 + wc * 32 + 8 * fq, row0 = u.pm * 256 + wr * 64 + fr;
#pragma unroll
        for (int ai = 0; ai < 2; ++ai)
#pragma unroll
            for (int m = 0; m < 4; ++m) {
                const int row = row0 + ai * 128 + m * 16; const float rs = row_rs(ssq, row);
                f32x4 h[2];
#pragma unroll
                for (int n = 0; n < 2; ++n)
#pragma unroll
                    for (int e = 0; e < 4; ++e) { const float gt = acc[ai][0][m][n][e] * rs, up = acc[ai][1][m][n][e] * rs; h[n][e] = gt * sigmoidf_(gt) * up; }
                *(u32x4*)(H + (size_t)row * DFF + colb) = pack8(h[0], h[1]);
                ROW_FENCE();
            }
    }
};

__device__ __forceinline__ void p0_prologue(const Ptrs& P, size_t tid, size_t nth) {
    for (int l = 0; l < DEPTH; ++l) {
        unsigned char* wb = P.ws + WS_W + l * LW_BYTES;
        bf16_t* W1 = (bf16_t*)(wb + LW_W1); bf16_t* W3 = (bf16_t*)(wb + LW_W3);
        bf16_t* W4 = (bf16_t*)(wb + LW_W4); bf16_t* W5 = (bf16_t*)(wb + LW_W5); bf16_t* W6 = (bf16_t*)(wb + LW_W6);
        const float* w_in = P.w_in + (size_t)l * DM * 6656; const float* w_merge = P.w_merge + (size_t)l * DM * 2048;
        const float* nm = P.norm_mix + l * DM; const float* nf = P.norm_ffn + l * DM;
        for (size_t e = tid; e < (size_t)N1 * DM; e += nth) { const int n = (int)(e % N1), k = (int)(e / N1); const int c = w1_src_col(n);
            const float v = (c < 6656 ? w_in[(size_t)k * 6656 + c] : w_merge[(size_t)k * 2048 + (c - 6656)]) * nm[k]; W1[(size_t)n * DM + k] = f2b(v); }
        const float* wl = P.w_branch_lru + (size_t)l * DR * DM;
        for (size_t e = tid; e < (size_t)DM * DR; e += nth) { const int n = (int)(e % DM), k = (int)(e / DM); W3[(size_t)n * K3 + k] = f2b(wl[(size_t)k * DM + n]); }
        const float* wa = P.w_branch_att + (size_t)l * AO * DM;
        for (size_t e = tid; e < (size_t)DM * AO; e += nth) { const int n = (int)(e % DM), k = (int)(e / DM); W3[(size_t)n * K3 + DR + k] = f2b(wa[(size_t)k * DM + n]); }
        const float* wo = P.w_o + (size_t)l * DM * DM;
        for (size_t e = tid; e < (size_t)DM * DM; e += nth) { const int n = (int)(e % DM), k = (int)(e / DM); W4[(size_t)n * DM + k] = f2b(wo[(size_t)k * DM + n]); }
        const float* wf = P.w_ffn_in + (size_t)l * DM * 2 * DFF;
        for (size_t e = tid; e < (size_t)2 * DFF * DM; e += nth) { const int n = (int)(e % (2 * DFF)), k = (int)(e / (2 * DFF)); W5[(size_t)n * DM + k] = f2b(wf[(size_t)k * 2 * DFF + w5_src_col(n)] * nf[k]); }
        const float* wf2 = P.w_ffn_out + (size_t)l * DFF * DM;
        for (size_t e = tid; e < (size_t)DM * DFF; e += nth) { const int n = (int)(e % DM), k = (int)(e / DM); W6[(size_t)n * DFF + k] = f2b(wf2[(size_t)k * DM + n]); }
    }
    float* BIAS = (float*)(P.ws + WS_BIAS);
    for (size_t e = tid; e < (size_t)NG * HPG * NKEY; e += nth) {
        const int kk = (int)(e % NKEY), hh = (int)((e / NKEY) % HPG), g = (int)(e / (NKEY * HPG));
        const int d = kk * g_dil(g); int bkt;
        if (d < 16) bkt = d; else { const float df = (float)d; int lg = 16 + (int)(logf(df / 16.0f) / logf(128.0f) * 16.0f); bkt = lg < 31 ? lg : 31; }
        BIAS[e] = P.rel_bias[bkt * NH + 8 * g + hh];
    }
    const int lane = (int)(tid & 63);
    for (size_t row = tid >> 6; row < (size_t)MT; row += nth >> 6) {
        const float* xr = xin_row(P, (int)row); bf16_t* xb = (bf16_t*)(P.ws + WS_XB) + row * DM; float* ssq = (float*)(P.ws + WS_SSQ) + row * 16;
        float s = 0.f;
        for (int c = lane; c < DM; c += 64) { const float v = xr[c]; s += v * v; xb[c] = f2b(v); }
        s = wave_sum(s);
        if (lane < 16) ssq[lane] = (lane == 0) ? s : 0.f;
    }
}

__device__ __forceinline__ void ph_conv(const Ptrs& P, int l, size_t gtid, size_t nth) {
    const bf16_t* LX = (const bf16_t*)(P.ws + WS_LX);
    const float* wc = P.w_conv + (size_t)l * CW * DR;
    for (size_t e = gtid; e < (size_t)MT * DR; e += nth) {
        const int row = (int)(e / DR), ch = (int)(e % DR);
        float acc = P.b_conv[l * DR + ch];
        if (row < MP) { const int t = row % SEQ;
#pragma unroll
            for (int k = 0; k < CW; ++k) { const int tt = t + k - 3; if (tt >= 0) acc += wc[k * DR + ch] * bf2f(LX[(size_t)(row + k - 3) * DR + ch]); } }
        else { const int b = row - MP; const float* sc = P.state_conv + (size_t)(l * SB + b) * 3 * DR;
            acc += wc[0 * DR + ch] * sc[ch] + wc[1 * DR + ch] * sc[DR + ch] + wc[2 * DR + ch] * sc[2 * DR + ch] + wc[3 * DR + ch] * bf2f(LX[(size_t)row * DR + ch]); }
        ((float*)(P.ws + WS_XC))[e] = acc;
    }
}
__device__ __forceinline__ void ph_gates(const Ptrs& P, int l, size_t gtid, size_t nth) {
    for (size_t e = gtid; e < (size_t)MT * DR; e += nth) {
        const int row = (int)(e / DR), ch = (int)(e % DR), n = ch >> 6, j = ch & 63;
        const float* XC = (const float*)(P.ws + WS_XC) + (size_t)row * DR + n * 64;
        const float* wa = P.w_rg_a + ((size_t)(l * NBLK + n) * 64) * 64 + j; const float* wx = P.w_rg_x + ((size_t)(l * NBLK + n) * 64) * 64 + j;
        float ga = P.b_rg_a[l * DR + ch], gx = P.b_rg_x[l * DR + ch];
        for (int i = 0; i < 64; ++i) { const float x = XC[i]; ga += x * wa[i * 64]; gx += x * wx[i * 64]; }
        const float rr = sigmoidf_(ga), ii = sigmoidf_(gx);
        const float lam = P.lru_lambda[l * DR + ch]; const float sp = log1pf(expf(-lam));
        const float log_a = -8.0f * rr * sp; const float av = expf(log_a);
        const bool pos0 = (row < MP) && (row % SEQ == 0);
        const float mult = pos0 ? 1.0f : sqrtf(-expm1f(2.0f * log_a));
        ((float*)(P.ws + WS_AA))[e] = av; ((float*)(P.ws + WS_UU))[e] = mult * ii * XC[j];
    }
}
__device__ __forceinline__ void ph_scan(const Ptrs& P, int l, size_t gtid, size_t nth) {
    const float* AA = (const float*)(P.ws + WS_AA); const float* UU = (const float*)(P.ws + WS_UU);
    const bf16_t* GG = (const bf16_t*)(P.ws + WS_GG); bf16_t* A3 = (bf16_t*)(P.ws + WS_A3);
    for (size_t e = gtid; e < (size_t)(NB + SB) * DR; e += nth) {
        const int s = (int)(e / DR), ch = (int)(e % DR);
        if (s < NB) { float h = 0.f; const size_t r0 = (size_t)s * SEQ;
            for (int t = 0; t < SEQ; t += 8) { float av[8], u[8], g[8];
#pragma unroll
                for (int i = 0; i < 8; ++i) { const size_t o = (r0 + t + i) * DR + ch; av[i] = AA[o]; u[i] = UU[o]; g[i] = bf2f(GG[o]); }
#pragma unroll
                for (int i = 0; i < 8; ++i) { h = av[i] * h + u[i]; A3[(r0 + t + i) * K3 + ch] = f2b(h * g[i]); } }
            P.out[O_HP + (size_t)(l * NB + s) * DR + ch] = h;
        } else { const int b = s - NB; const size_t o = (size_t)(MP + b) * DR + ch; float h = P.state_h[(size_t)(l * SB + b) * DR + ch];
            h = AA[o] * h + UU[o]; A3[(size_t)(MP + b) * K3 + ch] = f2b(h * bf2f(GG[o])); P.out[O_HS + (size_t)(l * SB + b) * DR + ch] = h; }
    }
}
__device__ __forceinline__ void ph_attn(const Ptrs& P, int l, int gwave, int nwaves, int lane, LAS float* qw) {
    const bf16_t* Q = (const bf16_t*)(P.ws + WS_Q); const bf16_t* K = (const bf16_t*)(P.ws + WS_K); const bf16_t* V = (const bf16_t*)(P.ws + WS_V);
    for (int gw = gwave; gw < MT * NH; gw += nwaves) {
        const int row = gw / NH, head = gw % NH, g = head / HPG, hh = head % HPG, dil = g_dil(g);
        const float* BIAS = (const float*)(P.ws + WS_BIAS) + (size_t)(g * HPG + hh) * NKEY;
        const bool samp = row >= MP; const int b = samp ? row - MP : row / SEQ, t = samp ? 0 : row % SEQ;
        const int nkeys = samp ? NKEY : ((t / dil) < 128 ? (t / dil) + 1 : NKEY);
        const float* cbase = (g == 0 ? P.cache[0] : (g == 1 ? P.cache[1] : P.cache[2]));
        const float* cache = cbase + (size_t)(l * SB + (samp ? b : 0)) * g_win(g) * 1024;
        const int Lc = g_win(g);
        asm volatile("" ::: "memory");
        qw[lane] = bf2f(Q[(size_t)row * AW + head * HD + lane]);
        asm volatile("s_waitcnt lgkmcnt(0)" ::: "memory");
        float s[3];
#pragma unroll
        for (int j = 0; j < 3; ++j) { const int kk = lane + 64 * j; float acc = -INFINITY;
            if (kk < nkeys) { acc = 0.f;
                if (!samp || kk == 0) { const bf16_t* kr = K + (size_t)(row - kk * dil) * AW + head * HD;
                    for (int d = 0; d < HD; ++d) acc += qw[d] * bf2f(kr[d]); }
                else { const float* kr = cache + ((size_t)(Lc - kk * dil) * 2 + 0) * 512 + hh * HD;
                    for (int d = 0; d < HD; ++d) acc += qw[d] * kr[d]; }
                acc = acc * 0.125f + BIAS[kk]; }
            s[j] = acc; }
        const float m = wave_max(fmaxf(fmaxf(s[0], s[1]), s[2]));
        float p[3]; float lsum = 0.f;
#pragma unroll
        for (int j = 0; j < 3; ++j) { p[j] = (lane + 64 * j < nkeys) ? __expf(s[j] - m) : 0.f; lsum += p[j]; }
        lsum = wave_sum(lsum);
        float o = 0.f;
        for (int kk = 0; kk < nkeys; ++kk) { const float pk = __shfl(kk < 64 ? p[0] : (kk < 128 ? p[1] : p[2]), kk & 63);
            float vv;
            if (!samp || kk == 0) vv = bf2f(V[(size_t)(row - kk * dil) * AW + head * HD + lane]);
            else vv = cache[((size_t)(Lc - kk * dil) * 2 + 1) * 512 + hh * HD + lane];
            o += pk * vv; }
        bf16_t* OG = (bf16_t*)(P.ws + WS_OG) + ((size_t)g * MT + row) * AO; OG[hh * HD + lane] = f2b(o / lsum);
        if (lane == 0) { float* ML = (float*)(P.ws + WS_ML) + (((size_t)g * MT + row) * HPG + hh) * 2; ML[0] = m; ML[1] = lsum; }
    }
}
__device__ __forceinline__ void ph_combine(const Ptrs& P, size_t gtid, size_t nth) {
    const bf16_t* OG = (const bf16_t*)(P.ws + WS_OG); const float* ML = (const float*)(P.ws + WS_ML);
    for (size_t e = gtid; e < (size_t)MT * AO; e += nth) {
        const int row = (int)(e / AO), c = (int)(e % AO), hh = c >> 6;
        float m[3], lz[3], mm = -INFINITY;
#pragma unroll
        for (int g = 0; g < 3; ++g) { const float* q = ML + (((size_t)g * MT + row) * HPG + hh) * 2; m[g] = q[0]; lz[g] = q[1]; mm = fmaxf(mm, m[g]); }
        float num = 0.f, den = 0.f;
#pragma unroll
        for (int g = 0; g < 3; ++g) { const float z = lz[g] * __expf(m[g] - mm); num += z * bf2f(OG[((size_t)g * MT + row) * AO + c]); den += z; }
        ((bf16_t*)(P.ws + WS_A3))[(size_t)row * K3 + DR + c] = f2b(num / den);
    }
}

constexpr int SC_XCF = 0;
constexpr int SC_HSF = 34816;
constexpr int SC_XCB = 69632;
constexpr int SC_WTA = 88064;
constexpr int SC_WTX = 97280;
constexpr int SC_WTOT = 106496;
constexpr int SC_WC = 110592;
constexpr int SC_END = 111872;
typedef float f32x2 __attribute__((ext_vector_type(2)));

template <int MODE>
__device__ __forceinline__ void scan_item(const Ptrs& P, int l, LAS unsigned char* lds, int wv, int tid, int b, int n, int span) {
    const int lane = tid & 63, fr = lane & 15, fq = lane >> 4;
    LAS float* XCF = (LAS float*)(lds + SC_XCF); LAS float* HSF = (LAS float*)(lds + SC_HSF); LAS bf16_t* XCB = (LAS bf16_t*)(lds + SC_XCB);
    LAS bf16_t* WTA = (LAS bf16_t*)(lds + SC_WTA); LAS bf16_t* WTX = (LAS bf16_t*)(lds + SC_WTX);
    LAS f32x2* WTOT = (LAS f32x2*)(lds + SC_WTOT); LAS float* WC = (LAS float*)(lds + SC_WC);
    const bf16_t* LX = (const bf16_t*)(P.ws + WS_LX); const bf16_t* GG = (const bf16_t*)(P.ws + WS_GG); bf16_t* A3 = (bf16_t*)(P.ws + WS_A3);
    float* SUM = (float*)(P.ws + WS_SUM);
    __syncthreads();
    {
        const float* wa = P.w_rg_a + (size_t)(l * NBLK + n) * 4096; const float* wx = P.w_rg_x + (size_t)(l * NBLK + n) * 4096;
        for (int e = tid; e < 4096; e += 512) { const int i = e >> 6, j = e & 63; WTA[j * 72 + i] = f2b(wa[e]); WTX[j * 72 + i] = f2b(wx[e]); }
        if (tid < 320) { const int k = tid >> 6, c = tid & 63; WC[tid] = (k < 4) ? P.w_conv[(size_t)(l * CW + k) * DR + 64 * n + c] : P.b_conv[l * DR + 64 * n + c]; }
    }
    __syncthreads();
    bf16x8 wfa[4][2], wfx[4][2];
#pragma unroll
    for (int nt = 0; nt < 4; ++nt)
#pragma unroll
        for (int ks = 0; ks < 2; ++ks) { wfa[nt][ks] = *(const LAS bf16x8*)(WTA + (16 * nt + fr) * 72 + 32 * ks + 8 * fq); wfx[nt][ks] = *(const LAS bf16x8*)(WTX + (16 * nt + fr) * 72 + 32 * ks + 8 * fq); }
    float cba[4], cbx[4], csp[4], hc[4], pc[4];
#pragma unroll
    for (int nt = 0; nt < 4; ++nt) { const int ch = 64 * n + 16 * nt + fr;
        cba[nt] = P.b_rg_a[l * DR + ch]; cbx[nt] = P.b_rg_x[l * DR + ch]; csp[nt] = 8.0f * log1pf(expf(-P.lru_lambda[l * DR + ch]));
        float h = 0.f;
        if (MODE == 1) { for (int s = 0; s < span; ++s) { const f32x2 q = *(const f32x2*)(SUM + (((size_t)b * 8 + s) * DR + ch) * 2); h = q.x * h + q.y; } }
        hc[nt] = h; pc[nt] = 1.f; }
    for (int c8 = 0; c8 < 8; ++c8) {
        const int t0 = span * 1024 + c8 * 128;
        u32x4 gg[2];
#pragma unroll
        for (int rep = 0; rep < 2; ++rep) {
            const int idx = tid + 512 * rep, tok = idx >> 3, cg = idx & 7, t = t0 + tok; const size_t rowg = (size_t)b * SEQ + t;
            float acc[8];
#pragma unroll
            for (int j = 0; j < 8; ++j) acc[j] = WC[4 * 64 + 8 * cg + j];
#pragma unroll
            for (int k = 0; k < 4; ++k) { const int tt = t + k - 3;
                if (tt >= 0) { const u32x4 x = *(const u32x4*)(LX + (rowg + k - 3) * DR + 64 * n + 8 * cg);
                    const LAS float* w = WC + k * 64 + 8 * cg;
                    acc[0] += w[0] * bflo(x.x); acc[1] += w[1] * bfhi(x.x); acc[2] += w[2] * bflo(x.y); acc[3] += w[3] * bfhi(x.y);
                    acc[4] += w[4] * bflo(x.z); acc[5] += w[5] * bfhi(x.z); acc[6] += w[6] * bflo(x.w); acc[7] += w[7] * bfhi(x.w); } }
            *(LAS f32x4*)(XCF + tok * 68 + 8 * cg) = (f32x4){acc[0], acc[1], acc[2], acc[3]}; *(LAS f32x4*)(XCF + tok * 68 + 8 * cg + 4) = (f32x4){acc[4], acc[5], acc[6], acc[7]};
            *(LAS u32x4*)(XCB + tok * 72 + 8 * cg) = pack8((f32x4){acc[0], acc[1], acc[2], acc[3]}, (f32x4){acc[4], acc[5], acc[6], acc[7]});
            if (MODE == 1) gg[rep] = *(const u32x4*)(GG + rowg * DR + 64 * n + 8 * cg);
        }
        __syncthreads();
        bf16x8 af[2];
#pragma unroll
        for (int ks = 0; ks < 2; ++ks) af[ks] = *(const LAS bf16x8*)(XCB + (16 * wv + fr) * 72 + 32 * ks + 8 * fq);
        float hl[4][4], ac[4][4], Ae[4], He[4];
#pragma unroll
        for (int nt = 0; nt < 4; ++nt) {
            f32x4 da = (f32x4){0.f, 0.f, 0.f, 0.f}, dx = (f32x4){0.f, 0.f, 0.f, 0.f};
#pragma unroll
            for (int ks = 0; ks < 2; ++ks) { da = __builtin_amdgcn_mfma_f32_16x16x32_bf16(af[ks], wfa[nt][ks], da, 0, 0, 0); dx = __builtin_amdgcn_mfma_f32_16x16x32_bf16(af[ks], wfx[nt][ks], dx, 0, 0, 0); }
            float A = 1.f, H = 0.f;
#pragma unroll
            for (int r = 0; r < 4; ++r) {
                const int tok = 16 * wv + 4 * fq + r;
                const float rr = sigmoidf_(da[r] + cba[nt]), ii = sigmoidf_(dx[r] + cbx[nt]);
                const float av = __expf(-rr * csp[nt]);
                float mult = sqrtf(fmaxf(fmaf(-av, av, 1.0f), 0.f)); if (t0 + tok == 0) mult = 1.0f;
                const float u = mult * ii * XCF[tok * 68 + 16 * nt + fr];
                H = av * H + u; A = A * av; hl[nt][r] = H; ac[nt][r] = A;
            }
            { const float A1 = __shfl(A, lane - 16), H1 = __shfl(H, lane - 16); if (fq >= 1) { H = A * H1 + H; A = A * A1; } }
            { const float A2 = __shfl(A, lane - 32), H2 = __shfl(H, lane - 32); if (fq >= 2) { H = A * H2 + H; A = A * A2; } }
            { const float A3_ = __shfl(A, lane - 16), H3 = __shfl(H, lane - 16); Ae[nt] = (fq >= 1) ? A3_ : 1.f; He[nt] = (fq >= 1) ? H3 : 0.f; }
            if (fq == 3) WTOT[wv * 64 + 16 * nt + fr] = (f32x2){A, H};
        }
        __syncthreads();
#pragma unroll
        for (int nt = 0; nt < 4; ++nt) {
            float hrun = hc[nt], prun = pc[nt], hin = 0.f;
#pragma unroll
            for (int w = 0; w < 8; ++w) { const f32x2 q = WTOT[w * 64 + 16 * nt + fr]; if (w == wv) hin = hrun; hrun = q.x * hrun + q.y; prun = prun * q.x; }
            hc[nt] = hrun; pc[nt] = prun;
            if (MODE == 1) {
#pragma unroll
                for (int r = 0; r < 4; ++r) { const int tok = 16 * wv + 4 * fq + r; HSF[tok * 68 + 16 * nt + fr] = (ac[nt][r] * Ae[nt]) * hin + (ac[nt][r] * He[nt] + hl[nt][r]); }
            }
        }
        if (MODE == 1) {
            __syncthreads();
#pragma unroll
            for (int rep = 0; rep < 2; ++rep) {
                const int idx = tid + 512 * rep, tok = idx >> 3, cg = idx & 7; const size_t rowg = (size_t)b * SEQ + t0 + tok;
                const f32x4 h0 = *(const LAS f32x4*)(HSF + tok * 68 + 8 * cg), h1 = *(const LAS f32x4*)(HSF + tok * 68 + 8 * cg + 4);
                const u32x4 g = gg[rep];
                const f32x4 o0 = (f32x4){h0[0] * bflo(g.x), h0[1] * bfhi(g.x), h0[2] * bflo(g.y), h0[3] * bfhi(g.y)}, o1 = (f32x4){h1[0] * bflo(g.z), h1[1] * bfhi(g.z), h1[2] * bflo(g.w), h1[3] * bfhi(g.w)};
                *(u32x4*)(A3 + rowg * K3 + 64 * n + 8 * cg) = pack8(o0, o1);
            }
        }
    }
    if (wv == 0 && fq == 0) {
#pragma unroll
        for (int nt = 0; nt < 4; ++nt) { const int ch = 64 * n + 16 * nt + fr;
            if (MODE == 0) *(f32x2*)(SUM + (((size_t)b * 8 + span) * DR + ch) * 2) = (f32x2){pc[nt], hc[nt]};
            else if (span == 7) P.out[O_HP + (size_t)(l * NB + b) * DR + ch] = hc[nt]; }
    }
}
__device__ __forceinline__ void scan_sample(const Ptrs& P, int l, LAS unsigned char* lds, int tid, int rg, int n) {
    LAS float* XS = (LAS float*)lds;
    const int r = tid >> 6, j = tid & 63, b = 8 * rg + r, ch = 64 * n + j; const size_t row = (size_t)MP + b;
    const bf16_t* LX = (const bf16_t*)(P.ws + WS_LX); const bf16_t* GG = (const bf16_t*)(P.ws + WS_GG); bf16_t* A3 = (bf16_t*)(P.ws + WS_A3);
    const float* wc = P.w_conv + (size_t)l * CW * DR; const float* sc = P.state_conv + (size_t)(l * SB + b) * 3 * DR;
    const float xc = P.b_conv[l * DR + ch] + wc[ch] * sc[ch] + wc[DR + ch] * sc[DR + ch] + wc[2 * DR + ch] * sc[2 * DR + ch] + wc[3 * DR + ch] * bf2f(LX[row * DR + ch]);
    __syncthreads();
    XS[r * 64 + j] = xc;
    __syncthreads();
    const float* wa = P.w_rg_a + (size_t)(l * NBLK + n) * 4096 + j; const float* wx = P.w_rg_x + (size_t)(l * NBLK + n) * 4096 + j;
    float ga = P.b_rg_a[l * DR + ch], gx = P.b_rg_x[l * DR + ch];
    for (int i = 0; i < 64; ++i) { const float x = XS[r * 64 + i]; ga += x * wa[i * 64]; gx += x * wx[i * 64]; }
    const float rr = sigmoidf_(ga), ii = sigmoidf_(gx);
    const float log_a = -8.0f * rr * log1pf(expf(-P.lru_lambda[l * DR + ch])); const float av = expf(log_a);
    const float mult = sqrtf(-expm1f(2.0f * log_a));
    const float h = av * P.state_h[(size_t)(l * SB + b) * DR + ch] + mult * ii * xc;
    P.out[O_HS + (size_t)(l * SB + b) * DR + ch] = h;
    A3[row * K3 + ch] = f2b(h * bf2f(GG[row * DR + ch]));
}

constexpr int RING_BYTES = 131072, LDSCTL_OFF = RING_BYTES, MISC_OFF = LDSCTL_OFF + 320, LDS_BYTES = 147456;
constexpr int CW_BAR = 4096;
constexpr int NPH = 1 + 8 * DEPTH;
#ifndef PHMASK
#define PHMASK 63
#endif
struct Args { Ptrs P; int ph_lo, ph_hi, pad0, pad1; };

__global__ void __launch_bounds__(512, 2) mega(Args a) {
    extern __shared__ __attribute__((aligned(16))) unsigned char lds_raw[];
    LAS unsigned char* lds = (LAS unsigned char*)lds_raw;
    const int wv = __builtin_amdgcn_readfirstlane(threadIdx.x >> 6);
#define TID() ((wv << 6) | (int)__builtin_amdgcn_mbcnt_hi(~0u, __builtin_amdgcn_mbcnt_lo(~0u, 0u)))
    { const int tid = TID(); for (int u = tid; u < (LDS_BYTES - LDSCTL_OFF) / 4; u += 512) ((LAS unsigned*)(lds + LDSCTL_OFF))[u] = 0u; }
    __syncthreads();
    unsigned char* ws0 = a.P.ws;
    XcdBarrier bar; bar.bar = (unsigned*)(ws0 + WS_CTL) + CW_BAR; bar.x = 0; bar.st = nullptr; bar.wv = wv;
    if (a.ph_hi - a.ph_lo > 1) bar = xcd_barrier_post((unsigned*)(ws0 + WS_CTL) + CW_BAR, (volatile LAS unsigned*)(lds + MISC_OFF) + 8);
    bar.wv = wv;
    const int G = gridDim.x;
    for (int ph = a.ph_lo; ph < a.ph_hi; ++ph) {
        const Ptrs& P = a.P;
        int bid = blockIdx.x; asm volatile("" : "+s"(bid));
        unsigned char* ws = P.ws;
        if (ph == 0 && (PHMASK & 32)) {
            int t_ = TID(); asm volatile("" : "+v"(t_));
            p0_prologue(P, (size_t)bid * 512 + t_, (size_t)G * 512);
        } else {
            const int l = __builtin_amdgcn_readfirstlane((ph - 1) >> 3), p = __builtin_amdgcn_readfirstlane((ph - 1) & 7);
            unsigned char* wb = ws + WS_W + l * LW_BYTES;
            if (p == 0 && (PHMASK & 1)) {
                pg8::Gemm g{(const bf16_t*)(ws + WS_XB), (const bf16_t*)(wb + LW_W1), MPAD, N1, DM, wv}; pg8::StaticOrder S; S.init(MPAD, N1, G, bid);
                Epi1 E{0, P, l}; pg8::gemm_phase<Epi1, pg8::StaticOrder, true, true>(lds, g, S, E);
            } else if (p == 4 && (PHMASK & 2)) {
                pg8::Gemm g{(const bf16_t*)(ws + WS_A3), (const bf16_t*)(wb + LW_W3), MPAD, DM, K3, wv}; pg8::StaticOrder S; S.init(MPAD, DM, G, bid);
                Epi3 E{DR / 64, P}; pg8::gemm_phase<Epi3, pg8::StaticOrder, true, true>(lds, g, S, E);
            } else if (p == 5 && (PHMASK & 4)) {
                pg8::Gemm g{(const bf16_t*)(ws + WS_MRG), (const bf16_t*)(wb + LW_W4), MPAD, DM, DM, wv}; pg8::StaticOrder S; S.init(MPAD, DM, G, bid);
                EpiRes E{0, P, l == 0 ? 1 : 0}; pg8::gemm_phase<EpiRes, pg8::StaticOrder, true, true>(lds, g, S, E);
            } else if (p == 6 && (PHMASK & 8)) {
                pg8::Gemm g{(const bf16_t*)(ws + WS_XB), (const bf16_t*)(wb + LW_W5), MPAD, 2 * DFF, DM, wv}; pg8::StaticOrder S; S.init(MPAD, 2 * DFF, G, bid);
                Epi5 E{0, P}; pg8::gemm_phase<Epi5, pg8::StaticOrder, true, true>(lds, g, S, E);
            } else if (p == 7 && (PHMASK & 16)) {
                pg8::Gemm g{(const bf16_t*)(ws + WS_H), (const bf16_t*)(wb + LW_W6), MPAD, DM, DFF, wv}; pg8::StaticOrder S; S.init(MPAD, DM, G, bid);
                EpiRes E{0, P, 0}; pg8::gemm_phase<EpiRes, pg8::StaticOrder, true, true>(lds, g, S, E);
            } else if (p >= 1 && p <= 3) {
                int t_ = TID(); asm volatile("" : "+v"(t_));
                const size_t gtid = (size_t)bid * 512 + t_, nth = (size_t)G * 512;
                if (p == 1) {
                    for (int it = bid; it < 256; it += G) scan_item<0>(P, l, lds, wv, t_, it >> 7, (it >> 3) & 15, it & 7);
                    __syncthreads();
                    ph_attn(P, l, bid * 8 + wv, G * 8, t_ & 63, (LAS float*)lds + wv * 64);
                } else if (p == 2) {
                    for (int it = bid; it < 256; it += G) scan_item<1>(P, l, lds, wv, t_, it >> 7, (it >> 3) & 15, it & 7);
                    for (int it = bid; it < 64; it += G) scan_sample(P, l, lds, t_, it >> 4, it & 15);
                    ph_combine(P, gtid, nth);
                }
            }
        }
        if (ph + 1 < a.ph_hi) xcd_barrier(bar);
    }
}

extern "C" void kernel_launch(void* const* d_in, const int* in_sizes, int n_in, void* d_out, int out_size, void* d_ws, size_t ws_size, hipStream_t stream) {
    static int grid = 0;
    if (grid == 0) {
        if (n_in != 27 || (size_t)out_size != O_END || ws_size < WS_END) { fprintf(stderr, "kernel_launch: unexpected sizes n_in %d out %d (want %zu) ws %zu (want %zu)\n", n_in, out_size, (size_t)O_END, ws_size, (size_t)WS_END); grid = -1; return; }
        int dev = 0, cus = 0;
        if (hipGetDevice(&dev) != hipSuccess || hipDeviceGetAttribute(&cus, hipDeviceAttributeMultiprocessorCount, dev) != hipSuccess) { grid = -1; return; }
        if (hipFuncSetAttribute((const void*)mega, hipFuncAttributeMaxDynamicSharedMemorySize, LDS_BYTES) != hipSuccess) { fprintf(stderr, "kernel_launch: hipFuncSetAttribute failed\n"); grid = -1; return; }
        grid = cus;
    }
    if (grid < 0) return;
    Args a{};
    Ptrs& P = a.P;
    const float* const* in = (const float* const*)d_in;
    P.x_prompt = in[0]; P.x_sample = in[1]; P.cache[0] = in[2]; P.cache[1] = in[3]; P.cache[2] = in[4]; P.state_conv = in[5]; P.state_h = in[6]; P.rel_bias = in[7];
    P.norm_mix = in[8]; P.w_in = in[9]; P.w_conv = in[10]; P.b_conv = in[11]; P.w_rg_a = in[12]; P.b_rg_a = in[13]; P.w_rg_x = in[14]; P.b_rg_x = in[15];
    P.lru_lambda = in[16]; P.q_gain = in[17]; P.k_gain = in[18]; P.w_merge = in[19]; P.b_merge = in[20]; P.w_branch_lru = in[21]; P.w_branch_att = in[22];
    P.w_o = in[23]; P.norm_ffn = in[24]; P.w_ffn_in = in[25]; P.w_ffn_out = in[26];
    P.out = (float*)d_out; P.ws = (unsigned char*)d_ws;
    (void)hipMemsetAsync((char*)d_ws + WS_CTL, 0, CTL_ZERO_BYTES, stream);
    a.ph_lo = 0; a.ph_hi = NPH;
    hipLaunchKernelGGL(mega, dim3(grid), dim3(512), LDS_BYTES, stream, a);
}
```

```cpp
#include <hip/hip_runtime.h>
#include <stdint.h>
#include <stdio.h>

typedef unsigned short bf16_t;
typedef short bf16x8 __attribute__((ext_vector_type(8)));
typedef float f32x4 __attribute__((ext_vector_type(4)));
typedef unsigned u32x4 __attribute__((ext_vector_type(4)));
typedef unsigned u32x2 __attribute__((ext_vector_type(2)));

constexpr int DM = 1024, NB = 2, SEQ = 8192, DEPTH = 2, SB = 32, PAST = 8192;
constexpr int MP = NB * SEQ;
constexpr int MT = MP + SB;
constexpr int MPAD = 16640;
constexpr int DR = 1024, NBLK = 16, CW = 4;
constexpr int HD = 64, HPG = 8, NG = 3, NH = 24, AW = 1536, AO = 512;
constexpr int DFF = 2816;
constexpr int N1 = 2 * DR + 3 * AW + 2 * DM;
constexpr int K3 = DR + AO;
constexpr float EPS = 1e-6f;
constexpr int NKEY = 129;

__host__ __device__ constexpr int g_dil(int g) { return g == 0 ? 1 : (g == 1 ? 4 : 16); }
__host__ __device__ constexpr int g_win(int g) { return g == 0 ? 128 : (g == 1 ? 512 : 2048); }

constexpr size_t O_Y = 0;
constexpr size_t O_KVP0 = (size_t)MT * DM;
constexpr size_t O_KVP1 = O_KVP0 + (size_t)DEPTH * NB * 128 * 1024;
constexpr size_t O_KVP2 = O_KVP1 + (size_t)DEPTH * NB * 512 * 1024;
constexpr size_t O_CONVP = O_KVP2 + (size_t)DEPTH * NB * 2048 * 1024;
constexpr size_t O_HP = O_CONVP + (size_t)DEPTH * NB * 3 * DR;
constexpr size_t O_KVS0 = O_HP + (size_t)DEPTH * NB * DR;
constexpr size_t O_KVS1 = O_KVS0 + (size_t)DEPTH * SB * 1024;
constexpr size_t O_KVS2 = O_KVS1 + (size_t)DEPTH * SB * 1024;
constexpr size_t O_CONVS = O_KVS2 + (size_t)DEPTH * SB * 1024;
constexpr size_t O_HS = O_CONVS + (size_t)DEPTH * SB * 3 * DR;
constexpr size_t O_END = O_HS + (size_t)DEPTH * SB * DR;
__host__ __device__ constexpr size_t o_kvp(int g) { return g == 0 ? O_KVP0 : (g == 1 ? O_KVP1 : O_KVP2); }
__host__ __device__ constexpr size_t o_kvs(int g) { return g == 0 ? O_KVS0 : (g == 1 ? O_KVS1 : O_KVS2); }

constexpr size_t MiB = 1u << 20;
constexpr size_t rup(size_t x) { return (x + MiB - 1) / MiB * MiB; }
constexpr size_t WS_CTL = 0, CTL_ZERO_BYTES = 1 * MiB;
constexpr size_t WS_BIAS = 1 * MiB;
constexpr size_t WS_SSQ = 2 * MiB;
constexpr size_t WS_SUM = 4 * MiB;
constexpr size_t WS_W = 8 * MiB;
constexpr size_t LW_W1 = 0;
constexpr size_t LW_W3 = LW_W1 + (size_t)N1 * DM * 2;
constexpr size_t LW_W4 = LW_W3 + (size_t)DM * K3 * 2;
constexpr size_t LW_W5 = LW_W4 + (size_t)DM * DM * 2;
constexpr size_t LW_W6 = LW_W5 + (size_t)2 * DFF * DM * 2;
constexpr size_t LW_BYTES = rup(LW_W6 + (size_t)DM * DFF * 2);
constexpr size_t WS_XB = WS_W + DEPTH * LW_BYTES;
constexpr size_t WS_LX = WS_XB + rup((size_t)MPAD * DM * 2);
constexpr size_t WS_GG = WS_LX + rup((size_t)MPAD * DM * 2);
constexpr size_t WS_Q = WS_GG + rup((size_t)MPAD * DM * 2);
constexpr size_t WS_K = WS_Q + rup((size_t)MPAD * AW * 2);
constexpr size_t WS_V = WS_K + rup((size_t)MPAD * AW * 2);
constexpr size_t WS_GM = WS_V + rup((size_t)MPAD * AW * 2);
constexpr size_t WS_OG = WS_GM + rup((size_t)MPAD * 2048 * 2);
constexpr size_t WS_ML = WS_OG + rup((size_t)3 * MPAD * AO * 2);
constexpr size_t WS_A3 = WS_ML + rup((size_t)3 * MPAD * 16 * 4);
constexpr size_t WS_MRG = WS_A3 + rup((size_t)MPAD * K3 * 2);
constexpr size_t WS_H = WS_MRG + rup((size_t)MPAD * DM * 2);
constexpr size_t WS_SIMPLE = WS_H + rup((size_t)MPAD * DFF * 2);
constexpr size_t WS_XC = WS_SIMPLE;
constexpr size_t WS_AA = WS_XC + rup((size_t)MPAD * DM * 4);
constexpr size_t WS_UU = WS_AA + rup((size_t)MPAD * DM * 4);
constexpr size_t WS_END = WS_UU + rup((size_t)MPAD * DM * 4);

__device__ __forceinline__ float bf2f(bf16_t v) { return __uint_as_float(((unsigned)v) << 16); }
__device__ __forceinline__ bf16_t f2b(float f) { unsigned u = __float_as_uint(f); u += 0x7fffu + ((u >> 16) & 1u); return (bf16_t)(u >> 16); }
__device__ __forceinline__ float wave_sum(float v) {
#pragma unroll
    for (int o = 1; o < 64; o <<= 1) v += __shfl_xor(v, o);
    return v;
}
__device__ __forceinline__ float wave_max(float v) {
#pragma unroll
    for (int o = 1; o < 64; o <<= 1) v = fmaxf(v, __shfl_xor(v, o));
    return v;
}
__device__ __forceinline__ float sigmoidf_(float x) { return 1.0f / (1.0f + __expf(-x)); }
__device__ __forceinline__ float gelu_tanh(float x) { const float u = 0.7978845608028654f * (x + 0.044715f * x * x * x); return 0.5f * x * (1.0f + tanhf(u)); }

__host__ __device__ __forceinline__ int w1_src_col(int nt) {
    if (nt < 2048) return nt;
    const int pn = nt >> 8, tc = nt & 255, bj = tc >> 7;
    if (nt >= 6656) return 6656 + bj * 1024 + (pn - 26) * 128 + (tc & 127);
    const int wc = (tc >> 5) & 3, i = tc & 31;
    return 2048 + (pn - 8) * 256 + wc * 64 + bj * 32 + i;
}
__host__ __device__ __forceinline__ int w5_src_col(int nt) { const int pn = nt >> 8, tc = nt & 255, bj = tc >> 7, j = tc & 127; return bj * DFF + pn * 128 + j; }

struct Ptrs {
    const float* x_prompt; const float* x_sample; const float* cache[3]; const float* state_conv; const float* state_h; const float* rel_bias;
    const float* norm_mix; const float* w_in; const float* w_conv; const float* b_conv; const float* w_rg_a; const float* b_rg_a; const float* w_rg_x; const float* b_rg_x;
    const float* lru_lambda; const float* q_gain; const float* k_gain; const float* w_merge; const float* b_merge; const float* w_branch_lru; const float* w_branch_att;
    const float* w_o; const float* norm_ffn; const float* w_ffn_in; const float* w_ffn_out;
    float* out; unsigned char* ws;
};
__device__ __forceinline__ const float* xin_row(const Ptrs& P, int row) { return row < MP ? P.x_prompt + (size_t)row * DM : P.x_sample + (size_t)(row - MP) * DM; }

namespace pg8 {
#define PG8_LAS __attribute__((address_space(3)))
typedef unsigned short bf16_t;
typedef short bf16x8 __attribute__((ext_vector_type(8)));
typedef float f32x4 __attribute__((ext_vector_type(4)));
typedef unsigned u32x4 __attribute__((ext_vector_type(4)));
constexpr int BM = 256, BK = 64, HALF = 128, HTB = HALF * BK * 2  , STAGE_BYTES = 8 * HTB, NXCD = 8, WGM = 8;

__host__ __device__ __forceinline__ int lds_byte(int r, int c) { const int st = (r >> 4) * 2 + (c >> 5), rr = r & 15, cc = c & 31, ob = rr * 64 + cc * 2; return st * 1024 + (ob ^ (((ob >> 9) & 1) << 5)); }
__host__ __device__ __forceinline__ void stage_rc(int b, int& R, int& C) { const int st = b / 1024, sb = b % 1024, swz = sb ^ (((sb >> 9) & 1) << 5); R = (st >> 1) * 16 + swz / 64; C = (st & 1) * 32 + (swz % 64) / 2; }
__host__ __device__ __forceinline__ int perm32(int rho) { const int n = rho >> 4, i = rho & 15; return 8 * (i >> 2) + 4 * n + (i & 3); }

struct Unit { int pm, pn; };
struct Gemm { const bf16_t* A; const bf16_t* Bt; int M, N, K; int wv; };

struct StaticOrder {
    int nM, nN, nwg, G, c;
    __host__ __device__ void init(int M, int N, int G_, int c_) { nM = M / BM; nN = N / BM; nwg = nM * nN; G = G_; c = c_; }
    __host__ __device__ bool next(int i, Unit& u) const {
        const long L = (long)i * G + c; if (L >= nwg) return false;
        int wgid = (int)L; { const int q = nwg / NXCD, r = nwg % NXCD, xcd = wgid % NXCD, off = wgid / NXCD; wgid = (xcd < r ? xcd * (q + 1) : r * (q + 1) + (xcd - r) * q) + off; }
        const int nig = WGM * nN, gid = wgid / nig, fm = gid * WGM, gsz = (nM - fm) < WGM ? (nM - fm) : WGM;
        u.pm = fm + ((wgid % nig) % gsz); u.pn = (wgid % nig) / gsz; return true;
    }
    __device__ __forceinline__ void a_ready(const Unit&) const {}
    __device__ __forceinline__ void done(const Unit&) const {}
};

template <class Epi, class Sched, bool ALIGN_EPI = false, bool SP2 = false>
__device__ __forceinline__ void gemm_phase(PG8_LAS unsigned char* lds, const Gemm g, const Sched& S, const Epi& E) {
    int tid_ = (g.wv << 6) | (int)__builtin_amdgcn_mbcnt_hi(~0u, __builtin_amdgcn_mbcnt_lo(~0u, 0u)); asm volatile("" : "+v"(tid_));
    const int tid = tid_, wid = __builtin_amdgcn_readfirstlane(tid >> 6), lane = tid & 63, wr = wid >> 2, wc = wid & 3, fr = lane & 15, fq = lane >> 4;
    const int K = g.K, nt = K / BK;
    unsigned voffA[2], voffB[2];
#pragma unroll
    for (int i = 0; i < 2; ++i) { int R, C; stage_rc(tid * 16 + i * 8192, R, C); const int Rb = Epi::PERM ? ((R & ~31) + perm32(R & 31)) : R;
        voffA[i] = (unsigned)(R * K + C) * 2u; voffB[i] = (unsigned)(Rb * K + C) * 2u; }
    const size_t kstep = (size_t)(BK * 2);
    const size_t hstep = (size_t)HALF * K * 2;
    const size_t tstep = 2 * hstep;
    const unsigned ldsw = (unsigned)wid * 1024u;
    const int aoff = lds_byte(wr * 64 + fr, fq * 8), boff = lds_byte(wc * 32 + fr, fq * 8);
#define PG8_SA(b, h) (((b) * 2 + (h)) * HTB)
#define PG8_SB(b, h) ((4 + (b) * 2 + (h)) * HTB)
#define PG8_STAGE(bufoff, gbase, voff) do { _Pragma("unroll") for (int _i = 0; _i < 2; ++_i) \
        __builtin_amdgcn_global_load_lds((const unsigned*)((const char*)(gbase) + (voff)[_i]), (PG8_LAS unsigned*)(lds + (bufoff) + ldsw + _i * 8192), 16, 0, 0); } while (0)
#define PG8_LDA(dst, b, h) do { _Pragma("unroll") for (int m = 0; m < 4; ++m) _Pragma("unroll") for (int k = 0; k < 2; ++k) dst[m][k] = *(const PG8_LAS bf16x8*)(lds + PG8_SA(b, h) + aoff + m * 2048 + k * 1024); } while (0)
#define PG8_LDB(dst, b, h) do { _Pragma("unroll") for (int n = 0; n < 2; ++n) _Pragma("unroll") for (int k = 0; k < 2; ++k) dst[n][k] = *(const PG8_LAS bf16x8*)(lds + PG8_SB(b, h) + boff + n * 2048 + k * 1024); } while (0)
#define PG8_MMA(ai, bj, At, Bt) do { __builtin_amdgcn_s_setprio(1); _Pragma("unroll") for (int m = 0; m < 4; ++m) _Pragma("unroll") for (int n = 0; n < 2; ++n) _Pragma("unroll") for (int k = 0; k < 2; ++k) \
        acc[ai][bj][m][n] = __builtin_amdgcn_mfma_f32_16x16x32_bf16(Bt[n][k], At[m][k], acc[ai][bj][m][n], 0, 0, 0); __builtin_amdgcn_s_setprio(0); } while (0)
#define PG8_WAIT_V(n) asm volatile("s_waitcnt vmcnt(" #n ")" ::: "memory")
#define PG8_WAIT_L(n) asm volatile("s_waitcnt lgkmcnt(" #n ")" ::: "memory")
#define PG8_BAR __builtin_amdgcn_s_barrier()
#define PG8_SCHED __builtin_amdgcn_sched_barrier(0)
    Unit cur, nxt; int ui = 0;
    if (!S.next(0, cur)) return;
    f32x4 acc[2][2][4][2];
#pragma unroll
    for (int a = 0; a < 2; ++a)
#pragma unroll
        for (int b = 0; b < 2; ++b)
#pragma unroll
            for (int m = 0; m < 4; ++m)
#pragma unroll
                for (int n = 0; n < 2; ++n) acc[a][b][m][n] = (f32x4){0.f, 0.f, 0.f, 0.f};
    bf16x8 At[4][2], B0[2][2], B1[2][2];
    const char* cA = (const char*)g.A + (size_t)cur.pm * tstep; const char* cB = (const char*)g.Bt + (size_t)cur.pn * tstep;
    S.a_ready(cur);
    if constexpr (SP2) {
        PG8_STAGE(PG8_SB(0, 0), cB, voffB); PG8_STAGE(PG8_SB(0, 1), cB + hstep, voffB); PG8_STAGE(PG8_SA(0, 0), cA, voffA); PG8_STAGE(PG8_SA(0, 1), cA + hstep, voffA);
        if (wr == 1) PG8_BAR;
        PG8_WAIT_V(2); PG8_BAR;
        PG8_STAGE(PG8_SB(1, 0), cB + kstep, voffB); PG8_STAGE(PG8_SA(1, 0), cA + kstep, voffA); PG8_STAGE(PG8_SB(1, 1), cB + hstep + kstep, voffB);
        PG8_WAIT_V(6); PG8_BAR;
    } else {
        PG8_STAGE(PG8_SB(0, 0), cB, voffB); PG8_STAGE(PG8_SA(0, 0), cA, voffA); PG8_STAGE(PG8_SB(0, 1), cB + hstep, voffB); PG8_STAGE(PG8_SA(0, 1), cA + hstep, voffA);
        if (wr == 1) PG8_BAR;
        PG8_WAIT_V(4); PG8_BAR;
        PG8_STAGE(PG8_SB(1, 0), cB + kstep, voffB); PG8_STAGE(PG8_SA(1, 0), cA + kstep, voffA); PG8_STAGE(PG8_SB(1, 1), cB + hstep + kstep, voffB);
        PG8_WAIT_V(6); PG8_BAR;
    }
    for (;;) {
        const bool has_next = S.next(ui + 1, nxt);
        const char* nA = has_next ? (const char*)g.A + (size_t)nxt.pm * tstep : cA; const char* nB = has_next ? (const char*)g.Bt + (size_t)nxt.pn * tstep : cB;
        for (int t = 0; t < nt; t += 2) {
            if constexpr (Epi::HAS_MID) { if (t == E.mid_t) E.mid(acc, cur, wr, wc, fr, fq); }
            const bool last = (t == nt - 2);
            const char* a1 = cA + (size_t)(t + 1) * kstep;
            const char* a2 = last ? nA : cA + (size_t)(t + 2) * kstep; const char* b2 = last ? nB : cB + (size_t)(t + 2) * kstep;
            const char* a3 = a2 + kstep; const char* b3 = b2 + kstep;
            if (last && has_next) S.a_ready(nxt);
            if constexpr (SP2) {
            PG8_LDB(B0, 0, 0); PG8_LDB(B1, 0, 1); PG8_SCHED; PG8_LDA(At, 0, 0); PG8_STAGE(PG8_SA(1, 1), a1 + hstep, voffA);
            PG8_WAIT_V(8); PG8_WAIT_L(0); PG8_BAR; PG8_MMA(0, 0, At, B0); PG8_MMA(0, 1, At, B1); PG8_BAR; PG8_SCHED;
            PG8_LDA(At, 0, 1); PG8_STAGE(PG8_SB(0, 0), b2, voffB); PG8_STAGE(PG8_SB(0, 1), b2 + hstep, voffB); PG8_STAGE(PG8_SA(0, 0), a2, voffA);
            PG8_WAIT_V(8); PG8_WAIT_L(0); PG8_BAR; PG8_MMA(1, 0, At, B0); PG8_MMA(1, 1, At, B1); PG8_BAR; PG8_SCHED;
            PG8_LDB(B0, 1, 0); PG8_LDB(B1, 1, 1); PG8_SCHED; PG8_LDA(At, 1, 0); PG8_STAGE(PG8_SA(0, 1), a2 + hstep, voffA);
            PG8_WAIT_V(8); PG8_WAIT_L(0); PG8_BAR; PG8_MMA(0, 0, At, B0); PG8_MMA(0, 1, At, B1); PG8_BAR; PG8_SCHED;
            PG8_LDA(At, 1, 1); PG8_STAGE(PG8_SB(1, 0), b3, voffB); PG8_STAGE(PG8_SB(1, 1), b3 + hstep, voffB); PG8_STAGE(PG8_SA(1, 0), a3, voffA);
            PG8_WAIT_V(8); PG8_WAIT_L(0); PG8_BAR; PG8_MMA(1, 0, At, B0); PG8_MMA(1, 1, At, B1); PG8_BAR; PG8_SCHED;
            } else {
            PG8_LDB(B0, 0, 0); PG8_SCHED; PG8_LDA(At, 0, 0); PG8_STAGE(PG8_SA(1, 1), a1 + hstep, voffA);
            PG8_WAIT_L(8); PG8_BAR; PG8_WAIT_L(0); PG8_MMA(0, 0, At, B0); PG8_BAR; PG8_SCHED;
            PG8_LDB(B1, 0, 1); PG8_STAGE(PG8_SB(0, 0), b2, voffB);
            PG8_BAR; PG8_WAIT_L(0); PG8_MMA(0, 1, At, B1); PG8_BAR;
            PG8_LDA(At, 0, 1); PG8_STAGE(PG8_SA(0, 0), a2, voffA);
            PG8_BAR; PG8_WAIT_L(0); PG8_MMA(1, 0, At, B0); PG8_BAR; PG8_SCHED;
            PG8_STAGE(PG8_SB(0, 1), b2 + hstep, voffB);
            PG8_WAIT_V(6); PG8_BAR; PG8_MMA(1, 1, At, B1); PG8_BAR;
            PG8_LDB(B0, 1, 0); PG8_SCHED; PG8_LDA(At, 1, 0); PG8_STAGE(PG8_SA(0, 1), a2 + hstep, voffA);
            PG8_WAIT_L(8); PG8_BAR; PG8_WAIT_L(0); PG8_MMA(0, 0, At, B0); PG8_BAR; PG8_SCHED;
            PG8_LDB(B1, 1, 1); PG8_STAGE(PG8_SB(1, 0), b3, voffB);
            PG8_BAR; PG8_WAIT_L(0); PG8_MMA(0, 1, At, B1); PG8_BAR;
            PG8_LDA(At, 1, 1); PG8_STAGE(PG8_SA(1, 0), a3, voffA);
            PG8_BAR; PG8_WAIT_L(0); PG8_MMA(1, 0, At, B0); PG8_BAR; PG8_SCHED;
            PG8_STAGE(PG8_SB(1, 1), b3 + hstep, voffB);
            PG8_WAIT_V(6); PG8_BAR; PG8_MMA(1, 1, At, B1); PG8_BAR;
            }
        }
        if constexpr (ALIGN_EPI) { if (wr == 0) PG8_BAR; }
        if constexpr (!Epi::AFTER_DRAIN) { E(acc, cur, wr, wc, fr, fq); S.done(cur); }
        if (!has_next) break;
#pragma unroll
        for (int a = 0; a < 2; ++a)
#pragma unroll
            for (int b = 0; b < 2; ++b)
#pragma unroll
                for (int m = 0; m < 4; ++m)
#pragma unroll
                    for (int n = 0; n < 2; ++n) acc[a][b][m][n] = (f32x4){0.f, 0.f, 0.f, 0.f};
        cur = nxt; cA = nA; cB = nB; ++ui;
        if constexpr (ALIGN_EPI) { if (wr == 1) PG8_BAR; }
    }
    PG8_WAIT_V(0);
    if constexpr (!ALIGN_EPI) { if (wr == 0) PG8_BAR; }
    PG8_BAR;
    if constexpr (Epi::AFTER_DRAIN) { E.fused(acc, cur, wr, wc, fr, fq, lds, wid, lane); S.done(cur); }
#undef PG8_SA
#undef PG8_SB
#undef PG8_STAGE
#undef PG8_LDA
#undef PG8_LDB
#undef PG8_MMA
#undef PG8_WAIT_V
#undef PG8_WAIT_L
#undef PG8_BAR
#undef PG8_SCHED
}
}
#define GAS __attribute__((address_space(1)))
#define LAS __attribute__((address_space(3)))
typedef unsigned short bf16;
typedef unsigned v4u __attribute__((ext_vector_type(4)));
typedef float f32x4 __attribute__((ext_vector_type(4)));
typedef short bf16x8 __attribute__((ext_vector_type(8)));
typedef GAS unsigned gu32;
typedef GAS unsigned long long gu64;
#define RLX_AGENT __ATOMIC_RELAXED, __HIP_MEMORY_SCOPE_AGENT
#define LDS_WAIT() asm volatile("s_waitcnt lgkmcnt(0)" ::: "memory")
#define VM_WAIT() asm volatile("s_waitcnt vmcnt(0)" ::: "memory")
__device__ __forceinline__ unsigned long long rt() { return __builtin_amdgcn_s_memrealtime(); }
__device__ __forceinline__ unsigned f2bf(float f) { unsigned u = __builtin_bit_cast(unsigned, f); return (u + 0x7fffu + ((u >> 16) & 1u)) >> 16; }
__device__ __forceinline__ unsigned pk2(float lo, float hi) { return f2bf(lo) | (f2bf(hi) << 16); }

#define XB_TMO      128
#define XB_XCNT(j)  (256  + 64 * (j))
#define XB_XSUB(j)  (1280 + 64 * (j))
#define XB_XGEN(j)  (2304 + 64 * (j))
#define XB_TOP      3328
#define XB_TOPGEN   3392
#define XCD_BAR_WORDS 3456
#define XB_SPIN_CAP (1u << 18)

__device__ __forceinline__ unsigned xb_ld(unsigned* p)              { return __hip_atomic_load(p, __ATOMIC_RELAXED, __HIP_MEMORY_SCOPE_AGENT); }
__device__ __forceinline__ unsigned xb_add(unsigned* p, unsigned v) { return __hip_atomic_fetch_add(p, v, __ATOMIC_RELAXED, __HIP_MEMORY_SCOPE_AGENT); }
__device__ __forceinline__ unsigned xb_xcc_id() { return (unsigned)__builtin_amdgcn_s_getreg((3 << 11) | 20) & 0xFu; }
#define XB_SPIN(cond, bar) do { unsigned _sp = 0; while (cond) { __builtin_amdgcn_s_sleep(1); \
    if ((++_sp & 255u) == 0u) { if (xb_ld(&(bar)[XB_TMO])) break; if (_sp > XB_SPIN_CAP) { atomicAdd(&(bar)[XB_TMO], 1u); break; } } } } while (0)

struct XcdBarrier {
    unsigned* bar; unsigned x; int wv;
    volatile LAS unsigned* st;
};

__device__ __forceinline__ XcdBarrier xcd_barrier_post(unsigned* bar, volatile LAS unsigned* st) {
    XcdBarrier b; b.bar = bar; b.x = xb_xcc_id(); b.st = st;
    if (threadIdx.x == 0) (void)xb_add(&bar[XB_XCNT(b.x)], 1u);
    return b;
}
__device__ __forceinline__ void xcd_barrier_complete(unsigned* bar, unsigned x, unsigned& nloc, unsigned& nx) {
    const unsigned G = gridDim.x * gridDim.y * gridDim.z;
    unsigned sum, cnt, mine, sp = 0u;
    for (;;) {
        sum = 0u; cnt = 0u; mine = 0u;
#pragma unroll
        for (unsigned j = 0; j < 16; ++j) { const unsigned c = xb_ld(&bar[XB_XCNT(j)]); sum += c; cnt += (c > 0u) ? 1u : 0u; mine = (j == x) ? c : mine; }
        if (sum == G) break;
        __builtin_amdgcn_s_sleep(1);
        if ((++sp & 255u) == 0u) { if (xb_ld(&bar[XB_TMO])) break; if (sp > XB_SPIN_CAP) { atomicAdd(&bar[XB_TMO], 1u); break; } }
    }
    nloc = mine > 0u ? mine : 1u; nx = cnt > 0u ? cnt : 1u;
}

__device__ __forceinline__ void xcd_barrier(const XcdBarrier& b) {
    asm volatile("s_waitcnt vmcnt(0)" ::: "memory");
    __syncthreads();
    if (b.wv == 0 && __builtin_amdgcn_mbcnt_hi(~0u, __builtin_amdgcn_mbcnt_lo(~0u, 0u)) == 0u) {
        unsigned* bar = b.bar; asm volatile("" : "+s"(bar));
        __builtin_amdgcn_s_waitcnt(0);
        unsigned nloc = b.st[0], nx = b.st[1];
        if (nloc == 0u) { xcd_barrier_complete(bar, b.x, nloc, nx); b.st[0] = nloc; b.st[1] = nx; }
        const unsigned old = xb_add(&bar[XB_XSUB(b.x)], 1u);
        const unsigned gen = old / nloc;
        if (old + 1u == (gen + 1u) * nloc) {
            __builtin_amdgcn_fence(__ATOMIC_RELEASE, "agent");
            asm volatile("s_waitcnt vmcnt(0)" ::: "memory");
            const unsigned og = xb_add(&bar[XB_TOP], 1u);
            const unsigned tg = og / nx;
            if (og + 1u == (tg + 1u) * nx) xb_add(&bar[XB_TOPGEN], 1u);
            else XB_SPIN(xb_ld(&bar[XB_TOPGEN]) == tg, bar);
            __builtin_amdgcn_fence(__ATOMIC_ACQUIRE, "agent");
            xb_add(&bar[XB_XGEN(b.x)], 1u);
            asm volatile("s_waitcnt vmcnt(0)" ::: "memory");
        } else {
            XB_SPIN(xb_ld(&bar[XB_XGEN(b.x)]) == gen, bar);
            __builtin_amdgcn_fence(__ATOMIC_ACQUIRE, "agent");
            asm volatile("s_waitcnt vmcnt(0)" ::: "memory");
        }
    }
    __syncthreads();
}

using pg8::Unit;
#define ROW_FENCE() asm volatile("" ::: "memory")
__device__ __forceinline__ float row_rs(const float* ssq, int row) {
    const f32x4* p = (const f32x4*)(ssq + (size_t)row * 16);
    const f32x4 a = p[0], b = p[1], c = p[2], d = p[3];
    const float s = (((a[0] + a[1]) + (a[2] + a[3])) + ((b[0] + b[1]) + (b[2] + b[3]))) + (((c[0] + c[1]) + (c[2] + c[3])) + ((d[0] + d[1]) + (d[2] + d[3])));
    return rsqrtf(s * (1.0f / DM) + EPS);
}
__device__ __forceinline__ unsigned pkbf(float lo, float hi) { return (unsigned)f2b(lo) | ((unsigned)f2b(hi) << 16); }
__device__ __forceinline__ u32x4 pack8(const f32x4 a, const f32x4 b) { u32x4 w; w.x = pkbf(a[0], a[1]); w.y = pkbf(a[2], a[3]); w.z = pkbf(b[0], b[1]); w.w = pkbf(b[2], b[3]); return w; }
__device__ __forceinline__ float bflo(unsigned w) { return __uint_as_float(w << 16); }
__device__ __forceinline__ float bfhi(unsigned w) { return __uint_as_float(w & 0xffff0000u); }

struct Epi1 {
    static constexpr bool PERM = true, AFTER_DRAIN = false, HAS_MID = false;
    int mid_t; Ptrs P; int l;
    __device__ __forceinline__ void operator()(const f32x4 (&acc)[2][2][4][2], const Unit& u, int wr, int wc, int fr0, int fq) const {
        int fr = fr0; asm volatile("" : "+v"(fr));
        const float* ssq = (const float*)(P.ws + WS_SSQ);
        const int pn = u.pn, c8 = wc * 32 + 8 * fq, row0 = u.pm * 256 + wr * 64 + fr;
        if (pn < 8) {
            bf16_t* dst = (bf16_t*)(P.ws + (pn < 4 ? WS_LX : WS_GG));
            const int colb = (pn & 3) * 256 + c8;
#pragma unroll
            for (int ai = 0; ai < 2; ++ai)
#pragma unroll
                for (int m = 0; m < 4; ++m) {
                    const int row = row0 + ai * 128 + m * 16; const float rs = row_rs(ssq, row);
#pragma unroll
                    for (int bj = 0; bj < 2; ++bj) {
                        f32x4 v0 = acc[ai][bj][m][0] * rs, v1 = acc[ai][bj][m][1] * rs; const int col = colb + bj * 128;
                        if (pn >= 4) {
#pragma unroll
                            for (int e = 0; e < 4; ++e) { v0[e] = gelu_tanh(v0[e]); v1[e] = gelu_tanh(v1[e]); }
                        }
                        *(u32x4*)(dst + (size_t)row * DR + col) = pack8(v0, v1);
                        if (pn < 4) {
                            if (row < MP) { const int t = row & (SEQ - 1); if (t >= SEQ - 3) { const int b = row >> 13; float* o = P.out + O_CONVP + ((size_t)(l * NB + b) * 3 + (t - (SEQ - 3))) * DR + col; *(f32x4*)o = v0; *(f32x4*)(o + 4) = v1; } }
                            else if (row < MT) { const int b = row - MP; float* cs = P.out + O_CONVS + (size_t)(l * SB + b) * 3 * DR + col; const float* sc = P.state_conv + (size_t)(l * SB + b) * 3 * DR + col;
                                *(f32x4*)cs = *(const f32x4*)(sc + DR); *(f32x4*)(cs + 4) = *(const f32x4*)(sc + DR + 4); *(f32x4*)(cs + DR) = *(const f32x4*)(sc + 2 * DR); *(f32x4*)(cs + DR + 4) = *(const f32x4*)(sc + 2 * DR + 4);
                                *(f32x4*)(cs + 2 * DR) = v0; *(f32x4*)(cs + 2 * DR + 4) = v1; }
                        }
                    }
                    ROW_FENCE();
                }
        } else if (pn < 26) {
            const int tq = pn - 8, type = tq / 6, head = 4 * (tq % 6) + wc, g = head >> 3, hh = head & 7;
            bf16_t* dst = (bf16_t*)(P.ws + (type == 0 ? WS_Q : (type == 1 ? WS_K : WS_V)));
            f32x4 gn[2][2];
#pragma unroll
            for (int bj = 0; bj < 2; ++bj)
#pragma unroll
                for (int n = 0; n < 2; ++n) gn[bj][n] = (f32x4){1.f, 1.f, 1.f, 1.f};
            if (type < 2) { const float* gp = (type == 0 ? P.q_gain : P.k_gain) + l * HD;
#pragma unroll
                for (int bj = 0; bj < 2; ++bj)
#pragma unroll
                    for (int n = 0; n < 2; ++n) gn[bj][n] = *(const f32x4*)(gp + 32 * bj + 8 * fq + 4 * n); }
            const int W = g_win(g);
#pragma unroll
            for (int ai = 0; ai < 2; ++ai)
#pragma unroll
                for (int m = 0; m < 4; ++m) {
                    const int row = row0 + ai * 128 + m * 16; const float rs = row_rs(ssq, row);
                    f32x4 v[2][2]; float ss = 0.f;
#pragma unroll
                    for (int bj = 0; bj < 2; ++bj)
#pragma unroll
                        for (int n = 0; n < 2; ++n) { v[bj][n] = acc[ai][bj][m][n] * rs; const f32x4 q = v[bj][n] * v[bj][n]; ss += (q[0] + q[1]) + (q[2] + q[3]); }
                    ss += __shfl_xor(ss, 16); ss += __shfl_xor(ss, 32);
                    const float inv = (type < 2) ? rsqrtf(ss * (1.0f / HD) + EPS) : 1.0f;
#pragma unroll
                    for (int bj = 0; bj < 2; ++bj) {
                        v[bj][0] = v[bj][0] * inv * gn[bj][0]; v[bj][1] = v[bj][1] * inv * gn[bj][1];
                        *(u32x4*)(dst + (size_t)row * AW + head * HD + 32 * bj + 8 * fq) = pack8(v[bj][0], v[bj][1]);
                    }
                    if (type >= 1) {
                        float* o = nullptr;
                        if (row < MP) { const int t = row & (SEQ - 1), b = row >> 13; if (t >= SEQ - W) o = P.out + o_kvp(g) + ((((size_t)(l * NB + b) * W + (t - (SEQ - W))) * 2 + (type - 1)) * HPG + hh) * HD + 8 * fq; }
                        else if (row < MT) { const int b = row - MP; o = P.out + o_kvs(g) + (((size_t)(l * SB + b) * 2 + (type - 1)) * HPG + hh) * HD + 8 * fq; }
                        if (o) {
#pragma unroll
                            for (int bj = 0; bj < 2; ++bj) { *(f32x4*)(o + 32 * bj) = v[bj][0]; *(f32x4*)(o + 32 * bj + 4) = v[bj][1]; } }
                    }
                    ROW_FENCE();
                }
        } else {
            bf16_t* GM = (bf16_t*)(P.ws + WS_GM); const float* bm = P.b_merge + (size_t)l * 2048;
            const int colb = (pn - 26) * 128 + c8;
            f32x4 bv[2][2];
#pragma unroll
            for (int bj = 0; bj < 2; ++bj)
#pragma unroll
                for (int n = 0; n < 2; ++n) bv[bj][n] = *(const f32x4*)(bm + bj * 1024 + colb + 4 * n);
#pragma unroll
            for (int ai = 0; ai < 2; ++ai)
#pragma unroll
                for (int m = 0; m < 4; ++m) {
                    const int row = row0 + ai * 128 + m * 16; const float rs = row_rs(ssq, row);
                    f32x4 rho[2], gav[2];
#pragma unroll
                    for (int n = 0; n < 2; ++n) {
                        const f32x4 xl = acc[ai][0][m][n] * rs + bv[0][n], xa = acc[ai][1][m][n] * rs + bv[1][n];
#pragma unroll
                        for (int e = 0; e < 4; ++e) { const float el = __expf(-xl[e]), ea = fminf(__expf(-xa[e]), 1e30f); gav[n][e] = __builtin_amdgcn_rcpf(1.0f + ea); rho[n][e] = (1.0f + ea) * __builtin_amdgcn_rcpf(1.0f + el); }
                    }
                    *(u32x4*)(GM + (size_t)row * 2048 + colb) = pack8(rho[0], rho[1]);
                    *(u32x4*)(GM + (size_t)row * 2048 + 1024 + colb) = pack8(gav[0], gav[1]);
                    ROW_FENCE();
                }
        }
    }
};

struct Epi3 {
    static constexpr bool PERM = true, AFTER_DRAIN = false, HAS_MID = true;
    int mid_t; Ptrs P;
    __device__ __forceinline__ void mid(f32x4 (&acc)[2][2][4][2], const Unit& u, int wr, int wc, int fr, int fq) const {
        const bf16_t* GM = (const bf16_t*)(P.ws + WS_GM);
        int fr_ = fr; asm volatile("" : "+v"(fr_));
        const int colb = u.pn * 256 + wc * 32 + 8 * fq, row0 = u.pm * 256 + wr * 64 + fr_;
#pragma unroll
        for (int ai = 0; ai < 2; ++ai)
#pragma unroll
            for (int m = 0; m < 4; ++m) {
                const int row = row0 + ai * 128 + m * 16;
#pragma unroll
                for (int bj = 0; bj < 2; ++bj) {
                    const u32x4 gl = *(const u32x4*)(GM + (size_t)row * 2048 + colb + bj * 128);
                    const f32x4 r0 = (f32x4){bflo(gl.x), bfhi(gl.x), bflo(gl.y), bfhi(gl.y)}, r1 = (f32x4){bflo(gl.z), bfhi(gl.z), bflo(gl.w), bfhi(gl.w)};
                    acc[ai][bj][m][0] = acc[ai][bj][m][0] * r0; acc[ai][bj][m][1] = acc[ai][bj][m][1] * r1;
                }
                ROW_FENCE();
            }
    }
    __device__ __forceinline__ void operator()(const f32x4 (&acc)[2][2][4][2], const Unit& u, int wr, int wc, int fr0, int fq) const {
        int fr = fr0; asm volatile("" : "+v"(fr));
        const bf16_t* GM = (const bf16_t*)(P.ws + WS_GM); bf16_t* MRG = (bf16_t*)(P.ws + WS_MRG);
        const int colb = u.pn * 256 + wc * 32 + 8 * fq, row0 = u.pm * 256 + wr * 64 + fr;
#pragma unroll
        for (int ai = 0; ai < 2; ++ai)
#pragma unroll
            for (int m = 0; m < 4; ++m) {
                const int row = row0 + ai * 128 + m * 16;
#pragma unroll
                for (int bj = 0; bj < 2; ++bj) {
                    const u32x4 ga = *(const u32x4*)(GM + (size_t)row * 2048 + 1024 + colb + bj * 128);
                    const f32x4 g0 = (f32x4){bflo(ga.x), bfhi(ga.x), bflo(ga.y), bfhi(ga.y)}, g1 = (f32x4){bflo(ga.z), bfhi(ga.z), bflo(ga.w), bfhi(ga.w)};
                    *(u32x4*)(MRG + (size_t)row * DM + colb + bj * 128) = pack8(acc[ai][bj][m][0] * g0, acc[ai][bj][m][1] * g1);
                }
                ROW_FENCE();
            }
    }
};

struct EpiRes {
    static constexpr bool PERM = false, AFTER_DRAIN = false, HAS_MID = false;
    int mid_t; Ptrs P; int first;
    __device__ __forceinline__ void operator()(const f32x4 (&acc)[2][2][4][2], const Unit& u, int wr, int wc, int fr0, int fq) const {
        int fr = fr0; asm volatile("" : "+v"(fr));
        float* Y = P.out + O_Y; bf16_t* XB = (bf16_t*)(P.ws + WS_XB); float* ssq = (float*)(P.ws + WS_SSQ);
        const int colb = u.pn * 256 + wc * 32 + 4 * fq, row0 = u.pm * 256 + wr * 64 + fr;
#pragma unroll
        for (int ai = 0; ai < 2; ++ai)
#pragma unroll
            for (int m = 0; m < 4; ++m) {
                const int row = row0 + ai * 128 + m * 16; const bool live = row < MT;
                const float* base = first ? xin_row(P, live ? row : 0) : Y + (size_t)(live ? row : 0) * DM;
                float ss = 0.f;
#pragma unroll
                for (int bj = 0; bj < 2; ++bj)
#pragma unroll
                    for (int n = 0; n < 2; ++n) {
                        const int col = colb + bj * 128 + n * 16;
                        f32x4 v = acc[ai][bj][m][n];
                        if (live) { v = v + *(const f32x4*)(base + col); *(f32x4*)(Y + (size_t)row * DM + col) = v; }
                        u32x2 w; w.x = pkbf(v[0], v[1]); w.y = pkbf(v[2], v[3]);
                        *(u32x2*)(XB + (size_t)row * DM + col) = w;
                        ss += (v[0] * v[0] + v[1] * v[1]) + (v[2] * v[2] + v[3] * v[3]);
                    }
                ss += __shfl_xor(ss, 16); ss += __shfl_xor(ss, 32);
                if (fq == 0) ssq[(size_t)row * 16 + u.pn * 4 + wc] = ss;
                ROW_FENCE();
            }
    }
};

struct Epi5 {
    static constexpr bool PERM = true, AFTER_DRAIN = false, HAS_MID = false;
    int mid_t; Ptrs P;
    __device__ __forceinline__ void operator()(const f32x4 (&acc)[2][2][4][2], const Unit& u, int wr, int wc, int fr0, int fq) const {
        int fr = fr0; asm volatile("" : "+v"(fr));
        const float* ssq = (const float*)(P.ws + WS_SSQ); bf16_t* H = (bf16_t*)(P.ws + WS_H);
        const int colb = u.pn * 128 + wc * 32 + 8 * fq, row0 = u.pm * 256 + wr * 64 + fr;
#pragma unroll
        for (int ai = 0; ai < 2; ++ai)
#pragma unroll
            for (int m = 0; m < 4; ++m) {
                const int row = row0 + ai * 128 + m * 16; const float rs = row_rs(ssq, row);
                f32x4 h[2];
#pragma unroll
                for (int n = 0; n < 2; ++n)
#pragma unroll
                    for (int e = 0; e < 4; ++e) { const float gt = acc[ai][0][m][n][e] * rs, up = acc[ai][1][m][n][e] * rs; h[n][e] = gt * sigmoidf_(gt) * up; }
                *(u32x4*)(H + (size_t)row * DFF + colb) = pack8(h[0], h[1]);
                ROW_FENCE();
            }
    }
};

__device__ __forceinline__ void tr_item(const float* W, int N, int s0, int k0, const float* gain, bf16_t* WT, int K, int r0, int kofs, LAS float* scr, int lane) {
#pragma unroll 8
    for (int i = 0; i < 32; ++i) { const int kk = 2 * i + (lane >> 5); float v = W[(size_t)(k0 + kk) * N + s0 + (lane & 31)]; if (gain) v *= gain[k0 + kk]; scr[kk * 33 + (lane & 31)] = v; }
    asm volatile("s_waitcnt lgkmcnt(0)" ::: "memory");
    const int c = lane & 7;
#pragma unroll
    for (int j = 0; j < 4; ++j) { const int n = (lane >> 3) + 8 * j; const LAS float* s = scr + (8 * c) * 33 + n;
        u32x4 o; o.x = pkbf(s[0 * 33], s[1 * 33]); o.y = pkbf(s[2 * 33], s[3 * 33]); o.z = pkbf(s[4 * 33], s[5 * 33]); o.w = pkbf(s[6 * 33], s[7 * 33]);
        *(u32x4*)(WT + (size_t)(r0 + n) * K + kofs + k0 + 8 * c) = o; }
    asm volatile("s_waitcnt lgkmcnt(0)" ::: "memory");
}
constexpr int IT_W1 = (N1 / 32) * (DM / 64), IT_W3A = (DM / 32) * (DR / 64), IT_W3B = (DM / 32) * (AO / 64), IT_W4 = (DM / 32) * (DM / 64), IT_W5 = (2 * DFF / 32) * (DM / 64), IT_W6 = (DM / 32) * (DFF / 64);
constexpr int IT_L = IT_W1 + IT_W3A + IT_W3B + IT_W4 + IT_W5 + IT_W6;
__device__ __forceinline__ void p0_prologue(const Ptrs& P, LAS unsigned char* lds, int gw, int ngw, int wv, int lane) {
    LAS float* scr = (LAS float*)(lds + wv * 16384);
    for (int it = gw; it < DEPTH * IT_L; it += ngw) {
        const int l = it / IT_L; int r = it % IT_L;
        unsigned char* wb = P.ws + WS_W + l * LW_BYTES;
        if (r < IT_W1) { const int kb = r & 15, nb = r >> 4, nt0 = 32 * nb, c = w1_src_col(nt0);
            if (c < 6656) tr_item(P.w_in + (size_t)l * DM * 6656, 6656, c, 64 * kb, P.norm_mix + l * DM, (bf16_t*)(wb + LW_W1), DM, nt0, 0, scr, lane);
            else tr_item(P.w_merge + (size_t)l * DM * 2048, 2048, c - 6656, 64 * kb, P.norm_mix + l * DM, (bf16_t*)(wb + LW_W1), DM, nt0, 0, scr, lane);
            continue; }
        r -= IT_W1;
        if (r < IT_W3A) { const int kb = r & 15, nb = r >> 4; tr_item(P.w_branch_lru + (size_t)l * DR * DM, DM, 32 * nb, 64 * kb, nullptr, (bf16_t*)(wb + LW_W3), K3, 32 * nb, 0, scr, lane); continue; }
        r -= IT_W3A;
        if (r < IT_W3B) { const int kb = r & 7, nb = r >> 3; tr_item(P.w_branch_att + (size_t)l * AO * DM, DM, 32 * nb, 64 * kb, nullptr, (bf16_t*)(wb + LW_W3), K3, 32 * nb, DR, scr, lane); continue; }
        r -= IT_W3B;
        if (r < IT_W4) { const int kb = r & 15, nb = r >> 4; tr_item(P.w_o + (size_t)l * DM * DM, DM, 32 * nb, 64 * kb, nullptr, (bf16_t*)(wb + LW_W4), DM, 32 * nb, 0, scr, lane); continue; }
        r -= IT_W4;
        if (r < IT_W5) { const int kb = r & 15, nb = r >> 4, nt0 = 32 * nb; tr_item(P.w_ffn_in + (size_t)l * DM * 2 * DFF, 2 * DFF, w5_src_col(nt0), 64 * kb, P.norm_ffn + l * DM, (bf16_t*)(wb + LW_W5), DM, nt0, 0, scr, lane); continue; }
        r -= IT_W5;
        { const int kb = r % 44, nb = r / 44; tr_item(P.w_ffn_out + (size_t)l * DFF * DM, DM, 32 * nb, 64 * kb, nullptr, (bf16_t*)(wb + LW_W6), DFF, 32 * nb, 0, scr, lane); }
    }
    float* BIAS = (float*)(P.ws + WS_BIAS);
    for (int e = gw * 64 + lane; e < NG * HPG * NKEY; e += ngw * 64) {
        const int kk = e % NKEY, hh = (e / NKEY) % HPG, g = e / (NKEY * HPG);
        const int d = kk * g_dil(g); int bkt;
        if (d < 16) bkt = d; else { const float df = (float)d; int lg = 16 + (int)(logf(df / 16.0f) / logf(128.0f) * 16.0f); bkt = lg < 31 ? lg : 31; }
        BIAS[e] = P.rel_bias[bkt * NH + 8 * g + hh];
    }
    for (int row = gw; row < MT; row += ngw) {
        const f32x4* xr = (const f32x4*)xin_row(P, row) + lane; bf16_t* xb = (bf16_t*)(P.ws + WS_XB) + (size_t)row * DM; float* ssq = (float*)(P.ws + WS_SSQ) + (size_t)row * 16;
        float s = 0.f;
#pragma unroll
        for (int j = 0; j < 4; ++j) { const f32x4 v = xr[64 * j]; s += (v[0] * v[0] + v[1] * v[1]) + (v[2] * v[2] + v[3] * v[3]);
            u32x2 w; w.x = pkbf(v[0], v[1]); w.y = pkbf(v[2], v[3]); *(u32x2*)(xb + 4 * lane + 256 * j) = w; }
        s = wave_sum(s);
        if (lane < 16) ssq[lane] = (lane == 0) ? s : 0.f;
    }
}

__device__ __forceinline__ void ph_conv(const Ptrs& P, int l, size_t gtid, size_t nth) {
    const bf16_t* LX = (const bf16_t*)(P.ws + WS_LX);
    const float* wc = P.w_conv + (size_t)l * CW * DR;
    for (size_t e = gtid; e < (size_t)MT * DR; e += nth) {
        const int row = (int)(e / DR), ch = (int)(e % DR);
        float acc = P.b_conv[l * DR + ch];
        if (row < MP) { const int t = row % SEQ;
#pragma unroll
            for (int k = 0; k < CW; ++k) { const int tt = t + k - 3; if (tt >= 0) acc += wc[k * DR + ch] * bf2f(LX[(size_t)(row + k - 3) * DR + ch]); } }
        else { const int b = row - MP; const float* sc = P.state_conv + (size_t)(l * SB + b) * 3 * DR;
            acc += wc[0 * DR + ch] * sc[ch] + wc[1 * DR + ch] * sc[DR + ch] + wc[2 * DR + ch] * sc[2 * DR + ch] + wc[3 * DR + ch] * bf2f(LX[(size_t)row * DR + ch]); }
        ((float*)(P.ws + WS_XC))[e] = acc;
    }
}
__device__ __forceinline__ void ph_gates(const Ptrs& P, int l, size_t gtid, size_t nth) {
    for (size_t e = gtid; e < (size_t)MT * DR; e += nth) {
        const int row = (int)(e / DR), ch = (int)(e % DR), n = ch >> 6, j = ch & 63;
        const float* XC = (const float*)(P.ws + WS_XC) + (size_t)row * DR + n * 64;
        const float* wa = P.w_rg_a + ((size_t)(l * NBLK + n) * 64) * 64 + j; const float* wx = P.w_rg_x + ((size_t)(l * NBLK + n) * 64) * 64 + j;
        float ga = P.b_rg_a[l * DR + ch], gx = P.b_rg_x[l * DR + ch];
        for (int i = 0; i < 64; ++i) { const float x = XC[i]; ga += x * wa[i * 64]; gx += x * wx[i * 64]; }
        const float rr = sigmoidf_(ga), ii = sigmoidf_(gx);
        const float lam = P.lru_lambda[l * DR + ch]; const float sp = log1pf(expf(-lam));
        const float log_a = -8.0f * rr * sp; const float av = expf(log_a);
        const bool pos0 = (row < MP) && (row % SEQ == 0);
        const float mult = pos0 ? 1.0f : sqrtf(-expm1f(2.0f * log_a));
        ((float*)(P.ws + WS_AA))[e] = av; ((float*)(P.ws + WS_UU))[e] = mult * ii * XC[j];
    }
}
__device__ __forceinline__ void ph_scan(const Ptrs& P, int l, size_t gtid, size_t nth) {
    const float* AA = (const float*)(P.ws + WS_AA); const float* UU = (const float*)(P.ws + WS_UU);
    const bf16_t* GG = (const bf16_t*)(P.ws + WS_GG); bf16_t* A3 = (bf16_t*)(P.ws + WS_A3);
    for (size_t e = gtid; e < (size_t)(NB + SB) * DR; e += nth) {
        const int s = (int)(e / DR), ch = (int)(e % DR);
        if (s < NB) { float h = 0.f; const size_t r0 = (size_t)s * SEQ;
            for (int t = 0; t < SEQ; t += 8) { float av[8], u[8], g[8];
#pragma unroll
                for (int i = 0; i < 8; ++i) { const size_t o = (r0 + t + i) * DR + ch; av[i] = AA[o]; u[i] = UU[o]; g[i] = bf2f(GG[o]); }
#pragma unroll
                for (int i = 0; i < 8; ++i) { h = av[i] * h + u[i]; A3[(r0 + t + i) * K3 + ch] = f2b(h * g[i]); } }
            P.out[O_HP + (size_t)(l * NB + s) * DR + ch] = h;
        } else { const int b = s - NB; const size_t o = (size_t)(MP + b) * DR + ch; float h = P.state_h[(size_t)(l * SB + b) * DR + ch];
            h = AA[o] * h + UU[o]; A3[(size_t)(MP + b) * K3 + ch] = f2b(h * bf2f(GG[o])); P.out[O_HS + (size_t)(l * SB + b) * DR + ch] = h; }
    }
}
__device__ __forceinline__ void ph_attn(const Ptrs& P, int l, int gwave, int nwaves, int lane, LAS float* qw) {
    const bf16_t* Q = (const bf16_t*)(P.ws + WS_Q); const bf16_t* K = (const bf16_t*)(P.ws + WS_K); const bf16_t* V = (const bf16_t*)(P.ws + WS_V);
    for (int gw = gwave; gw < MT * NH; gw += nwaves) {
        const int row = gw / NH, head = gw % NH, g = head / HPG, hh = head % HPG, dil = g_dil(g);
        const float* BIAS = (const float*)(P.ws + WS_BIAS) + (size_t)(g * HPG + hh) * NKEY;
        const bool samp = row >= MP; const int b = samp ? row - MP : row / SEQ, t = samp ? 0 : row % SEQ;
        const int nkeys = samp ? NKEY : ((t / dil) < 128 ? (t / dil) + 1 : NKEY);
        const float* cbase = (g == 0 ? P.cache[0] : (g == 1 ? P.cache[1] : P.cache[2]));
        const float* cache = cbase + (size_t)(l * SB + (samp ? b : 0)) * g_win(g) * 1024;
        const int Lc = g_win(g);
        asm volatile("" ::: "memory");
        qw[lane] = bf2f(Q[(size_t)row * AW + head * HD + lane]);
        asm volatile("s_waitcnt lgkmcnt(0)" ::: "memory");
        float s[3];
#pragma unroll
        for (int j = 0; j < 3; ++j) { const int kk = lane + 64 * j; float acc = -INFINITY;
            if (kk < nkeys) { acc = 0.f;
                if (!samp || kk == 0) { const bf16_t* kr = K + (size_t)(row - kk * dil) * AW + head * HD;
                    for (int d = 0; d < HD; ++d) acc += qw[d] * bf2f(kr[d]); }
                else { const float* kr = cache + ((size_t)(Lc - kk * dil) * 2 + 0) * 512 + hh * HD;
                    for (int d = 0; d < HD; ++d) acc += qw[d] * kr[d]; }
                acc = acc * 0.125f + BIAS[kk]; }
            s[j] = acc; }
        const float m = wave_max(fmaxf(fmaxf(s[0], s[1]), s[2]));
        float p[3]; float lsum = 0.f;
#pragma unroll
        for (int j = 0; j < 3; ++j) { p[j] = (lane + 64 * j < nkeys) ? __expf(s[j] - m) : 0.f; lsum += p[j]; }
        lsum = wave_sum(lsum);
        float o = 0.f;
        for (int kk = 0; kk < nkeys; ++kk) { const float pk = __shfl(kk < 64 ? p[0] : (kk < 128 ? p[1] : p[2]), kk & 63);
            float vv;
            if (!samp || kk == 0) vv = bf2f(V[(size_t)(row - kk * dil) * AW + head * HD + lane]);
            else vv = cache[((size_t)(Lc - kk * dil) * 2 + 1) * 512 + hh * HD + lane];
            o += pk * vv; }
        bf16_t* OG = (bf16_t*)(P.ws + WS_OG) + ((size_t)g * MT + row) * AO; OG[hh * HD + lane] = f2b(o / lsum);
        if (lane == 0) { float* ML = (float*)(P.ws + WS_ML) + (((size_t)g * MT + row) * HPG + hh) * 2; ML[0] = m; ML[1] = lsum; }
    }
}
__device__ __forceinline__ void ph_combine(const Ptrs& P, size_t gtid, size_t nth) {
    const bf16_t* OG = (const bf16_t*)(P.ws + WS_OG); const float* ML = (const float*)(P.ws + WS_ML);
    for (size_t e = gtid; e < (size_t)MT * AO; e += nth) {
        const int row = (int)(e / AO), c = (int)(e % AO), hh = c >> 6;
        float m[3], lz[3], mm = -INFINITY;
#pragma unroll
        for (int g = 0; g < 3; ++g) { const float* q = ML + (((size_t)g * MT + row) * HPG + hh) * 2; m[g] = q[0]; lz[g] = q[1]; mm = fmaxf(mm, m[g]); }
        float num = 0.f, den = 0.f;
#pragma unroll
        for (int g = 0; g < 3; ++g) { const float z = lz[g] * __expf(m[g] - mm); num += z * bf2f(OG[((size_t)g * MT + row) * AO + c]); den += z; }
        ((bf16_t*)(P.ws + WS_A3))[(size_t)row * K3 + DR + c] = f2b(num / den);
    }
}

constexpr int SC_XCF = 0;
constexpr int SC_HSF = 34816;
constexpr int SC_XCB = 69632;
constexpr int SC_WTA = 88064;
constexpr int SC_WTX = 97280;
constexpr int SC_WTOT = 106496;
constexpr int SC_WC = 110592;
constexpr int SC_END = 111872;
typedef float f32x2 __attribute__((ext_vector_type(2)));

template <int MODE>
__device__ __forceinline__ void scan_item(const Ptrs& P, int l, LAS unsigned char* lds, int wv, int tid, int b, int n, int span) {
    const int lane = tid & 63, fr = lane & 15, fq = lane >> 4;
    LAS float* XCF = (LAS float*)(lds + SC_XCF); LAS float* HSF = (LAS float*)(lds + SC_HSF); LAS bf16_t* XCB = (LAS bf16_t*)(lds + SC_XCB);
    LAS bf16_t* WTA = (LAS bf16_t*)(lds + SC_WTA); LAS bf16_t* WTX = (LAS bf16_t*)(lds + SC_WTX);
    LAS f32x2* WTOT = (LAS f32x2*)(lds + SC_WTOT); LAS float* WC = (LAS float*)(lds + SC_WC);
    const bf16_t* LX = (const bf16_t*)(P.ws + WS_LX); const bf16_t* GG = (const bf16_t*)(P.ws + WS_GG); bf16_t* A3 = (bf16_t*)(P.ws + WS_A3);
    float* SUM = (float*)(P.ws + WS_SUM);
    __syncthreads();
    {
        const float* wa = P.w_rg_a + (size_t)(l * NBLK + n) * 4096; const float* wx = P.w_rg_x + (size_t)(l * NBLK + n) * 4096;
        for (int e = tid; e < 4096; e += 512) { const int i = e >> 6, j = e & 63; WTA[j * 72 + i] = f2b(wa[e]); WTX[j * 72 + i] = f2b(wx[e]); }
        if (tid < 320) { const int k = tid >> 6, c = tid & 63; WC[tid] = (k < 4) ? P.w_conv[(size_t)(l * CW + k) * DR + 64 * n + c] : P.b_conv[l * DR + 64 * n + c]; }
    }
    __syncthreads();
    bf16x8 wfa[4][2], wfx[4][2];
#pragma unroll
    for (int nt = 0; nt < 4; ++nt)
#pragma unroll
        for (int ks = 0; ks < 2; ++ks) { wfa[nt][ks] = *(const LAS bf16x8*)(WTA + (16 * nt + fr) * 72 + 32 * ks + 8 * fq); wfx[nt][ks] = *(const LAS bf16x8*)(WTX + (16 * nt + fr) * 72 + 32 * ks + 8 * fq); }
    float cba[4], cbx[4], csp[4], hc[4], pc[4];
#pragma unroll
    for (int nt = 0; nt < 4; ++nt) { const int ch = 64 * n + 16 * nt + fr;
        cba[nt] = P.b_rg_a[l * DR + ch]; cbx[nt] = P.b_rg_x[l * DR + ch]; csp[nt] = 8.0f * log1pf(expf(-P.lru_lambda[l * DR + ch]));
        float h = 0.f;
        if (MODE == 1) { for (int s = 0; s < span; ++s) { const f32x2 q = *(const f32x2*)(SUM + (((size_t)b * 8 + s) * DR + ch) * 2); h = q.x * h + q.y; } }
        hc[nt] = h; pc[nt] = 1.f; }
    for (int c8 = 0; c8 < 8; ++c8) {
        const int t0 = span * 1024 + c8 * 128;
        u32x4 gg[2];
#pragma unroll
        for (int rep = 0; rep < 2; ++rep) {
            const int idx = tid + 512 * rep, tok = idx >> 3, cg = idx & 7, t = t0 + tok; const size_t rowg = (size_t)b * SEQ + t;
            float acc[8];
#pragma unroll
            for (int j = 0; j < 8; ++j) acc[j] = WC[4 * 64 + 8 * cg + j];
#pragma unroll
            for (int k = 0; k < 4; ++k) { const int tt = t + k - 3;
                if (tt >= 0) { const u32x4 x = *(const u32x4*)(LX + (rowg + k - 3) * DR + 64 * n + 8 * cg);
                    const LAS float* w = WC + k * 64 + 8 * cg;
                    acc[0] += w[0] * bflo(x.x); acc[1] += w[1] * bfhi(x.x); acc[2] += w[2] * bflo(x.y); acc[3] += w[3] * bfhi(x.y);
                    acc[4] += w[4] * bflo(x.z); acc[5] += w[5] * bfhi(x.z); acc[6] += w[6] * bflo(x.w); acc[7] += w[7] * bfhi(x.w); } }
            *(LAS f32x4*)(XCF + tok * 68 + 8 * cg) = (f32x4){acc[0], acc[1], acc[2], acc[3]}; *(LAS f32x4*)(XCF + tok * 68 + 8 * cg + 4) = (f32x4){acc[4], acc[5], acc[6], acc[7]};
            *(LAS u32x4*)(XCB + tok * 72 + 8 * cg) = pack8((f32x4){acc[0], acc[1], acc[2], acc[3]}, (f32x4){acc[4], acc[5], acc[6], acc[7]});
            if (MODE == 1) gg[rep] = *(const u32x4*)(GG + rowg * DR + 64 * n + 8 * cg);
        }
        __syncthreads();
        bf16x8 af[2];
#pragma unroll
        for (int ks = 0; ks < 2; ++ks) af[ks] = *(const LAS bf16x8*)(XCB + (16 * wv + fr) * 72 + 32 * ks + 8 * fq);
        float hl[4][4], ac[4][4], Ae[4], He[4];
#pragma unroll
        for (int nt = 0; nt < 4; ++nt) {
            f32x4 da = (f32x4){0.f, 0.f, 0.f, 0.f}, dx = (f32x4){0.f, 0.f, 0.f, 0.f};
#pragma unroll
            for (int ks = 0; ks < 2; ++ks) { da = __builtin_amdgcn_mfma_f32_16x16x32_bf16(af[ks], wfa[nt][ks], da, 0, 0, 0); dx = __builtin_amdgcn_mfma_f32_16x16x32_bf16(af[ks], wfx[nt][ks], dx, 0, 0, 0); }
            float A = 1.f, H = 0.f;
#pragma unroll
            for (int r = 0; r < 4; ++r) {
                const int tok = 16 * wv + 4 * fq + r;
                const float rr = sigmoidf_(da[r] + cba[nt]), ii = sigmoidf_(dx[r] + cbx[nt]);
                const float av = __expf(-rr * csp[nt]);
                float mult = sqrtf(fmaxf(fmaf(-av, av, 1.0f), 0.f)); if (t0 + tok == 0) mult = 1.0f;
                const float u = mult * ii * XCF[tok * 68 + 16 * nt + fr];
                H = av * H + u; A = A * av; hl[nt][r] = H; ac[nt][r] = A;
            }
            { const float A1 = __shfl(A, lane - 16), H1 = __shfl(H, lane - 16); if (fq >= 1) { H = A * H1 + H; A = A * A1; } }
            { const float A2 = __shfl(A, lane - 32), H2 = __shfl(H, lane - 32); if (fq >= 2) { H = A * H2 + H; A = A * A2; } }
            { const float A3_ = __shfl(A, lane - 16), H3 = __shfl(H, lane - 16); Ae[nt] = (fq >= 1) ? A3_ : 1.f; He[nt] = (fq >= 1) ? H3 : 0.f; }
            if (fq == 3) WTOT[wv * 64 + 16 * nt + fr] = (f32x2){A, H};
        }
        __syncthreads();
#pragma unroll
        for (int nt = 0; nt < 4; ++nt) {
            float hrun = hc[nt], prun = pc[nt], hin = 0.f;
#pragma unroll
            for (int w = 0; w < 8; ++w) { const f32x2 q = WTOT[w * 64 + 16 * nt + fr]; if (w == wv) hin = hrun; hrun = q.x * hrun + q.y; prun = prun * q.x; }
            hc[nt] = hrun; pc[nt] = prun;
            if (MODE == 1) {
#pragma unroll
                for (int r = 0; r < 4; ++r) { const int tok = 16 * wv + 4 * fq + r; HSF[tok * 68 + 16 * nt + fr] = (ac[nt][r] * Ae[nt]) * hin + (ac[nt][r] * He[nt] + hl[nt][r]); }
            }
        }
        if (MODE == 1) {
            __syncthreads();
#pragma unroll
            for (int rep = 0; rep < 2; ++rep) {
                const int idx = tid + 512 * rep, tok = idx >> 3, cg = idx & 7; const size_t rowg = (size_t)b * SEQ + t0 + tok;
                const f32x4 h0 = *(const LAS f32x4*)(HSF + tok * 68 + 8 * cg), h1 = *(const LAS f32x4*)(HSF + tok * 68 + 8 * cg + 4);
                const u32x4 g = gg[rep];
                const f32x4 o0 = (f32x4){h0[0] * bflo(g.x), h0[1] * bfhi(g.x), h0[2] * bflo(g.y), h0[3] * bfhi(g.y)}, o1 = (f32x4){h1[0] * bflo(g.z), h1[1] * bfhi(g.z), h1[2] * bflo(g.w), h1[3] * bfhi(g.w)};
                *(u32x4*)(A3 + rowg * K3 + 64 * n + 8 * cg) = pack8(o0, o1);
            }
        }
    }
    if (wv == 0 && fq == 0) {
#pragma unroll
        for (int nt = 0; nt < 4; ++nt) { const int ch = 64 * n + 16 * nt + fr;
            if (MODE == 0) *(f32x2*)(SUM + (((size_t)b * 8 + span) * DR + ch) * 2) = (f32x2){pc[nt], hc[nt]};
            else if (span == 7) P.out[O_HP + (size_t)(l * NB + b) * DR + ch] = hc[nt]; }
    }
}
__device__ __forceinline__ void scan_sample(const Ptrs& P, int l, LAS unsigned char* lds, int tid, int rg, int n) {
    LAS float* XS = (LAS float*)lds;
    const int r = tid >> 6, j = tid & 63, b = 8 * rg + r, ch = 64 * n + j; const size_t row = (size_t)MP + b;
    const bf16_t* LX = (const bf16_t*)(P.ws + WS_LX); const bf16_t* GG = (const bf16_t*)(P.ws + WS_GG); bf16_t* A3 = (bf16_t*)(P.ws + WS_A3);
    const float* wc = P.w_conv + (size_t)l * CW * DR; const float* sc = P.state_conv + (size_t)(l * SB + b) * 3 * DR;
    const float xc = P.b_conv[l * DR + ch] + wc[ch] * sc[ch] + wc[DR + ch] * sc[DR + ch] + wc[2 * DR + ch] * sc[2 * DR + ch] + wc[3 * DR + ch] * bf2f(LX[row * DR + ch]);
    __syncthreads();
    XS[r * 64 + j] = xc;
    __syncthreads();
    const float* wa = P.w_rg_a + (size_t)(l * NBLK + n) * 4096 + j; const float* wx = P.w_rg_x + (size_t)(l * NBLK + n) * 4096 + j;
    float ga = P.b_rg_a[l * DR + ch], gx = P.b_rg_x[l * DR + ch];
    for (int i = 0; i < 64; ++i) { const float x = XS[r * 64 + i]; ga += x * wa[i * 64]; gx += x * wx[i * 64]; }
    const float rr = sigmoidf_(ga), ii = sigmoidf_(gx);
    const float log_a = -8.0f * rr * log1pf(expf(-P.lru_lambda[l * DR + ch])); const float av = expf(log_a);
    const float mult = sqrtf(-expm1f(2.0f * log_a));
    const float h = av * P.state_h[(size_t)(l * SB + b) * DR + ch] + mult * ii * xc;
    P.out[O_HS + (size_t)(l * SB + b) * DR + ch] = h;
    A3[row * K3 + ch] = f2b(h * bf2f(GG[row * DR + ch]));
}

constexpr int AT_K = 0, AT_V = 49152, AT_B = 98304, AT_W = 99328, AT_END = 101376;
typedef float f32x16 __attribute__((ext_vector_type(16)));
typedef short s16x4 __attribute__((ext_vector_type(4)));
__device__ __forceinline__ int crow(int r, int hi) { return (r & 3) + 8 * (r >> 2) + 4 * hi; }
__device__ __forceinline__ s16x4 ds_tr16(const LAS unsigned char* p) { return __builtin_bit_cast(s16x4, __builtin_amdgcn_ds_read_tr16_b64_v4i16((LAS s16x4*)p)); }

__device__ __forceinline__ void attn_unit(const Ptrs& P, int l, LAS unsigned char* lds, int wv, int tid, int unit) {
    const int lane = tid & 63, l31 = lane & 31, hi = lane >> 5;
    const int g = unit >> 9, rem = unit & 511, b = rem >> 8, hh = (rem >> 5) & 7, ru = rem & 31;
    const int d = g_dil(g), nub = 32 / d, rho = ru / nub, u = ru % nub, head = 8 * g + hh, j0 = 256 * u;
    const bf16_t* Q = (const bf16_t*)(P.ws + WS_Q); const bf16_t* K = (const bf16_t*)(P.ws + WS_K); const bf16_t* V = (const bf16_t*)(P.ws + WS_V);
    const size_t rowbase = (size_t)b * SEQ + rho;
    LAS float* BL = (LAS float*)(lds + AT_B); LAS float* LW = (LAS float*)(lds + AT_W) + wv * 64;
    __syncthreads();
#pragma unroll
    for (int i = 0; i < 6; ++i) {
        const int idx = tid + 512 * i, key = idx >> 3, ch = idx & 7, j = j0 - 128 + key;
        u32x4 kq = (u32x4){0u, 0u, 0u, 0u}, vq = (u32x4){0u, 0u, 0u, 0u};
        if (j >= 0) { const size_t off = (rowbase + (size_t)d * j) * AW + head * HD + 8 * ch; kq = *(const u32x4*)(K + off); vq = *(const u32x4*)(V + off); }
        *(LAS u32x4*)(lds + AT_K + key * 128 + ((ch ^ ((key >> 1) & 7)) << 4)) = kq;
        *(LAS u32x4*)(lds + AT_V + key * 128 + (ch << 4)) = vq;
    }
    if (tid < NKEY) BL[tid] = ((const float*)(P.ws + WS_BIAS))[(size_t)(g * HPG + hh) * NKEY + tid];
    bf16x8 qf[4];
    { const size_t rq = (rowbase + (size_t)d * (j0 + 32 * wv + l31)) * AW + head * HD + 8 * hi;
#pragma unroll
      for (int ks = 0; ks < 4; ++ks) qf[ks] = *(const bf16x8*)(Q + rq + 16 * ks); }
    __syncthreads();
    f32x16 S[5];
#pragma unroll
    for (int c = 0; c < 5; ++c) {
        const int key = 32 * (wv + c) + l31;
        f32x16 acc = {};
#pragma unroll
        for (int ks = 0; ks < 4; ++ks) {
            const bf16x8 kf = *(const LAS bf16x8*)(lds + AT_K + key * 128 + (((2 * ks + hi) ^ ((key >> 1) & 7)) << 4));
            acc = __builtin_amdgcn_mfma_f32_32x32x16_bf16(kf, qf[ks], acc, 0, 0, 0);
        }
        S[c] = acc;
    }
    float mx = -INFINITY;
#pragma unroll
    for (int c = 0; c < 5; ++c) {
        const bool tile_ok = (u > 0) || (wv + c >= 4);
#pragma unroll
        for (int r = 0; r < 16; ++r) {
            const int dist = 128 - 32 * c + l31 - crow(r, hi);
            const bool ok = tile_ok && dist >= 0 && dist <= 128;
            const int dc = dist < 0 ? 0 : (dist > 128 ? 128 : dist);
            const float s = ok ? S[c][r] * 0.125f + BL[dc] : -INFINITY;
            S[c][r] = s; mx = fmaxf(mx, s);
        }
    }
    mx = fmaxf(mx, __shfl_xor(mx, 32));
    float lsum = 0.f;
#pragma unroll
    for (int c = 0; c < 5; ++c)
#pragma unroll
        for (int r = 0; r < 16; ++r) { const float p = __expf(S[c][r] - mx); S[c][r] = p; lsum += p; }
    lsum += __shfl_xor(lsum, 32);
    if (hi == 0) { LW[l31] = lsum;
        float* ML = (float*)(P.ws + WS_ML) + (((size_t)g * MT + rowbase + (size_t)d * (j0 + 32 * wv + l31)) * HPG + hh) * 2; ML[0] = mx; ML[1] = lsum; }
    f32x16 o[2]; o[0] = (f32x16){}; o[1] = (f32x16){};
    const int g16 = lane >> 4, i16 = lane & 15;
    const LAS unsigned char* vb = lds + AT_V + (4 * hi + (i16 >> 2)) * 128 + (16 * (g16 & 1) + 4 * (i16 & 3)) * 2;
#pragma unroll
    for (int c = 0; c < 5; ++c)
#pragma unroll
        for (int s = 0; s < 2; ++s) {
            bf16x8 pa;
#pragma unroll
            for (int j = 0; j < 8; j += 2) { const unsigned w = pkbf(S[c][8 * s + j], S[c][8 * s + j + 1]); pa[j] = (short)(w & 0xffffu); pa[j + 1] = (short)(w >> 16); }
            const LAS unsigned char* vp = vb + (32 * (wv + c) + 16 * s) * 128;
#pragma unroll
            for (int db = 0; db < 2; ++db) {
                const s16x4 lo = ds_tr16(vp + 64 * db), hi4 = ds_tr16(vp + 64 * db + 8 * 128);
                const bf16x8 vf = (bf16x8){lo[0], lo[1], lo[2], lo[3], hi4[0], hi4[1], hi4[2], hi4[3]};
                o[db] = __builtin_amdgcn_mfma_f32_32x32x16_bf16(pa, vf, o[db], 0, 0, 0);
            }
        }
    bf16_t* OG = (bf16_t*)(P.ws + WS_OG) + (size_t)g * MT * AO;
#pragma unroll
    for (int r = 0; r < 16; ++r) {
        const int q = crow(r, hi); const float inv = 1.0f / LW[q];
        const size_t row = rowbase + (size_t)d * (j0 + 32 * wv + q);
        OG[row * AO + hh * HD + l31] = f2b(o[0][r] * inv); OG[row * AO + hh * HD + 32 + l31] = f2b(o[1][r] * inv);
    }
}
__device__ __forceinline__ void attn_sample(const Ptrs& P, int l, LAS unsigned char* lds, int wv, int lane, int item) {
    const int b = item / NH, head = item % NH, g = head >> 3, hh = head & 7, dil = g_dil(g), Lc = g_win(g);
    const bf16_t* Q = (const bf16_t*)(P.ws + WS_Q); const bf16_t* K = (const bf16_t*)(P.ws + WS_K); const bf16_t* V = (const bf16_t*)(P.ws + WS_V);
    const float* BIAS = (const float*)(P.ws + WS_BIAS) + (size_t)(g * HPG + hh) * NKEY;
    const float* cache = P.cache[g] + (size_t)(l * SB + b) * Lc * 1024;
    const size_t row = (size_t)MP + b;
    LAS float* qw = (LAS float*)(lds + AT_W) + wv * 64;
    qw[lane] = bf2f(Q[row * AW + head * HD + lane]);
    asm volatile("s_waitcnt lgkmcnt(0)" ::: "memory");
    float s[3];
#pragma unroll
    for (int j = 0; j < 3; ++j) { const int kk = lane + 64 * j; float acc = -INFINITY;
        if (kk <= 128) { acc = 0.f;
            if (kk == 0) { const bf16_t* kr = K + row * AW + head * HD; for (int dd = 0; dd < HD; ++dd) acc += qw[dd] * bf2f(kr[dd]); }
            else { const f32x4* kr = (const f32x4*)(cache + ((size_t)(Lc - kk * dil) * 2 + 0) * 512 + hh * HD);
#pragma unroll
                for (int dd = 0; dd < 16; ++dd) { const f32x4 kv = kr[dd]; const f32x4 qv = *(const LAS f32x4*)(qw + 4 * dd); acc += (kv[0] * qv[0] + kv[1] * qv[1]) + (kv[2] * qv[2] + kv[3] * qv[3]); } }
            acc = acc * 0.125f + BIAS[kk]; }
        s[j] = acc; }
    const float m = wave_max(fmaxf(fmaxf(s[0], s[1]), s[2]));
    float p[3]; float lsum = 0.f;
#pragma unroll
    for (int j = 0; j < 3; ++j) { p[j] = (lane + 64 * j <= 128) ? __expf(s[j] - m) : 0.f; lsum += p[j]; }
    lsum = wave_sum(lsum);
    float o = __shfl(p[0], 0) * bf2f(V[row * AW + head * HD + lane]);
    for (int kk = 1; kk <= 128; ++kk) { const float pk = __shfl(kk < 64 ? p[0] : (kk < 128 ? p[1] : p[2]), kk & 63);
        o += pk * cache[((size_t)(Lc - kk * dil) * 2 + 1) * 512 + hh * HD + lane]; }
    bf16_t* OG = (bf16_t*)(P.ws + WS_OG) + ((size_t)g * MT + row) * AO; OG[hh * HD + lane] = f2b(o / lsum);
    if (lane == 0) { float* ML = (float*)(P.ws + WS_ML) + (((size_t)g * MT + row) * HPG + hh) * 2; ML[0] = m; ML[1] = lsum; }
}

constexpr int RING_BYTES = 131072, LDSCTL_OFF = RING_BYTES, MISC_OFF = LDSCTL_OFF + 320, LDS_BYTES = 147456;
constexpr int CW_BAR = 4096;
constexpr int NPH = 1 + 8 * DEPTH;
#ifndef PHMASK
#define PHMASK 63
#endif
struct Args { Ptrs P; int ph_lo, ph_hi, pad0, pad1; };

__global__ void __launch_bounds__(512, 2) mega(Args a) {
    extern __shared__ __attribute__((aligned(16))) unsigned char lds_raw[];
    LAS unsigned char* lds = (LAS unsigned char*)lds_raw;
    const int wv = __builtin_amdgcn_readfirstlane(threadIdx.x >> 6);
#define TID() ((wv << 6) | (int)__builtin_amdgcn_mbcnt_hi(~0u, __builtin_amdgcn_mbcnt_lo(~0u, 0u)))
    { const int tid = TID(); for (int u = tid; u < (LDS_BYTES - LDSCTL_OFF) / 4; u += 512) ((LAS unsigned*)(lds + LDSCTL_OFF))[u] = 0u; }
    __syncthreads();
    unsigned char* ws0 = a.P.ws;
    XcdBarrier bar; bar.bar = (unsigned*)(ws0 + WS_CTL) + CW_BAR; bar.x = 0; bar.st = nullptr; bar.wv = wv;
    if (a.ph_hi - a.ph_lo > 1) bar = xcd_barrier_post((unsigned*)(ws0 + WS_CTL) + CW_BAR, (volatile LAS unsigned*)(lds + MISC_OFF) + 8);
    bar.wv = wv;
    const int G = gridDim.x;
    for (int ph = a.ph_lo; ph < a.ph_hi; ++ph) {
        const Ptrs& P = a.P;
        int bid = blockIdx.x; asm volatile("" : "+s"(bid));
        unsigned char* ws = P.ws;
        if (ph == 0 && (PHMASK & 32)) {
            int t_ = TID(); asm volatile("" : "+v"(t_));
            p0_prologue(P, lds, bid * 8 + wv, G * 8, wv, t_ & 63);
        } else {
            const int l = __builtin_amdgcn_readfirstlane((ph - 1) >> 3), p = __builtin_amdgcn_readfirstlane((ph - 1) & 7);
            unsigned char* wb = ws + WS_W + l * LW_BYTES;
            if (p == 0 && (PHMASK & 1)) {
                pg8::Gemm g{(const bf16_t*)(ws + WS_XB), (const bf16_t*)(wb + LW_W1), MPAD, N1, DM, wv}; pg8::StaticOrder S; S.init(MPAD, N1, G, bid);
                Epi1 E{0, P, l}; pg8::gemm_phase<Epi1, pg8::StaticOrder, true, true>(lds, g, S, E);
            } else if (p == 4 && (PHMASK & 2)) {
                pg8::Gemm g{(const bf16_t*)(ws + WS_A3), (const bf16_t*)(wb + LW_W3), MPAD, DM, K3, wv}; pg8::StaticOrder S; S.init(MPAD, DM, G, bid);
                Epi3 E{DR / 64, P}; pg8::gemm_phase<Epi3, pg8::StaticOrder, true, true>(lds, g, S, E);
            } else if (p == 5 && (PHMASK & 4)) {
                pg8::Gemm g{(const bf16_t*)(ws + WS_MRG), (const bf16_t*)(wb + LW_W4), MPAD, DM, DM, wv}; pg8::StaticOrder S; S.init(MPAD, DM, G, bid);
                EpiRes E{0, P, l == 0 ? 1 : 0}; pg8::gemm_phase<EpiRes, pg8::StaticOrder, true, true>(lds, g, S, E);
            } else if (p == 6 && (PHMASK & 8)) {
                pg8::Gemm g{(const bf16_t*)(ws + WS_XB), (const bf16_t*)(wb + LW_W5), MPAD, 2 * DFF, DM, wv}; pg8::StaticOrder S; S.init(MPAD, 2 * DFF, G, bid);
                Epi5 E{0, P}; pg8::gemm_phase<Epi5, pg8::StaticOrder, true, true>(lds, g, S, E);
            } else if (p == 7 && (PHMASK & 16)) {
                pg8::Gemm g{(const bf16_t*)(ws + WS_H), (const bf16_t*)(wb + LW_W6), MPAD, DM, DFF, wv}; pg8::StaticOrder S; S.init(MPAD, DM, G, bid);
                EpiRes E{0, P, 0}; pg8::gemm_phase<EpiRes, pg8::StaticOrder, true, true>(lds, g, S, E);
            } else if (p >= 1 && p <= 3) {
                int t_ = TID(); asm volatile("" : "+v"(t_));
                const size_t gtid = (size_t)bid * 512 + t_, nth = (size_t)G * 512;
                if (p == 1) {
                    for (int it = bid; it < 256; it += G) scan_item<0>(P, l, lds, wv, t_, it >> 7, (it >> 3) & 15, it & 7);
                    for (int it = bid; it < 1536; it += G) attn_unit(P, l, lds, wv, t_, it);
                    __syncthreads();
                    if (wv < 3) { for (int it = bid * 3 + wv; it < SB * NH; it += G * 3) attn_sample(P, l, lds, wv, t_ & 63, it); }
                } else if (p == 2) {
                    for (int it = bid; it < 256; it += G) scan_item<1>(P, l, lds, wv, t_, it >> 7, (it >> 3) & 15, it & 7);
                    for (int it = bid; it < 64; it += G) scan_sample(P, l, lds, t_, it >> 4, it & 15);
                    ph_combine(P, gtid, nth);
                }
            }
        }
        if (ph + 1 < a.ph_hi) xcd_barrier(bar);
    }
}

extern "C" void kernel_launch(void* const* d_in, const int* in_sizes, int n_in, void* d_out, int out_size, void* d_ws, size_t ws_size, hipStream_t stream) {
    static int grid = 0;
    if (grid == 0) {
        if (n_in != 27 || (size_t)out_size != O_END || ws_size < WS_END) { fprintf(stderr, "kernel_launch: unexpected sizes n_in %d out %d (want %zu) ws %zu (want %zu)\n", n_in, out_size, (size_t)O_END, ws_size, (size_t)WS_END); grid = -1; return; }
        int dev = 0, cus = 0;
        if (hipGetDevice(&dev) != hipSuccess || hipDeviceGetAttribute(&cus, hipDeviceAttributeMultiprocessorCount, dev) != hipSuccess) { grid = -1; return; }
        if (hipFuncSetAttribute((const void*)mega, hipFuncAttributeMaxDynamicSharedMemorySize, LDS_BYTES) != hipSuccess) { fprintf(stderr, "kernel_launch: hipFuncSetAttribute failed\n"); grid = -1; return; }
        grid = cus;
    }
    if (grid < 0) return;
    Args a{};
    Ptrs& P = a.P;
    const float* const* in = (const float* const*)d_in;
    P.x_prompt = in[0]; P.x_sample = in[1]; P.cache[0] = in[2]; P.cache[1] = in[3]; P.cache[2] = in[4]; P.state_conv = in[5]; P.state_h = in[6]; P.rel_bias = in[7];
    P.norm_mix = in[8]; P.w_in = in[9]; P.w_conv = in[10]; P.b_conv = in[11]; P.w_rg_a = in[12]; P.b_rg_a = in[13]; P.w_rg_x = in[14]; P.b_rg_x = in[15];
    P.lru_lambda = in[16]; P.q_gain = in[17]; P.k_gain = in[18]; P.w_merge = in[19]; P.b_merge = in[20]; P.w_branch_lru = in[21]; P.w_branch_att = in[22];
    P.w_o = in[23]; P.norm_ffn = in[24]; P.w_ffn_in = in[25]; P.w_ffn_out = in[26];
    P.out = (float*)d_out; P.ws = (unsigned char*)d_ws;
    (void)hipMemsetAsync((char*)d_ws + WS_CTL, 0, CTL_ZERO_BYTES, stream);
    a.ph_lo = 0; a.ph_hi = NPH;
    hipLaunchKernelGGL(mega, dim3(grid), dim3(512), LDS_BYTES, stream, a);
}
```

```cpp
#include <hip/hip_runtime.h>
#include <stdint.h>
#include <stdio.h>

typedef unsigned short bf16_t;
typedef short bf16x8 __attribute__((ext_vector_type(8)));
typedef float f32x4 __attribute__((ext_vector_type(4)));
typedef unsigned u32x4 __attribute__((ext_vector_type(4)));
typedef unsigned u32x2 __attribute__((ext_vector_type(2)));

constexpr int DM = 1024, NB = 2, SEQ = 8192, DEPTH = 2, SB = 32, PAST = 8192;
constexpr int MP = NB * SEQ;
constexpr int MT = MP + SB;
constexpr int MPAD = 16640;
constexpr int DR = 1024, NBLK = 16, CW = 4;
constexpr int HD = 64, HPG = 8, NG = 3, NH = 24, AW = 1536, AO = 512;
constexpr int DFF = 2816;
constexpr int N1 = 2 * DR + 3 * AW + 2 * DM;
constexpr int K3 = DR + AO;
constexpr float EPS = 1e-6f;
constexpr int NKEY = 129;

__host__ __device__ constexpr int g_dil(int g) { return g == 0 ? 1 : (g == 1 ? 4 : 16); }
__host__ __device__ constexpr int g_win(int g) { return g == 0 ? 128 : (g == 1 ? 512 : 2048); }

constexpr size_t O_Y = 0;
constexpr size_t O_KVP0 = (size_t)MT * DM;
constexpr size_t O_KVP1 = O_KVP0 + (size_t)DEPTH * NB * 128 * 1024;
constexpr size_t O_KVP2 = O_KVP1 + (size_t)DEPTH * NB * 512 * 1024;
constexpr size_t O_CONVP = O_KVP2 + (size_t)DEPTH * NB * 2048 * 1024;
constexpr size_t O_HP = O_CONVP + (size_t)DEPTH * NB * 3 * DR;
constexpr size_t O_KVS0 = O_HP + (size_t)DEPTH * NB * DR;
constexpr size_t O_KVS1 = O_KVS0 + (size_t)DEPTH * SB * 1024;
constexpr size_t O_KVS2 = O_KVS1 + (size_t)DEPTH * SB * 1024;
constexpr size_t O_CONVS = O_KVS2 + (size_t)DEPTH * SB * 1024;
constexpr size_t O_HS = O_CONVS + (size_t)DEPTH * SB * 3 * DR;
constexpr size_t O_END = O_HS + (size_t)DEPTH * SB * DR;
__host__ __device__ constexpr size_t o_kvp(int g) { return g == 0 ? O_KVP0 : (g == 1 ? O_KVP1 : O_KVP2); }
__host__ __device__ constexpr size_t o_kvs(int g) { return g == 0 ? O_KVS0 : (g == 1 ? O_KVS1 : O_KVS2); }

constexpr size_t MiB = 1u << 20;
constexpr size_t rup(size_t x) { return (x + MiB - 1) / MiB * MiB; }
constexpr size_t WS_CTL = 0, CTL_ZERO_BYTES = 1 * MiB;
constexpr size_t WS_BIAS = 1 * MiB;
constexpr size_t WS_SSQ = 2 * MiB;
constexpr size_t WS_SUM = 4 * MiB;
constexpr size_t WS_W = 8 * MiB;
constexpr size_t LW_W1 = 0;
constexpr size_t LW_W3 = LW_W1 + (size_t)N1 * DM * 2;
constexpr size_t LW_W4 = LW_W3 + (size_t)DM * K3 * 2;
constexpr size_t LW_W5 = LW_W4 + (size_t)DM * DM * 2;
constexpr size_t LW_W6 = LW_W5 + (size_t)2 * DFF * DM * 2;
constexpr size_t LW_BYTES = rup(LW_W6 + (size_t)DM * DFF * 2);
constexpr size_t WS_XB = WS_W + DEPTH * LW_BYTES;
constexpr size_t WS_LX = WS_XB + rup((size_t)MPAD * DM * 2);
constexpr size_t WS_GG = WS_LX + rup((size_t)MPAD * DM * 2);
constexpr size_t WS_Q = WS_GG + rup((size_t)MPAD * DM * 2);
constexpr size_t WS_K = WS_Q + rup((size_t)MPAD * AW * 2);
constexpr size_t WS_V = WS_K + rup((size_t)MPAD * AW * 2);
constexpr size_t WS_GM = WS_V + rup((size_t)MPAD * AW * 2);
constexpr size_t WS_OG = WS_GM + rup((size_t)MPAD * 2048 * 2);
constexpr size_t WS_ML = WS_OG + rup((size_t)3 * MPAD * AO * 2);
constexpr size_t WS_A3 = WS_ML + rup((size_t)3 * MPAD * 16 * 4);
constexpr size_t WS_MRG = WS_A3 + rup((size_t)MPAD * K3 * 2);
constexpr size_t WS_H = WS_MRG + rup((size_t)MPAD * DM * 2);
constexpr size_t WS_SIMPLE = WS_H + rup((size_t)MPAD * DFF * 2);
constexpr size_t WS_XC = WS_SIMPLE;
constexpr size_t WS_AA = WS_XC + rup((size_t)MPAD * DM * 4);
constexpr size_t WS_UU = WS_AA + rup((size_t)MPAD * DM * 4);
constexpr size_t WS_END = WS_UU + rup((size_t)MPAD * DM * 4);

__device__ __forceinline__ float bf2f(bf16_t v) { return __uint_as_float(((unsigned)v) << 16); }
__device__ __forceinline__ bf16_t f2b(float f) { unsigned u = __float_as_uint(f); u += 0x7fffu + ((u >> 16) & 1u); return (bf16_t)(u >> 16); }
__device__ __forceinline__ float wave_sum(float v) {
#pragma unroll
    for (int o = 1; o < 64; o <<= 1) v += __shfl_xor(v, o);
    return v;
}
__device__ __forceinline__ float wave_max(float v) {
#pragma unroll
    for (int o = 1; o < 64; o <<= 1) v = fmaxf(v, __shfl_xor(v, o));
    return v;
}
__device__ __forceinline__ float sigmoidf_(float x) { return 1.0f / (1.0f + __expf(-x)); }
__device__ __forceinline__ float gelu_tanh(float x) { const float u = 0.7978845608028654f * (x + 0.044715f * x * x * x); return 0.5f * x * (1.0f + tanhf(u)); }

__host__ __device__ __forceinline__ int w1_src_col(int nt) {
    if (nt < 2048) return nt;
    const int pn = nt >> 8, tc = nt & 255, bj = tc >> 7;
    if (nt >= 6656) return 6656 + bj * 1024 + (pn - 26) * 128 + (tc & 127);
    const int wc = (tc >> 5) & 3, i = tc & 31;
    return 2048 + (pn - 8) * 256 + wc * 64 + bj * 32 + i;
}
__host__ __device__ __forceinline__ int w5_src_col(int nt) { const int pn = nt >> 8, tc = nt & 255, bj = tc >> 7, j = tc & 127; return bj * DFF + pn * 128 + j; }

struct Ptrs {
    const float* x_prompt; const float* x_sample; const float* cache[3]; const float* state_conv; const float* state_h; const float* rel_bias;
    const float* norm_mix; const float* w_in; const float* w_conv; const float* b_conv; const float* w_rg_a; const float* b_rg_a; const float* w_rg_x; const float* b_rg_x;
    const float* lru_lambda; const float* q_gain; const float* k_gain; const float* w_merge; const float* b_merge; const float* w_branch_lru; const float* w_branch_att;
    const float* w_o; const float* norm_ffn; const float* w_ffn_in; const float* w_ffn_out;
    float* out; unsigned char* ws;
};
__device__ __forceinline__ const float* xin_row(const Ptrs& P, int row) { return row < MP ? P.x_prompt + (size_t)row * DM : P.x_sample + (size_t)(row - MP) * DM; }

namespace pg8 {
#define PG8_LAS __attribute__((address_space(3)))
typedef unsigned short bf16_t;
typedef short bf16x8 __attribute__((ext_vector_type(8)));
typedef float f32x4 __attribute__((ext_vector_type(4)));
typedef unsigned u32x4 __attribute__((ext_vector_type(4)));
constexpr int BM = 256, BK = 64, HALF = 128, HTB = HALF * BK * 2  , STAGE_BYTES = 8 * HTB, NXCD = 8, WGM = 8;

__host__ __device__ __forceinline__ int lds_byte(int r, int c) { const int st = (r >> 4) * 2 + (c >> 5), rr = r & 15, cc = c & 31, ob = rr * 64 + cc * 2; return st * 1024 + (ob ^ (((ob >> 9) & 1) << 5)); }
__host__ __device__ __forceinline__ void stage_rc(int b, int& R, int& C) { const int st = b / 1024, sb = b % 1024, swz = sb ^ (((sb >> 9) & 1) << 5); R = (st >> 1) * 16 + swz / 64; C = (st & 1) * 32 + (swz % 64) / 2; }
__host__ __device__ __forceinline__ int perm32(int rho) { const int n = rho >> 4, i = rho & 15; return 8 * (i >> 2) + 4 * n + (i & 3); }

struct Unit { int pm, pn; };
struct Gemm { const bf16_t* A; const bf16_t* Bt; int M, N, K; int wv; };

struct StaticOrder {
    int nM, nN, nwg, G, c;
    __host__ __device__ void init(int M, int N, int G_, int c_) { nM = M / BM; nN = N / BM; nwg = nM * nN; G = G_; c = c_; }
    __host__ __device__ bool next(int i, Unit& u) const {
        const long L = (long)i * G + c; if (L >= nwg) return false;
        int wgid = (int)L; { const int q = nwg / NXCD, r = nwg % NXCD, xcd = wgid % NXCD, off = wgid / NXCD; wgid = (xcd < r ? xcd * (q + 1) : r * (q + 1) + (xcd - r) * q) + off; }
        const int nig = WGM * nN, gid = wgid / nig, fm = gid * WGM, gsz = (nM - fm) < WGM ? (nM - fm) : WGM;
        u.pm = fm + ((wgid % nig) % gsz); u.pn = (wgid % nig) / gsz; return true;
    }
    __device__ __forceinline__ void a_ready(const Unit&) const {}
    __device__ __forceinline__ void done(const Unit&) const {}
};

template <class Epi, class Sched, bool ALIGN_EPI = false, bool SP2 = false>
__device__ __forceinline__ void gemm_phase(PG8_LAS unsigned char* lds, const Gemm g, const Sched& S, const Epi& E) {
    int tid_ = (g.wv << 6) | (int)__builtin_amdgcn_mbcnt_hi(~0u, __builtin_amdgcn_mbcnt_lo(~0u, 0u)); asm volatile("" : "+v"(tid_));
    const int tid = tid_, wid = __builtin_amdgcn_readfirstlane(tid >> 6), lane = tid & 63, wr = wid >> 2, wc = wid & 3, fr = lane & 15, fq = lane >> 4;
    const int K = g.K, nt = K / BK;
    unsigned voffA[2], voffB[2];
#pragma unroll
    for (int i = 0; i < 2; ++i) { int R, C; stage_rc(tid * 16 + i * 8192, R, C); const int Rb = Epi::PERM ? ((R & ~31) + perm32(R & 31)) : R;
        voffA[i] = (unsigned)(R * K + C) * 2u; voffB[i] = (unsigned)(Rb * K + C) * 2u; }
    const size_t kstep = (size_t)(BK * 2);
    const size_t hstep = (size_t)HALF * K * 2;
    const size_t tstep = 2 * hstep;
    const unsigned ldsw = (unsigned)wid * 1024u;
    const int aoff = lds_byte(wr * 64 + fr, fq * 8), boff = lds_byte(wc * 32 + fr, fq * 8);
#define PG8_SA(b, h) (((b) * 2 + (h)) * HTB)
#define PG8_SB(b, h) ((4 + (b) * 2 + (h)) * HTB)
#define PG8_STAGE(bufoff, gbase, voff) do { _Pragma("unroll") for (int _i = 0; _i < 2; ++_i) \
        __builtin_amdgcn_global_load_lds((const unsigned*)((const char*)(gbase) + (voff)[_i]), (PG8_LAS unsigned*)(lds + (bufoff) + ldsw + _i * 8192), 16, 0, 0); } while (0)
#define PG8_LDA(dst, b, h) do { _Pragma("unroll") for (int m = 0; m < 4; ++m) _Pragma("unroll") for (int k = 0; k < 2; ++k) dst[m][k] = *(const PG8_LAS bf16x8*)(lds + PG8_SA(b, h) + aoff + m * 2048 + k * 1024); } while (0)
#define PG8_LDB(dst, b, h) do { _Pragma("unroll") for (int n = 0; n < 2; ++n) _Pragma("unroll") for (int k = 0; k < 2; ++k) dst[n][k] = *(const PG8_LAS bf16x8*)(lds + PG8_SB(b, h) + boff + n * 2048 + k * 1024); } while (0)
#define PG8_MMA(ai, bj, At, Bt) do { __builtin_amdgcn_s_setprio(1); _Pragma("unroll") for (int m = 0; m < 4; ++m) _Pragma("unroll") for (int n = 0; n < 2; ++n) _Pragma("unroll") for (int k = 0; k < 2; ++k) \
        acc[ai][bj][m][n] = __builtin_amdgcn_mfma_f32_16x16x32_bf16(Bt[n][k], At[m][k], acc[ai][bj][m][n], 0, 0, 0); __builtin_amdgcn_s_setprio(0); } while (0)
#define PG8_WAIT_V(n) asm volatile("s_waitcnt vmcnt(" #n ")" ::: "memory")
#define PG8_WAIT_L(n) asm volatile("s_waitcnt lgkmcnt(" #n ")" ::: "memory")
#define PG8_BAR __builtin_amdgcn_s_barrier()
#define PG8_SCHED __builtin_amdgcn_sched_barrier(0)
    Unit cur, nxt; int ui = 0;
    if (!S.next(0, cur)) return;
    f32x4 acc[2][2][4][2];
#pragma unroll
    for (int a = 0; a < 2; ++a)
#pragma unroll
        for (int b = 0; b < 2; ++b)
#pragma unroll
            for (int m = 0; m < 4; ++m)
#pragma unroll
                for (int n = 0; n < 2; ++n) acc[a][b][m][n] = (f32x4){0.f, 0.f, 0.f, 0.f};
    bf16x8 At[4][2], B0[2][2], B1[2][2];
    const char* cA = (const char*)g.A + (size_t)cur.pm * tstep; const char* cB = (const char*)g.Bt + (size_t)cur.pn * tstep;
    S.a_ready(cur);
    if constexpr (SP2) {
        PG8_STAGE(PG8_SB(0, 0), cB, voffB); PG8_STAGE(PG8_SB(0, 1), cB + hstep, voffB); PG8_STAGE(PG8_SA(0, 0), cA, voffA); PG8_STAGE(PG8_SA(0, 1), cA + hstep, voffA);
        if (wr == 1) PG8_BAR;
        PG8_WAIT_V(2); PG8_BAR;
        PG8_STAGE(PG8_SB(1, 0), cB + kstep, voffB); PG8_STAGE(PG8_SA(1, 0), cA + kstep, voffA); PG8_STAGE(PG8_SB(1, 1), cB + hstep + kstep, voffB);
        PG8_WAIT_V(6); PG8_BAR;
    } else {
        PG8_STAGE(PG8_SB(0, 0), cB, voffB); PG8_STAGE(PG8_SA(0, 0), cA, voffA); PG8_STAGE(PG8_SB(0, 1), cB + hstep, voffB); PG8_STAGE(PG8_SA(0, 1), cA + hstep, voffA);
        if (wr == 1) PG8_BAR;
        PG8_WAIT_V(4); PG8_BAR;
        PG8_STAGE(PG8_SB(1, 0), cB + kstep, voffB); PG8_STAGE(PG8_SA(1, 0), cA + kstep, voffA); PG8_STAGE(PG8_SB(1, 1), cB + hstep + kstep, voffB);
        PG8_WAIT_V(6); PG8_BAR;
    }
    for (;;) {
        const bool has_next = S.next(ui + 1, nxt);
        const char* nA = has_next ? (const char*)g.A + (size_t)nxt.pm * tstep : cA; const char* nB = has_next ? (const char*)g.Bt + (size_t)nxt.pn * tstep : cB;
        for (int t = 0; t < nt; t += 2) {
            if constexpr (Epi::HAS_MID) { if (t == E.mid_t) E.mid(acc, cur, wr, wc, fr, fq); }
            const bool last = (t == nt - 2);
            const char* a1 = cA + (size_t)(t + 1) * kstep;
            const char* a2 = last ? nA : cA + (size_t)(t + 2) * kstep; const char* b2 = last ? nB : cB + (size_t)(t + 2) * kstep;
            const char* a3 = a2 + kstep; const char* b3 = b2 + kstep;
            if (last && has_next) S.a_ready(nxt);
            if constexpr (SP2) {
            PG8_LDB(B0, 0, 0); PG8_LDB(B1, 0, 1); PG8_SCHED; PG8_LDA(At, 0, 0); PG8_STAGE(PG8_SA(1, 1), a1 + hstep, voffA);
            PG8_WAIT_V(8); PG8_WAIT_L(0); PG8_BAR; PG8_MMA(0, 0, At, B0); PG8_MMA(0, 1, At, B1); PG8_BAR; PG8_SCHED;
            PG8_LDA(At, 0, 1); PG8_STAGE(PG8_SB(0, 0), b2, voffB); PG8_STAGE(PG8_SB(0, 1), b2 + hstep, voffB); PG8_STAGE(PG8_SA(0, 0), a2, voffA);
            PG8_WAIT_V(8); PG8_WAIT_L(0); PG8_BAR; PG8_MMA(1, 0, At, B0); PG8_MMA(1, 1, At, B1); PG8_BAR; PG8_SCHED;
            PG8_LDB(B0, 1, 0); PG8_LDB(B1, 1, 1); PG8_SCHED; PG8_LDA(At, 1, 0); PG8_STAGE(PG8_SA(0, 1), a2 + hstep, voffA);
            PG8_WAIT_V(8); PG8_WAIT_L(0); PG8_BAR; PG8_MMA(0, 0, At, B0); PG8_MMA(0, 1, At, B1); PG8_BAR; PG8_SCHED;
            PG8_LDA(At, 1, 1); PG8_STAGE(PG8_SB(1, 0), b3, voffB); PG8_STAGE(PG8_SB(1, 1), b3 + hstep, voffB); PG8_STAGE(PG8_SA(1, 0), a3, voffA);
            PG8_WAIT_V(8); PG8_WAIT_L(0); PG8_BAR; PG8_MMA(1, 0, At, B0); PG8_MMA(1, 1, At, B1); PG8_BAR; PG8_SCHED;
            } else {
            PG8_LDB(B0, 0, 0); PG8_SCHED; PG8_LDA(At, 0, 0); PG8_STAGE(PG8_SA(1, 1), a1 + hstep, voffA);
            PG8_WAIT_L(8); PG8_BAR; PG8_WAIT_L(0); PG8_MMA(0, 0, At, B0); PG8_BAR; PG8_SCHED;
            PG8_LDB(B1, 0, 1); PG8_STAGE(PG8_SB(0, 0), b2, voffB);
            PG8_BAR; PG8_WAIT_L(0); PG8_MMA(0, 1, At, B1); PG8_BAR;
            PG8_LDA(At, 0, 1); PG8_STAGE(PG8_SA(0, 0), a2, voffA);
            PG8_BAR; PG8_WAIT_L(0); PG8_MMA(1, 0, At, B0); PG8_BAR; PG8_SCHED;
            PG8_STAGE(PG8_SB(0, 1), b2 + hstep, voffB);
            PG8_WAIT_V(6); PG8_BAR; PG8_MMA(1, 1, At, B1); PG8_BAR;
            PG8_LDB(B0, 1, 0); PG8_SCHED; PG8_LDA(At, 1, 0); PG8_STAGE(PG8_SA(0, 1), a2 + hstep, voffA);
            PG8_WAIT_L(8); PG8_BAR; PG8_WAIT_L(0); PG8_MMA(0, 0, At, B0); PG8_BAR; PG8_SCHED;
            PG8_LDB(B1, 1, 1); PG8_STAGE(PG8_SB(1, 0), b3, voffB);
            PG8_BAR; PG8_WAIT_L(0); PG8_MMA(0, 1, At, B1); PG8_BAR;
            PG8_LDA(At, 1, 1); PG8_STAGE(PG8_SA(1, 0), a3, voffA);
            PG8_BAR; PG8_WAIT_L(0); PG8_MMA(1, 0, At, B0); PG8_BAR; PG8_SCHED;
            PG8_STAGE(PG8_SB(1, 1), b3 + hstep, voffB);
            PG8_WAIT_V(6); PG8_BAR; PG8_MMA(1, 1, At, B1); PG8_BAR;
            }
        }
        if constexpr (ALIGN_EPI) { if (wr == 0) PG8_BAR; }
        if constexpr (!Epi::AFTER_DRAIN) { E(acc, cur, wr, wc, fr, fq); S.done(cur); }
        if (!has_next) break;
#pragma unroll
        for (int a = 0; a < 2; ++a)
#pragma unroll
            for (int b = 0; b < 2; ++b)
#pragma unroll
                for (int m = 0; m < 4; ++m)
#pragma unroll
                    for (int n = 0; n < 2; ++n) acc[a][b][m][n] = (f32x4){0.f, 0.f, 0.f, 0.f};
        cur = nxt; cA = nA; cB = nB; ++ui;
        if constexpr (ALIGN_EPI) { if (wr == 1) PG8_BAR; }
    }
    PG8_WAIT_V(0);
    if constexpr (!ALIGN_EPI) { if (wr == 0) PG8_BAR; }
    PG8_BAR;
    if constexpr (Epi::AFTER_DRAIN) { E.fused(acc, cur, wr, wc, fr, fq, lds, wid, lane); S.done(cur); }
#undef PG8_SA
#undef PG8_SB
#undef PG8_STAGE
#undef PG8_LDA
#undef PG8_LDB
#undef PG8_MMA
#undef PG8_WAIT_V
#undef PG8_WAIT_L
#undef PG8_BAR
#undef PG8_SCHED
}
}
#define GAS __attribute__((address_space(1)))
#define LAS __attribute__((address_space(3)))
typedef unsigned short bf16;
typedef unsigned v4u __attribute__((ext_vector_type(4)));
typedef float f32x4 __attribute__((ext_vector_type(4)));
typedef short bf16x8 __attribute__((ext_vector_type(8)));
typedef GAS unsigned gu32;
typedef GAS unsigned long long gu64;
#define RLX_AGENT __ATOMIC_RELAXED, __HIP_MEMORY_SCOPE_AGENT
#define LDS_WAIT() asm volatile("s_waitcnt lgkmcnt(0)" ::: "memory")
#define VM_WAIT() asm volatile("s_waitcnt vmcnt(0)" ::: "memory")
__device__ __forceinline__ unsigned long long rt() { return __builtin_amdgcn_s_memrealtime(); }
__device__ __forceinline__ unsigned f2bf(float f) { unsigned u = __builtin_bit_cast(unsigned, f); return (u + 0x7fffu + ((u >> 16) & 1u)) >> 16; }
__device__ __forceinline__ unsigned pk2(float lo, float hi) { return f2bf(lo) | (f2bf(hi) << 16); }

#define XB_TMO      128
#define XB_XCNT(j)  (256  + 64 * (j))
#define XB_XSUB(j)  (1280 + 64 * (j))
#define XB_XGEN(j)  (2304 + 64 * (j))
#define XB_TOP      3328
#define XB_TOPGEN   3392
#define XCD_BAR_WORDS 3456
#define XB_SPIN_CAP (1u << 18)

__device__ __forceinline__ unsigned xb_ld(unsigned* p)              { return __hip_atomic_load(p, __ATOMIC_RELAXED, __HIP_MEMORY_SCOPE_AGENT); }
__device__ __forceinline__ unsigned xb_add(unsigned* p, unsigned v) { return __hip_atomic_fetch_add(p, v, __ATOMIC_RELAXED, __HIP_MEMORY_SCOPE_AGENT); }
__device__ __forceinline__ unsigned xb_xcc_id() { return (unsigned)__builtin_amdgcn_s_getreg((3 << 11) | 20) & 0xFu; }
#define XB_SPIN(cond, bar) do { unsigned _sp = 0; while (cond) { __builtin_amdgcn_s_sleep(1); \
    if ((++_sp & 255u) == 0u) { if (xb_ld(&(bar)[XB_TMO])) break; if (_sp > XB_SPIN_CAP) { atomicAdd(&(bar)[XB_TMO], 1u); break; } } } } while (0)

struct XcdBarrier {
    unsigned* bar; unsigned x; int wv;
    volatile LAS unsigned* st;
};

__device__ __forceinline__ XcdBarrier xcd_barrier_post(unsigned* bar, volatile LAS unsigned* st) {
    XcdBarrier b; b.bar = bar; b.x = xb_xcc_id(); b.st = st;
    if (threadIdx.x == 0) (void)xb_add(&bar[XB_XCNT(b.x)], 1u);
    return b;
}
__device__ __forceinline__ void xcd_barrier_complete(unsigned* bar, unsigned x, unsigned& nloc, unsigned& nx) {
    const unsigned G = gridDim.x * gridDim.y * gridDim.z;
    unsigned sum, cnt, mine, sp = 0u;
    for (;;) {
        sum = 0u; cnt = 0u; mine = 0u;
#pragma unroll
        for (unsigned j = 0; j < 16; ++j) { const unsigned c = xb_ld(&bar[XB_XCNT(j)]); sum += c; cnt += (c > 0u) ? 1u : 0u; mine = (j == x) ? c : mine; }
        if (sum == G) break;
        __builtin_amdgcn_s_sleep(1);
        if ((++sp & 255u) == 0u) { if (xb_ld(&bar[XB_TMO])) break; if (sp > XB_SPIN_CAP) { atomicAdd(&bar[XB_TMO], 1u); break; } }
    }
    nloc = mine > 0u ? mine : 1u; nx = cnt > 0u ? cnt : 1u;
}

__device__ __forceinline__ void xcd_barrier(const XcdBarrier& b) {
    asm volatile("s_waitcnt vmcnt(0)" ::: "memory");
    __syncthreads();
    if (b.wv == 0 && __builtin_amdgcn_mbcnt_hi(~0u, __builtin_amdgcn_mbcnt_lo(~0u, 0u)) == 0u) {
        unsigned* bar = b.bar; asm volatile("" : "+s"(bar));
        __builtin_amdgcn_s_waitcnt(0);
        unsigned nloc = b.st[0], nx = b.st[1];
        if (nloc == 0u) { xcd_barrier_complete(bar, b.x, nloc, nx); b.st[0] = nloc; b.st[1] = nx; }
        const unsigned old = xb_add(&bar[XB_XSUB(b.x)], 1u);
        const unsigned gen = old / nloc;
        if (old + 1u == (gen + 1u) * nloc) {
            __builtin_amdgcn_fence(__ATOMIC_RELEASE, "agent");
            asm volatile("s_waitcnt vmcnt(0)" ::: "memory");
            const unsigned og = xb_add(&bar[XB_TOP], 1u);
            const unsigned tg = og / nx;
            if (og + 1u == (tg + 1u) * nx) xb_add(&bar[XB_TOPGEN], 1u);
            else XB_SPIN(xb_ld(&bar[XB_TOPGEN]) == tg, bar);
            __builtin_amdgcn_fence(__ATOMIC_ACQUIRE, "agent");
            xb_add(&bar[XB_XGEN(b.x)], 1u);
            asm volatile("s_waitcnt vmcnt(0)" ::: "memory");
        } else {
            XB_SPIN(xb_ld(&bar[XB_XGEN(b.x)]) == gen, bar);
            __builtin_amdgcn_fence(__ATOMIC_ACQUIRE, "agent");
            asm volatile("s_waitcnt vmcnt(0)" ::: "memory");
        }
    }
    __syncthreads();
}

using pg8::Unit;
#define ROW_FENCE() asm volatile("" ::: "memory")
__device__ __forceinline__ float row_rs(const float* ssq, int row) {
    const f32x4* p = (const f32x4*)(ssq + (size_t)row * 16);
    const f32x4 a = p[0], b = p[1], c = p[2], d = p[3];
    const float s = (((a[0] + a[1]) + (a[2] + a[3])) + ((b[0] + b[1]) + (b[2] + b[3]))) + (((c[0] + c[1]) + (c[2] + c[3])) + ((d[0] + d[1]) + (d[2] + d[3])));
    return rsqrtf(s * (1.0f / DM) + EPS);
}
__device__ __forceinline__ unsigned pkbf(float lo, float hi) { return (unsigned)f2b(lo) | ((unsigned)f2b(hi) << 16); }
__device__ __forceinline__ u32x4 pack8(const f32x4 a, const f32x4 b) { u32x4 w; w.x = pkbf(a[0], a[1]); w.y = pkbf(a[2], a[3]); w.z = pkbf(b[0], b[1]); w.w = pkbf(b[2], b[3]); return w; }
__device__ __forceinline__ float bflo(unsigned w) { return __uint_as_float(w << 16); }
__device__ __forceinline__ float bfhi(unsigned w) { return __uint_as_float(w & 0xffff0000u); }

struct Epi1 {
    static constexpr bool PERM = true, AFTER_DRAIN = false, HAS_MID = false;
    int mid_t; Ptrs P; int l;
    __device__ __forceinline__ void operator()(const f32x4 (&acc)[2][2][4][2], const Unit& u, int wr, int wc, int fr0, int fq) const {
        int fr = fr0; asm volatile("" : "+v"(fr));
        const float* ssq = (const float*)(P.ws + WS_SSQ);
        const int pn = u.pn, c8 = wc * 32 + 8 * fq, row0 = u.pm * 256 + wr * 64 + fr;
        if (pn < 8) {
            bf16_t* dst = (bf16_t*)(P.ws + (pn < 4 ? WS_LX : WS_GG));
            const int colb = (pn & 3) * 256 + c8;
#pragma unroll
            for (int ai = 0; ai < 2; ++ai)
#pragma unroll
                for (int m = 0; m < 4; ++m) {
                    const int row = row0 + ai * 128 + m * 16; const float rs = row_rs(ssq, row);
#pragma unroll
                    for (int bj = 0; bj < 2; ++bj) {
                        f32x4 v0 = acc[ai][bj][m][0] * rs, v1 = acc[ai][bj][m][1] * rs; const int col = colb + bj * 128;
                        if (pn >= 4) {
#pragma unroll
                            for (int e = 0; e < 4; ++e) { v0[e] = gelu_tanh(v0[e]); v1[e] = gelu_tanh(v1[e]); }
                        }
                        *(u32x4*)(dst + (size_t)row * DR + col) = pack8(v0, v1);
                        if (pn < 4) {
                            if (row < MP) { const int t = row & (SEQ - 1); if (t >= SEQ - 3) { const int b = row >> 13; float* o = P.out + O_CONVP + ((size_t)(l * NB + b) * 3 + (t - (SEQ - 3))) * DR + col; *(f32x4*)o = v0; *(f32x4*)(o + 4) = v1; } }
                            else if (row < MT) { const int b = row - MP; float* cs = P.out + O_CONVS + (size_t)(l * SB + b) * 3 * DR + col; const float* sc = P.state_conv + (size_t)(l * SB + b) * 3 * DR + col;
                                *(f32x4*)cs = *(const f32x4*)(sc + DR); *(f32x4*)(cs + 4) = *(const f32x4*)(sc + DR + 4); *(f32x4*)(cs + DR) = *(const f32x4*)(sc + 2 * DR); *(f32x4*)(cs + DR + 4) = *(const f32x4*)(sc + 2 * DR + 4);
                                *(f32x4*)(cs + 2 * DR) = v0; *(f32x4*)(cs + 2 * DR + 4) = v1; }
                        }
                    }
                    ROW_FENCE();
                }
        } else if (pn < 26) {
            const int tq = pn - 8, type = tq / 6, head = 4 * (tq % 6) + wc, g = head >> 3, hh = head & 7;
            bf16_t* dst = (bf16_t*)(P.ws + (type == 0 ? WS_Q : (type == 1 ? WS_K : WS_V)));
            f32x4 gn[2][2];
#pragma unroll
            for (int bj = 0; bj < 2; ++bj)
#pragma unroll
                for (int n = 0; n < 2; ++n) gn[bj][n] = (f32x4){1.f, 1.f, 1.f, 1.f};
            if (type < 2) { const float* gp = (type == 0 ? P.q_gain : P.k_gain) + l * HD;
#pragma unroll
                for (int bj = 0; bj < 2; ++bj)
#pragma unroll
                    for (int n = 0; n < 2; ++n) gn[bj][n] = *(const f32x4*)(gp + 32 * bj + 8 * fq + 4 * n); }
            const int W = g_win(g);
#pragma unroll
            for (int ai = 0; ai < 2; ++ai)
#pragma unroll
                for (int m = 0; m < 4; ++m) {
                    const int row = row0 + ai * 128 + m * 16; const float rs = row_rs(ssq, row);
                    f32x4 v[2][2]; float ss = 0.f;
#pragma unroll
                    for (int bj = 0; bj < 2; ++bj)
#pragma unroll
                        for (int n = 0; n < 2; ++n) { v[bj][n] = acc[ai][bj][m][n] * rs; const f32x4 q = v[bj][n] * v[bj][n]; ss += (q[0] + q[1]) + (q[2] + q[3]); }
                    ss += __shfl_xor(ss, 16); ss += __shfl_xor(ss, 32);
                    const float inv = (type < 2) ? rsqrtf(ss * (1.0f / HD) + EPS) : 1.0f;
#pragma unroll
                    for (int bj = 0; bj < 2; ++bj) {
                        v[bj][0] = v[bj][0] * inv * gn[bj][0]; v[bj][1] = v[bj][1] * inv * gn[bj][1];
                        *(u32x4*)(dst + (size_t)row * AW + head * HD + 32 * bj + 8 * fq) = pack8(v[bj][0], v[bj][1]);
                    }
                    if (type >= 1) {
                        float* o = nullptr;
                        if (row < MP) { const int t = row & (SEQ - 1), b = row >> 13; if (t >= SEQ - W) o = P.out + o_kvp(g) + ((((size_t)(l * NB + b) * W + (t - (SEQ - W))) * 2 + (type - 1)) * HPG + hh) * HD + 8 * fq; }
                        else if (row < MT) { const int b = row - MP; o = P.out + o_kvs(g) + (((size_t)(l * SB + b) * 2 + (type - 1)) * HPG + hh) * HD + 8 * fq; }
                        if (o) {
#pragma unroll
                            for (int bj = 0; bj < 2; ++bj) { *(f32x4*)(o + 32 * bj) = v[bj][0]; *(f32x4*)(o + 32 * bj + 4) = v[bj][1]; } }
                    }
                    ROW_FENCE();
                }
        } else {
            bf16_t* GM = (bf16_t*)(P.ws + WS_GM); const float* bm = P.b_merge + (size_t)l * 2048;
            const int colb = (pn - 26) * 128 + c8;
            f32x4 bv[2][2];
#pragma unroll
            for (int bj = 0; bj < 2; ++bj)
#pragma unroll
                for (int n = 0; n < 2; ++n) bv[bj][n] = *(const f32x4*)(bm + bj * 1024 + colb + 4 * n);
#pragma unroll
            for (int ai = 0; ai < 2; ++ai)
#pragma unroll
                for (int m = 0; m < 4; ++m) {
                    const int row = row0 + ai * 128 + m * 16; const float rs = row_rs(ssq, row);
                    f32x4 rho[2], gav[2];
#pragma unroll
                    for (int n = 0; n < 2; ++n) {
                        const f32x4 xl = acc[ai][0][m][n] * rs + bv[0][n], xa = acc[ai][1][m][n] * rs + bv[1][n];
#pragma unroll
                        for (int e = 0; e < 4; ++e) { const float el = __expf(-xl[e]), ea = fminf(__expf(-xa[e]), 1e30f); gav[n][e] = __builtin_amdgcn_rcpf(1.0f + ea); rho[n][e] = (1.0f + ea) * __builtin_amdgcn_rcpf(1.0f + el); }
                    }
                    *(u32x4*)(GM + (size_t)row * 2048 + colb) = pack8(rho[0], rho[1]);
                    *(u32x4*)(GM + (size_t)row * 2048 + 1024 + colb) = pack8(gav[0], gav[1]);
                    ROW_FENCE();
                }
        }
    }
};

struct Epi3 {
    static constexpr bool PERM = true, AFTER_DRAIN = false, HAS_MID = true;
    int mid_t; Ptrs P;
    __device__ __forceinline__ void mid(f32x4 (&acc)[2][2][4][2], const Unit& u, int wr, int wc, int fr, int fq) const {
        const bf16_t* GM = (const bf16_t*)(P.ws + WS_GM);
        int fr_ = fr; asm volatile("" : "+v"(fr_));
        const int colb = u.pn * 256 + wc * 32 + 8 * fq, row0 = u.pm * 256 + wr * 64 + fr_;
#pragma unroll
        for (int ai = 0; ai < 2; ++ai)
#pragma unroll
            for (int m = 0; m < 4; ++m) {
                const int row = row0 + ai * 128 + m * 16;
#pragma unroll
                for (int bj = 0; bj < 2; ++bj) {
                    const u32x4 gl = *(const u32x4*)(GM + (size_t)row * 2048 + colb + bj * 128);
                    const f32x4 r0 = (f32x4){bflo(gl.x), bfhi(gl.x), bflo(gl.y), bfhi(gl.y)}, r1 = (f32x4){bflo(gl.z), bfhi(gl.z), bflo(gl.w), bfhi(gl.w)};
                    acc[ai][bj][m][0] = acc[ai][bj][m][0] * r0; acc[ai][bj][m][1] = acc[ai][bj][m][1] * r1;
                }
                ROW_FENCE();
            }
    }
    __device__ __forceinline__ void operator()(const f32x4 (&acc)[2][2][4][2], const Unit& u, int wr, int wc, int fr0, int fq) const {
        int fr = fr0; asm volatile("" : "+v"(fr));
        const bf16_t* GM = (const bf16_t*)(P.ws + WS_GM); bf16_t* MRG = (bf16_t*)(P.ws + WS_MRG);
        const int colb = u.pn * 256 + wc * 32 + 8 * fq, row0 = u.pm * 256 + wr * 64 + fr;
#pragma unroll
        for (int ai = 0; ai < 2; ++ai)
#pragma unroll
            for (int m = 0; m < 4; ++m) {
                const int row = row0 + ai * 128 + m * 16;
#pragma unroll
                for (int bj = 0; bj < 2; ++bj) {
                    const u32x4 ga = *(const u32x4*)(GM + (size_t)row * 2048 + 1024 + colb + bj * 128);
                    const f32x4 g0 = (f32x4){bflo(ga.x), bfhi(ga.x), bflo(ga.y), bfhi(ga.y)}, g1 = (f32x4){bflo(ga.z), bfhi(ga.z), bflo(ga.w), bfhi(ga.w)};
                    *(u32x4*)(MRG + (size_t)row * DM + colb + bj * 128) = pack8(acc[ai][bj][m][0] * g0, acc[ai][bj][m][1] * g1);
                }
                ROW_FENCE();
            }
    }
};

struct EpiRes {
    static constexpr bool PERM = false, AFTER_DRAIN = false, HAS_MID = false;
    int mid_t; Ptrs P; int first;
    __device__ __forceinline__ void operator()(const f32x4 (&acc)[2][2][4][2], const Unit& u, int wr, int wc, int fr0, int fq) const {
        int fr = fr0; asm volatile("" : "+v"(fr));
        float* Y = P.out + O_Y; bf16_t* XB = (bf16_t*)(P.ws + WS_XB); float* ssq = (float*)(P.ws + WS_SSQ);
        const int colb = u.pn * 256 + wc * 32 + 4 * fq, row0 = u.pm * 256 + wr * 64 + fr;
#pragma unroll
        for (int ai = 0; ai < 2; ++ai)
#pragma unroll
            for (int m = 0; m < 4; ++m) {
                const int row = row0 + ai * 128 + m * 16; const bool live = row < MT;
                const float* base = first ? xin_row(P, live ? row : 0) : Y + (size_t)(live ? row : 0) * DM;
                float ss = 0.f;
#pragma unroll
                for (int bj = 0; bj < 2; ++bj)
#pragma unroll
                    for (int n = 0; n < 2; ++n) {
                        const int col = colb + bj * 128 + n * 16;
                        f32x4 v = acc[ai][bj][m][n];
                        if (live) { v = v + *(const f32x4*)(base + col); *(f32x4*)(Y + (size_t)row * DM + col) = v; }
                        u32x2 w; w.x = pkbf(v[0], v[1]); w.y = pkbf(v[2], v[3]);
                        *(u32x2*)(XB + (size_t)row * DM + col) = w;
                        ss += (v[0] * v[0] + v[1] * v[1]) + (v[2] * v[2] + v[3] * v[3]);
                    }
                ss += __shfl_xor(ss, 16); ss += __shfl_xor(ss, 32);
                if (fq == 0) ssq[(size_t)row * 16 + u.pn * 4 + wc] = ss;
                ROW_FENCE();
            }
    }
};

struct Epi5 {
    static constexpr bool PERM = true, AFTER_DRAIN = false, HAS_MID = false;
    int mid_t; Ptrs P;
    __device__ __forceinline__ void operator()(const f32x4 (&acc)[2][2][4][2], const Unit& u, int wr, int wc, int fr0, int fq) const {
        int fr = fr0; asm volatile("" : "+v"(fr));
        const float* ssq = (const float*)(P.ws + WS_SSQ); bf16_t* H = (bf16_t*)(P.ws + WS_H);
        const int colb = u.pn * 128 + wc * 32 + 8 * fq, row0 = u.pm * 256 + wr * 64 + fr;
#pragma unroll
        for (int ai = 0; ai < 2; ++ai)
#pragma unroll
            for (int m = 0; m < 4; ++m) {
                const int row = row0 + ai * 128 + m * 16; const float rs = row_rs(ssq, row);
                f32x4 h[2];
#pragma unroll
                for (int n = 0; n < 2; ++n)
#pragma unroll
                    for (int e = 0; e < 4; ++e) { const float gt = acc[ai][0][m][n][e] * rs, up = acc[ai][1][m][n][e] * rs; h[n][e] = gt * sigmoidf_(gt) * up; }
                *(u32x4*)(H + (size_t)row * DFF + colb) = pack8(h[0], h[1]);
                ROW_FENCE();
            }
    }
};

__device__ __forceinline__ void tr_item(const float* W, int N, int s0, int k0, const float* gain, bf16_t* WT, int K, int r0, int kofs, LAS float* scr, int lane) {
#pragma unroll 8
    for (int i = 0; i < 32; ++i) { const int kk = 2 * i + (lane >> 5); float v = W[(size_t)(k0 + kk) * N + s0 + (lane & 31)]; if (gain) v *= gain[k0 + kk]; scr[kk * 33 + (lane & 31)] = v; }
    asm volatile("s_waitcnt lgkmcnt(0)" ::: "memory");
    const int c = lane & 7;
#pragma unroll
    for (int j = 0; j < 4; ++j) { const int n = (lane >> 3) + 8 * j; const LAS float* s = scr + (8 * c) * 33 + n;
        u32x4 o; o.x = pkbf(s[0 * 33], s[1 * 33]); o.y = pkbf(s[2 * 33], s[3 * 33]); o.z = pkbf(s[4 * 33], s[5 * 33]); o.w = pkbf(s[6 * 33], s[7 * 33]);
        *(u32x4*)(WT + (size_t)(r0 + n) * K + kofs + k0 + 8 * c) = o; }
    asm volatile("s_waitcnt lgkmcnt(0)" ::: "memory");
}
constexpr int IT_W1 = (N1 / 32) * (DM / 64), IT_W3A = (DM / 32) * (DR / 64), IT_W3B = (DM / 32) * (AO / 64), IT_W4 = (DM / 32) * (DM / 64), IT_W5 = (2 * DFF / 32) * (DM / 64), IT_W6 = (DM / 32) * (DFF / 64);
constexpr int IT_L = IT_W1 + IT_W3A + IT_W3B + IT_W4 + IT_W5 + IT_W6;
__device__ __forceinline__ void p0_prologue(const Ptrs& P, LAS unsigned char* lds, int gw, int ngw, int wv, int lane) {
    LAS float* scr = (LAS float*)(lds + wv * 16384);
    for (int it = gw; it < DEPTH * IT_L; it += ngw) {
        const int l = it / IT_L; int r = it % IT_L;
        unsigned char* wb = P.ws + WS_W + l * LW_BYTES;
        if (r < IT_W1) { const int kb = r & 15, nb = r >> 4, nt0 = 32 * nb, c = w1_src_col(nt0);
            if (c < 6656) tr_item(P.w_in + (size_t)l * DM * 6656, 6656, c, 64 * kb, P.norm_mix + l * DM, (bf16_t*)(wb + LW_W1), DM, nt0, 0, scr, lane);
            else tr_item(P.w_merge + (size_t)l * DM * 2048, 2048, c - 6656, 64 * kb, P.norm_mix + l * DM, (bf16_t*)(wb + LW_W1), DM, nt0, 0, scr, lane);
            continue; }
        r -= IT_W1;
        if (r < IT_W3A) { const int kb = r & 15, nb = r >> 4; tr_item(P.w_branch_lru + (size_t)l * DR * DM, DM, 32 * nb, 64 * kb, nullptr, (bf16_t*)(wb + LW_W3), K3, 32 * nb, 0, scr, lane); continue; }
        r -= IT_W3A;
        if (r < IT_W3B) { const int kb = r & 7, nb = r >> 3; tr_item(P.w_branch_att + (size_t)l * AO * DM, DM, 32 * nb, 64 * kb, nullptr, (bf16_t*)(wb + LW_W3), K3, 32 * nb, DR, scr, lane); continue; }
        r -= IT_W3B;
        if (r < IT_W4) { const int kb = r & 15, nb = r >> 4; tr_item(P.w_o + (size_t)l * DM * DM, DM, 32 * nb, 64 * kb, nullptr, (bf16_t*)(wb + LW_W4), DM, 32 * nb, 0, scr, lane); continue; }
        r -= IT_W4;
        if (r < IT_W5) { const int kb = r & 15, nb = r >> 4, nt0 = 32 * nb; tr_item(P.w_ffn_in + (size_t)l * DM * 2 * DFF, 2 * DFF, w5_src_col(nt0), 64 * kb, P.norm_ffn + l * DM, (bf16_t*)(wb + LW_W5), DM, nt0, 0, scr, lane); continue; }
        r -= IT_W5;
        { const int kb = r % 44, nb = r / 44; tr_item(P.w_ffn_out + (size_t)l * DFF * DM, DM, 32 * nb, 64 * kb, nullptr, (bf16_t*)(wb + LW_W6), DFF, 32 * nb, 0, scr, lane); }
    }
    float* BIAS = (float*)(P.ws + WS_BIAS);
    for (int e = gw * 64 + lane; e < NG * HPG * NKEY; e += ngw * 64) {
        const int kk = e % NKEY, hh = (e / NKEY) % HPG, g = e / (NKEY * HPG);
        const int d = kk * g_dil(g); int bkt;
        if (d < 16) bkt = d; else { const float df = (float)d; int lg = 16 + (int)(logf(df / 16.0f) / logf(128.0f) * 16.0f); bkt = lg < 31 ? lg : 31; }
        BIAS[e] = P.rel_bias[bkt * NH + 8 * g + hh];
    }
    for (int row = gw; row < MT; row += ngw) {
        const f32x4* xr = (const f32x4*)xin_row(P, row) + lane; bf16_t* xb = (bf16_t*)(P.ws + WS_XB) + (size_t)row * DM; float* ssq = (float*)(P.ws + WS_SSQ) + (size_t)row * 16;
        float s = 0.f;
#pragma unroll
        for (int j = 0; j < 4; ++j) { const f32x4 v = xr[64 * j]; s += (v[0] * v[0] + v[1] * v[1]) + (v[2] * v[2] + v[3] * v[3]);
            u32x2 w; w.x = pkbf(v[0], v[1]); w.y = pkbf(v[2], v[3]); *(u32x2*)(xb + 4 * lane + 256 * j) = w; }
        s = wave_sum(s);
        if (lane < 16) ssq[lane] = (lane == 0) ? s : 0.f;
    }
}

__device__ __forceinline__ void ph_conv(const Ptrs& P, int l, size_t gtid, size_t nth) {
    const bf16_t* LX = (const bf16_t*)(P.ws + WS_LX);
    const float* wc = P.w_conv + (size_t)l * CW * DR;
    for (size_t e = gtid; e < (size_t)MT * DR; e += nth) {
        const int row = (int)(e / DR), ch = (int)(e % DR);
        float acc = P.b_conv[l * DR + ch];
        if (row < MP) { const int t = row % SEQ;
#pragma unroll
            for (int k = 0; k < CW; ++k) { const int tt = t + k - 3; if (tt >= 0) acc += wc[k * DR + ch] * bf2f(LX[(size_t)(row + k - 3) * DR + ch]); } }
        else { const int b = row - MP; const float* sc = P.state_conv + (size_t)(l * SB + b) * 3 * DR;
            acc += wc[0 * DR + ch] * sc[ch] + wc[1 * DR + ch] * sc[DR + ch] + wc[2 * DR + ch] * sc[2 * DR + ch] + wc[3 * DR + ch] * bf2f(LX[(size_t)row * DR + ch]); }
        ((float*)(P.ws + WS_XC))[e] = acc;
    }
}
__device__ __forceinline__ void ph_gates(const Ptrs& P, int l, size_t gtid, size_t nth) {
    for (size_t e = gtid; e < (size_t)MT * DR; e += nth) {
        const int row = (int)(e / DR), ch = (int)(e % DR), n = ch >> 6, j = ch & 63;
        const float* XC = (const float*)(P.ws + WS_XC) + (size_t)row * DR + n * 64;
        const float* wa = P.w_rg_a + ((size_t)(l * NBLK + n) * 64) * 64 + j; const float* wx = P.w_rg_x + ((size_t)(l * NBLK + n) * 64) * 64 + j;
        float ga = P.b_rg_a[l * DR + ch], gx = P.b_rg_x[l * DR + ch];
        for (int i = 0; i < 64; ++i) { const float x = XC[i]; ga += x * wa[i * 64]; gx += x * wx[i * 64]; }
        const float rr = sigmoidf_(ga), ii = sigmoidf_(gx);
        const float lam = P.lru_lambda[l * DR + ch]; const float sp = log1pf(expf(-lam));
        const float log_a = -8.0f * rr * sp; const float av = expf(log_a);
        const bool pos0 = (row < MP) && (row % SEQ == 0);
        const float mult = pos0 ? 1.0f : sqrtf(-expm1f(2.0f * log_a));
        ((float*)(P.ws + WS_AA))[e] = av; ((float*)(P.ws + WS_UU))[e] = mult * ii * XC[j];
    }
}
__device__ __forceinline__ void ph_scan(const Ptrs& P, int l, size_t gtid, size_t nth) {
    const float* AA = (const float*)(P.ws + WS_AA); const float* UU = (const float*)(P.ws + WS_UU);
    const bf16_t* GG = (const bf16_t*)(P.ws + WS_GG); bf16_t* A3 = (bf16_t*)(P.ws + WS_A3);
    for (size_t e = gtid; e < (size_t)(NB + SB) * DR; e += nth) {
        const int s = (int)(e / DR), ch = (int)(e % DR);
        if (s < NB) { float h = 0.f; const size_t r0 = (size_t)s * SEQ;
            for (int t = 0; t < SEQ; t += 8) { float av[8], u[8], g[8];
#pragma unroll
                for (int i = 0; i < 8; ++i) { const size_t o = (r0 + t + i) * DR + ch; av[i] = AA[o]; u[i] = UU[o]; g[i] = bf2f(GG[o]); }
#pragma unroll
                for (int i = 0; i < 8; ++i) { h = av[i] * h + u[i]; A3[(r0 + t + i) * K3 + ch] = f2b(h * g[i]); } }
            P.out[O_HP + (size_t)(l * NB + s) * DR + ch] = h;
        } else { const int b = s - NB; const size_t o = (size_t)(MP + b) * DR + ch; float h = P.state_h[(size_t)(l * SB + b) * DR + ch];
            h = AA[o] * h + UU[o]; A3[(size_t)(MP + b) * K3 + ch] = f2b(h * bf2f(GG[o])); P.out[O_HS + (size_t)(l * SB + b) * DR + ch] = h; }
    }
}
__device__ __forceinline__ void ph_attn(const Ptrs& P, int l, int gwave, int nwaves, int lane, LAS float* qw) {
    const bf16_t* Q = (const bf16_t*)(P.ws + WS_Q); const bf16_t* K = (const bf16_t*)(P.ws + WS_K); const bf16_t* V = (const bf16_t*)(P.ws + WS_V);
    for (int gw = gwave; gw < MT * NH; gw += nwaves) {
        const int row = gw / NH, head = gw % NH, g = head / HPG, hh = head % HPG, dil = g_dil(g);
        const float* BIAS = (const float*)(P.ws + WS_BIAS) + (size_t)(g * HPG + hh) * NKEY;
        const bool samp = row >= MP; const int b = samp ? row - MP : row / SEQ, t = samp ? 0 : row % SEQ;
        const int nkeys = samp ? NKEY : ((t / dil) < 128 ? (t / dil) + 1 : NKEY);
        const float* cbase = (g == 0 ? P.cache[0] : (g == 1 ? P.cache[1] : P.cache[2]));
        const float* cache = cbase + (size_t)(l * SB + (samp ? b : 0)) * g_win(g) * 1024;
        const int Lc = g_win(g);
        asm volatile("" ::: "memory");
        qw[lane] = bf2f(Q[(size_t)row * AW + head * HD + lane]);
        asm volatile("s_waitcnt lgkmcnt(0)" ::: "memory");
        float s[3];
#pragma unroll
        for (int j = 0; j < 3; ++j) { const int kk = lane + 64 * j; float acc = -INFINITY;
            if (kk < nkeys) { acc = 0.f;
                if (!samp || kk == 0) { const bf16_t* kr = K + (size_t)(row - kk * dil) * AW + head * HD;
                    for (int d = 0; d < HD; ++d) acc += qw[d] * bf2f(kr[d]); }
                else { const float* kr = cache + ((size_t)(Lc - kk * dil) * 2 + 0) * 512 + hh * HD;
                    for (int d = 0; d < HD; ++d) acc += qw[d] * kr[d]; }
                acc = acc * 0.125f + BIAS[kk]; }
            s[j] = acc; }
        const float m = wave_max(fmaxf(fmaxf(s[0], s[1]), s[2]));
        float p[3]; float lsum = 0.f;
#pragma unroll
        for (int j = 0; j < 3; ++j) { p[j] = (lane + 64 * j < nkeys) ? __expf(s[j] - m) : 0.f; lsum += p[j]; }
        lsum = wave_sum(lsum);
        float o = 0.f;
        for (int kk = 0; kk < nkeys; ++kk) { const float pk = __shfl(kk < 64 ? p[0] : (kk < 128 ? p[1] : p[2]), kk & 63);
            float vv;
            if (!samp || kk == 0) vv = bf2f(V[(size_t)(row - kk * dil) * AW + head * HD + lane]);
            else vv = cache[((size_t)(Lc - kk * dil) * 2 + 1) * 512 + hh * HD + lane];
            o += pk * vv; }
        bf16_t* OG = (bf16_t*)(P.ws + WS_OG) + ((size_t)g * MT + row) * AO; OG[hh * HD + lane] = f2b(o / lsum);
        if (lane == 0) { float* ML = (float*)(P.ws + WS_ML) + (((size_t)g * MT + row) * HPG + hh) * 2; ML[0] = m; ML[1] = lsum; }
    }
}
__device__ __forceinline__ void ph_combine(const Ptrs& P, size_t gtid, size_t nth) {
    const bf16_t* OG = (const bf16_t*)(P.ws + WS_OG); const float* ML = (const float*)(P.ws + WS_ML);
    for (size_t e = gtid; e < (size_t)MT * AO; e += nth) {
        const int row = (int)(e / AO), c = (int)(e % AO), hh = c >> 6;
        float m[3], lz[3], mm = -INFINITY;
#pragma unroll
        for (int g = 0; g < 3; ++g) { const float* q = ML + (((size_t)g * MT + row) * HPG + hh) * 2; m[g] = q[0]; lz[g] = q[1]; mm = fmaxf(mm, m[g]); }
        float num = 0.f, den = 0.f;
#pragma unroll
        for (int g = 0; g < 3; ++g) { const float z = lz[g] * __expf(m[g] - mm); num += z * bf2f(OG[((size_t)g * MT + row) * AO + c]); den += z; }
        ((bf16_t*)(P.ws + WS_A3))[(size_t)row * K3 + DR + c] = f2b(num / den);
    }
}

constexpr int SC_XCF = 0;
constexpr int SC_HSF = 34816;
constexpr int SC_XCB = 69632;
constexpr int SC_WTA = 88064;
constexpr int SC_WTX = 97280;
constexpr int SC_WTOT = 106496;
constexpr int SC_WC = 110592;
constexpr int SC_END = 111872;
typedef float f32x2 __attribute__((ext_vector_type(2)));

template <int MODE>
__device__ __forceinline__ void scan_item(const Ptrs& P, int l, LAS unsigned char* lds, int wv, int tid, int b, int n, int span) {
    const int lane = tid & 63, fr = lane & 15, fq = lane >> 4;
    LAS float* XCF = (LAS float*)(lds + SC_XCF); LAS float* HSF = (LAS float*)(lds + SC_HSF); LAS bf16_t* XCB = (LAS bf16_t*)(lds + SC_XCB);
    LAS bf16_t* WTA = (LAS bf16_t*)(lds + SC_WTA); LAS bf16_t* WTX = (LAS bf16_t*)(lds + SC_WTX);
    LAS f32x2* WTOT = (LAS f32x2*)(lds + SC_WTOT); LAS float* WC = (LAS float*)(lds + SC_WC);
    const bf16_t* LX = (const bf16_t*)(P.ws + WS_LX); const bf16_t* GG = (const bf16_t*)(P.ws + WS_GG); bf16_t* A3 = (bf16_t*)(P.ws + WS_A3);
    float* SUM = (float*)(P.ws + WS_SUM);
    __syncthreads();
    {
        const float* wa = P.w_rg_a + (size_t)(l * NBLK + n) * 4096; const float* wx = P.w_rg_x + (size_t)(l * NBLK + n) * 4096;
        for (int e = tid; e < 4096; e += 512) { const int i = e >> 6, j = e & 63; WTA[j * 72 + i] = f2b(wa[e]); WTX[j * 72 + i] = f2b(wx[e]); }
        if (tid < 320) { const int k = tid >> 6, c = tid & 63; WC[tid] = (k < 4) ? P.w_conv[(size_t)(l * CW + k) * DR + 64 * n + c] : P.b_conv[l * DR + 64 * n + c]; }
    }
    __syncthreads();
    bf16x8 wfa[4][2], wfx[4][2];
#pragma unroll
    for (int nt = 0; nt < 4; ++nt)
#pragma unroll
        for (int ks = 0; ks < 2; ++ks) { wfa[nt][ks] = *(const LAS bf16x8*)(WTA + (16 * nt + fr) * 72 + 32 * ks + 8 * fq); wfx[nt][ks] = *(const LAS bf16x8*)(WTX + (16 * nt + fr) * 72 + 32 * ks + 8 * fq); }
    float cba[4], cbx[4], csp[4], hc[4], pc[4];
#pragma unroll
    for (int nt = 0; nt < 4; ++nt) { const int ch = 64 * n + 16 * nt + fr;
        cba[nt] = P.b_rg_a[l * DR + ch]; cbx[nt] = P.b_rg_x[l * DR + ch]; csp[nt] = 8.0f * log1pf(expf(-P.lru_lambda[l * DR + ch]));
        float h = 0.f;
        if (MODE == 1) { for (int s = 0; s < span; ++s) { const f32x2 q = *(const f32x2*)(SUM + (((size_t)b * 8 + s) * DR + ch) * 2); h = q.x * h + q.y; } }
        hc[nt] = h; pc[nt] = 1.f; }
    for (int c8 = 0; c8 < 8; ++c8) {
        const int t0 = span * 1024 + c8 * 128;
        u32x4 gg[2];
#pragma unroll
        for (int rep = 0; rep < 2; ++rep) {
            const int idx = tid + 512 * rep, tok = idx >> 3, cg = idx & 7, t = t0 + tok; const size_t rowg = (size_t)b * SEQ + t;
            float acc[8];
#pragma unroll
            for (int j = 0; j < 8; ++j) acc[j] = WC[4 * 64 + 8 * cg + j];
#pragma unroll
            for (int k = 0; k < 4; ++k) { const int tt = t + k - 3;
                if (tt >= 0) { const u32x4 x = *(const u32x4*)(LX + (rowg + k - 3) * DR + 64 * n + 8 * cg);
                    const LAS float* w = WC + k * 64 + 8 * cg;
                    acc[0] += w[0] * bflo(x.x); acc[1] += w[1] * bfhi(x.x); acc[2] += w[2] * bflo(x.y); acc[3] += w[3] * bfhi(x.y);
                    acc[4] += w[4] * bflo(x.z); acc[5] += w[5] * bfhi(x.z); acc[6] += w[6] * bflo(x.w); acc[7] += w[7] * bfhi(x.w); } }
            *(LAS f32x4*)(XCF + tok * 68 + 8 * cg) = (f32x4){acc[0], acc[1], acc[2], acc[3]}; *(LAS f32x4*)(XCF + tok * 68 + 8 * cg + 4) = (f32x4){acc[4], acc[5], acc[6], acc[7]};
            *(LAS u32x4*)(XCB + tok * 72 + 8 * cg) = pack8((f32x4){acc[0], acc[1], acc[2], acc[3]}, (f32x4){acc[4], acc[5], acc[6], acc[7]});
            if (MODE == 1) gg[rep] = *(const u32x4*)(GG + rowg * DR + 64 * n + 8 * cg);
        }
        __syncthreads();
        bf16x8 af[2];
#pragma unroll
        for (int ks = 0; ks < 2; ++ks) af[ks] = *(const LAS bf16x8*)(XCB + (16 * wv + fr) * 72 + 32 * ks + 8 * fq);
        float hl[4][4], ac[4][4], Ae[4], He[4];
#pragma unroll
        for (int nt = 0; nt < 4; ++nt) {
            f32x4 da = (f32x4){0.f, 0.f, 0.f, 0.f}, dx = (f32x4){0.f, 0.f, 0.f, 0.f};
#pragma unroll
            for (int ks = 0; ks < 2; ++ks) { da = __builtin_amdgcn_mfma_f32_16x16x32_bf16(af[ks], wfa[nt][ks], da, 0, 0, 0); dx = __builtin_amdgcn_mfma_f32_16x16x32_bf16(af[ks], wfx[nt][ks], dx, 0, 0, 0); }
            float A = 1.f, H = 0.f;
#pragma unroll
            for (int r = 0; r < 4; ++r) {
                const int tok = 16 * wv + 4 * fq + r;
                const float rr = sigmoidf_(da[r] + cba[nt]), ii = sigmoidf_(dx[r] + cbx[nt]);
                const float av = __expf(-rr * csp[nt]);
                float mult = sqrtf(fmaxf(fmaf(-av, av, 1.0f), 0.f)); if (t0 + tok == 0) mult = 1.0f;
                const float u = mult * ii * XCF[tok * 68 + 16 * nt + fr];
                H = av * H + u; A = A * av; hl[nt][r] = H; ac[nt][r] = A;
            }
            { const float A1 = __shfl(A, lane - 16), H1 = __shfl(H, lane - 16); if (fq >= 1) { H = A * H1 + H; A = A * A1; } }
            { const float A2 = __shfl(A, lane - 32), H2 = __shfl(H, lane - 32); if (fq >= 2) { H = A * H2 + H; A = A * A2; } }
            { const float A3_ = __shfl(A, lane - 16), H3 = __shfl(H, lane - 16); Ae[nt] = (fq >= 1) ? A3_ : 1.f; He[nt] = (fq >= 1) ? H3 : 0.f; }
            if (fq == 3) WTOT[wv * 64 + 16 * nt + fr] = (f32x2){A, H};
        }
        __syncthreads();
#pragma unroll
        for (int nt = 0; nt < 4; ++nt) {
            float hrun = hc[nt], prun = pc[nt], hin = 0.f;
#pragma unroll
            for (int w = 0; w < 8; ++w) { const f32x2 q = WTOT[w * 64 + 16 * nt + fr]; if (w == wv) hin = hrun; hrun = q.x * hrun + q.y; prun = prun * q.x; }
            hc[nt] = hrun; pc[nt] = prun;
            if (MODE == 1) {
#pragma unroll
                for (int r = 0; r < 4; ++r) { const int tok = 16 * wv + 4 * fq + r; HSF[tok * 68 + 16 * nt + fr] = (ac[nt][r] * Ae[nt]) * hin + (ac[nt][r] * He[nt] + hl[nt][r]); }
            }
        }
        if (MODE == 1) {
            __syncthreads();
#pragma unroll
            for (int rep = 0; rep < 2; ++rep) {
                const int idx = tid + 512 * rep, tok = idx >> 3, cg = idx & 7; const size_t rowg = (size_t)b * SEQ + t0 + tok;
                const f32x4 h0 = *(const LAS f32x4*)(HSF + tok * 68 + 8 * cg), h1 = *(const LAS f32x4*)(HSF + tok * 68 + 8 * cg + 4);
                const u32x4 g = gg[rep];
                const f32x4 o0 = (f32x4){h0[0] * bflo(g.x), h0[1] * bfhi(g.x), h0[2] * bflo(g.y), h0[3] * bfhi(g.y)}, o1 = (f32x4){h1[0] * bflo(g.z), h1[1] * bfhi(g.z), h1[2] * bflo(g.w), h1[3] * bfhi(g.w)};
                *(u32x4*)(A3 + rowg * K3 + 64 * n + 8 * cg) = pack8(o0, o1);
            }
        }
    }
    if (wv == 0 && fq == 0) {
#pragma unroll
        for (int nt = 0; nt < 4; ++nt) { const int ch = 64 * n + 16 * nt + fr;
            if (MODE == 0) *(f32x2*)(SUM + (((size_t)b * 8 + span) * DR + ch) * 2) = (f32x2){pc[nt], hc[nt]};
            else if (span == 7) P.out[O_HP + (size_t)(l * NB + b) * DR + ch] = hc[nt]; }
    }
}
__device__ __forceinline__ void scan_sample(const Ptrs& P, int l, LAS unsigned char* lds, int tid, int rg, int n) {
    LAS float* XS = (LAS float*)lds;
    const int r = tid >> 6, j = tid & 63, b = 8 * rg + r, ch = 64 * n + j; const size_t row = (size_t)MP + b;
    const bf16_t* LX = (const bf16_t*)(P.ws + WS_LX); const bf16_t* GG = (const bf16_t*)(P.ws + WS_GG); bf16_t* A3 = (bf16_t*)(P.ws + WS_A3);
    const float* wc = P.w_conv + (size_t)l * CW * DR; const float* sc = P.state_conv + (size_t)(l * SB + b) * 3 * DR;
    const float xc = P.b_conv[l * DR + ch] + wc[ch] * sc[ch] + wc[DR + ch] * sc[DR + ch] + wc[2 * DR + ch] * sc[2 * DR + ch] + wc[3 * DR + ch] * bf2f(LX[row * DR + ch]);
    __syncthreads();
    XS[r * 64 + j] = xc;
    __syncthreads();
    const float* wa = P.w_rg_a + (size_t)(l * NBLK + n) * 4096 + j; const float* wx = P.w_rg_x + (size_t)(l * NBLK + n) * 4096 + j;
    float ga = P.b_rg_a[l * DR + ch], gx = P.b_rg_x[l * DR + ch];
    for (int i = 0; i < 64; ++i) { const float x = XS[r * 64 + i]; ga += x * wa[i * 64]; gx += x * wx[i * 64]; }
    const float rr = sigmoidf_(ga), ii = sigmoidf_(gx);
    const float log_a = -8.0f * rr * log1pf(expf(-P.lru_lambda[l * DR + ch])); const float av = expf(log_a);
    const float mult = sqrtf(-expm1f(2.0f * log_a));
    const float h = av * P.state_h[(size_t)(l * SB + b) * DR + ch] + mult * ii * xc;
    P.out[O_HS + (size_t)(l * SB + b) * DR + ch] = h;
    A3[row * K3 + ch] = f2b(h * bf2f(GG[row * DR + ch]));
}

constexpr int AT_K = 0, AT_V = 49152, AT_B = 98304, AT_W = 99328, AT_END = 101376;
typedef float f32x16 __attribute__((ext_vector_type(16)));
typedef short s16x4 __attribute__((ext_vector_type(4)));
__device__ __forceinline__ int crow(int r, int hi) { return (r & 3) + 8 * (r >> 2) + 4 * hi; }
__device__ __forceinline__ s16x4 ds_tr16(const LAS unsigned char* p) { return __builtin_bit_cast(s16x4, __builtin_amdgcn_ds_read_tr16_b64_v4i16((LAS s16x4*)p)); }

__device__ __forceinline__ void attn_unit(const Ptrs& P, int l, LAS unsigned char* lds, int wv, int tid, int unit) {
    const int lane = tid & 63, l31 = lane & 31, hi = lane >> 5;
    const int g = unit >> 9, rem = unit & 511, b = rem >> 8, hh = (rem >> 5) & 7, ru = rem & 31;
    const int d = g_dil(g), nub = 32 / d, rho = ru / nub, u = ru % nub, head = 8 * g + hh, j0 = 256 * u;
    const bf16_t* Q = (const bf16_t*)(P.ws + WS_Q); const bf16_t* K = (const bf16_t*)(P.ws + WS_K); const bf16_t* V = (const bf16_t*)(P.ws + WS_V);
    const size_t rowbase = (size_t)b * SEQ + rho;
    LAS float* BL = (LAS float*)(lds + AT_B); LAS float* LW = (LAS float*)(lds + AT_W) + wv * 64;
    __syncthreads();
#pragma unroll
    for (int i = 0; i < 6; ++i) {
        const int idx = tid + 512 * i, key = idx >> 3, ch = idx & 7, j = j0 - 128 + key;
        u32x4 kq = (u32x4){0u, 0u, 0u, 0u}, vq = (u32x4){0u, 0u, 0u, 0u};
        if (j >= 0) { const size_t off = (rowbase + (size_t)d * j) * AW + head * HD + 8 * ch; kq = *(const u32x4*)(K + off); vq = *(const u32x4*)(V + off); }
        *(LAS u32x4*)(lds + AT_K + key * 128 + ((ch ^ ((key >> 1) & 7)) << 4)) = kq;
        *(LAS u32x4*)(lds + AT_V + key * 128 + (ch << 4)) = vq;
    }
    if (tid < NKEY) BL[tid] = ((const float*)(P.ws + WS_BIAS))[(size_t)(g * HPG + hh) * NKEY + tid];
    bf16x8 qf[4];
    { const size_t rq = (rowbase + (size_t)d * (j0 + 32 * wv + l31)) * AW + head * HD + 8 * hi;
#pragma unroll
      for (int ks = 0; ks < 4; ++ks) qf[ks] = *(const bf16x8*)(Q + rq + 16 * ks); }
    __syncthreads();
    f32x16 S[5];
#pragma unroll
    for (int c = 0; c < 5; ++c) {
        const int key = 32 * (wv + c) + l31;
        f32x16 acc = {};
#pragma unroll
        for (int ks = 0; ks < 4; ++ks) {
            const bf16x8 kf = *(const LAS bf16x8*)(lds + AT_K + key * 128 + (((2 * ks + hi) ^ ((key >> 1) & 7)) << 4));
            acc = __builtin_amdgcn_mfma_f32_32x32x16_bf16(kf, qf[ks], acc, 0, 0, 0);
        }
        S[c] = acc;
    }
    float mx = -INFINITY;
#pragma unroll
    for (int c = 0; c < 5; ++c) {
        const bool tile_ok = (u > 0) || (wv + c >= 4);
#pragma unroll
        for (int r = 0; r < 16; ++r) {
            const int dist = 128 - 32 * c + l31 - crow(r, hi);
            const bool ok = tile_ok && dist >= 0 && dist <= 128;
            const int dc = dist < 0 ? 0 : (dist > 128 ? 128 : dist);
            const float s = ok ? S[c][r] * 0.125f + BL[dc] : -INFINITY;
            S[c][r] = s; mx = fmaxf(mx, s);
        }
    }
    mx = fmaxf(mx, __shfl_xor(mx, 32));
    float lsum = 0.f;
#pragma unroll
    for (int c = 0; c < 5; ++c)
#pragma unroll
        for (int r = 0; r < 16; ++r) { const float p = __expf(S[c][r] - mx); S[c][r] = p; lsum += p; }
    lsum += __shfl_xor(lsum, 32);
    if (hi == 0) { LW[l31] = lsum;
        float* ML = (float*)(P.ws + WS_ML) + (((size_t)g * MT + rowbase + (size_t)d * (j0 + 32 * wv + l31)) * HPG + hh) * 2; ML[0] = mx; ML[1] = lsum; }
    f32x16 o[2]; o[0] = (f32x16){}; o[1] = (f32x16){};
    const int g16 = lane >> 4, i16 = lane & 15;
    const LAS unsigned char* vb = lds + AT_V + (4 * hi + (i16 >> 2)) * 128 + (16 * (g16 & 1) + 4 * (i16 & 3)) * 2;
#pragma unroll
    for (int c = 0; c < 5; ++c)
#pragma unroll
        for (int s = 0; s < 2; ++s) {
            bf16x8 pa;
#pragma unroll
            for (int j = 0; j < 8; j += 2) { const unsigned w = pkbf(S[c][8 * s + j], S[c][8 * s + j + 1]); pa[j] = (short)(w & 0xffffu); pa[j + 1] = (short)(w >> 16); }
            const LAS unsigned char* vp = vb + (32 * (wv + c) + 16 * s) * 128;
#pragma unroll
            for (int db = 0; db < 2; ++db) {
                const s16x4 lo = ds_tr16(vp + 64 * db), hi4 = ds_tr16(vp + 64 * db + 8 * 128);
                const bf16x8 vf = (bf16x8){lo[0], lo[1], lo[2], lo[3], hi4[0], hi4[1], hi4[2], hi4[3]};
                o[db] = __builtin_amdgcn_mfma_f32_32x32x16_bf16(pa, vf, o[db], 0, 0, 0);
            }
        }
    bf16_t* OG = (bf16_t*)(P.ws + WS_OG) + (size_t)g * MT * AO;
#pragma unroll
    for (int r = 0; r < 16; ++r) {
        const int q = crow(r, hi); const float inv = 1.0f / LW[q];
        const size_t row = rowbase + (size_t)d * (j0 + 32 * wv + q);
        OG[row * AO + hh * HD + l31] = f2b(o[0][r] * inv); OG[row * AO + hh * HD + 32 + l31] = f2b(o[1][r] * inv);
    }
}
__device__ __forceinline__ void attn_sample(const Ptrs& P, int l, LAS unsigned char* lds, int wv, int lane, int item) {
    const int b = item / NH, head = item % NH, g = head >> 3, hh = head & 7, dil = g_dil(g), Lc = g_win(g);
    const bf16_t* Q = (const bf16_t*)(P.ws + WS_Q); const bf16_t* K = (const bf16_t*)(P.ws + WS_K); const bf16_t* V = (const bf16_t*)(P.ws + WS_V);
    const float* BIAS = (const float*)(P.ws + WS_BIAS) + (size_t)(g * HPG + hh) * NKEY;
    const float* cache = P.cache[g] + (size_t)(l * SB + b) * Lc * 1024;
    const size_t row = (size_t)MP + b;
    LAS float* qw = (LAS float*)(lds + AT_W) + wv * 64;
    qw[lane] = bf2f(Q[row * AW + head * HD + lane]);
    asm volatile("s_waitcnt lgkmcnt(0)" ::: "memory");
    float s[3];
#pragma unroll
    for (int j = 0; j < 3; ++j) { const int kk = lane + 64 * j; float acc = -INFINITY;
        if (kk <= 128) { acc = 0.f;
            if (kk == 0) { const bf16_t* kr = K + row * AW + head * HD; for (int dd = 0; dd < HD; ++dd) acc += qw[dd] * bf2f(kr[dd]); }
            else { const f32x4* kr = (const f32x4*)(cache + ((size_t)(Lc - kk * dil) * 2 + 0) * 512 + hh * HD);
#pragma unroll
                for (int dd = 0; dd < 16; ++dd) { const f32x4 kv = kr[dd]; const f32x4 qv = *(const LAS f32x4*)(qw + 4 * dd); acc += (kv[0] * qv[0] + kv[1] * qv[1]) + (kv[2] * qv[2] + kv[3] * qv[3]); } }
            acc = acc * 0.125f + BIAS[kk]; }
        s[j] = acc; }
    const float m = wave_max(fmaxf(fmaxf(s[0], s[1]), s[2]));
    float p[3]; float lsum = 0.f;
#pragma unroll
    for (int j = 0; j < 3; ++j) { p[j] = (lane + 64 * j <= 128) ? __expf(s[j] - m) : 0.f; lsum += p[j]; }
    lsum = wave_sum(lsum);
    float o = __shfl(p[0], 0) * bf2f(V[row * AW + head * HD + lane]);
    for (int kk = 1; kk <= 128; ++kk) { const float pk = __shfl(kk < 64 ? p[0] : (kk < 128 ? p[1] : p[2]), kk & 63);
        o += pk * cache[((size_t)(Lc - kk * dil) * 2 + 1) * 512 + hh * HD + lane]; }
    bf16_t* OG = (bf16_t*)(P.ws + WS_OG) + ((size_t)g * MT + row) * AO; OG[hh * HD + lane] = f2b(o / lsum);
    if (lane == 0) { float* ML = (float*)(P.ws + WS_ML) + (((size_t)g * MT + row) * HPG + hh) * 2; ML[0] = m; ML[1] = lsum; }
}

template <int NSTEP>
__device__ __forceinline__ void sg_part(const bf16_t* A, int lda, const bf16_t* Bt, int ldb, int k0, int colbase, LAS float* TLP, int wv, int lane) {
    const int l31 = lane & 31, hi = lane >> 5, cb = wv & 1, kq = wv >> 1;
    const bf16_t* ap = A + (size_t)l31 * lda + k0 + kq * (NSTEP * 16) + 8 * hi;
    const bf16_t* bp = Bt + (size_t)(colbase + 128 * cb + l31) * ldb + k0 + kq * (NSTEP * 16) + 8 * hi;
    f32x16 acc = {};
    int s = 0;
#pragma unroll 1
    for (; s + 8 <= NSTEP; s += 8) {
        bf16x8 a[8], b[8];
#pragma unroll
        for (int i = 0; i < 8; ++i) { a[i] = *(const bf16x8*)(ap + 16 * (s + i)); b[i] = *(const bf16x8*)(bp + 16 * (s + i)); }
#pragma unroll
        for (int i = 0; i < 8; ++i) acc = __builtin_amdgcn_mfma_f32_32x32x16_bf16(a[i], b[i], acc, 0, 0, 0);
    }
    if (NSTEP & 4) {
        bf16x8 a[4], b[4];
#pragma unroll
        for (int i = 0; i < 4; ++i) { a[i] = *(const bf16x8*)(ap + 16 * (s + i)); b[i] = *(const bf16x8*)(bp + 16 * (s + i)); }
#pragma unroll
        for (int i = 0; i < 4; ++i) acc = __builtin_amdgcn_mfma_f32_32x32x16_bf16(a[i], b[i], acc, 0, 0, 0);
    }
    LAS float* t = TLP + kq * 2048 + 32 * cb + l31;
#pragma unroll
    for (int r = 0; r < 16; ++r) t[crow(r, hi) * 64] = acc[r];
}
__device__ __forceinline__ f32x4 sg_sum(const LAS float* TLP, int r, int q) {
    const LAS f32x4* p = (const LAS f32x4*)(TLP + r * 64 + 4 * q);
    return (p[0] + p[512]) + (p[1024] + p[1536]);
}
__device__ __forceinline__ float red16(float v) { v += __shfl_xor(v, 1); v += __shfl_xor(v, 2); v += __shfl_xor(v, 4); v += __shfl_xor(v, 8); return v; }

template <int WHICH>
__device__ __forceinline__ void sample_strip(const Ptrs& P, int l, LAS unsigned char* lds, int wv, int tid, int s, int first) {
    const int lane = tid & 63, pn = s >> 2, wc = s & 3, colbase = 256 * pn + 32 * wc;
    unsigned char* ws = P.ws; unsigned char* wb = ws + WS_W + l * LW_BYTES;
    LAS float* TLP = (LAS float*)lds; LAS float* TLP2 = TLP + 8192;
    __syncthreads();
    if (WHICH == 1) sg_part<16>((const bf16_t*)(ws + WS_XB) + (size_t)MP * DM, DM, (const bf16_t*)(wb + LW_W1), DM, 0, colbase, TLP, wv, lane);
    if (WHICH == 3) { sg_part<16>((const bf16_t*)(ws + WS_A3) + (size_t)MP * K3, K3, (const bf16_t*)(wb + LW_W3), K3, 0, colbase, TLP, wv, lane);
                      sg_part<8>((const bf16_t*)(ws + WS_A3) + (size_t)MP * K3, K3, (const bf16_t*)(wb + LW_W3), K3, DR, colbase, TLP2, wv, lane); }
    if (WHICH == 4) sg_part<16>((const bf16_t*)(ws + WS_MRG) + (size_t)MP * DM, DM, (const bf16_t*)(wb + LW_W4), DM, 0, colbase, TLP, wv, lane);
    if (WHICH == 5) sg_part<16>((const bf16_t*)(ws + WS_XB) + (size_t)MP * DM, DM, (const bf16_t*)(wb + LW_W5), DM, 0, colbase, TLP, wv, lane);
    if (WHICH == 6) sg_part<44>((const bf16_t*)(ws + WS_H) + (size_t)MP * DFF, DFF, (const bf16_t*)(wb + LW_W6), DFF, 0, colbase, TLP, wv, lane);
    __syncthreads();
    const int r = tid >> 4, q = tid & 15, c0 = 4 * q, cb = q >> 3, i0 = c0 & 31;
    const size_t row = (size_t)MP + r;
    f32x4 y = sg_sum(TLP, r, q);
    const float* ssq = (const float*)(ws + WS_SSQ);
    if (WHICH == 1) {
        const float rs = row_rs(ssq, (int)row);
        const f32x4 v = y * rs;
        if (pn < 8) {
            const int col = (pn & 3) * 256 + 128 * cb + 32 * wc + i0;
            if (pn < 4) {
                u32x2 w; w.x = pkbf(v[0], v[1]); w.y = pkbf(v[2], v[3]); *(u32x2*)((bf16_t*)(ws + WS_LX) + row * DR + col) = w;
                float* cs = P.out + O_CONVS + (size_t)(l * SB + r) * 3 * DR + col; const float* sc = P.state_conv + (size_t)(l * SB + r) * 3 * DR + col;
                *(f32x4*)cs = *(const f32x4*)(sc + DR); *(f32x4*)(cs + DR) = *(const f32x4*)(sc + 2 * DR); *(f32x4*)(cs + 2 * DR) = v;
            } else {
                u32x2 w; w.x = pkbf(gelu_tanh(v[0]), gelu_tanh(v[1])); w.y = pkbf(gelu_tanh(v[2]), gelu_tanh(v[3])); *(u32x2*)((bf16_t*)(ws + WS_GG) + row * DR + col) = w;
            }
        } else if (pn < 26) {
            const int tq = pn - 8, type = tq / 6, head = 4 * (tq % 6) + wc, g = head >> 3, hh = head & 7;
            f32x4 o = v;
            const float ss = red16((v[0] * v[0] + v[1] * v[1]) + (v[2] * v[2] + v[3] * v[3]));
            if (type < 2) { const float inv = rsqrtf(ss * (1.0f / HD) + EPS); const f32x4 gn = *(const f32x4*)((type == 0 ? P.q_gain : P.k_gain) + l * HD + c0); o = v * inv * gn; }
            bf16_t* dst = (bf16_t*)(ws + (type == 0 ? WS_Q : (type == 1 ? WS_K : WS_V)));
            u32x2 w; w.x = pkbf(o[0], o[1]); w.y = pkbf(o[2], o[3]); *(u32x2*)(dst + row * AW + head * HD + c0) = w;
            if (type >= 1) *(f32x4*)(P.out + o_kvs(g) + (((size_t)(l * SB + r) * 2 + (type - 1)) * HPG + hh) * HD + c0) = o;
        } else if (q < 8) {
            const f32x4 ya = sg_sum(TLP, r, q + 8);
            const float* bm = P.b_merge + (size_t)l * 2048; const int col = (pn - 26) * 128 + 32 * wc + i0;
            const f32x4 xl = v + *(const f32x4*)(bm + col), xa = ya * rs + *(const f32x4*)(bm + 1024 + col);
            f32x4 rho, gav;
#pragma unroll
            for (int e = 0; e < 4; ++e) { const float el = __expf(-xl[e]), ea = fminf(__expf(-xa[e]), 1e30f); gav[e] = __builtin_amdgcn_rcpf(1.0f + ea); rho[e] = (1.0f + ea) * __builtin_amdgcn_rcpf(1.0f + el); }
            bf16_t* GM = (bf16_t*)(ws + WS_GM) + row * 2048;
            u32x2 w; w.x = pkbf(rho[0], rho[1]); w.y = pkbf(rho[2], rho[3]); *(u32x2*)(GM + col) = w;
            w.x = pkbf(gav[0], gav[1]); w.y = pkbf(gav[2], gav[3]); *(u32x2*)(GM + 1024 + col) = w;
        }
    } else if (WHICH == 3) {
        const f32x4 y2 = sg_sum(TLP2, r, q);
        const int col = 256 * pn + 128 * cb + 32 * wc + i0;
        const bf16_t* GM = (const bf16_t*)(ws + WS_GM) + row * 2048;
        const u32x2 gl = *(const u32x2*)(GM + col), ga = *(const u32x2*)(GM + 1024 + col);
        const f32x4 rho = (f32x4){bflo(gl.x), bfhi(gl.x), bflo(gl.y), bfhi(gl.y)}, gav = (f32x4){bflo(ga.x), bfhi(ga.x), bflo(ga.y), bfhi(ga.y)};
        const f32x4 mg = gav * (rho * y + y2);
        u32x2 w; w.x = pkbf(mg[0], mg[1]); w.y = pkbf(mg[2], mg[3]); *(u32x2*)((bf16_t*)(ws + WS_MRG) + row * DM + col) = w;
    } else if (WHICH == 4 || WHICH == 6) {
        const int col = 256 * pn + 128 * cb + 32 * wc + i0;
        float* Y = P.out + O_Y + row * DM + col;
        const f32x4 base = first ? *(const f32x4*)(P.x_sample + (size_t)r * DM + col) : *(const f32x4*)Y;
        const f32x4 v = base + y;
        *(f32x4*)Y = v;
        u32x2 w; w.x = pkbf(v[0], v[1]); w.y = pkbf(v[2], v[3]); *(u32x2*)((bf16_t*)(ws + WS_XB) + row * DM + col) = w;
        const float ss = red16((v[0] * v[0] + v[1] * v[1]) + (v[2] * v[2] + v[3] * v[3]));
        if (q == 0) ((float*)(ws + WS_SSQ))[row * 16 + pn * 4 + wc] = ss;
    } else if (WHICH == 5) {
        if (q < 8) {
            const float rs = row_rs(ssq, (int)row);
            const f32x4 yu = sg_sum(TLP, r, q + 8);
            f32x4 h;
#pragma unroll
            for (int e = 0; e < 4; ++e) { const float gt = y[e] * rs, up = yu[e] * rs; h[e] = gt * sigmoidf_(gt) * up; }
            u32x2 w; w.x = pkbf(h[0], h[1]); w.y = pkbf(h[2], h[3]); *(u32x2*)((bf16_t*)(ws + WS_H) + row * DFF + pn * 128 + 32 * wc + i0) = w;
        }
    }
}

constexpr int RING_BYTES = 131072, LDSCTL_OFF = RING_BYTES, MISC_OFF = LDSCTL_OFF + 320, LDS_BYTES = 147456;
constexpr int CW_BAR = 4096;
constexpr int NPH = 1 + 8 * DEPTH;
#ifndef PHMASK
#define PHMASK 63
#endif
struct Args { Ptrs P; int ph_lo, ph_hi, pad0, pad1; };

__global__ void __launch_bounds__(512, 2) mega(Args a) {
    extern __shared__ __attribute__((aligned(16))) unsigned char lds_raw[];
    LAS unsigned char* lds = (LAS unsigned char*)lds_raw;
    const int wv = __builtin_amdgcn_readfirstlane(threadIdx.x >> 6);
#define TID() ((wv << 6) | (int)__builtin_amdgcn_mbcnt_hi(~0u, __builtin_amdgcn_mbcnt_lo(~0u, 0u)))
    { const int tid = TID(); for (int u = tid; u < (LDS_BYTES - LDSCTL_OFF) / 4; u += 512) ((LAS unsigned*)(lds + LDSCTL_OFF))[u] = 0u; }
    __syncthreads();
    unsigned char* ws0 = a.P.ws;
    XcdBarrier bar; bar.bar = (unsigned*)(ws0 + WS_CTL) + CW_BAR; bar.x = 0; bar.st = nullptr; bar.wv = wv;
    if (a.ph_hi - a.ph_lo > 1) bar = xcd_barrier_post((unsigned*)(ws0 + WS_CTL) + CW_BAR, (volatile LAS unsigned*)(lds + MISC_OFF) + 8);
    bar.wv = wv;
    const int G = gridDim.x;
    for (int ph = a.ph_lo; ph < a.ph_hi; ++ph) {
        const Ptrs& P = a.P;
        int bid = blockIdx.x; asm volatile("" : "+s"(bid));
        unsigned char* ws = P.ws;
        if (ph == 0 && (PHMASK & 32)) {
            int t_ = TID(); asm volatile("" : "+v"(t_));
            p0_prologue(P, lds, bid * 8 + wv, G * 8, wv, t_ & 63);
        } else {
            const int l = __builtin_amdgcn_readfirstlane((ph - 1) >> 3), p = __builtin_amdgcn_readfirstlane((ph - 1) & 7);
            unsigned char* wb = ws + WS_W + l * LW_BYTES;
            if (p == 0 && (PHMASK & 1)) {
                pg8::Gemm g{(const bf16_t*)(ws + WS_XB), (const bf16_t*)(wb + LW_W1), MP, N1, DM, wv}; pg8::StaticOrder S; S.init(MP, N1, G, bid);
                Epi1 E{0, P, l}; pg8::gemm_phase<Epi1, pg8::StaticOrder, true, true>(lds, g, S, E);
                { int t_ = TID(); asm volatile("" : "+v"(t_)); for (int s = G - 1 - bid; s < N1 / 64; s += G) sample_strip<1>(P, l, lds, wv, t_, s, 0); }
            } else if (p == 4 && (PHMASK & 2)) {
                pg8::Gemm g{(const bf16_t*)(ws + WS_A3), (const bf16_t*)(wb + LW_W3), MP, DM, K3, wv}; pg8::StaticOrder S; S.init(MP, DM, G, bid);
                Epi3 E{DR / 64, P}; pg8::gemm_phase<Epi3, pg8::StaticOrder, true, true>(lds, g, S, E);
                { int t_ = TID(); asm volatile("" : "+v"(t_)); for (int s = G - 1 - bid; s < DM / 64; s += G) sample_strip<3>(P, l, lds, wv, t_, s, 0); }
            } else if (p == 5 && (PHMASK & 4)) {
                pg8::Gemm g{(const bf16_t*)(ws + WS_MRG), (const bf16_t*)(wb + LW_W4), MP, DM, DM, wv}; pg8::StaticOrder S; S.init(MP, DM, G, bid);
                EpiRes E{0, P, l == 0 ? 1 : 0}; pg8::gemm_phase<EpiRes, pg8::StaticOrder, true, true>(lds, g, S, E);
                { int t_ = TID(); asm volatile("" : "+v"(t_)); for (int s = G - 1 - bid; s < DM / 64; s += G) sample_strip<4>(P, l, lds, wv, t_, s, l == 0 ? 1 : 0); }
            } else if (p == 6 && (PHMASK & 8)) {
                pg8::Gemm g{(const bf16_t*)(ws + WS_XB), (const bf16_t*)(wb + LW_W5), MP, 2 * DFF, DM, wv}; pg8::StaticOrder S; S.init(MP, 2 * DFF, G, bid);
                Epi5 E{0, P}; pg8::gemm_phase<Epi5, pg8::StaticOrder, true, true>(lds, g, S, E);
                { int t_ = TID(); asm volatile("" : "+v"(t_)); for (int s = G - 1 - bid; s < 2 * DFF / 64; s += G) sample_strip<5>(P, l, lds, wv, t_, s, 0); }
            } else if (p == 7 && (PHMASK & 16)) {
                pg8::Gemm g{(const bf16_t*)(ws + WS_H), (const bf16_t*)(wb + LW_W6), MP, DM, DFF, wv}; pg8::StaticOrder S; S.init(MP, DM, G, bid);
                EpiRes E{0, P, 0}; pg8::gemm_phase<EpiRes, pg8::StaticOrder, true, true>(lds, g, S, E);
                { int t_ = TID(); asm volatile("" : "+v"(t_)); for (int s = G - 1 - bid; s < DM / 64; s += G) sample_strip<6>(P, l, lds, wv, t_, s, 0); }
            } else if (p >= 1 && p <= 3) {
                int t_ = TID(); asm volatile("" : "+v"(t_));
                const size_t gtid = (size_t)bid * 512 + t_, nth = (size_t)G * 512;
                if (p == 1) {
                    for (int it = bid; it < 256; it += G) scan_item<0>(P, l, lds, wv, t_, it >> 7, (it >> 3) & 15, it & 7);
                    for (int it = bid; it < 1536; it += G) attn_unit(P, l, lds, wv, t_, it);
                    __syncthreads();
                    if (wv < 3) { for (int it = bid * 3 + wv; it < SB * NH; it += G * 3) attn_sample(P, l, lds, wv, t_ & 63, it); }
                } else if (p == 2) {
                    for (int it = bid; it < 256; it += G) scan_item<1>(P, l, lds, wv, t_, it >> 7, (it >> 3) & 15, it & 7);
                    for (int it = bid; it < 64; it += G) scan_sample(P, l, lds, t_, it >> 4, it & 15);
                    ph_combine(P, gtid, nth);
                }
            }
        }
        if (ph + 1 < a.ph_hi) xcd_barrier(bar);
    }
}

extern "C" void kernel_launch(void* const* d_in, const int* in_sizes, int n_in, void* d_out, int out_size, void* d_ws, size_t ws_size, hipStream_t stream) {
    static int grid = 0;
    if (grid == 0) {
        if (n_in != 27 || (size_t)out_size != O_END || ws_size < WS_END) { fprintf(stderr, "kernel_launch: unexpected sizes n_in %d out %d (want %zu) ws %zu (want %zu)\n", n_in, out_size, (size_t)O_END, ws_size, (size_t)WS_END); grid = -1; return; }
        int dev = 0, cus = 0;
        if (hipGetDevice(&dev) != hipSuccess || hipDeviceGetAttribute(&cus, hipDeviceAttributeMultiprocessorCount, dev) != hipSuccess) { grid = -1; return; }
        if (hipFuncSetAttribute((const void*)mega, hipFuncAttributeMaxDynamicSharedMemorySize, LDS_BYTES) != hipSuccess) { fprintf(stderr, "kernel_launch: hipFuncSetAttribute failed\n"); grid = -1; return; }
        grid = cus;
    }
    if (grid < 0) return;
    Args a{};
    Ptrs& P = a.P;
    const float* const* in = (const float* const*)d_in;
    P.x_prompt = in[0]; P.x_sample = in[1]; P.cache[0] = in[2]; P.cache[1] = in[3]; P.cache[2] = in[4]; P.state_conv = in[5]; P.state_h = in[6]; P.rel_bias = in[7];
    P.norm_mix = in[8]; P.w_in = in[9]; P.w_conv = in[10]; P.b_conv = in[11]; P.w_rg_a = in[12]; P.b_rg_a = in[13]; P.w_rg_x = in[14]; P.b_rg_x = in[15];
    P.lru_lambda = in[16]; P.q_gain = in[17]; P.k_gain = in[18]; P.w_merge = in[19]; P.b_merge = in[20]; P.w_branch_lru = in[21]; P.w_branch_att = in[22];
    P.w_o = in[23]; P.norm_ffn = in[24]; P.w_ffn_in = in[25]; P.w_ffn_out = in[26];
    P.out = (float*)d_out; P.ws = (unsigned char*)d_ws;
    (void)hipMemsetAsync((char*)d_ws + WS_CTL, 0, CTL_ZERO_BYTES, stream);
    a.ph_lo = 0; a.ph_hi = NPH;
    hipLaunchKernelGGL(mega, dim3(grid), dim3(512), LDS_BYTES, stream, a);
}
```

```cpp
#include <hip/hip_runtime.h>
#include <stdint.h>
#include <stdio.h>

typedef unsigned short bf16_t;
typedef short bf16x8 __attribute__((ext_vector_type(8)));
typedef float f32x4 __attribute__((ext_vector_type(4)));
typedef unsigned u32x4 __attribute__((ext_vector_type(4)));
typedef unsigned u32x2 __attribute__((ext_vector_type(2)));
typedef float f32x2 __attribute__((ext_vector_type(2)));

constexpr int DM = 1024, NB = 2, SEQ = 8192, DEPTH = 2, SB = 32, PAST = 8192;
constexpr int MP = NB * SEQ;
constexpr int MT = MP + SB;
constexpr int MPAD = 16640;
constexpr int DR = 1024, NBLK = 16, CW = 4;
constexpr int HD = 64, HPG = 8, NG = 3, NH = 24, AW = 1536, AO = 512;
constexpr int DFF = 2816;
constexpr int N1 = 2 * DR + 3 * AW + 2 * DM;
constexpr int K3 = DR + AO;
constexpr float EPS = 1e-6f;
constexpr int NKEY = 129;

__host__ __device__ constexpr int g_dil(int g) { return g == 0 ? 1 : (g == 1 ? 4 : 16); }
__host__ __device__ constexpr int g_win(int g) { return g == 0 ? 128 : (g == 1 ? 512 : 2048); }

constexpr size_t O_Y = 0;
constexpr size_t O_KVP0 = (size_t)MT * DM;
constexpr size_t O_KVP1 = O_KVP0 + (size_t)DEPTH * NB * 128 * 1024;
constexpr size_t O_KVP2 = O_KVP1 + (size_t)DEPTH * NB * 512 * 1024;
constexpr size_t O_CONVP = O_KVP2 + (size_t)DEPTH * NB * 2048 * 1024;
constexpr size_t O_HP = O_CONVP + (size_t)DEPTH * NB * 3 * DR;
constexpr size_t O_KVS0 = O_HP + (size_t)DEPTH * NB * DR;
constexpr size_t O_KVS1 = O_KVS0 + (size_t)DEPTH * SB * 1024;
constexpr size_t O_KVS2 = O_KVS1 + (size_t)DEPTH * SB * 1024;
constexpr size_t O_CONVS = O_KVS2 + (size_t)DEPTH * SB * 1024;
constexpr size_t O_HS = O_CONVS + (size_t)DEPTH * SB * 3 * DR;
constexpr size_t O_END = O_HS + (size_t)DEPTH * SB * DR;
__host__ __device__ constexpr size_t o_kvp(int g) { return g == 0 ? O_KVP0 : (g == 1 ? O_KVP1 : O_KVP2); }
__host__ __device__ constexpr size_t o_kvs(int g) { return g == 0 ? O_KVS0 : (g == 1 ? O_KVS1 : O_KVS2); }

constexpr size_t MiB = 1u << 20;
constexpr size_t rup(size_t x) { return (x + MiB - 1) / MiB * MiB; }
constexpr size_t WS_CTL = 0, CTL_ZERO_BYTES = 1 * MiB;
constexpr size_t WS_BIAS = 1 * MiB;
constexpr size_t WS_SSQ = 2 * MiB;
constexpr size_t WS_SUM = 4 * MiB;
constexpr size_t WS_W = 8 * MiB;
constexpr size_t LW_W1 = 0;
constexpr size_t LW_W3 = LW_W1 + (size_t)N1 * DM * 2;
constexpr size_t LW_W4 = LW_W3 + (size_t)DM * K3 * 2;
constexpr size_t LW_W5 = LW_W4 + (size_t)DM * DM * 2;
constexpr size_t LW_W6 = LW_W5 + (size_t)2 * DFF * DM * 2;
constexpr size_t LW_BYTES = rup(LW_W6 + (size_t)DM * DFF * 2);
constexpr size_t WS_XB = WS_W + DEPTH * LW_BYTES;
constexpr size_t WS_LX = WS_XB + rup((size_t)MPAD * DM * 2);
constexpr size_t WS_GG = WS_LX + rup((size_t)MPAD * DM * 2);
constexpr size_t WS_Q = WS_GG + rup((size_t)MPAD * DM * 2);
constexpr size_t WS_K = WS_Q + rup((size_t)MPAD * AW * 2);
constexpr size_t WS_V = WS_K + rup((size_t)MPAD * AW * 2);
constexpr size_t WS_GM = WS_V + rup((size_t)MPAD * AW * 2);
constexpr size_t WS_OG = WS_GM + rup((size_t)MPAD * 2048 * 2);
constexpr size_t WS_ML = WS_OG + rup((size_t)3 * MPAD * AO * 2);
constexpr size_t WS_A3 = WS_ML + rup((size_t)3 * MPAD * 16 * 4);
constexpr size_t WS_MRG = WS_A3 + rup((size_t)MPAD * K3 * 2);
constexpr size_t WS_H = WS_MRG + rup((size_t)MPAD * DM * 2);
constexpr size_t WS_SIMPLE = WS_H + rup((size_t)MPAD * DFF * 2);
constexpr size_t WS_XC = WS_SIMPLE;
constexpr size_t WS_AA = WS_XC + rup((size_t)MPAD * DM * 4);
constexpr size_t WS_UU = WS_AA + rup((size_t)MPAD * DM * 4);
constexpr size_t WS_DUMMY = WS_UU + rup((size_t)MPAD * DM * 4);
constexpr size_t WS_END = WS_DUMMY + 160 * MiB;

__device__ __forceinline__ int lane_id_v() { int x; asm volatile("v_mbcnt_lo_u32_b32 %0, -1, 0\n\tv_mbcnt_hi_u32_b32 %0, -1, %0" : "=v"(x)); return x; }
__device__ __forceinline__ float bf2f(bf16_t v) { return __uint_as_float(((unsigned)v) << 16); }
__device__ __forceinline__ bf16_t f2b(float f) { unsigned u = __float_as_uint(f); u += 0x7fffu + ((u >> 16) & 1u); return (bf16_t)(u >> 16); }
__device__ __forceinline__ float wave_sum(float v) {
#pragma unroll
    for (int o = 1; o < 64; o <<= 1) v += __shfl_xor(v, o);
    return v;
}
__device__ __forceinline__ float wave_max(float v) {
#pragma unroll
    for (int o = 1; o < 64; o <<= 1) v = fmaxf(v, __shfl_xor(v, o));
    return v;
}
__device__ __forceinline__ float sigmoidf_(float x) { return 1.0f / (1.0f + __expf(-x)); }
__device__ __forceinline__ float gelu_tanh(float x) { const float u = 0.7978845608028654f * (x + 0.044715f * x * x * x); return 0.5f * x * (1.0f + tanhf(u)); }

__host__ __device__ __forceinline__ int w1_src_col(int nt) {
    if (nt < 2048) return nt;
    const int pn = nt >> 8, tc = nt & 255, bj = tc >> 7;
    if (nt >= 6656) return 6656 + bj * 1024 + (pn - 26) * 128 + (tc & 127);
    const int wc = (tc >> 5) & 3, i = tc & 31;
    return 2048 + (pn - 8) * 256 + wc * 64 + bj * 32 + i;
}
__host__ __device__ __forceinline__ int w5_src_col(int nt) { const int pn = nt >> 8, tc = nt & 255, bj = tc >> 7, j = tc & 127; return bj * DFF + pn * 128 + j; }

struct Ptrs {
    const float* x_prompt; const float* x_sample; const float* cache[3]; const float* state_conv; const float* state_h; const float* rel_bias;
    const float* norm_mix; const float* w_in; const float* w_conv; const float* b_conv; const float* w_rg_a; const float* b_rg_a; const float* w_rg_x; const float* b_rg_x;
    const float* lru_lambda; const float* q_gain; const float* k_gain; const float* w_merge; const float* b_merge; const float* w_branch_lru; const float* w_branch_att;
    const float* w_o; const float* norm_ffn; const float* w_ffn_in; const float* w_ffn_out;
    float* out; unsigned char* ws;
};
__device__ __forceinline__ const float* xin_row(const Ptrs& P, int row) { return row < MP ? P.x_prompt + (size_t)row * DM : P.x_sample + (size_t)(row - MP) * DM; }

namespace pg8 {
#define PG8_LAS __attribute__((address_space(3)))
typedef unsigned short bf16_t;
typedef short bf16x8 __attribute__((ext_vector_type(8)));
typedef float f32x4 __attribute__((ext_vector_type(4)));
typedef unsigned u32x4 __attribute__((ext_vector_type(4)));
constexpr int BM = 256, BK = 64, HALF = 128, HTB = HALF * BK * 2  , STAGE_BYTES = 8 * HTB, NXCD = 8, WGM = 8;

__host__ __device__ __forceinline__ int lds_byte(int r, int c) { const int st = (r >> 4) * 2 + (c >> 5), rr = r & 15, cc = c & 31, ob = rr * 64 + cc * 2; return st * 1024 + (ob ^ (((ob >> 9) & 1) << 5)); }
__host__ __device__ __forceinline__ void stage_rc(int b, int& R, int& C) { const int st = b / 1024, sb = b % 1024, swz = sb ^ (((sb >> 9) & 1) << 5); R = (st >> 1) * 16 + swz / 64; C = (st & 1) * 32 + (swz % 64) / 2; }
__host__ __device__ __forceinline__ int perm32(int rho) { const int n = rho >> 4, i = rho & 15; return 8 * (i >> 2) + 4 * n + (i & 3); }

struct Unit { int pm, pn; };
struct Gemm { const bf16_t* A; const bf16_t* Bt; int M, N, K; int wv; };

struct StaticOrder {
    int nM, nN, nwg, G, c;
    __host__ __device__ void init(int M, int N, int G_, int c_) { nM = M / BM; nN = N / BM; nwg = nM * nN; G = G_; c = c_; }
    __host__ __device__ bool next(int i, Unit& u) const {
        const long L = (long)i * G + c; if (L >= nwg) return false;
        int wgid = (int)L; { const int q = nwg / NXCD, r = nwg % NXCD, xcd = wgid % NXCD, off = wgid / NXCD; wgid = (xcd < r ? xcd * (q + 1) : r * (q + 1) + (xcd - r) * q) + off; }
        const int nig = WGM * nN, gid = wgid / nig, fm = gid * WGM, gsz = (nM - fm) < WGM ? (nM - fm) : WGM;
        u.pm = fm + ((wgid % nig) % gsz); u.pn = (wgid % nig) / gsz; return true;
    }
    __device__ __forceinline__ void a_ready(const Unit&) const {}
    __device__ __forceinline__ void done(const Unit&) const {}
};

template <class Epi, class Sched, bool ALIGN_EPI = false, bool SP2 = false>
__device__ __forceinline__ void gemm_phase(PG8_LAS unsigned char* lds, const Gemm g, const Sched& S, const Epi& E) {
    int tid_ = (g.wv << 6) | lane_id_v(); asm volatile("" : "+v"(tid_));
    const int tid = tid_, wid = __builtin_amdgcn_readfirstlane(tid >> 6), lane = tid & 63, wr = wid >> 2, wc = wid & 3, fr = lane & 15, fq = lane >> 4;
    const int K = g.K, nt = K / BK;
    unsigned voffA[2], voffB[2];
#pragma unroll
    for (int i = 0; i < 2; ++i) { int R, C; stage_rc(tid * 16 + i * 8192, R, C); const int Rb = Epi::PERM ? ((R & ~31) + perm32(R & 31)) : R;
        voffA[i] = (unsigned)(R * K + C) * 2u; voffB[i] = (unsigned)(Rb * K + C) * 2u; }
    const size_t kstep = (size_t)(BK * 2);
    const size_t hstep = (size_t)HALF * K * 2;
    const size_t tstep = 2 * hstep;
    const unsigned ldsw = (unsigned)wid * 1024u;
    const int aoff = lds_byte(wr * 64 + fr, fq * 8), boff = lds_byte(wc * 32 + fr, fq * 8);
#define PG8_SA(b, h) (((b) * 2 + (h)) * HTB)
#define PG8_SB(b, h) ((4 + (b) * 2 + (h)) * HTB)
#define PG8_STAGE(bufoff, gbase, voff) do { _Pragma("unroll") for (int _i = 0; _i < 2; ++_i) \
        __builtin_amdgcn_global_load_lds((const unsigned*)((const char*)(gbase) + (voff)[_i]), (PG8_LAS unsigned*)(lds + (bufoff) + ldsw + _i * 8192), 16, 0, 0); } while (0)
#define PG8_LDA(dst, b, h) do { _Pragma("unroll") for (int m = 0; m < 4; ++m) _Pragma("unroll") for (int k = 0; k < 2; ++k) dst[m][k] = *(const PG8_LAS bf16x8*)(lds + PG8_SA(b, h) + aoff + m * 2048 + k * 1024); } while (0)
#define PG8_LDB(dst, b, h) do { _Pragma("unroll") for (int n = 0; n < 2; ++n) _Pragma("unroll") for (int k = 0; k < 2; ++k) dst[n][k] = *(const PG8_LAS bf16x8*)(lds + PG8_SB(b, h) + boff + n * 2048 + k * 1024); } while (0)
#define PG8_MMA(ai, bj, At, Bt) do { __builtin_amdgcn_s_setprio(1); _Pragma("unroll") for (int m = 0; m < 4; ++m) _Pragma("unroll") for (int n = 0; n < 2; ++n) _Pragma("unroll") for (int k = 0; k < 2; ++k) \
        acc[ai][bj][m][n] = __builtin_amdgcn_mfma_f32_16x16x32_bf16(Bt[n][k], At[m][k], acc[ai][bj][m][n], 0, 0, 0); __builtin_amdgcn_s_setprio(0); } while (0)
#define PG8_WAIT_V(n) asm volatile("s_waitcnt vmcnt(" #n ")" ::: "memory")
#define PG8_WAIT_L(n) asm volatile("s_waitcnt lgkmcnt(" #n ")" ::: "memory")
#define PG8_BAR __builtin_amdgcn_s_barrier()
#define PG8_SCHED __builtin_amdgcn_sched_barrier(0)
    Unit cur, nxt; int ui = 0;
    if (!S.next(0, cur)) return;
    f32x4 acc[2][2][4][2];
#pragma unroll
    for (int a = 0; a < 2; ++a)
#pragma unroll
        for (int b = 0; b < 2; ++b)
#pragma unroll
            for (int m = 0; m < 4; ++m)
#pragma unroll
                for (int n = 0; n < 2; ++n) acc[a][b][m][n] = (f32x4){0.f, 0.f, 0.f, 0.f};
    bf16x8 At[4][2], B0[2][2], B1[2][2];
    const char* cA = (const char*)g.A + (size_t)cur.pm * tstep; const char* cB = (const char*)g.Bt + (size_t)cur.pn * tstep;
    S.a_ready(cur);
    if constexpr (SP2) {
        PG8_STAGE(PG8_SB(0, 0), cB, voffB); PG8_STAGE(PG8_SB(0, 1), cB + hstep, voffB); PG8_STAGE(PG8_SA(0, 0), cA, voffA); PG8_STAGE(PG8_SA(0, 1), cA + hstep, voffA);
        if (wr == 1) PG8_BAR;
        PG8_WAIT_V(2); PG8_BAR;
        PG8_STAGE(PG8_SB(1, 0), cB + kstep, voffB); PG8_STAGE(PG8_SA(1, 0), cA + kstep, voffA); PG8_STAGE(PG8_SB(1, 1), cB + hstep + kstep, voffB);
        PG8_WAIT_V(6); PG8_BAR;
    } else {
        PG8_STAGE(PG8_SB(0, 0), cB, voffB); PG8_STAGE(PG8_SA(0, 0), cA, voffA); PG8_STAGE(PG8_SB(0, 1), cB + hstep, voffB); PG8_STAGE(PG8_SA(0, 1), cA + hstep, voffA);
        if (wr == 1) PG8_BAR;
        PG8_WAIT_V(4); PG8_BAR;
        PG8_STAGE(PG8_SB(1, 0), cB + kstep, voffB); PG8_STAGE(PG8_SA(1, 0), cA + kstep, voffA); PG8_STAGE(PG8_SB(1, 1), cB + hstep + kstep, voffB);
        PG8_WAIT_V(6); PG8_BAR;
    }
    for (;;) {
        const bool has_next = S.next(ui + 1, nxt);
        const char* nA = has_next ? (const char*)g.A + (size_t)nxt.pm * tstep : cA; const char* nB = has_next ? (const char*)g.Bt + (size_t)nxt.pn * tstep : cB;
        for (int t = 0; t < nt; t += 2) {
            if constexpr (Epi::HAS_MID) { if (t == E.mid_t) E.mid(acc, cur, wr, wc, fr, fq); }
            const bool last = (t == nt - 2);
            const char* a1 = cA + (size_t)(t + 1) * kstep;
            const char* a2 = last ? nA : cA + (size_t)(t + 2) * kstep; const char* b2 = last ? nB : cB + (size_t)(t + 2) * kstep;
            const char* a3 = a2 + kstep; const char* b3 = b2 + kstep;
            if (last && has_next) S.a_ready(nxt);
            if constexpr (SP2) {
            PG8_LDB(B0, 0, 0); PG8_LDB(B1, 0, 1); PG8_SCHED; PG8_LDA(At, 0, 0); PG8_STAGE(PG8_SA(1, 1), a1 + hstep, voffA);
            PG8_WAIT_V(8); PG8_WAIT_L(0); PG8_BAR; PG8_MMA(0, 0, At, B0); PG8_MMA(0, 1, At, B1); PG8_BAR; PG8_SCHED;
            PG8_LDA(At, 0, 1); PG8_STAGE(PG8_SB(0, 0), b2, voffB); PG8_STAGE(PG8_SB(0, 1), b2 + hstep, voffB); PG8_STAGE(PG8_SA(0, 0), a2, voffA);
            PG8_WAIT_V(8); PG8_WAIT_L(0); PG8_BAR; PG8_MMA(1, 0, At, B0); PG8_MMA(1, 1, At, B1); PG8_BAR; PG8_SCHED;
            PG8_LDB(B0, 1, 0); PG8_LDB(B1, 1, 1); PG8_SCHED; PG8_LDA(At, 1, 0); PG8_STAGE(PG8_SA(0, 1), a2 + hstep, voffA);
            PG8_WAIT_V(8); PG8_WAIT_L(0); PG8_BAR; PG8_MMA(0, 0, At, B0); PG8_MMA(0, 1, At, B1); PG8_BAR; PG8_SCHED;
            PG8_LDA(At, 1, 1); PG8_STAGE(PG8_SB(1, 0), b3, voffB); PG8_STAGE(PG8_SB(1, 1), b3 + hstep, voffB); PG8_STAGE(PG8_SA(1, 0), a3, voffA);
            PG8_WAIT_V(8); PG8_WAIT_L(0); PG8_BAR; PG8_MMA(1, 0, At, B0); PG8_MMA(1, 1, At, B1); PG8_BAR; PG8_SCHED;
            } else {
            PG8_LDB(B0, 0, 0); PG8_SCHED; PG8_LDA(At, 0, 0); PG8_STAGE(PG8_SA(1, 1), a1 + hstep, voffA);
            PG8_WAIT_L(8); PG8_BAR; PG8_WAIT_L(0); PG8_MMA(0, 0, At, B0); PG8_BAR; PG8_SCHED;
            PG8_LDB(B1, 0, 1); PG8_STAGE(PG8_SB(0, 0), b2, voffB);
            PG8_BAR; PG8_WAIT_L(0); PG8_MMA(0, 1, At, B1); PG8_BAR;
            PG8_LDA(At, 0, 1); PG8_STAGE(PG8_SA(0, 0), a2, voffA);
            PG8_BAR; PG8_WAIT_L(0); PG8_MMA(1, 0, At, B0); PG8_BAR; PG8_SCHED;
            PG8_STAGE(PG8_SB(0, 1), b2 + hstep, voffB);
            PG8_WAIT_V(6); PG8_BAR; PG8_MMA(1, 1, At, B1); PG8_BAR;
            PG8_LDB(B0, 1, 0); PG8_SCHED; PG8_LDA(At, 1, 0); PG8_STAGE(PG8_SA(0, 1), a2 + hstep, voffA);
            PG8_WAIT_L(8); PG8_BAR; PG8_WAIT_L(0); PG8_MMA(0, 0, At, B0); PG8_BAR; PG8_SCHED;
            PG8_LDB(B1, 1, 1); PG8_STAGE(PG8_SB(1, 0), b3, voffB);
            PG8_BAR; PG8_WAIT_L(0); PG8_MMA(0, 1, At, B1); PG8_BAR;
            PG8_LDA(At, 1, 1); PG8_STAGE(PG8_SA(1, 0), a3, voffA);
            PG8_BAR; PG8_WAIT_L(0); PG8_MMA(1, 0, At, B0); PG8_BAR; PG8_SCHED;
            PG8_STAGE(PG8_SB(1, 1), b3 + hstep, voffB);
            PG8_WAIT_V(6); PG8_BAR; PG8_MMA(1, 1, At, B1); PG8_BAR;
            }
        }
        if constexpr (ALIGN_EPI) { if (wr == 0) PG8_BAR; }
        if constexpr (!Epi::AFTER_DRAIN) { E(acc, cur, wr, wc, fr, fq); S.done(cur); }
        if (!has_next) break;
#pragma unroll
        for (int a = 0; a < 2; ++a)
#pragma unroll
            for (int b = 0; b < 2; ++b)
#pragma unroll
                for (int m = 0; m < 4; ++m)
#pragma unroll
                    for (int n = 0; n < 2; ++n) acc[a][b][m][n] = (f32x4){0.f, 0.f, 0.f, 0.f};
        cur = nxt; cA = nA; cB = nB; ++ui;
        if constexpr (ALIGN_EPI) { if (wr == 1) PG8_BAR; }
    }
    PG8_WAIT_V(0);
    if constexpr (!ALIGN_EPI) { if (wr == 0) PG8_BAR; }
    PG8_BAR;
    if constexpr (Epi::AFTER_DRAIN) { E.fused(acc, cur, wr, wc, fr, fq, lds, wid, lane); S.done(cur); }
#undef PG8_SA
#undef PG8_SB
#undef PG8_STAGE
#undef PG8_LDA
#undef PG8_LDB
#undef PG8_MMA
#undef PG8_WAIT_V
#undef PG8_WAIT_L
#undef PG8_BAR
#undef PG8_SCHED
}
}
#define GAS __attribute__((address_space(1)))
#define LAS __attribute__((address_space(3)))
typedef unsigned short bf16;
typedef unsigned v4u __attribute__((ext_vector_type(4)));
typedef float f32x4 __attribute__((ext_vector_type(4)));
typedef short bf16x8 __attribute__((ext_vector_type(8)));
typedef GAS unsigned gu32;
typedef GAS unsigned long long gu64;
#define RLX_AGENT __ATOMIC_RELAXED, __HIP_MEMORY_SCOPE_AGENT
#define LDS_WAIT() asm volatile("s_waitcnt lgkmcnt(0)" ::: "memory")
#define VM_WAIT() asm volatile("s_waitcnt vmcnt(0)" ::: "memory")
__device__ __forceinline__ unsigned long long rt() { return __builtin_amdgcn_s_memrealtime(); }
__device__ __forceinline__ unsigned f2bf(float f) { unsigned u = __builtin_bit_cast(unsigned, f); return (u + 0x7fffu + ((u >> 16) & 1u)) >> 16; }
__device__ __forceinline__ unsigned pk2(float lo, float hi) { return f2bf(lo) | (f2bf(hi) << 16); }

#define XB_TMO      128
#define XB_XCNT(j)  (256  + 64 * (j))
#define XB_XSUB(j)  (1280 + 64 * (j))
#define XB_XGEN(j)  (2304 + 64 * (j))
#define XB_TOP      3328
#define XB_TOPGEN   3392
#define XCD_BAR_WORDS 3456
#define XB_SPIN_CAP (1u << 18)

__device__ __forceinline__ unsigned xb_ld(unsigned* p)              { return __hip_atomic_load(p, __ATOMIC_RELAXED, __HIP_MEMORY_SCOPE_AGENT); }
__device__ __forceinline__ unsigned xb_add(unsigned* p, unsigned v) { return __hip_atomic_fetch_add(p, v, __ATOMIC_RELAXED, __HIP_MEMORY_SCOPE_AGENT); }
__device__ __forceinline__ unsigned xb_xcc_id() { return (unsigned)__builtin_amdgcn_s_getreg((3 << 11) | 20) & 0xFu; }
#define XB_SPIN(cond, bar) do { unsigned _sp = 0; while (cond) { __builtin_amdgcn_s_sleep(1); \
    if ((++_sp & 255u) == 0u) { if (xb_ld(&(bar)[XB_TMO])) break; if (_sp > XB_SPIN_CAP) { atomicAdd(&(bar)[XB_TMO], 1u); break; } } } } while (0)

struct XcdBarrier {
    unsigned* bar; unsigned x; int wv;
    volatile LAS unsigned* st;
};

__device__ __forceinline__ XcdBarrier xcd_barrier_post(unsigned* bar, volatile LAS unsigned* st) {
    XcdBarrier b; b.bar = bar; b.x = xb_xcc_id(); b.st = st;
    if (threadIdx.x == 0) (void)xb_add(&bar[XB_XCNT(b.x)], 1u);
    return b;
}
__device__ __forceinline__ void xcd_barrier_complete(unsigned* bar, unsigned x, unsigned& nloc, unsigned& nx) {
    const unsigned G = gridDim.x * gridDim.y * gridDim.z;
    unsigned sum, cnt, mine, sp = 0u;
    for (;;) {
        sum = 0u; cnt = 0u; mine = 0u;
#pragma unroll
        for (unsigned j = 0; j < 16; ++j) { const unsigned c = xb_ld(&bar[XB_XCNT(j)]); sum += c; cnt += (c > 0u) ? 1u : 0u; mine = (j == x) ? c : mine; }
        if (sum == G) break;
        __builtin_amdgcn_s_sleep(1);
        if ((++sp & 255u) == 0u) { if (xb_ld(&bar[XB_TMO])) break; if (sp > XB_SPIN_CAP) { atomicAdd(&bar[XB_TMO], 1u); break; } }
    }
    nloc = mine > 0u ? mine : 1u; nx = cnt > 0u ? cnt : 1u;
}

__device__ __forceinline__ void xcd_barrier(const XcdBarrier& b) {
    asm volatile("s_waitcnt vmcnt(0)" ::: "memory");
    __syncthreads();
    if (b.wv == 0 && lane_id_v() == 0) {
        unsigned* bar = b.bar; asm volatile("" : "+s"(bar));
        __builtin_amdgcn_s_waitcnt(0);
        unsigned nloc = b.st[0], nx = b.st[1];
        if (nloc == 0u) { xcd_barrier_complete(bar, b.x, nloc, nx); b.st[0] = nloc; b.st[1] = nx; }
        const unsigned old = xb_add(&bar[XB_XSUB(b.x)], 1u);
        const unsigned gen = old / nloc;
        if (old + 1u == (gen + 1u) * nloc) {
            __builtin_amdgcn_fence(__ATOMIC_RELEASE, "agent");
            asm volatile("s_waitcnt vmcnt(0)" ::: "memory");
            const unsigned og = xb_add(&bar[XB_TOP], 1u);
            const unsigned tg = og / nx;
            if (og + 1u == (tg + 1u) * nx) xb_add(&bar[XB_TOPGEN], 1u);
            else XB_SPIN(xb_ld(&bar[XB_TOPGEN]) == tg, bar);
            __builtin_amdgcn_fence(__ATOMIC_ACQUIRE, "agent");
            xb_add(&bar[XB_XGEN(b.x)], 1u);
            asm volatile("s_waitcnt vmcnt(0)" ::: "memory");
        } else {
            XB_SPIN(xb_ld(&bar[XB_XGEN(b.x)]) == gen, bar);
            __builtin_amdgcn_fence(__ATOMIC_ACQUIRE, "agent");
            asm volatile("s_waitcnt vmcnt(0)" ::: "memory");
        }
    }
    __syncthreads();
}

using pg8::Unit;
constexpr float LOG2E = 1.4426950408889634f, QSCALE = 0.125f * LOG2E;
#define ROW_FENCE() asm volatile("" ::: "memory")
__device__ __forceinline__ float row_rs(const float* ssq, int row) {
    const f32x4* p = (const f32x4*)(ssq + (size_t)row * 16);
    const f32x4 a = p[0], b = p[1], c = p[2], d = p[3];
    const float s = (((a[0] + a[1]) + (a[2] + a[3])) + ((b[0] + b[1]) + (b[2] + b[3]))) + (((c[0] + c[1]) + (c[2] + c[3])) + ((d[0] + d[1]) + (d[2] + d[3])));
    return rsqrtf(s * (1.0f / DM) + EPS);
}
typedef float f32x2_t __attribute__((ext_vector_type(2))); typedef __bf16 bf16x2_t __attribute__((ext_vector_type(2)));
__device__ __forceinline__ unsigned pkbf(float lo, float hi) { const f32x2_t v = {lo, hi}; const bf16x2_t b = __builtin_convertvector(v, bf16x2_t); return __builtin_bit_cast(unsigned, b); }
__device__ __forceinline__ u32x4 pack8(const f32x4 a, const f32x4 b) { u32x4 w; w.x = pkbf(a[0], a[1]); w.y = pkbf(a[2], a[3]); w.z = pkbf(b[0], b[1]); w.w = pkbf(b[2], b[3]); return w; }
__device__ __forceinline__ float bflo(unsigned w) { return __uint_as_float(w << 16); }
__device__ __forceinline__ float bfhi(unsigned w) { return __uint_as_float(w & 0xffff0000u); }

struct Epi1 {
    static constexpr bool PERM = true, AFTER_DRAIN = false, HAS_MID = false;
    int mid_t; Ptrs P; int l;
    __device__ __forceinline__ void operator()(const f32x4 (&acc)[2][2][4][2], const Unit& u, int wr, int wc, int fr0, int fq) const {
        int fr = fr0; asm volatile("" : "+v"(fr));
        const float* ssq = (const float*)(P.ws + WS_SSQ);
        const int pn = u.pn, c8 = wc * 32 + 8 * fq, row0 = u.pm * 256 + wr * 64 + fr;
        if (pn < 8) {
            bf16_t* dst = (bf16_t*)(P.ws + (pn < 4 ? WS_LX : WS_GG));
            const int colb = (pn & 3) * 256 + c8;
#pragma unroll
            for (int ai = 0; ai < 2; ++ai)
#pragma unroll
                for (int m = 0; m < 4; ++m) {
                    const int row = row0 + ai * 128 + m * 16; const float rs = row_rs(ssq, row);
#pragma unroll
                    for (int bj = 0; bj < 2; ++bj) {
                        f32x4 v0 = acc[ai][bj][m][0] * rs, v1 = acc[ai][bj][m][1] * rs; const int col = colb + bj * 128;
                        if (pn >= 4) {
#pragma unroll
                            for (int e = 0; e < 4; ++e) { v0[e] = gelu_tanh(v0[e]); v1[e] = gelu_tanh(v1[e]); }
                        }
                        *(u32x4*)(dst + (size_t)row * DR + col) = pack8(v0, v1);
                        if (pn < 4) {
                            if (row < MP) { const int t = row & (SEQ - 1); if (t >= SEQ - 3) { const int b = row >> 13; float* o = P.out + O_CONVP + ((size_t)(l * NB + b) * 3 + (t - (SEQ - 3))) * DR + col; *(f32x4*)o = v0; *(f32x4*)(o + 4) = v1; } }
                            else if (row < MT) { const int b = row - MP; float* cs = P.out + O_CONVS + (size_t)(l * SB + b) * 3 * DR + col; const float* sc = P.state_conv + (size_t)(l * SB + b) * 3 * DR + col;
                                *(f32x4*)cs = *(const f32x4*)(sc + DR); *(f32x4*)(cs + 4) = *(const f32x4*)(sc + DR + 4); *(f32x4*)(cs + DR) = *(const f32x4*)(sc + 2 * DR); *(f32x4*)(cs + DR + 4) = *(const f32x4*)(sc + 2 * DR + 4);
                                *(f32x4*)(cs + 2 * DR) = v0; *(f32x4*)(cs + 2 * DR + 4) = v1; }
                        }
                    }
                    ROW_FENCE();
                }
        } else if (pn < 26) {
            const int tq = pn - 8, type = tq / 6, head = 4 * (tq % 6) + wc, g = head >> 3, hh = head & 7;
            bf16_t* dst = (bf16_t*)(P.ws + (type == 0 ? WS_Q : (type == 1 ? WS_K : WS_V)));
            f32x4 gn[2][2];
#pragma unroll
            for (int bj = 0; bj < 2; ++bj)
#pragma unroll
                for (int n = 0; n < 2; ++n) gn[bj][n] = (f32x4){1.f, 1.f, 1.f, 1.f};
            if (type < 2) { const float* gp = (type == 0 ? P.q_gain : P.k_gain) + l * HD;
#pragma unroll
                for (int bj = 0; bj < 2; ++bj)
#pragma unroll
                    for (int n = 0; n < 2; ++n) gn[bj][n] = *(const f32x4*)(gp + 32 * bj + 8 * fq + 4 * n); }
            const int W = g_win(g);
#pragma unroll
            for (int ai = 0; ai < 2; ++ai)
#pragma unroll
                for (int m = 0; m < 4; ++m) {
                    const int row = row0 + ai * 128 + m * 16; const float rs = row_rs(ssq, row);
                    f32x4 v[2][2]; float ss = 0.f;
#pragma unroll
                    for (int bj = 0; bj < 2; ++bj)
#pragma unroll
                        for (int n = 0; n < 2; ++n) { v[bj][n] = acc[ai][bj][m][n] * rs; const f32x4 q = v[bj][n] * v[bj][n]; ss += (q[0] + q[1]) + (q[2] + q[3]); }
                    ss += __shfl_xor(ss, 16); ss += __shfl_xor(ss, 32);
                    const float inv = (type < 2) ? rsqrtf(ss * (1.0f / HD) + EPS) * (type == 0 ? QSCALE : 1.0f) : 1.0f;
#pragma unroll
                    for (int bj = 0; bj < 2; ++bj) {
                        v[bj][0] = v[bj][0] * inv * gn[bj][0]; v[bj][1] = v[bj][1] * inv * gn[bj][1];
                        *(u32x4*)(dst + (size_t)row * AW + head * HD + 32 * bj + 8 * fq) = pack8(v[bj][0], v[bj][1]);
                    }
                    if (type >= 1) {
                        float* o = nullptr;
                        if (row < MP) { const int t = row & (SEQ - 1), b = row >> 13; if (t >= SEQ - W) o = P.out + o_kvp(g) + ((((size_t)(l * NB + b) * W + (t - (SEQ - W))) * 2 + (type - 1)) * HPG + hh) * HD + 8 * fq; }
                        else if (row < MT) { const int b = row - MP; o = P.out + o_kvs(g) + (((size_t)(l * SB + b) * 2 + (type - 1)) * HPG + hh) * HD + 8 * fq; }
                        if (o) {
#pragma unroll
                            for (int bj = 0; bj < 2; ++bj) { *(f32x4*)(o + 32 * bj) = v[bj][0]; *(f32x4*)(o + 32 * bj + 4) = v[bj][1]; } }
                    }
                    ROW_FENCE();
                }
        } else {
            bf16_t* GM = (bf16_t*)(P.ws + WS_GM); const float* bm = P.b_merge + (size_t)l * 2048;
            const int colb = (pn - 26) * 128 + c8;
            f32x4 bv[2][2];
#pragma unroll
            for (int bj = 0; bj < 2; ++bj)
#pragma unroll
                for (int n = 0; n < 2; ++n) bv[bj][n] = *(const f32x4*)(bm + bj * 1024 + colb + 4 * n);
#pragma unroll
            for (int ai = 0; ai < 2; ++ai)
#pragma unroll
                for (int m = 0; m < 4; ++m) {
                    const int row = row0 + ai * 128 + m * 16; const float rs = row_rs(ssq, row);
                    f32x4 rho[2], gav[2];
#pragma unroll
                    for (int n = 0; n < 2; ++n) {
                        const f32x4 xl = acc[ai][0][m][n] * rs + bv[0][n], xa = acc[ai][1][m][n] * rs + bv[1][n];
#pragma unroll
                        for (int e = 0; e < 4; ++e) { const float el = __expf(-xl[e]), ea = fminf(__expf(-xa[e]), 1e30f); gav[n][e] = __builtin_amdgcn_rcpf(1.0f + ea); rho[n][e] = (1.0f + ea) * __builtin_amdgcn_rcpf(1.0f + el); }
                    }
                    *(u32x4*)(GM + (size_t)row * 2048 + colb) = pack8(rho[0], rho[1]);
                    *(u32x4*)(GM + (size_t)row * 2048 + 1024 + colb) = pack8(gav[0], gav[1]);
                    ROW_FENCE();
                }
        }
    }
};

struct Epi3 {
    static constexpr bool PERM = true, AFTER_DRAIN = false, HAS_MID = true;
    int mid_t; Ptrs P;
    __device__ __forceinline__ void mid(f32x4 (&acc)[2][2][4][2], const Unit& u, int wr, int wc, int fr, int fq) const {
        const bf16_t* GM = (const bf16_t*)(P.ws + WS_GM);
        int fr_ = fr; asm volatile("" : "+v"(fr_));
        const int colb = u.pn * 256 + wc * 32 + 8 * fq, row0 = u.pm * 256 + wr * 64 + fr_;
#pragma unroll
        for (int ai = 0; ai < 2; ++ai)
#pragma unroll
            for (int m = 0; m < 4; ++m) {
                const int row = row0 + ai * 128 + m * 16;
#pragma unroll
                for (int bj = 0; bj < 2; ++bj) {
                    const u32x4 gl = *(const u32x4*)(GM + (size_t)row * 2048 + colb + bj * 128);
                    const f32x4 r0 = (f32x4){bflo(gl.x), bfhi(gl.x), bflo(gl.y), bfhi(gl.y)}, r1 = (f32x4){bflo(gl.z), bfhi(gl.z), bflo(gl.w), bfhi(gl.w)};
                    acc[ai][bj][m][0] = acc[ai][bj][m][0] * r0; acc[ai][bj][m][1] = acc[ai][bj][m][1] * r1;
                }
                ROW_FENCE();
            }
    }
    __device__ __forceinline__ void operator()(const f32x4 (&acc)[2][2][4][2], const Unit& u, int wr, int wc, int fr0, int fq) const {
        int fr = fr0; asm volatile("" : "+v"(fr));
        const bf16_t* GM = (const bf16_t*)(P.ws + WS_GM); bf16_t* MRG = (bf16_t*)(P.ws + WS_MRG);
        const int colb = u.pn * 256 + wc * 32 + 8 * fq, row0 = u.pm * 256 + wr * 64 + fr;
#pragma unroll
        for (int ai = 0; ai < 2; ++ai)
#pragma unroll
            for (int m = 0; m < 4; ++m) {
                const int row = row0 + ai * 128 + m * 16;
#pragma unroll
                for (int bj = 0; bj < 2; ++bj) {
                    const u32x4 ga = *(const u32x4*)(GM + (size_t)row * 2048 + 1024 + colb + bj * 128);
                    const f32x4 g0 = (f32x4){bflo(ga.x), bfhi(ga.x), bflo(ga.y), bfhi(ga.y)}, g1 = (f32x4){bflo(ga.z), bfhi(ga.z), bflo(ga.w), bfhi(ga.w)};
                    *(u32x4*)(MRG + (size_t)row * DM + colb + bj * 128) = pack8(acc[ai][bj][m][0] * g0, acc[ai][bj][m][1] * g1);
                }
                ROW_FENCE();
            }
    }
};

struct EpiRes {
    static constexpr bool PERM = false, AFTER_DRAIN = false, HAS_MID = false;
    int mid_t; Ptrs P; int first; int dry;
    __device__ __forceinline__ void operator()(const f32x4 (&acc)[2][2][4][2], const Unit& u, int wr, int wc, int fr0, int fq) const {
        int fr = fr0; asm volatile("" : "+v"(fr));
        float* Y = P.out + O_Y; float* Yo = dry ? (float*)(P.ws + WS_DUMMY) : Y; bf16_t* XB = (bf16_t*)(P.ws + (dry ? WS_DUMMY + 80 * MiB : WS_XB)); float* ssq = (float*)(P.ws + (dry ? WS_DUMMY + 120 * MiB : WS_SSQ));
        const int colb = u.pn * 256 + wc * 32 + 4 * fq, row0 = u.pm * 256 + wr * 64 + fr;
#pragma unroll
        for (int ai = 0; ai < 2; ++ai)
#pragma unroll
            for (int m = 0; m < 4; ++m) {
                const int row = row0 + ai * 128 + m * 16; const bool live = row < MT;
                const float* base = first ? xin_row(P, live ? row : 0) : Y + (size_t)(live ? row : 0) * DM;
                float ss = 0.f;
#pragma unroll
                for (int bj = 0; bj < 2; ++bj)
#pragma unroll
                    for (int n = 0; n < 2; ++n) {
                        const int col = colb + bj * 128 + n * 16;
                        f32x4 v = acc[ai][bj][m][n];
                        if (live) { v = v + *(const f32x4*)(base + col); *(f32x4*)(Yo + (size_t)row * DM + col) = v; }
                        u32x2 w; w.x = pkbf(v[0], v[1]); w.y = pkbf(v[2], v[3]);
                        *(u32x2*)(XB + (size_t)row * DM + col) = w;
                        ss += (v[0] * v[0] + v[1] * v[1]) + (v[2] * v[2] + v[3] * v[3]);
                    }
                ss += __shfl_xor(ss, 16); ss += __shfl_xor(ss, 32);
                if (fq == 0) ssq[(size_t)row * 16 + u.pn * 4 + wc] = ss;
                ROW_FENCE();
            }
    }
};

struct Epi5 {
    static constexpr bool PERM = true, AFTER_DRAIN = false, HAS_MID = false;
    int mid_t; Ptrs P;
    __device__ __forceinline__ void operator()(const f32x4 (&acc)[2][2][4][2], const Unit& u, int wr, int wc, int fr0, int fq) const {
        int fr = fr0; asm volatile("" : "+v"(fr));
        const float* ssq = (const float*)(P.ws + WS_SSQ); bf16_t* H = (bf16_t*)(P.ws + WS_H);
        const int colb = u.pn * 128 + wc * 32 + 8 * fq, row0 = u.pm * 256 + wr * 64 + fr;
#pragma unroll
        for (int ai = 0; ai < 2; ++ai)
#pragma unroll
            for (int m = 0; m < 4; ++m) {
                const int row = row0 + ai * 128 + m * 16; const float rs = row_rs(ssq, row);
                f32x4 h[2];
#pragma unroll
                for (int n = 0; n < 2; ++n)
#pragma unroll
                    for (int e = 0; e < 4; ++e) { const float gt = acc[ai][0][m][n][e] * rs, up = acc[ai][1][m][n][e] * rs; h[n][e] = gt * sigmoidf_(gt) * up; }
                *(u32x4*)(H + (size_t)row * DFF + colb) = pack8(h[0], h[1]);
                ROW_FENCE();
            }
    }
};

__device__ __forceinline__ void tr_item(const float* W, int N, int s0, int k0, const float* gain, bf16_t* WT, int K, int r0, int kofs, LAS float* scr, int lane) {
#pragma unroll 8
    for (int i = 0; i < 32; ++i) { const int kk = 2 * i + (lane >> 5); float v = W[(size_t)(k0 + kk) * N + s0 + (lane & 31)]; if (gain) v *= gain[k0 + kk]; scr[kk * 33 + (lane & 31)] = v; }
    asm volatile("s_waitcnt lgkmcnt(0)" ::: "memory");
    const int c = lane & 7;
#pragma unroll
    for (int j = 0; j < 4; ++j) { const int n = (lane >> 3) + 8 * j; const LAS float* s = scr + (8 * c) * 33 + n;
        u32x4 o; o.x = pkbf(s[0 * 33], s[1 * 33]); o.y = pkbf(s[2 * 33], s[3 * 33]); o.z = pkbf(s[4 * 33], s[5 * 33]); o.w = pkbf(s[6 * 33], s[7 * 33]);
        *(u32x4*)(WT + (size_t)(r0 + n) * K + kofs + k0 + 8 * c) = o; }
    asm volatile("s_waitcnt lgkmcnt(0)" ::: "memory");
}
constexpr int IT_W1 = (N1 / 32) * (DM / 64), IT_W3A = (DM / 32) * (DR / 64), IT_W3B = (DM / 32) * (AO / 64), IT_W4 = (DM / 32) * (DM / 64), IT_W5 = (2 * DFF / 32) * (DM / 64), IT_W6 = (DM / 32) * (DFF / 64);
constexpr int IT_L = IT_W1 + IT_W3A + IT_W3B + IT_W4 + IT_W5 + IT_W6;
__device__ __forceinline__ void p0_prologue(const Ptrs& P, LAS unsigned char* lds, int gw, int ngw, int wv, int lane) {
    LAS float* scr = (LAS float*)(lds + wv * 16384);
    for (int it = gw; it < DEPTH * IT_L; it += ngw) {
        const int l = it / IT_L; int r = it % IT_L;
        unsigned char* wb = P.ws + WS_W + l * LW_BYTES;
        if (r < IT_W1) { const int kb = r & 15, nb = r >> 4, nt0 = 32 * nb, c = w1_src_col(nt0);
            if (c < 6656) tr_item(P.w_in + (size_t)l * DM * 6656, 6656, c, 64 * kb, P.norm_mix + l * DM, (bf16_t*)(wb + LW_W1), DM, nt0, 0, scr, lane);
            else tr_item(P.w_merge + (size_t)l * DM * 2048, 2048, c - 6656, 64 * kb, P.norm_mix + l * DM, (bf16_t*)(wb + LW_W1), DM, nt0, 0, scr, lane);
            continue; }
        r -= IT_W1;
        if (r < IT_W3A) { const int kb = r & 15, nb = r >> 4; tr_item(P.w_branch_lru + (size_t)l * DR * DM, DM, 32 * nb, 64 * kb, nullptr, (bf16_t*)(wb + LW_W3), K3, 32 * nb, 0, scr, lane); continue; }
        r -= IT_W3A;
        if (r < IT_W3B) { const int kb = r & 7, nb = r >> 3; tr_item(P.w_branch_att + (size_t)l * AO * DM, DM, 32 * nb, 64 * kb, nullptr, (bf16_t*)(wb + LW_W3), K3, 32 * nb, DR, scr, lane); continue; }
        r -= IT_W3B;
        if (r < IT_W4) { const int kb = r & 15, nb = r >> 4; tr_item(P.w_o + (size_t)l * DM * DM, DM, 32 * nb, 64 * kb, nullptr, (bf16_t*)(wb + LW_W4), DM, 32 * nb, 0, scr, lane); continue; }
        r -= IT_W4;
        if (r < IT_W5) { const int kb = r & 15, nb = r >> 4, nt0 = 32 * nb; tr_item(P.w_ffn_in + (size_t)l * DM * 2 * DFF, 2 * DFF, w5_src_col(nt0), 64 * kb, P.norm_ffn + l * DM, (bf16_t*)(wb + LW_W5), DM, nt0, 0, scr, lane); continue; }
        r -= IT_W5;
        { const int kb = r % 44, nb = r / 44; tr_item(P.w_ffn_out + (size_t)l * DFF * DM, DM, 32 * nb, 64 * kb, nullptr, (bf16_t*)(wb + LW_W6), DFF, 32 * nb, 0, scr, lane); }
    }
    float* BIAS = (float*)(P.ws + WS_BIAS);
    for (int e = gw * 64 + lane; e < NG * HPG * NKEY; e += ngw * 64) {
        const int kk = e % NKEY, hh = (e / NKEY) % HPG, g = e / (NKEY * HPG);
        const int d = kk * g_dil(g); int bkt;
        if (d < 16) bkt = d; else { const float df = (float)d; int lg = 16 + (int)(logf(df / 16.0f) / logf(128.0f) * 16.0f); bkt = lg < 31 ? lg : 31; }
        BIAS[e] = P.rel_bias[bkt * NH + 8 * g + hh] * LOG2E;
    }
    for (int row = gw; row < MT; row += ngw) {
        const f32x4* xr = (const f32x4*)xin_row(P, row) + lane; bf16_t* xb = (bf16_t*)(P.ws + WS_XB) + (size_t)row * DM; float* ssq = (float*)(P.ws + WS_SSQ) + (size_t)row * 16;
        float s = 0.f;
#pragma unroll
        for (int j = 0; j < 4; ++j) { const f32x4 v = xr[64 * j]; s += (v[0] * v[0] + v[1] * v[1]) + (v[2] * v[2] + v[3] * v[3]);
            u32x2 w; w.x = pkbf(v[0], v[1]); w.y = pkbf(v[2], v[3]); *(u32x2*)(xb + 4 * lane + 256 * j) = w; }
        s = wave_sum(s);
        if (lane < 16) ssq[lane] = (lane == 0) ? s : 0.f;
    }
}

__device__ __forceinline__ void ph_combine(const Ptrs& P, size_t gtid, size_t nth) {
    const bf16_t* OG = (const bf16_t*)(P.ws + WS_OG); const float* ML = (const float*)(P.ws + WS_ML); bf16_t* A3 = (bf16_t*)(P.ws + WS_A3);
    for (size_t e = gtid; e < (size_t)MT * 64; e += nth) {
        const size_t row = e >> 6; const int hh = (int)(e >> 3) & 7, ch = (int)e & 7;
        f32x2 q[3]; u32x4 og[3];
#pragma unroll
        for (int g = 0; g < 3; ++g) { q[g] = *(const f32x2*)(ML + (((size_t)g * MT + row) * HPG + hh) * 2); og[g] = *(const u32x4*)(OG + ((size_t)g * MT + row) * AO + hh * HD + 8 * ch); }
        const float mm = fmaxf(fmaxf(q[0].x, q[1].x), q[2].x);
        float z[3], den = 0.f;
#pragma unroll
        for (int g = 0; g < 3; ++g) { z[g] = q[g].y * __builtin_amdgcn_exp2f(q[g].x - mm); den += z[g]; }
        const float inv = 1.0f / den;
        f32x4 o0 = (f32x4){0.f, 0.f, 0.f, 0.f}, o1 = (f32x4){0.f, 0.f, 0.f, 0.f};
#pragma unroll
        for (int g = 0; g < 3; ++g) { const float w = z[g] * inv; const u32x4 v = og[g];
            o0 = o0 + (f32x4){bflo(v.x), bfhi(v.x), bflo(v.y), bfhi(v.y)} * w; o1 = o1 + (f32x4){bflo(v.z), bfhi(v.z), bflo(v.w), bfhi(v.w)} * w; }
        *(u32x4*)(A3 + row * K3 + DR + hh * HD + 8 * ch) = pack8(o0, o1);
    }
}

constexpr int SC_XCF = 0;
constexpr int SC_HSF = 34816;
constexpr int SC_XCB = 69632;
constexpr int SC_WTA = 88064;
constexpr int SC_WTX = 97280;
constexpr int SC_WTOT = 106496;
constexpr int SC_WC = 110592;
constexpr int SC_END = 111872;

template <int MODE>
__device__ __forceinline__ void scan_item(const Ptrs& P, int l, LAS unsigned char* lds, int wv, int tid, int b, int n, int span) {
    const int lane = tid & 63, fr = lane & 15, fq = lane >> 4;
    LAS float* XCF = (LAS float*)(lds + SC_XCF); LAS float* HSF = (LAS float*)(lds + SC_HSF); LAS bf16_t* XCB = (LAS bf16_t*)(lds + SC_XCB);
    LAS bf16_t* WTA = (LAS bf16_t*)(lds + SC_WTA); LAS bf16_t* WTX = (LAS bf16_t*)(lds + SC_WTX);
    LAS f32x2* WTOT = (LAS f32x2*)(lds + SC_WTOT); LAS float* WC = (LAS float*)(lds + SC_WC);
    const bf16_t* LX = (const bf16_t*)(P.ws + WS_LX); const bf16_t* GG = (const bf16_t*)(P.ws + WS_GG); bf16_t* A3 = (bf16_t*)(P.ws + WS_A3);
    float* SUM = (float*)(P.ws + WS_SUM);
    __syncthreads();
    {
        const float* wa = P.w_rg_a + (size_t)(l * NBLK + n) * 4096; const float* wx = P.w_rg_x + (size_t)(l * NBLK + n) * 4096;
        for (int e = tid; e < 4096; e += 512) { const int i = e >> 6, j = e & 63; WTA[j * 72 + i] = f2b(wa[e]); WTX[j * 72 + i] = f2b(wx[e]); }
        if (tid < 320) { const int k = tid >> 6, c = tid & 63; WC[tid] = (k < 4) ? P.w_conv[(size_t)(l * CW + k) * DR + 64 * n + c] : P.b_conv[l * DR + 64 * n + c]; }
    }
    __syncthreads();
    bf16x8 wfa[4][2], wfx[4][2];
#pragma unroll
    for (int nt = 0; nt < 4; ++nt)
#pragma unroll
        for (int ks = 0; ks < 2; ++ks) { wfa[nt][ks] = *(const LAS bf16x8*)(WTA + (16 * nt + fr) * 72 + 32 * ks + 8 * fq); wfx[nt][ks] = *(const LAS bf16x8*)(WTX + (16 * nt + fr) * 72 + 32 * ks + 8 * fq); }
    float cba[4], cbx[4], csp[4], hc[4], pc[4];
#pragma unroll
    for (int nt = 0; nt < 4; ++nt) { const int ch = 64 * n + 16 * nt + fr;
        cba[nt] = P.b_rg_a[l * DR + ch]; cbx[nt] = P.b_rg_x[l * DR + ch]; csp[nt] = 8.0f * log1pf(expf(-P.lru_lambda[l * DR + ch]));
        float h = 0.f;
        if (MODE == 1) { for (int s = 0; s < span; ++s) { const f32x2 q = *(const f32x2*)(SUM + (((size_t)b * 8 + s) * DR + ch) * 2); h = q.x * h + q.y; } }
        hc[nt] = h; pc[nt] = 1.f; }
    for (int c8 = 0; c8 < 8; ++c8) {
        const int t0 = span * 1024 + c8 * 128;
        u32x4 gg[2];
#pragma unroll
        for (int rep = 0; rep < 2; ++rep) {
            const int idx = tid + 512 * rep, tok = idx >> 3, cg = idx & 7, t = t0 + tok; const size_t rowg = (size_t)b * SEQ + t;
            float acc[8];
#pragma unroll
            for (int j = 0; j < 8; ++j) acc[j] = WC[4 * 64 + 8 * cg + j];
#pragma unroll
            for (int k = 0; k < 4; ++k) { const int tt = t + k - 3;
                if (tt >= 0) { const u32x4 x = *(const u32x4*)(LX + (rowg + k - 3) * DR + 64 * n + 8 * cg);
                    const LAS float* w = WC + k * 64 + 8 * cg;
                    acc[0] += w[0] * bflo(x.x); acc[1] += w[1] * bfhi(x.x); acc[2] += w[2] * bflo(x.y); acc[3] += w[3] * bfhi(x.y);
                    acc[4] += w[4] * bflo(x.z); acc[5] += w[5] * bfhi(x.z); acc[6] += w[6] * bflo(x.w); acc[7] += w[7] * bfhi(x.w); } }
            *(LAS f32x4*)(XCF + tok * 68 + 8 * cg) = (f32x4){acc[0], acc[1], acc[2], acc[3]}; *(LAS f32x4*)(XCF + tok * 68 + 8 * cg + 4) = (f32x4){acc[4], acc[5], acc[6], acc[7]};
            *(LAS u32x4*)(XCB + tok * 72 + 8 * cg) = pack8((f32x4){acc[0], acc[1], acc[2], acc[3]}, (f32x4){acc[4], acc[5], acc[6], acc[7]});
            if (MODE == 1) gg[rep] = *(const u32x4*)(GG + rowg * DR + 64 * n + 8 * cg);
        }
        __syncthreads();
        bf16x8 af[2];
#pragma unroll
        for (int ks = 0; ks < 2; ++ks) af[ks] = *(const LAS bf16x8*)(XCB + (16 * wv + fr) * 72 + 32 * ks + 8 * fq);
        float hl[4][4], ac[4][4], Ae[4], He[4];
#pragma unroll
        for (int nt = 0; nt < 4; ++nt) {
            f32x4 da = (f32x4){0.f, 0.f, 0.f, 0.f}, dx = (f32x4){0.f, 0.f, 0.f, 0.f};
#pragma unroll
            for (int ks = 0; ks < 2; ++ks) { da = __builtin_amdgcn_mfma_f32_16x16x32_bf16(af[ks], wfa[nt][ks], da, 0, 0, 0); dx = __builtin_amdgcn_mfma_f32_16x16x32_bf16(af[ks], wfx[nt][ks], dx, 0, 0, 0); }
            float A = 1.f, H = 0.f;
#pragma unroll
            for (int r = 0; r < 4; ++r) {
                const int tok = 16 * wv + 4 * fq + r;
                const float rr = sigmoidf_(da[r] + cba[nt]), ii = sigmoidf_(dx[r] + cbx[nt]);
                const float av = __expf(-rr * csp[nt]);
                float mult = sqrtf(fmaxf(fmaf(-av, av, 1.0f), 0.f)); if (t0 + tok == 0) mult = 1.0f;
                const float u = mult * ii * XCF[tok * 68 + 16 * nt + fr];
                H = av * H + u; A = A * av; hl[nt][r] = H; ac[nt][r] = A;
            }
            { const float A1 = __shfl(A, lane - 16), H1 = __shfl(H, lane - 16); if (fq >= 1) { H = A * H1 + H; A = A * A1; } }
            { const float A2 = __shfl(A, lane - 32), H2 = __shfl(H, lane - 32); if (fq >= 2) { H = A * H2 + H; A = A * A2; } }
            { const float A3_ = __shfl(A, lane - 16), H3 = __shfl(H, lane - 16); Ae[nt] = (fq >= 1) ? A3_ : 1.f; He[nt] = (fq >= 1) ? H3 : 0.f; }
            if (fq == 3) WTOT[wv * 64 + 16 * nt + fr] = (f32x2){A, H};
        }
        __syncthreads();
#pragma unroll
        for (int nt = 0; nt < 4; ++nt) {
            float hrun = hc[nt], prun = pc[nt], hin = 0.f;
#pragma unroll
            for (int w = 0; w < 8; ++w) { const f32x2 q = WTOT[w * 64 + 16 * nt + fr]; if (w == wv) hin = hrun; hrun = q.x * hrun + q.y; prun = prun * q.x; }
            hc[nt] = hrun; pc[nt] = prun;
            if (MODE == 1) {
#pragma unroll
                for (int r = 0; r < 4; ++r) { const int tok = 16 * wv + 4 * fq + r; HSF[tok * 68 + 16 * nt + fr] = (ac[nt][r] * Ae[nt]) * hin + (ac[nt][r] * He[nt] + hl[nt][r]); }
            }
        }
        if (MODE == 1) {
            __syncthreads();
#pragma unroll
            for (int rep = 0; rep < 2; ++rep) {
                const int idx = tid + 512 * rep, tok = idx >> 3, cg = idx & 7; const size_t rowg = (size_t)b * SEQ + t0 + tok;
                const f32x4 h0 = *(const LAS f32x4*)(HSF + tok * 68 + 8 * cg), h1 = *(const LAS f32x4*)(HSF + tok * 68 + 8 * cg + 4);
                const u32x4 g = gg[rep];
                const f32x4 o0 = (f32x4){h0[0] * bflo(g.x), h0[1] * bfhi(g.x), h0[2] * bflo(g.y), h0[3] * bfhi(g.y)}, o1 = (f32x4){h1[0] * bflo(g.z), h1[1] * bfhi(g.z), h1[2] * bflo(g.w), h1[3] * bfhi(g.w)};
                *(u32x4*)(A3 + rowg * K3 + 64 * n + 8 * cg) = pack8(o0, o1);
            }
        }
    }
    if (wv == 0 && fq == 0) {
#pragma unroll
        for (int nt = 0; nt < 4; ++nt) { const int ch = 64 * n + 16 * nt + fr;
            if (MODE == 0) *(f32x2*)(SUM + (((size_t)b * 8 + span) * DR + ch) * 2) = (f32x2){pc[nt], hc[nt]};
            else if (span == 7) P.out[O_HP + (size_t)(l * NB + b) * DR + ch] = hc[nt]; }
    }
}
__device__ __forceinline__ void scan_sample(const Ptrs& P, int l, LAS unsigned char* lds, int tid, int rg, int n) {
    LAS float* XS = (LAS float*)lds;
    const int r = tid >> 6, j = tid & 63, b = 8 * rg + r, ch = 64 * n + j; const size_t row = (size_t)MP + b;
    const bf16_t* LX = (const bf16_t*)(P.ws + WS_LX); const bf16_t* GG = (const bf16_t*)(P.ws + WS_GG); bf16_t* A3 = (bf16_t*)(P.ws + WS_A3);
    const float* wc = P.w_conv + (size_t)l * CW * DR; const float* sc = P.state_conv + (size_t)(l * SB + b) * 3 * DR;
    const float xc = P.b_conv[l * DR + ch] + wc[ch] * sc[ch] + wc[DR + ch] * sc[DR + ch] + wc[2 * DR + ch] * sc[2 * DR + ch] + wc[3 * DR + ch] * bf2f(LX[row * DR + ch]);
    __syncthreads();
    XS[r * 64 + j] = xc;
    __syncthreads();
    const float* wa = P.w_rg_a + (size_t)(l * NBLK + n) * 4096 + j; const float* wx = P.w_rg_x + (size_t)(l * NBLK + n) * 4096 + j;
    float ga = P.b_rg_a[l * DR + ch], gx = P.b_rg_x[l * DR + ch];
#pragma unroll 1
    for (int i0 = 0; i0 < 64; i0 += 16) {
        float wa_[16], wx_[16];
#pragma unroll
        for (int i = 0; i < 16; ++i) { wa_[i] = wa[(i0 + i) * 64]; wx_[i] = wx[(i0 + i) * 64]; }
#pragma unroll
        for (int i = 0; i < 16; ++i) { const float x = XS[r * 64 + i0 + i]; ga += x * wa_[i]; gx += x * wx_[i]; }
    }
    const float rr = sigmoidf_(ga), ii = sigmoidf_(gx);
    const float log_a = -8.0f * rr * log1pf(expf(-P.lru_lambda[l * DR + ch])); const float av = expf(log_a);
    const float mult = sqrtf(-expm1f(2.0f * log_a));
    const float h = av * P.state_h[(size_t)(l * SB + b) * DR + ch] + mult * ii * xc;
    P.out[O_HS + (size_t)(l * SB + b) * DR + ch] = h;
    A3[row * K3 + ch] = f2b(h * bf2f(GG[row * DR + ch]));
}

constexpr int AT_K = 0, AT_V = 49152, AT_B = 98304, AT_W = 99328, AT_O = 101376, AT_END = 134144;
typedef float f32x16 __attribute__((ext_vector_type(16)));
typedef short s16x4 __attribute__((ext_vector_type(4)));
__device__ __forceinline__ int crow(int r, int hi) { return (r & 3) + 8 * (r >> 2) + 4 * hi; }
__device__ __forceinline__ s16x4 ds_tr16(const LAS unsigned char* p) { return __builtin_bit_cast(s16x4, __builtin_amdgcn_ds_read_tr16_b64_v4i16((LAS s16x4*)p)); }
struct AttnUnit { int g, b, hh, d, rho, u, head, j0; size_t rowbase; };
__device__ __forceinline__ AttnUnit attn_decode(int unit) {
    AttnUnit a; a.g = unit >> 9; const int rem = unit & 511; a.b = rem >> 8; a.hh = (rem >> 5) & 7; const int ru = rem & 31;
    a.d = g_dil(a.g); const int nub = 32 / a.d; a.rho = ru / nub; a.u = ru % nub; a.head = 8 * a.g + a.hh; a.j0 = 256 * a.u; a.rowbase = (size_t)a.b * SEQ + a.rho; return a;
}
__device__ __forceinline__ void attn_load(const Ptrs& P, const AttnUnit& a, int tid, u32x4 (&kq)[6], u32x4 (&vq)[6]) {
    const bf16_t* K = (const bf16_t*)(P.ws + WS_K); const bf16_t* V = (const bf16_t*)(P.ws + WS_V);
#pragma unroll
    for (int i = 0; i < 6; ++i) {
        const int idx = tid + 512 * i, key = idx >> 3, ch = idx & 7, j = a.j0 - 128 + key;
        const size_t off = (a.rowbase + (size_t)a.d * (j < 0 ? 0 : j)) * AW + a.head * HD + 8 * ch;
        const u32x4 k4 = *(const u32x4*)(K + off), v4 = *(const u32x4*)(V + off); const unsigned msk = (j >= 0) ? 0xffffffffu : 0u;
        kq[i] = k4 & msk; vq[i] = v4 & msk;
    }
}
__device__ __forceinline__ void attn_loadq(const Ptrs& P, const AttnUnit& a, int wv, int tid, bf16x8 (&qf)[4]) {
    const bf16_t* Q = (const bf16_t*)(P.ws + WS_Q);
    const int lane = tid & 63, l31 = lane & 31, hi = lane >> 5;
    const size_t rq = (a.rowbase + (size_t)a.d * (a.j0 + 32 * wv + l31)) * AW + a.head * HD + 8 * hi;
#pragma unroll
    for (int ks = 0; ks < 4; ++ks) qf[ks] = *(const bf16x8*)(Q + rq + 16 * ks);
}
__device__ __forceinline__ void attn_phase(const Ptrs& P, int l, LAS unsigned char* lds, int wv, int tid, int bid, int G) {
    const int lane = tid & 63, l31 = lane & 31, hi = lane >> 5;
    LAS float* BL = (LAS float*)(lds + AT_B); LAS float* LW = (LAS float*)(lds + AT_W) + wv * 64; LAS bf16_t* OS = (LAS bf16_t*)(lds + AT_O) + wv * 2048;
    u32x4 kq[6], vq[6];
    int unit = bid;
    if (unit >= 1536) return;
    AttnUnit a = attn_decode(unit);
    attn_load(P, a, tid, kq, vq);
    for (; unit < 1536; unit += G) {
        bf16x8 qf[4];
        attn_loadq(P, a, wv, tid, qf);
        __syncthreads();
#pragma unroll
        for (int i = 0; i < 6; ++i) {
            const int idx = tid + 512 * i, key = idx >> 3, ch = idx & 7;
            *(LAS u32x4*)(lds + AT_K + key * 128 + ((ch ^ ((key >> 1) & 7)) << 4)) = kq[i];
            *(LAS u32x4*)(lds + AT_V + key * 128 + (ch << 4)) = vq[i];
        }
        if (tid < NKEY) BL[tid] = ((const float*)(P.ws + WS_BIAS))[(size_t)(a.g * HPG + a.hh) * NKEY + tid];
        const AttnUnit cur = a;
        if (unit + G < 1536) { a = attn_decode(unit + G); attn_load(P, a, tid, kq, vq); }
        __syncthreads();
        f32x16 S[5];
#pragma unroll
        for (int c = 0; c < 5; ++c) {
            const int key = 32 * (wv + c) + l31;
            f32x16 acc = {};
#pragma unroll
            for (int ks = 0; ks < 4; ++ks) {
                const bf16x8 kf = *(const LAS bf16x8*)(lds + AT_K + key * 128 + (((2 * ks + hi) ^ ((key >> 1) & 7)) << 4));
                acc = __builtin_amdgcn_mfma_f32_32x32x16_bf16(kf, qf[ks], acc, 0, 0, 0);
            }
            S[c] = acc;
            if (c & 1) asm volatile("" ::: "memory");
        }
        float mx = -INFINITY;
#pragma unroll
        for (int c = 0; c < 5; ++c) {
            const bool tile_ok = (cur.u > 0) || (wv + c >= 4);
#pragma unroll
            for (int r = 0; r < 16; ++r) {
                const int dist = 128 - 32 * c + l31 - crow(r, hi);
                const int dcl = (c == 0) ? (dist > 128 ? 128 : dist) : ((c == 4) ? (dist < 0 ? 0 : dist) : dist);
                const float bv = BL[dcl];
                float s = S[c][r] + bv;
                if (c == 0) s = (dist > 128) ? -INFINITY : s;
                if (c == 4) s = (dist < 0) ? -INFINITY : s;
                s = tile_ok ? s : -INFINITY;
                S[c][r] = s; mx = fmaxf(mx, s);
            }
        }
        mx = fmaxf(mx, __shfl_xor(mx, 32));
        float lsum = 0.f;
        u32x4 pw[5][2];
#pragma unroll
        for (int c = 0; c < 5; ++c)
#pragma unroll
            for (int s = 0; s < 2; ++s) {
                float p[8];
#pragma unroll
                for (int j = 0; j < 8; ++j) { p[j] = __builtin_amdgcn_exp2f(S[c][8 * s + j] - mx); lsum += p[j]; }
                pw[c][s].x = pkbf(p[0], p[1]); pw[c][s].y = pkbf(p[2], p[3]); pw[c][s].z = pkbf(p[4], p[5]); pw[c][s].w = pkbf(p[6], p[7]);
            }
        lsum += __shfl_xor(lsum, 32);
        if (hi == 0) { LW[l31] = lsum;
            float* ML = (float*)(P.ws + WS_ML) + (((size_t)cur.g * MT + cur.rowbase + (size_t)cur.d * (cur.j0 + 32 * wv + l31)) * HPG + cur.hh) * 2; *(f32x2*)ML = (f32x2){mx, lsum}; }
        f32x16 o[2]; o[0] = (f32x16){}; o[1] = (f32x16){};
        const int g16 = lane >> 4, i16 = lane & 15;
        const LAS unsigned char* vb = lds + AT_V + (4 * hi + (i16 >> 2)) * 128 + (16 * (g16 & 1) + 4 * (i16 & 3)) * 2;
#pragma unroll
        for (int c = 0; c < 5; ++c)
#pragma unroll
            for (int s = 0; s < 2; ++s) {
                const bf16x8 pa = __builtin_bit_cast(bf16x8, pw[c][s]);
                const LAS unsigned char* vp = vb + (32 * (wv + c) + 16 * s) * 128;
#pragma unroll
                for (int db = 0; db < 2; ++db) {
                    const s16x4 lo = ds_tr16(vp + 64 * db), hi4 = ds_tr16(vp + 64 * db + 8 * 128);
                    const bf16x8 vf = (bf16x8){lo[0], lo[1], lo[2], lo[3], hi4[0], hi4[1], hi4[2], hi4[3]};
                    o[db] = __builtin_amdgcn_mfma_f32_32x32x16_bf16(pa, vf, o[db], 0, 0, 0);
                }
            }
#pragma unroll
        for (int r = 0; r < 16; ++r) {
            const int q = crow(r, hi); const float inv = __builtin_amdgcn_rcpf(LW[q]);
            const unsigned w = pkbf(o[0][r] * inv, o[1][r] * inv);
            OS[q * 64 + l31] = (bf16_t)(w & 0xffffu); OS[q * 64 + 32 + l31] = (bf16_t)(w >> 16);
        }
        asm volatile("s_waitcnt lgkmcnt(0)" ::: "memory");
        bf16_t* OG = (bf16_t*)(P.ws + WS_OG) + (size_t)cur.g * MT * AO;
#pragma unroll
        for (int i = 0; i < 4; ++i) {
            const int q = 8 * i + (lane >> 3), ch = lane & 7;
            const u32x4 v = *(const LAS u32x4*)(OS + q * 64 + 8 * ch);
            *(u32x4*)(OG + (cur.rowbase + (size_t)cur.d * (cur.j0 + 32 * wv + q)) * AO + cur.hh * HD + 8 * ch) = v;
        }
    }
}
__device__ __forceinline__ void attn_sample(const Ptrs& P, int l, LAS unsigned char* lds, int wv, int lane, int item) {
    const int b = item / NH, head = item % NH, g = head >> 3, hh = head & 7, dil = g_dil(g), Lc = g_win(g);
    const bf16_t* Q = (const bf16_t*)(P.ws + WS_Q); const bf16_t* K = (const bf16_t*)(P.ws + WS_K); const bf16_t* V = (const bf16_t*)(P.ws + WS_V);
    const float* BIAS = (const float*)(P.ws + WS_BIAS) + (size_t)(g * HPG + hh) * NKEY;
    const float* cache = P.cache[g] + (size_t)(l * SB + b) * Lc * 1024;
    const size_t row = (size_t)MP + b;
    LAS float* qw = (LAS float*)(lds + AT_W) + wv * 64;
    qw[lane] = bf2f(Q[row * AW + head * HD + lane]);
    asm volatile("s_waitcnt lgkmcnt(0)" ::: "memory");
    float s[3];
#pragma unroll
    for (int j = 0; j < 3; ++j) { const int kk = lane + 64 * j; float acc = -INFINITY;
        if (kk <= 128) { acc = 0.f;
            if (kk == 0) { const bf16_t* kr = K + row * AW + head * HD; for (int dd = 0; dd < HD; ++dd) acc += qw[dd] * bf2f(kr[dd]); }
            else { const f32x4* kr = (const f32x4*)(cache + ((size_t)(Lc - kk * dil) * 2 + 0) * 512 + hh * HD);
#pragma unroll
                for (int dd = 0; dd < 16; ++dd) { const f32x4 kv = kr[dd]; const f32x4 qv = *(const LAS f32x4*)(qw + 4 * dd); acc += (kv[0] * qv[0] + kv[1] * qv[1]) + (kv[2] * qv[2] + kv[3] * qv[3]); } }
            acc = acc + BIAS[kk]; }
        s[j] = acc; }
    const float m = wave_max(fmaxf(fmaxf(s[0], s[1]), s[2]));
    float p[3]; float lsum = 0.f;
#pragma unroll
    for (int j = 0; j < 3; ++j) { p[j] = (lane + 64 * j <= 128) ? __builtin_amdgcn_exp2f(s[j] - m) : 0.f; lsum += p[j]; }
    lsum = wave_sum(lsum);
    float o = __shfl(p[0], 0) * bf2f(V[row * AW + head * HD + lane]);
#pragma unroll 1
    for (int k0 = 1; k0 <= 128; k0 += 32) {
        float vv[32];
#pragma unroll
        for (int i = 0; i < 32; ++i) vv[i] = cache[((size_t)(Lc - (k0 + i) * dil) * 2 + 1) * 512 + hh * HD + lane];
#pragma unroll
        for (int i = 0; i < 32; ++i) { const int kk = k0 + i; const float pk = __shfl(kk < 64 ? p[0] : (kk < 128 ? p[1] : p[2]), kk & 63); o += pk * vv[i]; }
    }
    bf16_t* OG = (bf16_t*)(P.ws + WS_OG) + ((size_t)g * MT + row) * AO; OG[hh * HD + lane] = f2b(o / lsum);
    if (lane == 0) { float* ML = (float*)(P.ws + WS_ML) + (((size_t)g * MT + row) * HPG + hh) * 2; ML[0] = m; ML[1] = lsum; }
}

template <int NSTEP>
__device__ __forceinline__ void sg_part(const bf16_t* A, int lda, const bf16_t* Bt, int ldb, int k0, int colbase, LAS float* TLP, int wv, int lane) {
    const int l31 = lane & 31, hi = lane >> 5, cb = wv & 1, kq = wv >> 1;
    const bf16_t* ap = A + (size_t)l31 * lda + k0 + kq * (NSTEP * 16) + 8 * hi;
    const bf16_t* bp = Bt + (size_t)(colbase + 128 * cb + l31) * ldb + k0 + kq * (NSTEP * 16) + 8 * hi;
    f32x16 acc = {};
    int s = 0;
#pragma unroll 1
    for (; s + 8 <= NSTEP; s += 8) {
        bf16x8 a[8], b[8];
#pragma unroll
        for (int i = 0; i < 8; ++i) { a[i] = *(const bf16x8*)(ap + 16 * (s + i)); b[i] = *(const bf16x8*)(bp + 16 * (s + i)); }
#pragma unroll
        for (int i = 0; i < 8; ++i) acc = __builtin_amdgcn_mfma_f32_32x32x16_bf16(a[i], b[i], acc, 0, 0, 0);
    }
    if (NSTEP & 4) {
        bf16x8 a[4], b[4];
#pragma unroll
        for (int i = 0; i < 4; ++i) { a[i] = *(const bf16x8*)(ap + 16 * (s + i)); b[i] = *(const bf16x8*)(bp + 16 * (s + i)); }
#pragma unroll
        for (int i = 0; i < 4; ++i) acc = __builtin_amdgcn_mfma_f32_32x32x16_bf16(a[i], b[i], acc, 0, 0, 0);
    }
    LAS float* t = TLP + kq * 2048 + 32 * cb + l31;
#pragma unroll
    for (int r = 0; r < 16; ++r) t[crow(r, hi) * 64] = acc[r];
}
__device__ __forceinline__ f32x4 sg_sum(const LAS float* TLP, int r, int q) {
    const LAS f32x4* p = (const LAS f32x4*)(TLP + r * 64 + 4 * q);
    return (p[0] + p[512]) + (p[1024] + p[1536]);
}
__device__ __forceinline__ float red16(float v) { v += __shfl_xor(v, 1); v += __shfl_xor(v, 2); v += __shfl_xor(v, 4); v += __shfl_xor(v, 8); return v; }

template <int WHICH>
__device__ __forceinline__ void sample_strip(const Ptrs& P, int l, LAS unsigned char* lds, int wv, int tid, int s, int first) {
    const int lane = tid & 63, pn = s >> 2, wc = s & 3, colbase = 256 * pn + 32 * wc;
    unsigned char* ws = P.ws; unsigned char* wb = ws + WS_W + l * LW_BYTES;
    LAS float* TLP = (LAS float*)lds; LAS float* TLP2 = TLP + 8192;
    __syncthreads();
    if (WHICH == 1) sg_part<16>((const bf16_t*)(ws + WS_XB) + (size_t)MP * DM, DM, (const bf16_t*)(wb + LW_W1), DM, 0, colbase, TLP, wv, lane);
    if (WHICH == 3) { sg_part<16>((const bf16_t*)(ws + WS_A3) + (size_t)MP * K3, K3, (const bf16_t*)(wb + LW_W3), K3, 0, colbase, TLP, wv, lane);
                      sg_part<8>((const bf16_t*)(ws + WS_A3) + (size_t)MP * K3, K3, (const bf16_t*)(wb + LW_W3), K3, DR, colbase, TLP2, wv, lane); }
    if (WHICH == 4) sg_part<16>((const bf16_t*)(ws + WS_MRG) + (size_t)MP * DM, DM, (const bf16_t*)(wb + LW_W4), DM, 0, colbase, TLP, wv, lane);
    if (WHICH == 5) sg_part<16>((const bf16_t*)(ws + WS_XB) + (size_t)MP * DM, DM, (const bf16_t*)(wb + LW_W5), DM, 0, colbase, TLP, wv, lane);
    if (WHICH == 6) sg_part<44>((const bf16_t*)(ws + WS_H) + (size_t)MP * DFF, DFF, (const bf16_t*)(wb + LW_W6), DFF, 0, colbase, TLP, wv, lane);
    __syncthreads();
    const int r = tid >> 4, q = tid & 15, c0 = 4 * q, cb = q >> 3, i0 = c0 & 31;
    const size_t row = (size_t)MP + r;
    f32x4 y = sg_sum(TLP, r, q);
    const float* ssq = (const float*)(ws + WS_SSQ);
    if (WHICH == 1) {
        const float rs = row_rs(ssq, (int)row);
        const f32x4 v = y * rs;
        if (pn < 8) {
            const int col = (pn & 3) * 256 + 128 * cb + 32 * wc + i0;
            if (pn < 4) {
                u32x2 w; w.x = pkbf(v[0], v[1]); w.y = pkbf(v[2], v[3]); *(u32x2*)((bf16_t*)(ws + WS_LX) + row * DR + col) = w;
                float* cs = P.out + O_CONVS + (size_t)(l * SB + r) * 3 * DR + col; const float* sc = P.state_conv + (size_t)(l * SB + r) * 3 * DR + col;
                *(f32x4*)cs = *(const f32x4*)(sc + DR); *(f32x4*)(cs + DR) = *(const f32x4*)(sc + 2 * DR); *(f32x4*)(cs + 2 * DR) = v;
            } else {
                u32x2 w; w.x = pkbf(gelu_tanh(v[0]), gelu_tanh(v[1])); w.y = pkbf(gelu_tanh(v[2]), gelu_tanh(v[3])); *(u32x2*)((bf16_t*)(ws + WS_GG) + row * DR + col) = w;
            }
        } else if (pn < 26) {
            const int tq = pn - 8, type = tq / 6, head = 4 * (tq % 6) + wc, g = head >> 3, hh = head & 7;
            f32x4 o = v;
            const float ss = red16((v[0] * v[0] + v[1] * v[1]) + (v[2] * v[2] + v[3] * v[3]));
            if (type < 2) { const float inv = rsqrtf(ss * (1.0f / HD) + EPS) * (type == 0 ? QSCALE : 1.0f); const f32x4 gn = *(const f32x4*)((type == 0 ? P.q_gain : P.k_gain) + l * HD + c0); o = v * inv * gn; }
            bf16_t* dst = (bf16_t*)(ws + (type == 0 ? WS_Q : (type == 1 ? WS_K : WS_V)));
            u32x2 w; w.x = pkbf(o[0], o[1]); w.y = pkbf(o[2], o[3]); *(u32x2*)(dst + row * AW + head * HD + c0) = w;
            if (type >= 1) *(f32x4*)(P.out + o_kvs(g) + (((size_t)(l * SB + r) * 2 + (type - 1)) * HPG + hh) * HD + c0) = o;
        } else if (q < 8) {
            const f32x4 ya = sg_sum(TLP, r, q + 8);
            const float* bm = P.b_merge + (size_t)l * 2048; const int col = (pn - 26) * 128 + 32 * wc + i0;
            const f32x4 xl = v + *(const f32x4*)(bm + col), xa = ya * rs + *(const f32x4*)(bm + 1024 + col);
            f32x4 rho, gav;
#pragma unroll
            for (int e = 0; e < 4; ++e) { const float el = __expf(-xl[e]), ea = fminf(__expf(-xa[e]), 1e30f); gav[e] = __builtin_amdgcn_rcpf(1.0f + ea); rho[e] = (1.0f + ea) * __builtin_amdgcn_rcpf(1.0f + el); }
            bf16_t* GM = (bf16_t*)(ws + WS_GM) + row * 2048;
            u32x2 w; w.x = pkbf(rho[0], rho[1]); w.y = pkbf(rho[2], rho[3]); *(u32x2*)(GM + col) = w;
            w.x = pkbf(gav[0], gav[1]); w.y = pkbf(gav[2], gav[3]); *(u32x2*)(GM + 1024 + col) = w;
        }
    } else if (WHICH == 3) {
        const f32x4 y2 = sg_sum(TLP2, r, q);
        const int col = 256 * pn + 128 * cb + 32 * wc + i0;
        const bf16_t* GM = (const bf16_t*)(ws + WS_GM) + row * 2048;
        const u32x2 gl = *(const u32x2*)(GM + col), ga = *(const u32x2*)(GM + 1024 + col);
        const f32x4 rho = (f32x4){bflo(gl.x), bfhi(gl.x), bflo(gl.y), bfhi(gl.y)}, gav = (f32x4){bflo(ga.x), bfhi(ga.x), bflo(ga.y), bfhi(ga.y)};
        const f32x4 mg = gav * (rho * y + y2);
        u32x2 w; w.x = pkbf(mg[0], mg[1]); w.y = pkbf(mg[2], mg[3]); *(u32x2*)((bf16_t*)(ws + WS_MRG) + row * DM + col) = w;
    } else if (WHICH == 4 || WHICH == 6) {
        const int col = 256 * pn + 128 * cb + 32 * wc + i0;
        float* Y = P.out + O_Y + row * DM + col;
        const f32x4 base = first ? *(const f32x4*)(P.x_sample + (size_t)r * DM + col) : *(const f32x4*)Y;
        const f32x4 v = base + y;
        *(f32x4*)Y = v;
        u32x2 w; w.x = pkbf(v[0], v[1]); w.y = pkbf(v[2], v[3]); *(u32x2*)((bf16_t*)(ws + WS_XB) + row * DM + col) = w;
        const float ss = red16((v[0] * v[0] + v[1] * v[1]) + (v[2] * v[2] + v[3] * v[3]));
        if (q == 0) ((float*)(ws + WS_SSQ))[row * 16 + pn * 4 + wc] = ss;
    } else if (WHICH == 5) {
        if (q < 8) {
            const float rs = row_rs(ssq, (int)row);
            const f32x4 yu = sg_sum(TLP, r, q + 8);
            f32x4 h;
#pragma unroll
            for (int e = 0; e < 4; ++e) { const float gt = y[e] * rs, up = yu[e] * rs; h[e] = gt * sigmoidf_(gt) * up; }
            u32x2 w; w.x = pkbf(h[0], h[1]); w.y = pkbf(h[2], h[3]); *(u32x2*)((bf16_t*)(ws + WS_H) + row * DFF + pn * 128 + 32 * wc + i0) = w;
        }
    }
}

constexpr int RING_BYTES = 131072, LDS_BYTES = 147456, LDSCTL_OFF = LDS_BYTES - 1024, MISC_OFF = LDSCTL_OFF + 320;
static_assert(AT_END <= LDSCTL_OFF && SC_END <= LDSCTL_OFF && RING_BYTES <= LDSCTL_OFF, "LDS map");
constexpr int CW_BAR = 4096;
constexpr int NPH = 1 + 8 * DEPTH;
#ifndef PHMASK
#define PHMASK 63
#endif
struct Args { Ptrs P; int ph_lo, ph_hi, pad0, pad1; };

__global__ void __launch_bounds__(512, 2) mega(Args a) {
    extern __shared__ __attribute__((aligned(16))) unsigned char lds_raw[];
    LAS unsigned char* lds = (LAS unsigned char*)lds_raw;
    const int wv = __builtin_amdgcn_readfirstlane(threadIdx.x >> 6);
#define TID() ((wv << 6) | lane_id_v())
    { const int tid = TID(); for (int u = tid; u < (LDS_BYTES - LDSCTL_OFF) / 4; u += 512) ((LAS unsigned*)(lds + LDSCTL_OFF))[u] = 0u; }
    __syncthreads();
    unsigned char* ws0 = a.P.ws;
    XcdBarrier bar; bar.bar = (unsigned*)(ws0 + WS_CTL) + CW_BAR; bar.x = 0; bar.st = nullptr; bar.wv = wv;
    if (a.ph_hi - a.ph_lo > 1) bar = xcd_barrier_post((unsigned*)(ws0 + WS_CTL) + CW_BAR, (volatile LAS unsigned*)(lds + MISC_OFF) + 8);
    bar.wv = wv;
    const int G = gridDim.x;
#ifndef PROBE_REPEAT
#define PROBE_REPEAT -1
#endif
    for (int ph2_ = a.ph_lo * 2; ph2_ < a.ph_hi * 2; ph2_ = __builtin_amdgcn_readfirstlane(ph2_ + 1)) {
        const int ph2 = __builtin_amdgcn_readfirstlane(ph2_), ph = ph2 >> 1;
        const bool isrep = (PROBE_REPEAT == 8) ? (ph == 0) : (PROBE_REPEAT == 9 ? true : (ph > 0 && ((ph - 1) & 7) == PROBE_REPEAT));
        if (!isrep && (ph2 & 1) == 0) continue;
        const int dry = (isrep && (ph2 & 1) == 0) ? 1 : 0;
        if (PROBE_REPEAT == 9 && dry) { xcd_barrier(bar); continue; }
        const Ptrs& P = a.P;
        int bid = blockIdx.x; asm volatile("" : "+s"(bid));
        unsigned char* ws = P.ws;
        if (ph == 0 && (PHMASK & 32)) {
            int t_ = TID(); asm volatile("" : "+v"(t_));
            p0_prologue(P, lds, bid * 8 + wv, G * 8, wv, t_ & 63);
        } else {
            const int l = __builtin_amdgcn_readfirstlane((ph - 1) >> 3), p = __builtin_amdgcn_readfirstlane((ph - 1) & 7);
            unsigned char* wb = ws + WS_W + l * LW_BYTES;
            if (p == 0 && (PHMASK & 1)) {
                pg8::Gemm g{(const bf16_t*)(ws + WS_XB), (const bf16_t*)(wb + LW_W1), MP, N1, DM, wv}; pg8::StaticOrder S; S.init(MP, N1, G, bid);
                Epi1 E{0, P, l}; pg8::gemm_phase<Epi1, pg8::StaticOrder, true, true>(lds, g, S, E);
                { int t_ = TID(); asm volatile("" : "+v"(t_)); for (int s = G - 1 - bid; s < N1 / 64; s += G) sample_strip<1>(P, l, lds, wv, t_, s, 0); }
            } else if (p == 4 && (PHMASK & 2)) {
                pg8::Gemm g{(const bf16_t*)(ws + WS_A3), (const bf16_t*)(wb + LW_W3), MP, DM, K3, wv}; pg8::StaticOrder S; S.init(MP, DM, G, bid);
                Epi3 E{DR / 64, P}; pg8::gemm_phase<Epi3, pg8::StaticOrder, true, true>(lds, g, S, E);
                { int t_ = TID(); asm volatile("" : "+v"(t_)); for (int s = G - 1 - bid; s < DM / 64; s += G) sample_strip<3>(P, l, lds, wv, t_, s, 0); }
            } else if (p == 5 && (PHMASK & 4)) {
                pg8::Gemm g{(const bf16_t*)(ws + WS_MRG), (const bf16_t*)(wb + LW_W4), MP, DM, DM, wv}; pg8::StaticOrder S; S.init(MP, DM, G, bid);
                EpiRes E{0, P, l == 0 ? 1 : 0, dry}; pg8::gemm_phase<EpiRes, pg8::StaticOrder, true, true>(lds, g, S, E);
                { int t_ = TID(); asm volatile("" : "+v"(t_)); for (int s = G - 1 - bid; s < DM / 64; s += G) if (!dry) sample_strip<4>(P, l, lds, wv, t_, s, l == 0 ? 1 : 0); }
            } else if (p == 6 && (PHMASK & 8)) {
                pg8::Gemm g{(const bf16_t*)(ws + WS_XB), (const bf16_t*)(wb + LW_W5), MP, 2 * DFF, DM, wv}; pg8::StaticOrder S; S.init(MP, 2 * DFF, G, bid);
                Epi5 E{0, P}; pg8::gemm_phase<Epi5, pg8::StaticOrder, true, true>(lds, g, S, E);
                { int t_ = TID(); asm volatile("" : "+v"(t_)); for (int s = G - 1 - bid; s < 2 * DFF / 64; s += G) sample_strip<5>(P, l, lds, wv, t_, s, 0); }
            } else if (p == 7 && (PHMASK & 16)) {
                pg8::Gemm g{(const bf16_t*)(ws + WS_H), (const bf16_t*)(wb + LW_W6), MP, DM, DFF, wv}; pg8::StaticOrder S; S.init(MP, DM, G, bid);
                EpiRes E{0, P, 0, dry}; pg8::gemm_phase<EpiRes, pg8::StaticOrder, true, true>(lds, g, S, E);
                { int t_ = TID(); asm volatile("" : "+v"(t_)); for (int s = G - 1 - bid; s < DM / 64; s += G) if (!dry) sample_strip<6>(P, l, lds, wv, t_, s, 0); }
            } else if (p >= 1 && p <= 3) {
                int t_ = TID(); asm volatile("" : "+v"(t_));
                const size_t gtid = (size_t)bid * 512 + t_, nth = (size_t)G * 512;
                if (p == 1) {
                    for (int rp = 0; rp < (PROBE_REPEAT == 10 ? 2 : 1); ++rp)
                    for (int it = bid; it < 256; it += G) scan_item<0>(P, l, lds, wv, t_, it >> 7, (it >> 3) & 15, it & 7);
                    for (int rp = 0; rp < (PROBE_REPEAT == 11 ? 2 : 1); ++rp)
                    attn_phase(P, l, lds, wv, t_, bid, G);
                    __syncthreads();
                    for (int it = bid * 8 + wv; it < SB * NH; it += G * 8) attn_sample(P, l, lds, wv, t_ & 63, it);
                } else if (p == 2) {
                    for (int rp = 0; rp < (PROBE_REPEAT == 12 ? 2 : 1); ++rp)
                    for (int it = bid; it < 256; it += G) scan_item<1>(P, l, lds, wv, t_, it >> 7, (it >> 3) & 15, it & 7);
                    for (int rp = 0; rp < (PROBE_REPEAT == 13 ? 2 : 1); ++rp) {
                    for (int it = bid; it < 64; it += G) scan_sample(P, l, lds, t_, it >> 4, it & 15);
                    ph_combine(P, gtid, nth); }
                }
            }
        }
        if (ph2 + 1 < a.ph_hi * 2) xcd_barrier(bar);
    }
}

extern "C" void kernel_launch(void* const* d_in, const int* in_sizes, int n_in, void* d_out, int out_size, void* d_ws, size_t ws_size, hipStream_t stream) {
    static int grid = 0;
    if (grid == 0) {
        if (n_in != 27 || (size_t)out_size != O_END || ws_size < WS_END) { fprintf(stderr, "kernel_launch: unexpected sizes n_in %d out %d (want %zu) ws %zu (want %zu)\n", n_in, out_size, (size_t)O_END, ws_size, (size_t)WS_END); grid = -1; return; }
        int dev = 0, cus = 0;
        if (hipGetDevice(&dev) != hipSuccess || hipDeviceGetAttribute(&cus, hipDeviceAttributeMultiprocessorCount, dev) != hipSuccess) { grid = -1; return; }
        if (hipFuncSetAttribute((const void*)mega, hipFuncAttributeMaxDynamicSharedMemorySize, LDS_BYTES) != hipSuccess) { fprintf(stderr, "kernel_launch: hipFuncSetAttribute failed\n"); grid = -1; return; }
        grid = cus;
    }
    if (grid < 0) return;
    Args a{};
    Ptrs& P = a.P;
    const float* const* in = (const float* const*)d_in;
    P.x_prompt = in[0]; P.x_sample = in[1]; P.cache[0] = in[2]; P.cache[1] = in[3]; P.cache[2] = in[4]; P.state_conv = in[5]; P.state_h = in[6]; P.rel_bias = in[7];
    P.norm_mix = in[8]; P.w_in = in[9]; P.w_conv = in[10]; P.b_conv = in[11]; P.w_rg_a = in[12]; P.b_rg_a = in[13]; P.w_rg_x = in[14]; P.b_rg_x = in[15];
    P.lru_lambda = in[16]; P.q_gain = in[17]; P.k_gain = in[18]; P.w_merge = in[19]; P.b_merge = in[20]; P.w_branch_lru = in[21]; P.w_branch_att = in[22];
    P.w_o = in[23]; P.norm_ffn = in[24]; P.w_ffn_in = in[25]; P.w_ffn_out = in[26];
    P.out = (float*)d_out; P.ws = (unsigned char*)d_ws;
    (void)hipMemsetAsync((char*)d_ws + WS_CTL, 0, CTL_ZERO_BYTES, stream);
    a.ph_lo = 0; a.ph_hi = NPH;
    hipLaunchKernelGGL(mega, dim3(grid), dim3(512), LDS_BYTES, stream, a);
}
```

```cpp
#include <hip/hip_runtime.h>
#include <stdint.h>
#include <stdio.h>

typedef unsigned short bf16_t;
typedef short bf16x8 __attribute__((ext_vector_type(8)));
typedef float f32x4 __attribute__((ext_vector_type(4)));
typedef unsigned u32x4 __attribute__((ext_vector_type(4)));
typedef unsigned u32x2 __attribute__((ext_vector_type(2)));
typedef float f32x2 __attribute__((ext_vector_type(2)));

constexpr int DM = 1024, NB = 2, SEQ = 8192, DEPTH = 2, SB = 32, PAST = 8192;
constexpr int MP = NB * SEQ;
constexpr int MT = MP + SB;
constexpr int MPAD = 16640;
constexpr int DR = 1024, NBLK = 16, CW = 4;
constexpr int HD = 64, HPG = 8, NG = 3, NH = 24, AW = 1536, AO = 512;
constexpr int DFF = 2816;
constexpr int N1 = 2 * DR + 3 * AW + 2 * DM;
constexpr int K3 = DR + AO;
constexpr float EPS = 1e-6f;
constexpr int NKEY = 129;

__host__ __device__ constexpr int g_dil(int g) { return g == 0 ? 1 : (g == 1 ? 4 : 16); }
__host__ __device__ constexpr int g_win(int g) { return g == 0 ? 128 : (g == 1 ? 512 : 2048); }

constexpr size_t O_Y = 0;
constexpr size_t O_KVP0 = (size_t)MT * DM;
constexpr size_t O_KVP1 = O_KVP0 + (size_t)DEPTH * NB * 128 * 1024;
constexpr size_t O_KVP2 = O_KVP1 + (size_t)DEPTH * NB * 512 * 1024;
constexpr size_t O_CONVP = O_KVP2 + (size_t)DEPTH * NB * 2048 * 1024;
constexpr size_t O_HP = O_CONVP + (size_t)DEPTH * NB * 3 * DR;
constexpr size_t O_KVS0 = O_HP + (size_t)DEPTH * NB * DR;
constexpr size_t O_KVS1 = O_KVS0 + (size_t)DEPTH * SB * 1024;
constexpr size_t O_KVS2 = O_KVS1 + (size_t)DEPTH * SB * 1024;
constexpr size_t O_CONVS = O_KVS2 + (size_t)DEPTH * SB * 1024;
constexpr size_t O_HS = O_CONVS + (size_t)DEPTH * SB * 3 * DR;
constexpr size_t O_END = O_HS + (size_t)DEPTH * SB * DR;
__host__ __device__ constexpr size_t o_kvp(int g) { return g == 0 ? O_KVP0 : (g == 1 ? O_KVP1 : O_KVP2); }
__host__ __device__ constexpr size_t o_kvs(int g) { return g == 0 ? O_KVS0 : (g == 1 ? O_KVS1 : O_KVS2); }

constexpr size_t MiB = 1u << 20;
constexpr size_t rup(size_t x) { return (x + MiB - 1) / MiB * MiB; }
constexpr size_t WS_CTL = 0, CTL_ZERO_BYTES = 1 * MiB;
constexpr size_t WS_BIAS = 1 * MiB;
constexpr size_t WS_SSQ = 2 * MiB;
constexpr size_t WS_SUM = 4 * MiB;
constexpr size_t WS_W = 8 * MiB;
constexpr size_t LW_W1 = 0;
constexpr size_t LW_W3 = LW_W1 + (size_t)N1 * DM * 2;
constexpr size_t LW_W4 = LW_W3 + (size_t)DM * K3 * 2;
constexpr size_t LW_W5 = LW_W4 + (size_t)DM * DM * 2;
constexpr size_t LW_W6 = LW_W5 + (size_t)2 * DFF * DM * 2;
constexpr size_t LW_BYTES = rup(LW_W6 + (size_t)DM * DFF * 2);
constexpr size_t WS_XB = WS_W + DEPTH * LW_BYTES;
constexpr size_t WS_LX = WS_XB + rup((size_t)MPAD * DM * 2);
constexpr size_t WS_GG = WS_LX + rup((size_t)MPAD * DM * 2);
constexpr size_t WS_Q = WS_GG + rup((size_t)MPAD * DM * 2);
constexpr size_t WS_K = WS_Q + rup((size_t)MPAD * AW * 2);
constexpr size_t WS_V = WS_K + rup((size_t)MPAD * AW * 2);
constexpr size_t WS_GM = WS_V + rup((size_t)MPAD * AW * 2);
constexpr size_t WS_OG = WS_GM + rup((size_t)MPAD * 2048 * 2);
constexpr size_t WS_ML = WS_OG + rup((size_t)3 * MPAD * AO * 2);
constexpr size_t WS_A3 = WS_ML + rup((size_t)3 * MPAD * 16 * 4);
constexpr size_t WS_MRG = WS_A3 + rup((size_t)MPAD * K3 * 2);
constexpr size_t WS_H = WS_MRG + rup((size_t)MPAD * DM * 2);
constexpr size_t WS_SIMPLE = WS_H + rup((size_t)MPAD * DFF * 2);
constexpr size_t WS_XC = WS_SIMPLE;
constexpr size_t WS_AA = WS_XC + rup((size_t)MPAD * DM * 4);
constexpr size_t WS_UU = WS_AA + rup((size_t)MPAD * DM * 4);
constexpr size_t WS_DUMMY = WS_UU + rup((size_t)MPAD * DM * 4);
constexpr size_t WS_END = WS_DUMMY + 160 * MiB;

__device__ __forceinline__ int lane_id_v() { int x; asm volatile("v_mbcnt_lo_u32_b32 %0, -1, 0\n\tv_mbcnt_hi_u32_b32 %0, -1, %0" : "=v"(x)); return x; }
__device__ __forceinline__ float bf2f(bf16_t v) { return __uint_as_float(((unsigned)v) << 16); }
__device__ __forceinline__ bf16_t f2b(float f) { unsigned u = __float_as_uint(f); u += 0x7fffu + ((u >> 16) & 1u); return (bf16_t)(u >> 16); }
__device__ __forceinline__ float wave_sum(float v) {
#pragma unroll
    for (int o = 1; o < 64; o <<= 1) v += __shfl_xor(v, o);
    return v;
}
__device__ __forceinline__ float wave_max(float v) {
#pragma unroll
    for (int o = 1; o < 64; o <<= 1) v = fmaxf(v, __shfl_xor(v, o));
    return v;
}
__device__ __forceinline__ float sigmoidf_(float x) { return __builtin_amdgcn_rcpf(1.0f + __builtin_amdgcn_exp2f(-1.4426950408889634f * x)); }
__device__ __forceinline__ float gelu_tanh(float x) { const float u2 = x * (1.5957691216057308f + 0.07135481627159831f * x * x); return x * __builtin_amdgcn_rcpf(1.0f + __builtin_amdgcn_exp2f(-1.4426950408889634f * u2)); }

__host__ __device__ __forceinline__ int w1_src_col(int nt) {
    if (nt < 2048) return nt;
    const int pn = nt >> 8, tc = nt & 255, bj = tc >> 7;
    if (nt >= 6656) return 6656 + bj * 1024 + (pn - 26) * 128 + (tc & 127);
    const int wc = (tc >> 5) & 3, i = tc & 31;
    return 2048 + (pn - 8) * 256 + wc * 64 + bj * 32 + i;
}
__host__ __device__ __forceinline__ int w5_src_col(int nt) { const int pn = nt >> 8, tc = nt & 255, bj = tc >> 7, j = tc & 127; return bj * DFF + pn * 128 + j; }

struct Ptrs {
    const float* x_prompt; const float* x_sample; const float* cache[3]; const float* state_conv; const float* state_h; const float* rel_bias;
    const float* norm_mix; const float* w_in; const float* w_conv; const float* b_conv; const float* w_rg_a; const float* b_rg_a; const float* w_rg_x; const float* b_rg_x;
    const float* lru_lambda; const float* q_gain; const float* k_gain; const float* w_merge; const float* b_merge; const float* w_branch_lru; const float* w_branch_att;
    const float* w_o; const float* norm_ffn; const float* w_ffn_in; const float* w_ffn_out;
    float* out; unsigned char* ws;
};
__device__ __forceinline__ const float* xin_row(const Ptrs& P, int row) { return row < MP ? P.x_prompt + (size_t)row * DM : P.x_sample + (size_t)(row - MP) * DM; }

namespace pg8 {
#define PG8_LAS __attribute__((address_space(3)))
typedef unsigned short bf16_t;
typedef short bf16x8 __attribute__((ext_vector_type(8)));
typedef float f32x4 __attribute__((ext_vector_type(4)));
typedef unsigned u32x4 __attribute__((ext_vector_type(4)));
constexpr int BM = 256, BK = 64, HALF = 128, HTB = HALF * BK * 2  , STAGE_BYTES = 8 * HTB, NXCD = 8, WGM = 8;

__host__ __device__ __forceinline__ int lds_byte(int r, int c) { const int st = (r >> 4) * 2 + (c >> 5), rr = r & 15, cc = c & 31, ob = rr * 64 + cc * 2; return st * 1024 + (ob ^ (((ob >> 9) & 1) << 5)); }
__host__ __device__ __forceinline__ void stage_rc(int b, int& R, int& C) { const int st = b / 1024, sb = b % 1024, swz = sb ^ (((sb >> 9) & 1) << 5); R = (st >> 1) * 16 + swz / 64; C = (st & 1) * 32 + (swz % 64) / 2; }
__host__ __device__ __forceinline__ int perm32(int rho) { const int n = rho >> 4, i = rho & 15; return 8 * (i >> 2) + 4 * n + (i & 3); }

struct Unit { int pm, pn; };
struct Gemm { const bf16_t* A; const bf16_t* Bt; int M, N, K; int wv; };

struct StaticOrder {
    int nM, nN, nwg, G, c;
    __host__ __device__ void init(int M, int N, int G_, int c_) { nM = M / BM; nN = N / BM; nwg = nM * nN; G = G_; c = c_; }
    __host__ __device__ bool next(int i, Unit& u) const {
        const long L = (long)i * G + c; if (L >= nwg) return false;
        int wgid = (int)L; { const int q = nwg / NXCD, r = nwg % NXCD, xcd = wgid % NXCD, off = wgid / NXCD; wgid = (xcd < r ? xcd * (q + 1) : r * (q + 1) + (xcd - r) * q) + off; }
        const int nig = WGM * nN, gid = wgid / nig, fm = gid * WGM, gsz = (nM - fm) < WGM ? (nM - fm) : WGM;
        u.pm = fm + ((wgid % nig) % gsz); u.pn = (wgid % nig) / gsz; return true;
    }
    __device__ __forceinline__ void a_ready(const Unit&) const {}
    __device__ __forceinline__ void done(const Unit&) const {}
};

template <class Epi, class Sched, bool ALIGN_EPI = false, bool SP2 = false>
__device__ __forceinline__ void gemm_phase(PG8_LAS unsigned char* lds, const Gemm g, const Sched& S, const Epi& E) {
    int tid_ = (g.wv << 6) | lane_id_v(); asm volatile("" : "+v"(tid_));
    const int tid = tid_, wid = __builtin_amdgcn_readfirstlane(tid >> 6), lane = tid & 63, wr = wid >> 2, wc = wid & 3, fr = lane & 15, fq = lane >> 4;
    const int K = g.K, nt = K / BK;
    unsigned voffA[2], voffB[2];
#pragma unroll
    for (int i = 0; i < 2; ++i) { int R, C; stage_rc(tid * 16 + i * 8192, R, C); const int Rb = Epi::PERM ? ((R & ~31) + perm32(R & 31)) : R;
        voffA[i] = (unsigned)(R * K + C) * 2u; voffB[i] = (unsigned)(Rb * K + C) * 2u; }
    const size_t kstep = (size_t)(BK * 2);
    const size_t hstep = (size_t)HALF * K * 2;
    const size_t tstep = 2 * hstep;
    const unsigned ldsw = (unsigned)wid * 1024u;
    const int aoff = lds_byte(wr * 64 + fr, fq * 8), boff = lds_byte(wc * 32 + fr, fq * 8);
#define PG8_SA(b, h) (((b) * 2 + (h)) * HTB)
#define PG8_SB(b, h) ((4 + (b) * 2 + (h)) * HTB)
#define PG8_STAGE(bufoff, gbase, voff) do { _Pragma("unroll") for (int _i = 0; _i < 2; ++_i) \
        __builtin_amdgcn_global_load_lds((const unsigned*)((const char*)(gbase) + (voff)[_i]), (PG8_LAS unsigned*)(lds + (bufoff) + ldsw + _i * 8192), 16, 0, 0); } while (0)
#define PG8_LDA(dst, b, h) do { _Pragma("unroll") for (int m = 0; m < 4; ++m) _Pragma("unroll") for (int k = 0; k < 2; ++k) dst[m][k] = *(const PG8_LAS bf16x8*)(lds + PG8_SA(b, h) + aoff + m * 2048 + k * 1024); } while (0)
#define PG8_LDB(dst, b, h) do { _Pragma("unroll") for (int n = 0; n < 2; ++n) _Pragma("unroll") for (int k = 0; k < 2; ++k) dst[n][k] = *(const PG8_LAS bf16x8*)(lds + PG8_SB(b, h) + boff + n * 2048 + k * 1024); } while (0)
#define PG8_MMA(ai, bj, At, Bt) do { __builtin_amdgcn_s_setprio(1); _Pragma("unroll") for (int m = 0; m < 4; ++m) _Pragma("unroll") for (int n = 0; n < 2; ++n) _Pragma("unroll") for (int k = 0; k < 2; ++k) \
        acc[ai][bj][m][n] = __builtin_amdgcn_mfma_f32_16x16x32_bf16(Bt[n][k], At[m][k], acc[ai][bj][m][n], 0, 0, 0); __builtin_amdgcn_s_setprio(0); } while (0)
#define PG8_WAIT_V(n) asm volatile("s_waitcnt vmcnt(" #n ")" ::: "memory")
#define PG8_WAIT_L(n) asm volatile("s_waitcnt lgkmcnt(" #n ")" ::: "memory")
#define PG8_BAR __builtin_amdgcn_s_barrier()
#define PG8_SCHED __builtin_amdgcn_sched_barrier(0)
    Unit cur, nxt; int ui = 0;
    if (!S.next(0, cur)) return;
    f32x4 acc[2][2][4][2];
#pragma unroll
    for (int a = 0; a < 2; ++a)
#pragma unroll
        for (int b = 0; b < 2; ++b)
#pragma unroll
            for (int m = 0; m < 4; ++m)
#pragma unroll
                for (int n = 0; n < 2; ++n) acc[a][b][m][n] = (f32x4){0.f, 0.f, 0.f, 0.f};
    bf16x8 At[4][2], B0[2][2], B1[2][2];
    const char* cA = (const char*)g.A + (size_t)cur.pm * tstep; const char* cB = (const char*)g.Bt + (size_t)cur.pn * tstep;
    S.a_ready(cur);
    if constexpr (SP2) {
        PG8_STAGE(PG8_SB(0, 0), cB, voffB); PG8_STAGE(PG8_SB(0, 1), cB + hstep, voffB); PG8_STAGE(PG8_SA(0, 0), cA, voffA); PG8_STAGE(PG8_SA(0, 1), cA + hstep, voffA);
        if (wr == 1) PG8_BAR;
        PG8_WAIT_V(2); PG8_BAR;
        PG8_STAGE(PG8_SB(1, 0), cB + kstep, voffB); PG8_STAGE(PG8_SA(1, 0), cA + kstep, voffA); PG8_STAGE(PG8_SB(1, 1), cB + hstep + kstep, voffB);
        PG8_WAIT_V(6); PG8_BAR;
    } else {
        PG8_STAGE(PG8_SB(0, 0), cB, voffB); PG8_STAGE(PG8_SA(0, 0), cA, voffA); PG8_STAGE(PG8_SB(0, 1), cB + hstep, voffB); PG8_STAGE(PG8_SA(0, 1), cA + hstep, voffA);
        if (wr == 1) PG8_BAR;
        PG8_WAIT_V(4); PG8_BAR;
        PG8_STAGE(PG8_SB(1, 0), cB + kstep, voffB); PG8_STAGE(PG8_SA(1, 0), cA + kstep, voffA); PG8_STAGE(PG8_SB(1, 1), cB + hstep + kstep, voffB);
        PG8_WAIT_V(6); PG8_BAR;
    }
    for (;;) {
        const bool has_next = S.next(ui + 1, nxt);
        const char* nA = has_next ? (const char*)g.A + (size_t)nxt.pm * tstep : cA; const char* nB = has_next ? (const char*)g.Bt + (size_t)nxt.pn * tstep : cB;
        for (int t = 0; t < nt; t += 2) {
            if constexpr (Epi::HAS_MID) { if (t == E.mid_t) E.mid(acc, cur, wr, wc, fr, fq); }
            const bool last = (t == nt - 2);
            const char* a1 = cA + (size_t)(t + 1) * kstep;
            const char* a2 = last ? nA : cA + (size_t)(t + 2) * kstep; const char* b2 = last ? nB : cB + (size_t)(t + 2) * kstep;
            const char* a3 = a2 + kstep; const char* b3 = b2 + kstep;
            if (last && has_next) S.a_ready(nxt);
            if constexpr (SP2) {
            PG8_LDB(B0, 0, 0); PG8_LDB(B1, 0, 1); PG8_SCHED; PG8_LDA(At, 0, 0); PG8_STAGE(PG8_SA(1, 1), a1 + hstep, voffA);
            PG8_WAIT_V(8); PG8_WAIT_L(0); PG8_BAR; PG8_MMA(0, 0, At, B0); PG8_MMA(0, 1, At, B1); PG8_BAR; PG8_SCHED;
            PG8_LDA(At, 0, 1); PG8_STAGE(PG8_SB(0, 0), b2, voffB); PG8_STAGE(PG8_SB(0, 1), b2 + hstep, voffB); PG8_STAGE(PG8_SA(0, 0), a2, voffA);
            PG8_WAIT_V(8); PG8_WAIT_L(0); PG8_BAR; PG8_MMA(1, 0, At, B0); PG8_MMA(1, 1, At, B1); PG8_BAR; PG8_SCHED;
            PG8_LDB(B0, 1, 0); PG8_LDB(B1, 1, 1); PG8_SCHED; PG8_LDA(At, 1, 0); PG8_STAGE(PG8_SA(0, 1), a2 + hstep, voffA);
            PG8_WAIT_V(8); PG8_WAIT_L(0); PG8_BAR; PG8_MMA(0, 0, At, B0); PG8_MMA(0, 1, At, B1); PG8_BAR; PG8_SCHED;
            PG8_LDA(At, 1, 1); PG8_STAGE(PG8_SB(1, 0), b3, voffB); PG8_STAGE(PG8_SB(1, 1), b3 + hstep, voffB); PG8_STAGE(PG8_SA(1, 0), a3, voffA);
            PG8_WAIT_V(8); PG8_WAIT_L(0); PG8_BAR; PG8_MMA(1, 0, At, B0); PG8_MMA(1, 1, At, B1); PG8_BAR; PG8_SCHED;
            } else {
            PG8_LDB(B0, 0, 0); PG8_SCHED; PG8_LDA(At, 0, 0); PG8_STAGE(PG8_SA(1, 1), a1 + hstep, voffA);
            PG8_WAIT_L(8); PG8_BAR; PG8_WAIT_L(0); PG8_MMA(0, 0, At, B0); PG8_BAR; PG8_SCHED;
            PG8_LDB(B1, 0, 1); PG8_STAGE(PG8_SB(0, 0), b2, voffB);
            PG8_BAR; PG8_WAIT_L(0); PG8_MMA(0, 1, At, B1); PG8_BAR;
            PG8_LDA(At, 0, 1); PG8_STAGE(PG8_SA(0, 0), a2, voffA);
            PG8_BAR; PG8_WAIT_L(0); PG8_MMA(1, 0, At, B0); PG8_BAR; PG8_SCHED;
            PG8_STAGE(PG8_SB(0, 1), b2 + hstep, voffB);
            PG8_WAIT_V(6); PG8_BAR; PG8_MMA(1, 1, At, B1); PG8_BAR;
            PG8_LDB(B0, 1, 0); PG8_SCHED; PG8_LDA(At, 1, 0); PG8_STAGE(PG8_SA(0, 1), a2 + hstep, voffA);
            PG8_WAIT_L(8); PG8_BAR; PG8_WAIT_L(0); PG8_MMA(0, 0, At, B0); PG8_BAR; PG8_SCHED;
            PG8_LDB(B1, 1, 1); PG8_STAGE(PG8_SB(1, 0), b3, voffB);
            PG8_BAR; PG8_WAIT_L(0); PG8_MMA(0, 1, At, B1); PG8_BAR;
            PG8_LDA(At, 1, 1); PG8_STAGE(PG8_SA(1, 0), a3, voffA);
            PG8_BAR; PG8_WAIT_L(0); PG8_MMA(1, 0, At, B0); PG8_BAR; PG8_SCHED;
            PG8_STAGE(PG8_SB(1, 1), b3 + hstep, voffB);
            PG8_WAIT_V(6); PG8_BAR; PG8_MMA(1, 1, At, B1); PG8_BAR;
            }
        }
        if constexpr (ALIGN_EPI) { if (wr == 0) PG8_BAR; }
        if constexpr (!Epi::AFTER_DRAIN) { E(acc, cur, wr, wc, fr, fq); S.done(cur); }
        if (!has_next) break;
#pragma unroll
        for (int a = 0; a < 2; ++a)
#pragma unroll
            for (int b = 0; b < 2; ++b)
#pragma unroll
                for (int m = 0; m < 4; ++m)
#pragma unroll
                    for (int n = 0; n < 2; ++n) acc[a][b][m][n] = (f32x4){0.f, 0.f, 0.f, 0.f};
        cur = nxt; cA = nA; cB = nB; ++ui;
        if constexpr (ALIGN_EPI) { if (wr == 1) PG8_BAR; }
    }
    PG8_WAIT_V(0);
    if constexpr (!ALIGN_EPI) { if (wr == 0) PG8_BAR; }
    PG8_BAR;
    if constexpr (Epi::AFTER_DRAIN) { E.fused(acc, cur, wr, wc, fr, fq, lds, wid, lane); S.done(cur); }
#undef PG8_SA
#undef PG8_SB
#undef PG8_STAGE
#undef PG8_LDA
#undef PG8_LDB
#undef PG8_MMA
#undef PG8_WAIT_V
#undef PG8_WAIT_L
#undef PG8_BAR
#undef PG8_SCHED
}
}
#define GAS __attribute__((address_space(1)))
#define LAS __attribute__((address_space(3)))
typedef unsigned short bf16;
typedef unsigned v4u __attribute__((ext_vector_type(4)));
typedef float f32x4 __attribute__((ext_vector_type(4)));
typedef short bf16x8 __attribute__((ext_vector_type(8)));
typedef GAS unsigned gu32;
typedef GAS unsigned long long gu64;
#define RLX_AGENT __ATOMIC_RELAXED, __HIP_MEMORY_SCOPE_AGENT
#define LDS_WAIT() asm volatile("s_waitcnt lgkmcnt(0)" ::: "memory")
#define VM_WAIT() asm volatile("s_waitcnt vmcnt(0)" ::: "memory")
__device__ __forceinline__ unsigned long long rt() { return __builtin_amdgcn_s_memrealtime(); }
__device__ __forceinline__ unsigned f2bf(float f) { unsigned u = __builtin_bit_cast(unsigned, f); return (u + 0x7fffu + ((u >> 16) & 1u)) >> 16; }
__device__ __forceinline__ unsigned pk2(float lo, float hi) { return f2bf(lo) | (f2bf(hi) << 16); }

#define XB_TMO      128
#define XB_XCNT(j)  (256  + 64 * (j))
#define XB_XSUB(j)  (1280 + 64 * (j))
#define XB_XGEN(j)  (2304 + 64 * (j))
#define XB_TOP      3328
#define XB_TOPGEN   3392
#define XCD_BAR_WORDS 3456
#define XB_SPIN_CAP (1u << 18)

__device__ __forceinline__ unsigned xb_ld(unsigned* p)              { return __hip_atomic_load(p, __ATOMIC_RELAXED, __HIP_MEMORY_SCOPE_AGENT); }
__device__ __forceinline__ unsigned xb_add(unsigned* p, unsigned v) { return __hip_atomic_fetch_add(p, v, __ATOMIC_RELAXED, __HIP_MEMORY_SCOPE_AGENT); }
__device__ __forceinline__ unsigned xb_xcc_id() { return (unsigned)__builtin_amdgcn_s_getreg((3 << 11) | 20) & 0xFu; }
#define XB_SPIN(cond, bar) do { unsigned _sp = 0; while (cond) { __builtin_amdgcn_s_sleep(1); \
    if ((++_sp & 255u) == 0u) { if (xb_ld(&(bar)[XB_TMO])) break; if (_sp > XB_SPIN_CAP) { atomicAdd(&(bar)[XB_TMO], 1u); break; } } } } while (0)

struct XcdBarrier {
    unsigned* bar; unsigned x; int wv;
    volatile LAS unsigned* st;
};

__device__ __forceinline__ XcdBarrier xcd_barrier_post(unsigned* bar, volatile LAS unsigned* st) {
    XcdBarrier b; b.bar = bar; b.x = xb_xcc_id(); b.st = st;
    if (threadIdx.x == 0) (void)xb_add(&bar[XB_XCNT(b.x)], 1u);
    return b;
}
__device__ __forceinline__ void xcd_barrier_complete(unsigned* bar, unsigned x, unsigned& nloc, unsigned& nx) {
    const unsigned G = gridDim.x * gridDim.y * gridDim.z;
    unsigned sum, cnt, mine, sp = 0u;
    for (;;) {
        sum = 0u; cnt = 0u; mine = 0u;
#pragma unroll
        for (unsigned j = 0; j < 16; ++j) { const unsigned c = xb_ld(&bar[XB_XCNT(j)]); sum += c; cnt += (c > 0u) ? 1u : 0u; mine = (j == x) ? c : mine; }
        if (sum == G) break;
        __builtin_amdgcn_s_sleep(1);
        if ((++sp & 255u) == 0u) { if (xb_ld(&bar[XB_TMO])) break; if (sp > XB_SPIN_CAP) { atomicAdd(&bar[XB_TMO], 1u); break; } }
    }
    nloc = mine > 0u ? mine : 1u; nx = cnt > 0u ? cnt : 1u;
}

__device__ __forceinline__ void xcd_barrier(const XcdBarrier& b) {
    asm volatile("s_waitcnt vmcnt(0)" ::: "memory");
    __syncthreads();
    if (b.wv == 0 && lane_id_v() == 0) {
        unsigned* bar = b.bar; asm volatile("" : "+s"(bar));
        __builtin_amdgcn_s_waitcnt(0);
        unsigned nloc = b.st[0], nx = b.st[1];
        if (nloc == 0u) { xcd_barrier_complete(bar, b.x, nloc, nx); b.st[0] = nloc; b.st[1] = nx; }
        const unsigned old = xb_add(&bar[XB_XSUB(b.x)], 1u);
        const unsigned gen = old / nloc;
        if (old + 1u == (gen + 1u) * nloc) {
            __builtin_amdgcn_fence(__ATOMIC_RELEASE, "agent");
            asm volatile("s_waitcnt vmcnt(0)" ::: "memory");
            const unsigned og = xb_add(&bar[XB_TOP], 1u);
            const unsigned tg = og / nx;
            if (og + 1u == (tg + 1u) * nx) xb_add(&bar[XB_TOPGEN], 1u);
            else XB_SPIN(xb_ld(&bar[XB_TOPGEN]) == tg, bar);
            __builtin_amdgcn_fence(__ATOMIC_ACQUIRE, "agent");
            xb_add(&bar[XB_XGEN(b.x)], 1u);
            asm volatile("s_waitcnt vmcnt(0)" ::: "memory");
        } else {
            XB_SPIN(xb_ld(&bar[XB_XGEN(b.x)]) == gen, bar);
            __builtin_amdgcn_fence(__ATOMIC_ACQUIRE, "agent");
            asm volatile("s_waitcnt vmcnt(0)" ::: "memory");
        }
    }
    __syncthreads();
}

using pg8::Unit;
constexpr float LOG2E = 1.4426950408889634f, QSCALE = 0.125f * LOG2E;
#define ROW_FENCE() asm volatile("" ::: "memory")
#define LDS_BARRIER() do { asm volatile("s_waitcnt lgkmcnt(0)" ::: "memory"); __builtin_amdgcn_s_barrier(); asm volatile("" ::: "memory"); } while (0)
__device__ __forceinline__ float row_rs(const float* ssq, int row) {
    const f32x4* p = (const f32x4*)(ssq + (size_t)row * 16);
    const f32x4 a = p[0], b = p[1], c = p[2], d = p[3];
    const float s = (((a[0] + a[1]) + (a[2] + a[3])) + ((b[0] + b[1]) + (b[2] + b[3]))) + (((c[0] + c[1]) + (c[2] + c[3])) + ((d[0] + d[1]) + (d[2] + d[3])));
    return rsqrtf(s * (1.0f / DM) + EPS);
}
__device__ __forceinline__ float row_rs4(const float* ssq, int row, int fq) {
    const f32x4 a = *(const f32x4*)(ssq + (size_t)row * 16 + 4 * fq);
    float s = (a[0] + a[1]) + (a[2] + a[3]);
    s += __shfl_xor(s, 16); s += __shfl_xor(s, 32);
    return rsqrtf(s * (1.0f / DM) + EPS);
}
typedef float f32x2_t __attribute__((ext_vector_type(2))); typedef __bf16 bf16x2_t __attribute__((ext_vector_type(2)));
__device__ __forceinline__ unsigned pkbf(float lo, float hi) { const f32x2_t v = {lo, hi}; const bf16x2_t b = __builtin_convertvector(v, bf16x2_t); return __builtin_bit_cast(unsigned, b); }
__device__ __forceinline__ u32x4 pack8(const f32x4 a, const f32x4 b) { u32x4 w; w.x = pkbf(a[0], a[1]); w.y = pkbf(a[2], a[3]); w.z = pkbf(b[0], b[1]); w.w = pkbf(b[2], b[3]); return w; }
__device__ __forceinline__ float bflo(unsigned w) { return __uint_as_float(w << 16); }
__device__ __forceinline__ float bfhi(unsigned w) { return __uint_as_float(w & 0xffff0000u); }

struct Epi1 {
    static constexpr bool PERM = true, AFTER_DRAIN = false, HAS_MID = false;
    int mid_t; Ptrs P; int l;
    __device__ __forceinline__ void operator()(const f32x4 (&acc)[2][2][4][2], const Unit& u, int wr, int wc, int fr0, int fq) const {
        int fr = fr0; asm volatile("" : "+v"(fr));
        const float* ssq = (const float*)(P.ws + WS_SSQ);
        const int pn = u.pn, c8 = wc * 32 + 8 * fq, row0 = u.pm * 256 + wr * 64 + fr;
        if (pn < 8) {
            bf16_t* dst = (bf16_t*)(P.ws + (pn < 4 ? WS_LX : WS_GG));
            const int colb = (pn & 3) * 256 + c8;
#pragma unroll
            for (int ai = 0; ai < 2; ++ai)
#pragma unroll
                for (int m = 0; m < 4; ++m) {
                    const int row = row0 + ai * 128 + m * 16; const float rs = row_rs4(ssq, row, fq);
#pragma unroll
                    for (int bj = 0; bj < 2; ++bj) {
                        f32x4 v0 = acc[ai][bj][m][0] * rs, v1 = acc[ai][bj][m][1] * rs; const int col = colb + bj * 128;
                        if (pn >= 4) {
#pragma unroll
                            for (int e = 0; e < 4; ++e) { v0[e] = gelu_tanh(v0[e]); v1[e] = gelu_tanh(v1[e]); }
                        }
                        *(u32x4*)(dst + (size_t)row * DR + col) = pack8(v0, v1);
                        if (pn < 4) {
                            if (row < MP) { const int t = row & (SEQ - 1); if (t >= SEQ - 3) { const int b = row >> 13; float* o = P.out + O_CONVP + ((size_t)(l * NB + b) * 3 + (t - (SEQ - 3))) * DR + col; *(f32x4*)o = v0; *(f32x4*)(o + 4) = v1; } }
                            else if (row < MT) { const int b = row - MP; float* cs = P.out + O_CONVS + (size_t)(l * SB + b) * 3 * DR + col; const float* sc = P.state_conv + (size_t)(l * SB + b) * 3 * DR + col;
                                *(f32x4*)cs = *(const f32x4*)(sc + DR); *(f32x4*)(cs + 4) = *(const f32x4*)(sc + DR + 4); *(f32x4*)(cs + DR) = *(const f32x4*)(sc + 2 * DR); *(f32x4*)(cs + DR + 4) = *(const f32x4*)(sc + 2 * DR + 4);
                                *(f32x4*)(cs + 2 * DR) = v0; *(f32x4*)(cs + 2 * DR + 4) = v1; }
                        }
                    }
                    ROW_FENCE();
                }
        } else if (pn < 26) {
            const int tq = pn - 8, type = tq / 6, head = 4 * (tq % 6) + wc, g = head >> 3, hh = head & 7;
            bf16_t* dst = (bf16_t*)(P.ws + (type == 0 ? WS_Q : (type == 1 ? WS_K : WS_V)));
            f32x4 gn[2][2];
#pragma unroll
            for (int bj = 0; bj < 2; ++bj)
#pragma unroll
                for (int n = 0; n < 2; ++n) gn[bj][n] = (f32x4){1.f, 1.f, 1.f, 1.f};
            if (type < 2) { const float* gp = (type == 0 ? P.q_gain : P.k_gain) + l * HD;
#pragma unroll
                for (int bj = 0; bj < 2; ++bj)
#pragma unroll
                    for (int n = 0; n < 2; ++n) gn[bj][n] = *(const f32x4*)(gp + 32 * bj + 8 * fq + 4 * n); }
            const int W = g_win(g);
#pragma unroll
            for (int ai = 0; ai < 2; ++ai)
#pragma unroll
                for (int m = 0; m < 4; ++m) {
                    const int row = row0 + ai * 128 + m * 16; const float rs = row_rs4(ssq, row, fq);
                    f32x4 v[2][2]; float ss = 0.f;
#pragma unroll
                    for (int bj = 0; bj < 2; ++bj)
#pragma unroll
                        for (int n = 0; n < 2; ++n) { v[bj][n] = acc[ai][bj][m][n] * rs; const f32x4 q = v[bj][n] * v[bj][n]; ss += (q[0] + q[1]) + (q[2] + q[3]); }
                    ss += __shfl_xor(ss, 16); ss += __shfl_xor(ss, 32);
                    const float inv = (type < 2) ? rsqrtf(ss * (1.0f / HD) + EPS) * (type == 0 ? QSCALE : 1.0f) : 1.0f;
#pragma unroll
                    for (int bj = 0; bj < 2; ++bj) {
                        v[bj][0] = v[bj][0] * inv * gn[bj][0]; v[bj][1] = v[bj][1] * inv * gn[bj][1];
                        *(u32x4*)(dst + (size_t)row * AW + head * HD + 32 * bj + 8 * fq) = pack8(v[bj][0], v[bj][1]);
                    }
                    if (type >= 1) {
                        float* o = nullptr;
                        if (row < MP) { const int t = row & (SEQ - 1), b = row >> 13; if (t >= SEQ - W) o = P.out + o_kvp(g) + ((((size_t)(l * NB + b) * W + (t - (SEQ - W))) * 2 + (type - 1)) * HPG + hh) * HD + 8 * fq; }
                        else if (row < MT) { const int b = row - MP; o = P.out + o_kvs(g) + (((size_t)(l * SB + b) * 2 + (type - 1)) * HPG + hh) * HD + 8 * fq; }
                        if (o) {
#pragma unroll
                            for (int bj = 0; bj < 2; ++bj) { *(f32x4*)(o + 32 * bj) = v[bj][0]; *(f32x4*)(o + 32 * bj + 4) = v[bj][1]; } }
                    }
                    ROW_FENCE();
                }
        } else {
            bf16_t* GM = (bf16_t*)(P.ws + WS_GM); const float* bm = P.b_merge + (size_t)l * 2048;
            const int colb = (pn - 26) * 128 + c8;
            f32x4 bv[2][2];
#pragma unroll
            for (int bj = 0; bj < 2; ++bj)
#pragma unroll
                for (int n = 0; n < 2; ++n) bv[bj][n] = *(const f32x4*)(bm + bj * 1024 + colb + 4 * n);
#pragma unroll
            for (int ai = 0; ai < 2; ++ai)
#pragma unroll
                for (int m = 0; m < 4; ++m) {
                    const int row = row0 + ai * 128 + m * 16; const float rs = row_rs4(ssq, row, fq);
                    f32x4 rho[2], gav[2];
#pragma unroll
                    for (int n = 0; n < 2; ++n) {
                        const f32x4 xl = acc[ai][0][m][n] * rs + bv[0][n], xa = acc[ai][1][m][n] * rs + bv[1][n];
#pragma unroll
                        for (int e = 0; e < 4; ++e) { const float el = __expf(-xl[e]), ea = fminf(__expf(-xa[e]), 1e30f); gav[n][e] = __builtin_amdgcn_rcpf(1.0f + ea); rho[n][e] = (1.0f + ea) * __builtin_amdgcn_rcpf(1.0f + el); }
                    }
                    *(u32x4*)(GM + (size_t)row * 2048 + colb) = pack8(rho[0], rho[1]);
                    *(u32x4*)(GM + (size_t)row * 2048 + 1024 + colb) = pack8(gav[0], gav[1]);
                    ROW_FENCE();
                }
        }
    }
};

struct Epi3 {
    static constexpr bool PERM = true, AFTER_DRAIN = false, HAS_MID = true;
    int mid_t; Ptrs P;
    __device__ __forceinline__ void mid(f32x4 (&acc)[2][2][4][2], const Unit& u, int wr, int wc, int fr, int fq) const {
        const bf16_t* GM = (const bf16_t*)(P.ws + WS_GM);
        int fr_ = fr; asm volatile("" : "+v"(fr_));
        const int colb = u.pn * 256 + wc * 32 + 8 * fq, row0 = u.pm * 256 + wr * 64 + fr_;
#pragma unroll
        for (int ai = 0; ai < 2; ++ai)
#pragma unroll
            for (int m = 0; m < 4; ++m) {
                const int row = row0 + ai * 128 + m * 16;
#pragma unroll
                for (int bj = 0; bj < 2; ++bj) {
                    const u32x4 gl = *(const u32x4*)(GM + (size_t)row * 2048 + colb + bj * 128);
                    const f32x4 r0 = (f32x4){bflo(gl.x), bfhi(gl.x), bflo(gl.y), bfhi(gl.y)}, r1 = (f32x4){bflo(gl.z), bfhi(gl.z), bflo(gl.w), bfhi(gl.w)};
                    acc[ai][bj][m][0] = acc[ai][bj][m][0] * r0; acc[ai][bj][m][1] = acc[ai][bj][m][1] * r1;
                }
                ROW_FENCE();
            }
    }
    __device__ __forceinline__ void operator()(const f32x4 (&acc)[2][2][4][2], const Unit& u, int wr, int wc, int fr0, int fq) const {
        int fr = fr0; asm volatile("" : "+v"(fr));
        const bf16_t* GM = (const bf16_t*)(P.ws + WS_GM); bf16_t* MRG = (bf16_t*)(P.ws + WS_MRG);
        const int colb = u.pn * 256 + wc * 32 + 8 * fq, row0 = u.pm * 256 + wr * 64 + fr;
#pragma unroll
        for (int ai = 0; ai < 2; ++ai)
#pragma unroll
            for (int m = 0; m < 4; ++m) {
                const int row = row0 + ai * 128 + m * 16;
#pragma unroll
                for (int bj = 0; bj < 2; ++bj) {
                    const u32x4 ga = *(const u32x4*)(GM + (size_t)row * 2048 + 1024 + colb + bj * 128);
                    const f32x4 g0 = (f32x4){bflo(ga.x), bfhi(ga.x), bflo(ga.y), bfhi(ga.y)}, g1 = (f32x4){bflo(ga.z), bfhi(ga.z), bflo(ga.w), bfhi(ga.w)};
                    *(u32x4*)(MRG + (size_t)row * DM + colb + bj * 128) = pack8(acc[ai][bj][m][0] * g0, acc[ai][bj][m][1] * g1);
                }
                ROW_FENCE();
            }
    }
};

struct EpiRes {
    static constexpr bool PERM = false, AFTER_DRAIN = false, HAS_MID = false;
    int mid_t; Ptrs P; int first; int dry;
    __device__ __forceinline__ void operator()(const f32x4 (&acc)[2][2][4][2], const Unit& u, int wr, int wc, int fr0, int fq) const {
        int fr = fr0; asm volatile("" : "+v"(fr));
        float* Y = P.out + O_Y; float* Yo = dry ? (float*)(P.ws + WS_DUMMY) : Y; bf16_t* XB = (bf16_t*)(P.ws + (dry ? WS_DUMMY + 80 * MiB : WS_XB)); float* ssq = (float*)(P.ws + (dry ? WS_DUMMY + 120 * MiB : WS_SSQ));
        const int colb = u.pn * 256 + wc * 32 + 4 * fq, row0 = u.pm * 256 + wr * 64 + fr;
#pragma unroll
        for (int ai = 0; ai < 2; ++ai)
#pragma unroll
            for (int m = 0; m < 4; ++m) {
                const int row = row0 + ai * 128 + m * 16; const bool live = row < MT;
                const float* base = first ? xin_row(P, live ? row : 0) : Y + (size_t)(live ? row : 0) * DM;
                float ss = 0.f;
#pragma unroll
                for (int bj = 0; bj < 2; ++bj)
#pragma unroll
                    for (int n = 0; n < 2; ++n) {
                        const int col = colb + bj * 128 + n * 16;
                        f32x4 v = acc[ai][bj][m][n];
                        if (live) { v = v + *(const f32x4*)(base + col); *(f32x4*)(Yo + (size_t)row * DM + col) = v; }
                        u32x2 w; w.x = pkbf(v[0], v[1]); w.y = pkbf(v[2], v[3]);
                        *(u32x2*)(XB + (size_t)row * DM + col) = w;
                        ss += (v[0] * v[0] + v[1] * v[1]) + (v[2] * v[2] + v[3] * v[3]);
                    }
                ss += __shfl_xor(ss, 16); ss += __shfl_xor(ss, 32);
                if (fq == 0) ssq[(size_t)row * 16 + u.pn * 4 + wc] = ss;
                ROW_FENCE();
            }
    }
};

struct Epi5 {
    static constexpr bool PERM = true, AFTER_DRAIN = false, HAS_MID = false;
    int mid_t; Ptrs P;
    __device__ __forceinline__ void operator()(const f32x4 (&acc)[2][2][4][2], const Unit& u, int wr, int wc, int fr0, int fq) const {
        int fr = fr0; asm volatile("" : "+v"(fr));
        const float* ssq = (const float*)(P.ws + WS_SSQ); bf16_t* H = (bf16_t*)(P.ws + WS_H);
        const int colb = u.pn * 128 + wc * 32 + 8 * fq, row0 = u.pm * 256 + wr * 64 + fr;
#pragma unroll
        for (int ai = 0; ai < 2; ++ai)
#pragma unroll
            for (int m = 0; m < 4; ++m) {
                const int row = row0 + ai * 128 + m * 16; const float rs = row_rs4(ssq, row, fq);
                f32x4 h[2];
#pragma unroll
                for (int n = 0; n < 2; ++n)
#pragma unroll
                    for (int e = 0; e < 4; ++e) { const float gt = acc[ai][0][m][n][e] * rs, up = acc[ai][1][m][n][e] * rs; h[n][e] = gt * sigmoidf_(gt) * up; }
                *(u32x4*)(H + (size_t)row * DFF + colb) = pack8(h[0], h[1]);
                ROW_FENCE();
            }
    }
};

__device__ __forceinline__ void tr_item(const float* W, int N, int s0, int k0, const float* gain, bf16_t* WT, int K, int r0, int kofs, LAS float* scr, int lane) {
#pragma unroll 8
    for (int i = 0; i < 32; ++i) { const int kk = 2 * i + (lane >> 5); float v = W[(size_t)(k0 + kk) * N + s0 + (lane & 31)]; if (gain) v *= gain[k0 + kk]; scr[kk * 33 + (lane & 31)] = v; }
    asm volatile("s_waitcnt lgkmcnt(0)" ::: "memory");
    const int c = lane & 7;
#pragma unroll
    for (int j = 0; j < 4; ++j) { const int n = (lane >> 3) + 8 * j; const LAS float* s = scr + (8 * c) * 33 + n;
        u32x4 o; o.x = pkbf(s[0 * 33], s[1 * 33]); o.y = pkbf(s[2 * 33], s[3 * 33]); o.z = pkbf(s[4 * 33], s[5 * 33]); o.w = pkbf(s[6 * 33], s[7 * 33]);
        *(u32x4*)(WT + (size_t)(r0 + n) * K + kofs + k0 + 8 * c) = o; }
    asm volatile("s_waitcnt lgkmcnt(0)" ::: "memory");
}
constexpr int IT_W1 = (N1 / 32) * (DM / 64), IT_W3A = (DM / 32) * (DR / 64), IT_W3B = (DM / 32) * (AO / 64), IT_W4 = (DM / 32) * (DM / 64), IT_W5 = (2 * DFF / 32) * (DM / 64), IT_W6 = (DM / 32) * (DFF / 64);
constexpr int IT_L = IT_W1 + IT_W3A + IT_W3B + IT_W4 + IT_W5 + IT_W6;
__device__ __forceinline__ void p0_prologue(const Ptrs& P, LAS unsigned char* lds, int gw, int ngw, int wv, int lane) {
    LAS float* scr = (LAS float*)(lds + wv * 16384);
    for (int it = gw; it < DEPTH * IT_L; it += ngw) {
        const int l = it / IT_L; int r = it % IT_L;
        unsigned char* wb = P.ws + WS_W + l * LW_BYTES;
        if (r < IT_W1) { const int kb = r & 15, nb = r >> 4, nt0 = 32 * nb, c = w1_src_col(nt0);
            if (c < 6656) tr_item(P.w_in + (size_t)l * DM * 6656, 6656, c, 64 * kb, P.norm_mix + l * DM, (bf16_t*)(wb + LW_W1), DM, nt0, 0, scr, lane);
            else tr_item(P.w_merge + (size_t)l * DM * 2048, 2048, c - 6656, 64 * kb, P.norm_mix + l * DM, (bf16_t*)(wb + LW_W1), DM, nt0, 0, scr, lane);
            continue; }
        r -= IT_W1;
        if (r < IT_W3A) { const int kb = r & 15, nb = r >> 4; tr_item(P.w_branch_lru + (size_t)l * DR * DM, DM, 32 * nb, 64 * kb, nullptr, (bf16_t*)(wb + LW_W3), K3, 32 * nb, 0, scr, lane); continue; }
        r -= IT_W3A;
        if (r < IT_W3B) { const int kb = r & 7, nb = r >> 3; tr_item(P.w_branch_att + (size_t)l * AO * DM, DM, 32 * nb, 64 * kb, nullptr, (bf16_t*)(wb + LW_W3), K3, 32 * nb, DR, scr, lane); continue; }
        r -= IT_W3B;
        if (r < IT_W4) { const int kb = r & 15, nb = r >> 4; tr_item(P.w_o + (size_t)l * DM * DM, DM, 32 * nb, 64 * kb, nullptr, (bf16_t*)(wb + LW_W4), DM, 32 * nb, 0, scr, lane); continue; }
        r -= IT_W4;
        if (r < IT_W5) { const int kb = r & 15, nb = r >> 4, nt0 = 32 * nb; tr_item(P.w_ffn_in + (size_t)l * DM * 2 * DFF, 2 * DFF, w5_src_col(nt0), 64 * kb, P.norm_ffn + l * DM, (bf16_t*)(wb + LW_W5), DM, nt0, 0, scr, lane); continue; }
        r -= IT_W5;
        { const int kb = r % 44, nb = r / 44; tr_item(P.w_ffn_out + (size_t)l * DFF * DM, DM, 32 * nb, 64 * kb, nullptr, (bf16_t*)(wb + LW_W6), DFF, 32 * nb, 0, scr, lane); }
    }
    float* BIAS = (float*)(P.ws + WS_BIAS);
    for (int e = gw * 64 + lane; e < NG * HPG * NKEY; e += ngw * 64) {
        const int kk = e % NKEY, hh = (e / NKEY) % HPG, g = e / (NKEY * HPG);
        const int d = kk * g_dil(g); int bkt;
        if (d < 16) bkt = d; else { const float df = (float)d; int lg = 16 + (int)(logf(df / 16.0f) / logf(128.0f) * 16.0f); bkt = lg < 31 ? lg : 31; }
        BIAS[e] = P.rel_bias[bkt * NH + 8 * g + hh] * LOG2E;
    }
    for (int row = gw; row < MT; row += ngw) {
        const f32x4* xr = (const f32x4*)xin_row(P, row) + lane; bf16_t* xb = (bf16_t*)(P.ws + WS_XB) + (size_t)row * DM; float* ssq = (float*)(P.ws + WS_SSQ) + (size_t)row * 16;
        float s = 0.f;
#pragma unroll
        for (int j = 0; j < 4; ++j) { const f32x4 v = xr[64 * j]; s += (v[0] * v[0] + v[1] * v[1]) + (v[2] * v[2] + v[3] * v[3]);
            u32x2 w; w.x = pkbf(v[0], v[1]); w.y = pkbf(v[2], v[3]); *(u32x2*)(xb + 4 * lane + 256 * j) = w; }
        s = wave_sum(s);
        if (lane < 16) ssq[lane] = (lane == 0) ? s : 0.f;
    }
}

__device__ __forceinline__ void ph_combine(const Ptrs& P, size_t gtid, size_t nth) {
    const bf16_t* OG = (const bf16_t*)(P.ws + WS_OG); const float* ML = (const float*)(P.ws + WS_ML); bf16_t* A3 = (bf16_t*)(P.ws + WS_A3);
    for (size_t e = gtid; e < (size_t)MT * 64; e += nth) {
        const size_t row = e >> 6; const int hh = (int)(e >> 3) & 7, ch = (int)e & 7;
        f32x2 q[3]; u32x4 og[3];
#pragma unroll
        for (int g = 0; g < 3; ++g) { q[g] = *(const f32x2*)(ML + (((size_t)g * MT + row) * HPG + hh) * 2); og[g] = *(const u32x4*)(OG + ((size_t)g * MT + row) * AO + hh * HD + 8 * ch); }
        const float mm = fmaxf(fmaxf(q[0].x, q[1].x), q[2].x);
        float z[3], den = 0.f;
#pragma unroll
        for (int g = 0; g < 3; ++g) { z[g] = q[g].y * __builtin_amdgcn_exp2f(q[g].x - mm); den += z[g]; }
        const float inv = 1.0f / den;
        f32x4 o0 = (f32x4){0.f, 0.f, 0.f, 0.f}, o1 = (f32x4){0.f, 0.f, 0.f, 0.f};
#pragma unroll
        for (int g = 0; g < 3; ++g) { const float w = z[g] * inv; const u32x4 v = og[g];
            o0 = o0 + (f32x4){bflo(v.x), bfhi(v.x), bflo(v.y), bfhi(v.y)} * w; o1 = o1 + (f32x4){bflo(v.z), bfhi(v.z), bflo(v.w), bfhi(v.w)} * w; }
        *(u32x4*)(A3 + row * K3 + DR + hh * HD + 8 * ch) = pack8(o0, o1);
    }
}

constexpr int SC_XCF = 0;
constexpr int SC_HSF = 34816;
constexpr int SC_XCB = 69632;
constexpr int SC_WTA = 88064;
constexpr int SC_WTX = 97280;
constexpr int SC_WTOT = 106496;
constexpr int SC_WC = 110592;
constexpr int SC_END = 111872;

template <int MODE>
__device__ __forceinline__ void scan_item(const Ptrs& P, int l, LAS unsigned char* lds, int wv, int tid, int b, int n, int span) {
    const int lane = tid & 63, fr = lane & 15, fq = lane >> 4;
    LAS float* XCF = (LAS float*)(lds + SC_XCF); LAS float* HSF = (LAS float*)(lds + SC_HSF); LAS bf16_t* XCB = (LAS bf16_t*)(lds + SC_XCB);
    LAS bf16_t* WTA = (LAS bf16_t*)(lds + SC_WTA); LAS bf16_t* WTX = (LAS bf16_t*)(lds + SC_WTX);
    LAS f32x2* WTOT = (LAS f32x2*)(lds + SC_WTOT); LAS float* WC = (LAS float*)(lds + SC_WC);
    const bf16_t* LX = (const bf16_t*)(P.ws + WS_LX); const bf16_t* GG = (const bf16_t*)(P.ws + WS_GG); bf16_t* A3 = (bf16_t*)(P.ws + WS_A3);
    float* SUM = (float*)(P.ws + WS_SUM);
    __syncthreads();
    {
        const float* wa = P.w_rg_a + (size_t)(l * NBLK + n) * 4096; const float* wx = P.w_rg_x + (size_t)(l * NBLK + n) * 4096;
        for (int e = tid; e < 4096; e += 512) { const int i = e >> 6, j = e & 63; WTA[j * 72 + i] = f2b(wa[e]); WTX[j * 72 + i] = f2b(wx[e]); }
        if (tid < 320) { const int k = tid >> 6, c = tid & 63; WC[tid] = (k < 4) ? P.w_conv[(size_t)(l * CW + k) * DR + 64 * n + c] : P.b_conv[l * DR + 64 * n + c]; }
    }
    __syncthreads();
    bf16x8 wfa[4][2], wfx[4][2];
#pragma unroll
    for (int nt = 0; nt < 4; ++nt)
#pragma unroll
        for (int ks = 0; ks < 2; ++ks) { wfa[nt][ks] = *(const LAS bf16x8*)(WTA + (16 * nt + fr) * 72 + 32 * ks + 8 * fq); wfx[nt][ks] = *(const LAS bf16x8*)(WTX + (16 * nt + fr) * 72 + 32 * ks + 8 * fq); }
    float cba[4], cbx[4], csp[4], hc[4], pc[4];
#pragma unroll
    for (int nt = 0; nt < 4; ++nt) { const int ch = 64 * n + 16 * nt + fr;
        cba[nt] = P.b_rg_a[l * DR + ch]; cbx[nt] = P.b_rg_x[l * DR + ch]; csp[nt] = 8.0f * log1pf(expf(-P.lru_lambda[l * DR + ch]));
        float h = 0.f;
        if (MODE == 1) { for (int s = 0; s < span; ++s) { const f32x2 q = *(const f32x2*)(SUM + (((size_t)b * 8 + s) * DR + ch) * 2); h = q.x * h + q.y; } }
        hc[nt] = h; pc[nt] = 1.f; }
    for (int c8 = 0; c8 < 8; ++c8) {
        const int t0 = span * 1024 + c8 * 128;
        u32x4 gg[2];
#pragma unroll
        for (int rep = 0; rep < 2; ++rep) {
            const int idx = tid + 512 * rep, tok = idx >> 3, cg = idx & 7, t = t0 + tok; const size_t rowg = (size_t)b * SEQ + t;
            float acc[8];
#pragma unroll
            for (int j = 0; j < 8; ++j) acc[j] = WC[4 * 64 + 8 * cg + j];
#pragma unroll
            for (int k = 0; k < 4; ++k) { const int tt = t + k - 3;
                if (tt >= 0) { const u32x4 x = *(const u32x4*)(LX + (rowg + k - 3) * DR + 64 * n + 8 * cg);
                    const LAS float* w = WC + k * 64 + 8 * cg;
                    acc[0] += w[0] * bflo(x.x); acc[1] += w[1] * bfhi(x.x); acc[2] += w[2] * bflo(x.y); acc[3] += w[3] * bfhi(x.y);
                    acc[4] += w[4] * bflo(x.z); acc[5] += w[5] * bfhi(x.z); acc[6] += w[6] * bflo(x.w); acc[7] += w[7] * bfhi(x.w); } }
            *(LAS f32x4*)(XCF + tok * 68 + 8 * cg) = (f32x4){acc[0], acc[1], acc[2], acc[3]}; *(LAS f32x4*)(XCF + tok * 68 + 8 * cg + 4) = (f32x4){acc[4], acc[5], acc[6], acc[7]};
            *(LAS u32x4*)(XCB + tok * 72 + 8 * cg) = pack8((f32x4){acc[0], acc[1], acc[2], acc[3]}, (f32x4){acc[4], acc[5], acc[6], acc[7]});
            if (MODE == 1) gg[rep] = *(const u32x4*)(GG + rowg * DR + 64 * n + 8 * cg);
        }
        __syncthreads();
        bf16x8 af[2];
#pragma unroll
        for (int ks = 0; ks < 2; ++ks) af[ks] = *(const LAS bf16x8*)(XCB + (16 * wv + fr) * 72 + 32 * ks + 8 * fq);
        float hl[4][4], ac[4][4], Ae[4], He[4];
#pragma unroll
        for (int nt = 0; nt < 4; ++nt) {
            f32x4 da = (f32x4){0.f, 0.f, 0.f, 0.f}, dx = (f32x4){0.f, 0.f, 0.f, 0.f};
#pragma unroll
            for (int ks = 0; ks < 2; ++ks) { da = __builtin_amdgcn_mfma_f32_16x16x32_bf16(af[ks], wfa[nt][ks], da, 0, 0, 0); dx = __builtin_amdgcn_mfma_f32_16x16x32_bf16(af[ks], wfx[nt][ks], dx, 0, 0, 0); }
            float A = 1.f, H = 0.f;
#pragma unroll
            for (int r = 0; r < 4; ++r) {
                const int tok = 16 * wv + 4 * fq + r;
                const float rr = sigmoidf_(da[r] + cba[nt]), ii = sigmoidf_(dx[r] + cbx[nt]);
                const float av = __expf(-rr * csp[nt]);
                float mult = sqrtf(fmaxf(fmaf(-av, av, 1.0f), 0.f)); if (t0 + tok == 0) mult = 1.0f;
                const float u = mult * ii * XCF[tok * 68 + 16 * nt + fr];
                H = av * H + u; A = A * av; hl[nt][r] = H; ac[nt][r] = A;
            }
            { const float A1 = __shfl(A, lane - 16), H1 = __shfl(H, lane - 16); if (fq >= 1) { H = A * H1 + H; A = A * A1; } }
            { const float A2 = __shfl(A, lane - 32), H2 = __shfl(H, lane - 32); if (fq >= 2) { H = A * H2 + H; A = A * A2; } }
            { const float A3_ = __shfl(A, lane - 16), H3 = __shfl(H, lane - 16); Ae[nt] = (fq >= 1) ? A3_ : 1.f; He[nt] = (fq >= 1) ? H3 : 0.f; }
            if (fq == 3) WTOT[wv * 64 + 16 * nt + fr] = (f32x2){A, H};
        }
        __syncthreads();
#pragma unroll
        for (int nt = 0; nt < 4; ++nt) {
            float hrun = hc[nt], prun = pc[nt], hin = 0.f;
#pragma unroll
            for (int w = 0; w < 8; ++w) { const f32x2 q = WTOT[w * 64 + 16 * nt + fr]; if (w == wv) hin = hrun; hrun = q.x * hrun + q.y; prun = prun * q.x; }
            hc[nt] = hrun; pc[nt] = prun;
            if (MODE == 1) {
#pragma unroll
                for (int r = 0; r < 4; ++r) { const int tok = 16 * wv + 4 * fq + r; HSF[tok * 68 + 16 * nt + fr] = (ac[nt][r] * Ae[nt]) * hin + (ac[nt][r] * He[nt] + hl[nt][r]); }
            }
        }
        if (MODE == 1) {
            __syncthreads();
#pragma unroll
            for (int rep = 0; rep < 2; ++rep) {
                const int idx = tid + 512 * rep, tok = idx >> 3, cg = idx & 7; const size_t rowg = (size_t)b * SEQ + t0 + tok;
                const f32x4 h0 = *(const LAS f32x4*)(HSF + tok * 68 + 8 * cg), h1 = *(const LAS f32x4*)(HSF + tok * 68 + 8 * cg + 4);
                const u32x4 g = gg[rep];
                const f32x4 o0 = (f32x4){h0[0] * bflo(g.x), h0[1] * bfhi(g.x), h0[2] * bflo(g.y), h0[3] * bfhi(g.y)}, o1 = (f32x4){h1[0] * bflo(g.z), h1[1] * bfhi(g.z), h1[2] * bflo(g.w), h1[3] * bfhi(g.w)};
                *(u32x4*)(A3 + rowg * K3 + 64 * n + 8 * cg) = pack8(o0, o1);
            }
        }
    }
    if (wv == 0 && fq == 0) {
#pragma unroll
        for (int nt = 0; nt < 4; ++nt) { const int ch = 64 * n + 16 * nt + fr;
            if (MODE == 0) *(f32x2*)(SUM + (((size_t)b * 8 + span) * DR + ch) * 2) = (f32x2){pc[nt], hc[nt]};
            else if (span == 7) P.out[O_HP + (size_t)(l * NB + b) * DR + ch] = hc[nt]; }
    }
}
__device__ __forceinline__ void scan_sample(const Ptrs& P, int l, LAS unsigned char* lds, int tid, int rg, int n) {
    LAS float* XS = (LAS float*)lds;
    const int r = tid >> 6, j = tid & 63, b = 8 * rg + r, ch = 64 * n + j; const size_t row = (size_t)MP + b;
    const bf16_t* LX = (const bf16_t*)(P.ws + WS_LX); const bf16_t* GG = (const bf16_t*)(P.ws + WS_GG); bf16_t* A3 = (bf16_t*)(P.ws + WS_A3);
    const float* wc = P.w_conv + (size_t)l * CW * DR; const float* sc = P.state_conv + (size_t)(l * SB + b) * 3 * DR;
    const float xc = P.b_conv[l * DR + ch] + wc[ch] * sc[ch] + wc[DR + ch] * sc[DR + ch] + wc[2 * DR + ch] * sc[2 * DR + ch] + wc[3 * DR + ch] * bf2f(LX[row * DR + ch]);
    __syncthreads();
    XS[r * 64 + j] = xc;
    __syncthreads();
    const float* wa = P.w_rg_a + (size_t)(l * NBLK + n) * 4096 + j; const float* wx = P.w_rg_x + (size_t)(l * NBLK + n) * 4096 + j;
    float ga = P.b_rg_a[l * DR + ch], gx = P.b_rg_x[l * DR + ch];
#pragma unroll 1
    for (int i0 = 0; i0 < 64; i0 += 16) {
        float wa_[16], wx_[16];
#pragma unroll
        for (int i = 0; i < 16; ++i) { wa_[i] = wa[(i0 + i) * 64]; wx_[i] = wx[(i0 + i) * 64]; }
#pragma unroll
        for (int i = 0; i < 16; ++i) { const float x = XS[r * 64 + i0 + i]; ga += x * wa_[i]; gx += x * wx_[i]; }
    }
    const float rr = sigmoidf_(ga), ii = sigmoidf_(gx);
    const float log_a = -8.0f * rr * log1pf(expf(-P.lru_lambda[l * DR + ch])); const float av = expf(log_a);
    const float mult = sqrtf(-expm1f(2.0f * log_a));
    const float h = av * P.state_h[(size_t)(l * SB + b) * DR + ch] + mult * ii * xc;
    P.out[O_HS + (size_t)(l * SB + b) * DR + ch] = h;
    A3[row * K3 + ch] = f2b(h * bf2f(GG[row * DR + ch]));
}

constexpr int AT_K = 0, AT_V = 49152, AT_B = 98304, AT_W = 99328, AT_O = 101376, AT_END = 134144;
typedef float f32x16 __attribute__((ext_vector_type(16)));
typedef short s16x4 __attribute__((ext_vector_type(4)));
__device__ __forceinline__ int crow(int r, int hi) { return (r & 3) + 8 * (r >> 2) + 4 * hi; }
__device__ __forceinline__ s16x4 ds_tr16(const LAS unsigned char* p) { return __builtin_bit_cast(s16x4, __builtin_amdgcn_ds_read_tr16_b64_v4i16((LAS s16x4*)p)); }
struct AttnUnit { int g, b, hh, d, rho, u, head, j0; size_t rowbase; };
__device__ __forceinline__ AttnUnit attn_decode(int unit) {
    AttnUnit a; a.g = unit >> 9; const int rem = unit & 511; a.b = rem >> 8; a.hh = (rem >> 5) & 7; const int ru = rem & 31;
    a.d = g_dil(a.g); const int nub = 32 / a.d; a.rho = ru / nub; a.u = ru % nub; a.head = 8 * a.g + a.hh; a.j0 = 256 * a.u; a.rowbase = (size_t)a.b * SEQ + a.rho; return a;
}
__device__ __forceinline__ void attn_load(const Ptrs& P, const AttnUnit& a, int tid, u32x4 (&kq)[6], u32x4 (&vq)[6]) {
    const bf16_t* K = (const bf16_t*)(P.ws + WS_K); const bf16_t* V = (const bf16_t*)(P.ws + WS_V);
#pragma unroll
    for (int i = 0; i < 6; ++i) {
        const int idx = tid + 512 * i, key = idx >> 3, ch = idx & 7, j = a.j0 - 128 + key;
        const size_t off = (a.rowbase + (size_t)a.d * (j < 0 ? 0 : j)) * AW + a.head * HD + 8 * ch;
        kq[i] = *(const u32x4*)(K + off); vq[i] = *(const u32x4*)(V + off);
    }
}
__device__ __forceinline__ void attn_loadq(const Ptrs& P, const AttnUnit& a, int wv, int tid, bf16x8 (&qf)[4]) {
    const bf16_t* Q = (const bf16_t*)(P.ws + WS_Q);
    const int lane = tid & 63, l31 = lane & 31, hi = lane >> 5;
    const size_t rq = (a.rowbase + (size_t)a.d * (a.j0 + 32 * wv + l31)) * AW + a.head * HD + 8 * hi;
#pragma unroll
    for (int ks = 0; ks < 4; ++ks) qf[ks] = *(const bf16x8*)(Q + rq + 16 * ks);
}
__device__ __forceinline__ void attn_phase(const Ptrs& P, int l, LAS unsigned char* lds, int wv, int tid, int bid, int G) {
    const int lane = tid & 63, l31 = lane & 31, hi = lane >> 5;
    LAS float* BL = (LAS float*)(lds + AT_B); LAS float* LW = (LAS float*)(lds + AT_W) + wv * 64; LAS bf16_t* OS = (LAS bf16_t*)(lds + AT_O) + wv * 2048;
    u32x4 kq[6], vq[6]; float bl = 0.f;
    int unit = bid;
    if (unit >= 1536) return;
    AttnUnit a = attn_decode(unit);
    attn_load(P, a, tid, kq, vq); if (tid < NKEY) bl = ((const float*)(P.ws + WS_BIAS))[(size_t)(a.g * HPG + a.hh) * NKEY + tid];
    bf16x8 qn[4];
    attn_loadq(P, a, wv, tid, qn);
    for (; unit < 1536; unit += G) {
        LDS_BARRIER();
        int tl = tid; asm volatile("" : "+v"(tl));
#pragma unroll
        for (int i = 0; i < 6; ++i) {
            const int idx = tl + 512 * i, key = idx >> 3, ch = idx & 7; const unsigned msk = (a.j0 - 128 + key >= 0) ? 0xffffffffu : 0u;
            *(LAS u32x4*)(lds + AT_K + key * 128 + ((ch ^ ((key >> 1) & 7)) << 4)) = kq[i] & msk;
            *(LAS u32x4*)(lds + AT_V + key * 128 + (ch << 4)) = vq[i] & msk;
        }
        if (tl < NKEY) BL[tl] = bl;
        const AttnUnit cur = a;
        bf16x8 qf[4];
#pragma unroll
        for (int ks = 0; ks < 4; ++ks) qf[ks] = qn[ks];
        LDS_BARRIER();
        f32x16 S[5];
#pragma unroll
        for (int c = 0; c < 5; ++c) {
            const int key = 32 * (wv + c) + l31;
            f32x16 acc = {};
#pragma unroll
            for (int ks = 0; ks < 4; ++ks) {
                const bf16x8 kf = *(const LAS bf16x8*)(lds + AT_K + key * 128 + (((2 * ks + hi) ^ ((key >> 1) & 7)) << 4));
                acc = __builtin_amdgcn_mfma_f32_32x32x16_bf16(kf, qf[ks], acc, 0, 0, 0);
            }
            S[c] = acc;
            if (c & 1) asm volatile("" ::: "memory");
        }
        asm volatile("" ::: "memory");
        if (unit + G < 1536) { a = attn_decode(unit + G); attn_load(P, a, tid, kq, vq); attn_loadq(P, a, wv, tid, qn); if (tid < NKEY) bl = ((const float*)(P.ws + WS_BIAS))[(size_t)(a.g * HPG + a.hh) * NKEY + tid]; }
        float mx = -INFINITY;
#pragma unroll
        for (int c = 0; c < 5; ++c) {
            const bool tile_ok = (cur.u > 0) || (wv + c >= 4);
#pragma unroll
            for (int r = 0; r < 16; ++r) {
                const int dist = 128 - 32 * c + l31 - crow(r, hi);
                const int dcl = (c == 0) ? (dist > 128 ? 128 : dist) : ((c == 4) ? (dist < 0 ? 0 : dist) : dist);
                const float bv = BL[dcl];
                float s = S[c][r] + bv;
                if (c == 0) s = (dist > 128) ? -INFINITY : s;
                if (c == 4) s = (dist < 0) ? -INFINITY : s;
                s = tile_ok ? s : -INFINITY;
                S[c][r] = s; mx = fmaxf(mx, s);
            }
        }
        mx = fmaxf(mx, __shfl_xor(mx, 32));
        float lsum = 0.f;
        u32x4 pw[5][2];
#pragma unroll
        for (int c = 0; c < 5; ++c)
#pragma unroll
            for (int s = 0; s < 2; ++s) {
                float p[8];
#pragma unroll
                for (int j = 0; j < 8; ++j) { p[j] = __builtin_amdgcn_exp2f(S[c][8 * s + j] - mx); lsum += p[j]; }
                pw[c][s].x = pkbf(p[0], p[1]); pw[c][s].y = pkbf(p[2], p[3]); pw[c][s].z = pkbf(p[4], p[5]); pw[c][s].w = pkbf(p[6], p[7]);
            }
        lsum += __shfl_xor(lsum, 32);
        if (hi == 0) { LW[l31] = lsum;
            float* ML = (float*)(P.ws + WS_ML) + (((size_t)cur.g * MT + cur.rowbase + (size_t)cur.d * (cur.j0 + 32 * wv + l31)) * HPG + cur.hh) * 2; *(f32x2*)ML = (f32x2){mx, lsum}; }
        f32x16 o[2]; o[0] = (f32x16){}; o[1] = (f32x16){};
        const int g16 = lane >> 4, i16 = lane & 15;
        const LAS unsigned char* vb = lds + AT_V + (4 * hi + (i16 >> 2)) * 128 + (16 * (g16 & 1) + 4 * (i16 & 3)) * 2;
#pragma unroll
        for (int c = 0; c < 5; ++c)
#pragma unroll
            for (int s = 0; s < 2; ++s) {
                const bf16x8 pa = __builtin_bit_cast(bf16x8, pw[c][s]);
                const LAS unsigned char* vp = vb + (32 * (wv + c) + 16 * s) * 128;
#pragma unroll
                for (int db = 0; db < 2; ++db) {
                    const s16x4 lo = ds_tr16(vp + 64 * db), hi4 = ds_tr16(vp + 64 * db + 8 * 128);
                    const bf16x8 vf = (bf16x8){lo[0], lo[1], lo[2], lo[3], hi4[0], hi4[1], hi4[2], hi4[3]};
                    o[db] = __builtin_amdgcn_mfma_f32_32x32x16_bf16(pa, vf, o[db], 0, 0, 0);
                }
            }
        int lo_ = lane; asm volatile("" : "+v"(lo_)); const int l31o = lo_ & 31, hio = lo_ >> 5;
#pragma unroll
        for (int r = 0; r < 16; ++r) {
            const int q = crow(r, hio); const float inv = __builtin_amdgcn_rcpf(LW[q]);
            const unsigned w = pkbf(o[0][r] * inv, o[1][r] * inv);
            OS[q * 64 + l31o] = (bf16_t)(w & 0xffffu); OS[q * 64 + 32 + l31o] = (bf16_t)(w >> 16);
        }
        asm volatile("s_waitcnt lgkmcnt(0)" ::: "memory");
        bf16_t* OG = (bf16_t*)(P.ws + WS_OG) + (size_t)cur.g * MT * AO;
#pragma unroll
        for (int i = 0; i < 4; ++i) {
            const int q = 8 * i + (lo_ >> 3), ch = lo_ & 7;
            const u32x4 v = *(const LAS u32x4*)(OS + q * 64 + 8 * ch);
            *(u32x4*)(OG + (cur.rowbase + (size_t)cur.d * (cur.j0 + 32 * wv + q)) * AO + cur.hh * HD + 8 * ch) = v;
        }
    }
}
__device__ __forceinline__ void attn_sample(const Ptrs& P, int l, LAS unsigned char* lds, int wv, int lane, int item) {
    const int b = item / NH, head = item % NH, g = head >> 3, hh = head & 7, dil = g_dil(g), Lc = g_win(g);
    const bf16_t* Q = (const bf16_t*)(P.ws + WS_Q); const bf16_t* K = (const bf16_t*)(P.ws + WS_K); const bf16_t* V = (const bf16_t*)(P.ws + WS_V);
    const float* BIAS = (const float*)(P.ws + WS_BIAS) + (size_t)(g * HPG + hh) * NKEY;
    const float* cache = P.cache[g] + (size_t)(l * SB + b) * Lc * 1024;
    const size_t row = (size_t)MP + b;
    LAS float* qw = (LAS float*)(lds + AT_W) + wv * 64;
    qw[lane] = bf2f(Q[row * AW + head * HD + lane]);
    asm volatile("s_waitcnt lgkmcnt(0)" ::: "memory");
    float s[3];
#pragma unroll
    for (int j = 0; j < 3; ++j) { const int kk = lane + 64 * j; float acc = -INFINITY;
        if (kk <= 128) { acc = 0.f;
            if (kk == 0) { const bf16_t* kr = K + row * AW + head * HD; for (int dd = 0; dd < HD; ++dd) acc += qw[dd] * bf2f(kr[dd]); }
            else { const f32x4* kr = (const f32x4*)(cache + ((size_t)(Lc - kk * dil) * 2 + 0) * 512 + hh * HD);
#pragma unroll
                for (int dd = 0; dd < 16; ++dd) { const f32x4 kv = kr[dd]; const f32x4 qv = *(const LAS f32x4*)(qw + 4 * dd); acc += (kv[0] * qv[0] + kv[1] * qv[1]) + (kv[2] * qv[2] + kv[3] * qv[3]); } }
            acc = acc + BIAS[kk]; }
        s[j] = acc; }
    const float m = wave_max(fmaxf(fmaxf(s[0], s[1]), s[2]));
    float p[3]; float lsum = 0.f;
#pragma unroll
    for (int j = 0; j < 3; ++j) { p[j] = (lane + 64 * j <= 128) ? __builtin_amdgcn_exp2f(s[j] - m) : 0.f; lsum += p[j]; }
    lsum = wave_sum(lsum);
    float o = __shfl(p[0], 0) * bf2f(V[row * AW + head * HD + lane]);
#pragma unroll 1
    for (int k0 = 1; k0 <= 128; k0 += 32) {
        float vv[32];
#pragma unroll
        for (int i = 0; i < 32; ++i) vv[i] = cache[((size_t)(Lc - (k0 + i) * dil) * 2 + 1) * 512 + hh * HD + lane];
#pragma unroll
        for (int i = 0; i < 32; ++i) { const int kk = k0 + i; const float pk = __shfl(kk < 64 ? p[0] : (kk < 128 ? p[1] : p[2]), kk & 63); o += pk * vv[i]; }
    }
    bf16_t* OG = (bf16_t*)(P.ws + WS_OG) + ((size_t)g * MT + row) * AO; OG[hh * HD + lane] = f2b(o / lsum);
    if (lane == 0) { float* ML = (float*)(P.ws + WS_ML) + (((size_t)g * MT + row) * HPG + hh) * 2; ML[0] = m; ML[1] = lsum; }
}

template <int NSTEP>
__device__ __forceinline__ void sg_part(const bf16_t* A, int lda, const bf16_t* Bt, int ldb, int k0, int colbase, LAS float* TLP, int wv, int lane) {
    const int l31 = lane & 31, hi = lane >> 5, cb = wv & 1, kq = wv >> 1;
    const bf16_t* ap = A + (size_t)l31 * lda + k0 + kq * (NSTEP * 16) + 8 * hi;
    const bf16_t* bp = Bt + (size_t)(colbase + 128 * cb + l31) * ldb + k0 + kq * (NSTEP * 16) + 8 * hi;
    f32x16 acc = {};
    int s = 0;
#pragma unroll 1
    for (; s + 8 <= NSTEP; s += 8) {
        bf16x8 a[8], b[8];
#pragma unroll
        for (int i = 0; i < 8; ++i) { a[i] = *(const bf16x8*)(ap + 16 * (s + i)); b[i] = *(const bf16x8*)(bp + 16 * (s + i)); }
#pragma unroll
        for (int i = 0; i < 8; ++i) acc = __builtin_amdgcn_mfma_f32_32x32x16_bf16(a[i], b[i], acc, 0, 0, 0);
    }
    if (NSTEP & 4) {
        bf16x8 a[4], b[4];
#pragma unroll
        for (int i = 0; i < 4; ++i) { a[i] = *(const bf16x8*)(ap + 16 * (s + i)); b[i] = *(const bf16x8*)(bp + 16 * (s + i)); }
#pragma unroll
        for (int i = 0; i < 4; ++i) acc = __builtin_amdgcn_mfma_f32_32x32x16_bf16(a[i], b[i], acc, 0, 0, 0);
    }
    LAS float* t = TLP + kq * 2048 + 32 * cb + l31;
#pragma unroll
    for (int r = 0; r < 16; ++r) t[crow(r, hi) * 64] = acc[r];
}
__device__ __forceinline__ f32x4 sg_sum(const LAS float* TLP, int r, int q) {
    const LAS f32x4* p = (const LAS f32x4*)(TLP + r * 64 + 4 * q);
    return (p[0] + p[512]) + (p[1024] + p[1536]);
}
__device__ __forceinline__ float red16(float v) { v += __shfl_xor(v, 1); v += __shfl_xor(v, 2); v += __shfl_xor(v, 4); v += __shfl_xor(v, 8); return v; }

template <int WHICH>
__device__ __forceinline__ void sample_strip(const Ptrs& P, int l, LAS unsigned char* lds, int wv, int tid, int s, int first) {
    const int lane = tid & 63, pn = s >> 2, wc = s & 3, colbase = 256 * pn + 32 * wc;
    unsigned char* ws = P.ws; unsigned char* wb = ws + WS_W + l * LW_BYTES;
    LAS float* TLP = (LAS float*)lds; LAS float* TLP2 = TLP + 8192;
    __syncthreads();
    if (WHICH == 1) sg_part<16>((const bf16_t*)(ws + WS_XB) + (size_t)MP * DM, DM, (const bf16_t*)(wb + LW_W1), DM, 0, colbase, TLP, wv, lane);
    if (WHICH == 3) { sg_part<16>((const bf16_t*)(ws + WS_A3) + (size_t)MP * K3, K3, (const bf16_t*)(wb + LW_W3), K3, 0, colbase, TLP, wv, lane);
                      sg_part<8>((const bf16_t*)(ws + WS_A3) + (size_t)MP * K3, K3, (const bf16_t*)(wb + LW_W3), K3, DR, colbase, TLP2, wv, lane); }
    if (WHICH == 4) sg_part<16>((const bf16_t*)(ws + WS_MRG) + (size_t)MP * DM, DM, (const bf16_t*)(wb + LW_W4), DM, 0, colbase, TLP, wv, lane);
    if (WHICH == 5) sg_part<16>((const bf16_t*)(ws + WS_XB) + (size_t)MP * DM, DM, (const bf16_t*)(wb + LW_W5), DM, 0, colbase, TLP, wv, lane);
    if (WHICH == 6) sg_part<44>((const bf16_t*)(ws + WS_H) + (size_t)MP * DFF, DFF, (const bf16_t*)(wb + LW_W6), DFF, 0, colbase, TLP, wv, lane);
    __syncthreads();
    const int r = tid >> 4, q = tid & 15, c0 = 4 * q, cb = q >> 3, i0 = c0 & 31;
    const size_t row = (size_t)MP + r;
    f32x4 y = sg_sum(TLP, r, q);
    const float* ssq = (const float*)(ws + WS_SSQ);
    if (WHICH == 1) {
        const float rs = row_rs(ssq, (int)row);
        const f32x4 v = y * rs;
        if (pn < 8) {
            const int col = (pn & 3) * 256 + 128 * cb + 32 * wc + i0;
            if (pn < 4) {
                u32x2 w; w.x = pkbf(v[0], v[1]); w.y = pkbf(v[2], v[3]); *(u32x2*)((bf16_t*)(ws + WS_LX) + row * DR + col) = w;
                float* cs = P.out + O_CONVS + (size_t)(l * SB + r) * 3 * DR + col; const float* sc = P.state_conv + (size_t)(l * SB + r) * 3 * DR + col;
                *(f32x4*)cs = *(const f32x4*)(sc + DR); *(f32x4*)(cs + DR) = *(const f32x4*)(sc + 2 * DR); *(f32x4*)(cs + 2 * DR) = v;
            } else {
                u32x2 w; w.x = pkbf(gelu_tanh(v[0]), gelu_tanh(v[1])); w.y = pkbf(gelu_tanh(v[2]), gelu_tanh(v[3])); *(u32x2*)((bf16_t*)(ws + WS_GG) + row * DR + col) = w;
            }
        } else if (pn < 26) {
            const int tq = pn - 8, type = tq / 6, head = 4 * (tq % 6) + wc, g = head >> 3, hh = head & 7;
            f32x4 o = v;
            const float ss = red16((v[0] * v[0] + v[1] * v[1]) + (v[2] * v[2] + v[3] * v[3]));
            if (type < 2) { const float inv = rsqrtf(ss * (1.0f / HD) + EPS) * (type == 0 ? QSCALE : 1.0f); const f32x4 gn = *(const f32x4*)((type == 0 ? P.q_gain : P.k_gain) + l * HD + c0); o = v * inv * gn; }
            bf16_t* dst = (bf16_t*)(ws + (type == 0 ? WS_Q : (type == 1 ? WS_K : WS_V)));
            u32x2 w; w.x = pkbf(o[0], o[1]); w.y = pkbf(o[2], o[3]); *(u32x2*)(dst + row * AW + head * HD + c0) = w;
            if (type >= 1) *(f32x4*)(P.out + o_kvs(g) + (((size_t)(l * SB + r) * 2 + (type - 1)) * HPG + hh) * HD + c0) = o;
        } else if (q < 8) {
            const f32x4 ya = sg_sum(TLP, r, q + 8);
            const float* bm = P.b_merge + (size_t)l * 2048; const int col = (pn - 26) * 128 + 32 * wc + i0;
            const f32x4 xl = v + *(const f32x4*)(bm + col), xa = ya * rs + *(const f32x4*)(bm + 1024 + col);
            f32x4 rho, gav;
#pragma unroll
            for (int e = 0; e < 4; ++e) { const float el = __expf(-xl[e]), ea = fminf(__expf(-xa[e]), 1e30f); gav[e] = __builtin_amdgcn_rcpf(1.0f + ea); rho[e] = (1.0f + ea) * __builtin_amdgcn_rcpf(1.0f + el); }
            bf16_t* GM = (bf16_t*)(ws + WS_GM) + row * 2048;
            u32x2 w; w.x = pkbf(rho[0], rho[1]); w.y = pkbf(rho[2], rho[3]); *(u32x2*)(GM + col) = w;
            w.x = pkbf(gav[0], gav[1]); w.y = pkbf(gav[2], gav[3]); *(u32x2*)(GM + 1024 + col) = w;
        }
    } else if (WHICH == 3) {
        const f32x4 y2 = sg_sum(TLP2, r, q);
        const int col = 256 * pn + 128 * cb + 32 * wc + i0;
        const bf16_t* GM = (const bf16_t*)(ws + WS_GM) + row * 2048;
        const u32x2 gl = *(const u32x2*)(GM + col), ga = *(const u32x2*)(GM + 1024 + col);
        const f32x4 rho = (f32x4){bflo(gl.x), bfhi(gl.x), bflo(gl.y), bfhi(gl.y)}, gav = (f32x4){bflo(ga.x), bfhi(ga.x), bflo(ga.y), bfhi(ga.y)};
        const f32x4 mg = gav * (rho * y + y2);
        u32x2 w; w.x = pkbf(mg[0], mg[1]); w.y = pkbf(mg[2], mg[3]); *(u32x2*)((bf16_t*)(ws + WS_MRG) + row * DM + col) = w;
    } else if (WHICH == 4 || WHICH == 6) {
        const int col = 256 * pn + 128 * cb + 32 * wc + i0;
        float* Y = P.out + O_Y + row * DM + col;
        const f32x4 base = first ? *(const f32x4*)(P.x_sample + (size_t)r * DM + col) : *(const f32x4*)Y;
        const f32x4 v = base + y;
        *(f32x4*)Y = v;
        u32x2 w; w.x = pkbf(v[0], v[1]); w.y = pkbf(v[2], v[3]); *(u32x2*)((bf16_t*)(ws + WS_XB) + row * DM + col) = w;
        const float ss = red16((v[0] * v[0] + v[1] * v[1]) + (v[2] * v[2] + v[3] * v[3]));
        if (q == 0) ((float*)(ws + WS_SSQ))[row * 16 + pn * 4 + wc] = ss;
    } else if (WHICH == 5) {
        if (q < 8) {
            const float rs = row_rs(ssq, (int)row);
            const f32x4 yu = sg_sum(TLP, r, q + 8);
            f32x4 h;
#pragma unroll
            for (int e = 0; e < 4; ++e) { const float gt = y[e] * rs, up = yu[e] * rs; h[e] = gt * sigmoidf_(gt) * up; }
            u32x2 w; w.x = pkbf(h[0], h[1]); w.y = pkbf(h[2], h[3]); *(u32x2*)((bf16_t*)(ws + WS_H) + row * DFF + pn * 128 + 32 * wc + i0) = w;
        }
    }
}

constexpr int RING_BYTES = 131072, LDS_BYTES = 147456, LDSCTL_OFF = LDS_BYTES - 1024, MISC_OFF = LDSCTL_OFF + 320;
static_assert(AT_END <= LDSCTL_OFF && SC_END <= LDSCTL_OFF && RING_BYTES <= LDSCTL_OFF, "LDS map");
constexpr int CW_BAR = 4096;
constexpr int NPH = 1 + 8 * DEPTH;
#ifndef PHMASK
#define PHMASK 63
#endif
struct Args { Ptrs P; int ph_lo, ph_hi, pad0, pad1; };

__global__ void __launch_bounds__(512, 2) mega(Args a) {
    extern __shared__ __attribute__((aligned(16))) unsigned char lds_raw[];
    LAS unsigned char* lds = (LAS unsigned char*)lds_raw;
    const int wv = __builtin_amdgcn_readfirstlane(threadIdx.x >> 6);
#define TID() ((wv << 6) | lane_id_v())
    { const int tid = TID(); for (int u = tid; u < (LDS_BYTES - LDSCTL_OFF) / 4; u += 512) ((LAS unsigned*)(lds + LDSCTL_OFF))[u] = 0u; }
    __syncthreads();
    unsigned char* ws0 = a.P.ws;
    XcdBarrier bar; bar.bar = (unsigned*)(ws0 + WS_CTL) + CW_BAR; bar.x = 0; bar.st = nullptr; bar.wv = wv;
    if (a.ph_hi - a.ph_lo > 1) bar = xcd_barrier_post((unsigned*)(ws0 + WS_CTL) + CW_BAR, (volatile LAS unsigned*)(lds + MISC_OFF) + 8);
    bar.wv = wv;
    const int G = gridDim.x;
#ifndef PROBE_REPEAT
#define PROBE_REPEAT -1
#endif
    for (int ph2_ = a.ph_lo * 2; ph2_ < a.ph_hi * 2; ph2_ = __builtin_amdgcn_readfirstlane(ph2_ + 1)) {
        const int ph2 = __builtin_amdgcn_readfirstlane(ph2_), ph = ph2 >> 1;
        const bool isrep = (PROBE_REPEAT == 8) ? (ph == 0) : (PROBE_REPEAT == 9 ? true : (ph > 0 && ((ph - 1) & 7) == PROBE_REPEAT));
        if (!isrep && (ph2 & 1) == 0) continue;
        const int dry = (isrep && (ph2 & 1) == 0) ? 1 : 0;
        if (PROBE_REPEAT == 9 && dry) { xcd_barrier(bar); continue; }
        const Ptrs& P = a.P;
        int bid = blockIdx.x; asm volatile("" : "+s"(bid));
        unsigned char* ws = P.ws;
        if (ph == 0 && (PHMASK & 32)) {
            int t_ = TID(); asm volatile("" : "+v"(t_));
            p0_prologue(P, lds, bid * 8 + wv, G * 8, wv, t_ & 63);
        } else {
            const int l = __builtin_amdgcn_readfirstlane((ph - 1) >> 3), p = __builtin_amdgcn_readfirstlane((ph - 1) & 7);
            unsigned char* wb = ws + WS_W + l * LW_BYTES;
            if (p == 0 && (PHMASK & 1)) {
                pg8::Gemm g{(const bf16_t*)(ws + WS_XB), (const bf16_t*)(wb + LW_W1), MP, N1, DM, wv}; pg8::StaticOrder S; S.init(MP, N1, G, bid);
                Epi1 E{0, P, l}; pg8::gemm_phase<Epi1, pg8::StaticOrder, true, true>(lds, g, S, E);
                { int t_ = TID(); asm volatile("" : "+v"(t_)); for (int s = G - 1 - bid; s < N1 / 64; s += G) sample_strip<1>(P, l, lds, wv, t_, s, 0); }
            } else if (p == 4 && (PHMASK & 2)) {
                pg8::Gemm g{(const bf16_t*)(ws + WS_A3), (const bf16_t*)(wb + LW_W3), MP, DM, K3, wv}; pg8::StaticOrder S; S.init(MP, DM, G, bid);
                Epi3 E{DR / 64, P}; pg8::gemm_phase<Epi3, pg8::StaticOrder, true, true>(lds, g, S, E);
                { int t_ = TID(); asm volatile("" : "+v"(t_)); for (int s = G - 1 - bid; s < DM / 64; s += G) sample_strip<3>(P, l, lds, wv, t_, s, 0); }
            } else if (p == 5 && (PHMASK & 4)) {
                pg8::Gemm g{(const bf16_t*)(ws + WS_MRG), (const bf16_t*)(wb + LW_W4), MP, DM, DM, wv}; pg8::StaticOrder S; S.init(MP, DM, G, bid);
                EpiRes E{0, P, l == 0 ? 1 : 0, dry}; pg8::gemm_phase<EpiRes, pg8::StaticOrder, true, true>(lds, g, S, E);
                { int t_ = TID(); asm volatile("" : "+v"(t_)); for (int s = G - 1 - bid; s < DM / 64; s += G) if (!dry) sample_strip<4>(P, l, lds, wv, t_, s, l == 0 ? 1 : 0); }
            } else if (p == 6 && (PHMASK & 8)) {
                pg8::Gemm g{(const bf16_t*)(ws + WS_XB), (const bf16_t*)(wb + LW_W5), MP, 2 * DFF, DM, wv}; pg8::StaticOrder S; S.init(MP, 2 * DFF, G, bid);
                Epi5 E{0, P}; pg8::gemm_phase<Epi5, pg8::StaticOrder, true, true>(lds, g, S, E);
                { int t_ = TID(); asm volatile("" : "+v"(t_)); for (int s = G - 1 - bid; s < 2 * DFF / 64; s += G) sample_strip<5>(P, l, lds, wv, t_, s, 0); }
            } else if (p == 7 && (PHMASK & 16)) {
                pg8::Gemm g{(const bf16_t*)(ws + WS_H), (const bf16_t*)(wb + LW_W6), MP, DM, DFF, wv}; pg8::StaticOrder S; S.init(MP, DM, G, bid);
                EpiRes E{0, P, 0, dry}; pg8::gemm_phase<EpiRes, pg8::StaticOrder, true, true>(lds, g, S, E);
                { int t_ = TID(); asm volatile("" : "+v"(t_)); for (int s = G - 1 - bid; s < DM / 64; s += G) if (!dry) sample_strip<6>(P, l, lds, wv, t_, s, 0); }
            } else if (p >= 1 && p <= 3) {
                int t_ = TID(); asm volatile("" : "+v"(t_));
                const size_t gtid = (size_t)bid * 512 + t_, nth = (size_t)G * 512;
                if (p == 1) {
                    for (int rp = 0; rp < (PROBE_REPEAT == 10 ? 2 : 1); ++rp)
                    for (int it = bid; it < 256; it += G) scan_item<0>(P, l, lds, wv, t_, it >> 7, (it >> 3) & 15, it & 7);
                    for (int rp = 0; rp < (PROBE_REPEAT == 11 ? 2 : 1); ++rp)
                    attn_phase(P, l, lds, wv, t_, bid, G);
                    __syncthreads();
                    for (int it = bid * 8 + wv; it < SB * NH; it += G * 8) attn_sample(P, l, lds, wv, t_ & 63, it);
                } else if (p == 2) {
                    for (int rp = 0; rp < (PROBE_REPEAT == 12 ? 2 : 1); ++rp)
                    for (int it = bid; it < 256; it += G) scan_item<1>(P, l, lds, wv, t_, it >> 7, (it >> 3) & 15, it & 7);
                    for (int rp = 0; rp < (PROBE_REPEAT == 13 ? 2 : 1); ++rp) {
                    for (int it = bid; it < 64; it += G) scan_sample(P, l, lds, t_, it >> 4, it & 15);
                    ph_combine(P, gtid, nth); }
                }
            }
        }
        if (ph2 + 1 < a.ph_hi * 2) xcd_barrier(bar);
    }
}

extern "C" void kernel_launch(void* const* d_in, const int* in_sizes, int n_in, void* d_out, int out_size, void* d_ws, size_t ws_size, hipStream_t stream) {
    static int grid = 0;
    if (grid == 0) {
        if (n_in != 27 || (size_t)out_size != O_END || ws_size < WS_END) { fprintf(stderr, "kernel_launch: unexpected sizes n_in %d out %d (want %zu) ws %zu (want %zu)\n", n_in, out_size, (size_t)O_END, ws_size, (size_t)WS_END); grid = -1; return; }
        int dev = 0, cus = 0;
        if (hipGetDevice(&dev) != hipSuccess || hipDeviceGetAttribute(&cus, hipDeviceAttributeMultiprocessorCount, dev) != hipSuccess) { grid = -1; return; }
        if (hipFuncSetAttribute((const void*)mega, hipFuncAttributeMaxDynamicSharedMemorySize, LDS_BYTES) != hipSuccess) { fprintf(stderr, "kernel_launch: hipFuncSetAttribute failed\n"); grid = -1; return; }
        grid = cus;
    }
    if (grid < 0) return;
    Args a{};
    Ptrs& P = a.P;
    const float* const* in = (const float* const*)d_in;
    P.x_prompt = in[0]; P.x_sample = in[1]; P.cache[0] = in[2]; P.cache[1] = in[3]; P.cache[2] = in[4]; P.state_conv = in[5]; P.state_h = in[6]; P.rel_bias = in[7];
    P.norm_mix = in[8]; P.w_in = in[9]; P.w_conv = in[10]; P.b_conv = in[11]; P.w_rg_a = in[12]; P.b_rg_a = in[13]; P.w_rg_x = in[14]; P.b_rg_x = in[15];
    P.lru_lambda = in[16]; P.q_gain = in[17]; P.k_gain = in[18]; P.w_merge = in[19]; P.b_merge = in[20]; P.w_branch_lru = in[21]; P.w_branch_att = in[22];
    P.w_o = in[23]; P.norm_ffn = in[24]; P.w_ffn_in = in[25]; P.w_ffn_out = in[26];
    P.out = (float*)d_out; P.ws = (unsigned char*)d_ws;
    (void)hipMemsetAsync((char*)d_ws + WS_CTL, 0, CTL_ZERO_BYTES, stream);
    a.ph_lo = 0; a.ph_hi = NPH;
    hipLaunchKernelGGL(mega, dim3(grid), dim3(512), LDS_BYTES, stream, a);
}
```

```cpp
#include <hip/hip_runtime.h>
#include <stdint.h>
#include <stdio.h>

typedef unsigned short bf16_t;
typedef short bf16x8 __attribute__((ext_vector_type(8)));
typedef float f32x4 __attribute__((ext_vector_type(4)));
typedef unsigned u32x4 __attribute__((ext_vector_type(4)));
typedef unsigned u32x2 __attribute__((ext_vector_type(2)));
typedef float f32x2 __attribute__((ext_vector_type(2)));

constexpr int DM = 1024, NB = 2, SEQ = 8192, DEPTH = 2, SB = 32, PAST = 8192;
constexpr int MP = NB * SEQ;
constexpr int MT = MP + SB;
constexpr int MPAD = 16640;
constexpr int DR = 1024, NBLK = 16, CW = 4;
constexpr int HD = 64, HPG = 8, NG = 3, NH = 24, AW = 1536, AO = 512;
constexpr int DFF = 2816;
constexpr int N1 = 2 * DR + 3 * AW + 2 * DM;
constexpr int K3 = DR + AO;
constexpr float EPS = 1e-6f;
constexpr int NKEY = 129;

__host__ __device__ constexpr int g_dil(int g) { return g == 0 ? 1 : (g == 1 ? 4 : 16); }
__host__ __device__ constexpr int g_win(int g) { return g == 0 ? 128 : (g == 1 ? 512 : 2048); }

constexpr size_t O_Y = 0;
constexpr size_t O_KVP0 = (size_t)MT * DM;
constexpr size_t O_KVP1 = O_KVP0 + (size_t)DEPTH * NB * 128 * 1024;
constexpr size_t O_KVP2 = O_KVP1 + (size_t)DEPTH * NB * 512 * 1024;
constexpr size_t O_CONVP = O_KVP2 + (size_t)DEPTH * NB * 2048 * 1024;
constexpr size_t O_HP = O_CONVP + (size_t)DEPTH * NB * 3 * DR;
constexpr size_t O_KVS0 = O_HP + (size_t)DEPTH * NB * DR;
constexpr size_t O_KVS1 = O_KVS0 + (size_t)DEPTH * SB * 1024;
constexpr size_t O_KVS2 = O_KVS1 + (size_t)DEPTH * SB * 1024;
constexpr size_t O_CONVS = O_KVS2 + (size_t)DEPTH * SB * 1024;
constexpr size_t O_HS = O_CONVS + (size_t)DEPTH * SB * 3 * DR;
constexpr size_t O_END = O_HS + (size_t)DEPTH * SB * DR;
__host__ __device__ constexpr size_t o_kvp(int g) { return g == 0 ? O_KVP0 : (g == 1 ? O_KVP1 : O_KVP2); }
__host__ __device__ constexpr size_t o_kvs(int g) { return g == 0 ? O_KVS0 : (g == 1 ? O_KVS1 : O_KVS2); }

constexpr size_t MiB = 1u << 20;
constexpr size_t rup(size_t x) { return (x + MiB - 1) / MiB * MiB; }
constexpr size_t WS_CTL = 0, CTL_ZERO_BYTES = 1 * MiB;
constexpr size_t WS_BIAS = 1 * MiB;
constexpr size_t WS_SSQ = 2 * MiB;
constexpr size_t WS_SUM = 4 * MiB;
constexpr size_t WS_W = 8 * MiB;
constexpr size_t LW_W1 = 0;
constexpr size_t LW_W3 = LW_W1 + (size_t)N1 * DM * 2;
constexpr size_t LW_W4 = LW_W3 + (size_t)DM * K3 * 2;
constexpr size_t LW_W5 = LW_W4 + (size_t)DM * DM * 2;
constexpr size_t LW_W6 = LW_W5 + (size_t)2 * DFF * DM * 2;
constexpr size_t LW_BYTES = rup(LW_W6 + (size_t)DM * DFF * 2);
constexpr size_t WS_XB = WS_W + DEPTH * LW_BYTES;
constexpr size_t WS_LX = WS_XB + rup((size_t)MPAD * DM * 2);
constexpr size_t WS_GG = WS_LX + rup((size_t)MPAD * DM * 2);
constexpr size_t WS_Q = WS_GG + rup((size_t)MPAD * DM * 2);
constexpr size_t WS_K = WS_Q + rup((size_t)MPAD * AW * 2);
constexpr size_t WS_V = WS_K + rup((size_t)MPAD * AW * 2);
constexpr size_t WS_GM = WS_V + rup((size_t)MPAD * AW * 2);
constexpr size_t WS_OG = WS_GM + rup((size_t)MPAD * 2048 * 2);
constexpr size_t WS_ML = WS_OG + rup((size_t)3 * MPAD * AO * 2);
constexpr size_t WS_A3 = WS_ML + rup((size_t)3 * MPAD * 16 * 4);
constexpr size_t WS_MRG = WS_A3 + rup((size_t)MPAD * K3 * 2);
constexpr size_t WS_H = WS_MRG + rup((size_t)MPAD * DM * 2);
constexpr size_t WS_SIMPLE = WS_H + rup((size_t)MPAD * DFF * 2);
constexpr size_t WS_XC = WS_SIMPLE;
constexpr size_t WS_AA = WS_XC + rup((size_t)MPAD * DM * 4);
constexpr size_t WS_UU = WS_AA + rup((size_t)MPAD * DM * 4);
constexpr size_t WS_DUMMY = WS_UU + rup((size_t)MPAD * DM * 4);
constexpr size_t WS_END = WS_DUMMY + 160 * MiB;

__device__ __forceinline__ int lane_id_v() { int x; asm volatile("v_mbcnt_lo_u32_b32 %0, -1, 0\n\tv_mbcnt_hi_u32_b32 %0, -1, %0" : "=v"(x)); return x; }
__device__ __forceinline__ float bf2f(bf16_t v) { return __uint_as_float(((unsigned)v) << 16); }
__device__ __forceinline__ bf16_t f2b(float f) { unsigned u = __float_as_uint(f); u += 0x7fffu + ((u >> 16) & 1u); return (bf16_t)(u >> 16); }
__device__ __forceinline__ float wave_sum(float v) {
#pragma unroll
    for (int o = 1; o < 64; o <<= 1) v += __shfl_xor(v, o);
    return v;
}
__device__ __forceinline__ float wave_max(float v) {
#pragma unroll
    for (int o = 1; o < 64; o <<= 1) v = fmaxf(v, __shfl_xor(v, o));
    return v;
}
__device__ __forceinline__ float sigmoidf_(float x) { return __builtin_amdgcn_rcpf(1.0f + __builtin_amdgcn_exp2f(-1.4426950408889634f * x)); }
__device__ __forceinline__ float gelu_tanh(float x) { const float u2 = x * (1.5957691216057308f + 0.07135481627159831f * x * x); return x * __builtin_amdgcn_rcpf(1.0f + __builtin_amdgcn_exp2f(-1.4426950408889634f * u2)); }

__host__ __device__ __forceinline__ int w1_src_col(int nt) {
    if (nt < 2048) return nt;
    const int pn = nt >> 8, tc = nt & 255, bj = tc >> 7;
    if (nt >= 6656) return 6656 + bj * 1024 + (pn - 26) * 128 + (tc & 127);
    const int wc = (tc >> 5) & 3, i = tc & 31;
    return 2048 + (pn - 8) * 256 + wc * 64 + bj * 32 + i;
}
__host__ __device__ __forceinline__ int w5_src_col(int nt) { const int pn = nt >> 8, tc = nt & 255, bj = tc >> 7, j = tc & 127; return bj * DFF + pn * 128 + j; }

struct Ptrs {
    const float* x_prompt; const float* x_sample; const float* cache[3]; const float* state_conv; const float* state_h; const float* rel_bias;
    const float* norm_mix; const float* w_in; const float* w_conv; const float* b_conv; const float* w_rg_a; const float* b_rg_a; const float* w_rg_x; const float* b_rg_x;
    const float* lru_lambda; const float* q_gain; const float* k_gain; const float* w_merge; const float* b_merge; const float* w_branch_lru; const float* w_branch_att;
    const float* w_o; const float* norm_ffn; const float* w_ffn_in; const float* w_ffn_out;
    float* out; unsigned char* ws;
};
__device__ __forceinline__ const float* xin_row(const Ptrs& P, int row) { return row < MP ? P.x_prompt + (size_t)row * DM : P.x_sample + (size_t)(row - MP) * DM; }

namespace pg8 {
#define PG8_LAS __attribute__((address_space(3)))
typedef unsigned short bf16_t;
typedef short bf16x8 __attribute__((ext_vector_type(8)));
typedef float f32x4 __attribute__((ext_vector_type(4)));
typedef unsigned u32x4 __attribute__((ext_vector_type(4)));
constexpr int BM = 256, BK = 64, HALF = 128, HTB = HALF * BK * 2  , STAGE_BYTES = 8 * HTB, NXCD = 8, WGM = 8;

__host__ __device__ __forceinline__ int lds_byte(int r, int c) { const int st = (r >> 4) * 2 + (c >> 5), rr = r & 15, cc = c & 31, ob = rr * 64 + cc * 2; return st * 1024 + (ob ^ (((ob >> 9) & 1) << 5)); }
__host__ __device__ __forceinline__ void stage_rc(int b, int& R, int& C) { const int st = b / 1024, sb = b % 1024, swz = sb ^ (((sb >> 9) & 1) << 5); R = (st >> 1) * 16 + swz / 64; C = (st & 1) * 32 + (swz % 64) / 2; }
__host__ __device__ __forceinline__ int perm32(int rho) { const int n = rho >> 4, i = rho & 15; return 8 * (i >> 2) + 4 * n + (i & 3); }

struct Unit { int pm, pn; };
struct Gemm { const bf16_t* A; const bf16_t* Bt; int M, N, K; int wv; };

struct StaticOrder {
    int nM, nN, nwg, G, c;
    __host__ __device__ void init(int M, int N, int G_, int c_) { nM = M / BM; nN = N / BM; nwg = nM * nN; G = G_; c = c_; }
    __host__ __device__ bool next(int i, Unit& u) const {
        const long L = (long)i * G + c; if (L >= nwg) return false;
        int wgid = (int)L; { const int q = nwg / NXCD, r = nwg % NXCD, xcd = wgid % NXCD, off = wgid / NXCD; wgid = (xcd < r ? xcd * (q + 1) : r * (q + 1) + (xcd - r) * q) + off; }
        const int nig = WGM * nN, gid = wgid / nig, fm = gid * WGM, gsz = (nM - fm) < WGM ? (nM - fm) : WGM;
        u.pm = fm + ((wgid % nig) % gsz); u.pn = (wgid % nig) / gsz; return true;
    }
    __device__ __forceinline__ void a_ready(const Unit&) const {}
    __device__ __forceinline__ void done(const Unit&) const {}
};

template <class Epi, class Sched, bool ALIGN_EPI = false, bool SP2 = false>
__device__ __forceinline__ void gemm_phase(PG8_LAS unsigned char* lds, const Gemm g, const Sched& S, const Epi& E) {
    int tid_ = (g.wv << 6) | lane_id_v(); asm volatile("" : "+v"(tid_));
    const int tid = tid_, wid = __builtin_amdgcn_readfirstlane(tid >> 6), lane = tid & 63, wr = wid >> 2, wc = wid & 3, fr = lane & 15, fq = lane >> 4;
    const int K = g.K, nt = K / BK;
    unsigned voffA[2], voffB[2];
#pragma unroll
    for (int i = 0; i < 2; ++i) { int R, C; stage_rc(tid * 16 + i * 8192, R, C); const int Rb = Epi::PERM ? ((R & ~31) + perm32(R & 31)) : R;
        voffA[i] = (unsigned)(R * K + C) * 2u; voffB[i] = (unsigned)(Rb * K + C) * 2u; }
    const size_t kstep = (size_t)(BK * 2);
    const size_t hstep = (size_t)HALF * K * 2;
    const size_t tstep = 2 * hstep;
    const unsigned ldsw = (unsigned)wid * 1024u;
    const int aoff = lds_byte(wr * 64 + fr, fq * 8), boff = lds_byte(wc * 32 + fr, fq * 8);
#define PG8_SA(b, h) (((b) * 2 + (h)) * HTB)
#define PG8_SB(b, h) ((4 + (b) * 2 + (h)) * HTB)
#define PG8_STAGE(bufoff, gbase, voff) do { _Pragma("unroll") for (int _i = 0; _i < 2; ++_i) \
        __builtin_amdgcn_global_load_lds((const unsigned*)((const char*)(gbase) + (voff)[_i]), (PG8_LAS unsigned*)(lds + (bufoff) + ldsw + _i * 8192), 16, 0, 0); } while (0)
#define PG8_LDA(dst, b, h) do { _Pragma("unroll") for (int m = 0; m < 4; ++m) _Pragma("unroll") for (int k = 0; k < 2; ++k) dst[m][k] = *(const PG8_LAS bf16x8*)(lds + PG8_SA(b, h) + aoff + m * 2048 + k * 1024); } while (0)
#define PG8_LDB(dst, b, h) do { _Pragma("unroll") for (int n = 0; n < 2; ++n) _Pragma("unroll") for (int k = 0; k < 2; ++k) dst[n][k] = *(const PG8_LAS bf16x8*)(lds + PG8_SB(b, h) + boff + n * 2048 + k * 1024); } while (0)
#define PG8_MMA(ai, bj, At, Bt) do { __builtin_amdgcn_s_setprio(1); _Pragma("unroll") for (int m = 0; m < 4; ++m) _Pragma("unroll") for (int n = 0; n < 2; ++n) _Pragma("unroll") for (int k = 0; k < 2; ++k) \
        acc[ai][bj][m][n] = __builtin_amdgcn_mfma_f32_16x16x32_bf16(Bt[n][k], At[m][k], acc[ai][bj][m][n], 0, 0, 0); __builtin_amdgcn_s_setprio(0); } while (0)
#define PG8_WAIT_V(n) asm volatile("s_waitcnt vmcnt(" #n ")" ::: "memory")
#define PG8_WAIT_L(n) asm volatile("s_waitcnt lgkmcnt(" #n ")" ::: "memory")
#define PG8_BAR __builtin_amdgcn_s_barrier()
#define PG8_SCHED __builtin_amdgcn_sched_barrier(0)
    Unit cur, nxt; int ui = 0;
    if (!S.next(0, cur)) return;
    f32x4 acc[2][2][4][2];
#pragma unroll
    for (int a = 0; a < 2; ++a)
#pragma unroll
        for (int b = 0; b < 2; ++b)
#pragma unroll
            for (int m = 0; m < 4; ++m)
#pragma unroll
                for (int n = 0; n < 2; ++n) acc[a][b][m][n] = (f32x4){0.f, 0.f, 0.f, 0.f};
    bf16x8 At[4][2], B0[2][2], B1[2][2];
    const char* cA = (const char*)g.A + (size_t)cur.pm * tstep; const char* cB = (const char*)g.Bt + (size_t)cur.pn * tstep;
    S.a_ready(cur);
    if constexpr (SP2) {
        PG8_STAGE(PG8_SB(0, 0), cB, voffB); PG8_STAGE(PG8_SB(0, 1), cB + hstep, voffB); PG8_STAGE(PG8_SA(0, 0), cA, voffA); PG8_STAGE(PG8_SA(0, 1), cA + hstep, voffA);
        if (wr == 1) PG8_BAR;
        PG8_WAIT_V(2); PG8_BAR;
        PG8_STAGE(PG8_SB(1, 0), cB + kstep, voffB); PG8_STAGE(PG8_SA(1, 0), cA + kstep, voffA); PG8_STAGE(PG8_SB(1, 1), cB + hstep + kstep, voffB);
        PG8_WAIT_V(6); PG8_BAR;
    } else {
        PG8_STAGE(PG8_SB(0, 0), cB, voffB); PG8_STAGE(PG8_SA(0, 0), cA, voffA); PG8_STAGE(PG8_SB(0, 1), cB + hstep, voffB); PG8_STAGE(PG8_SA(0, 1), cA + hstep, voffA);
        if (wr == 1) PG8_BAR;
        PG8_WAIT_V(4); PG8_BAR;
        PG8_STAGE(PG8_SB(1, 0), cB + kstep, voffB); PG8_STAGE(PG8_SA(1, 0), cA + kstep, voffA); PG8_STAGE(PG8_SB(1, 1), cB + hstep + kstep, voffB);
        PG8_WAIT_V(6); PG8_BAR;
    }
    for (;;) {
        const bool has_next = S.next(ui + 1, nxt);
        const char* nA = has_next ? (const char*)g.A + (size_t)nxt.pm * tstep : cA; const char* nB = has_next ? (const char*)g.Bt + (size_t)nxt.pn * tstep : cB;
        for (int t = 0; t < nt; t += 2) {
            if constexpr (Epi::HAS_MID) { if (t == E.mid_t) E.mid(acc, cur, wr, wc, fr, fq); }
            const bool last = (t == nt - 2);
            const char* a1 = cA + (size_t)(t + 1) * kstep;
            const char* a2 = last ? nA : cA + (size_t)(t + 2) * kstep; const char* b2 = last ? nB : cB + (size_t)(t + 2) * kstep;
            const char* a3 = a2 + kstep; const char* b3 = b2 + kstep;
            if (last && has_next) S.a_ready(nxt);
            if constexpr (SP2) {
            PG8_LDB(B0, 0, 0); PG8_LDB(B1, 0, 1); PG8_SCHED; PG8_LDA(At, 0, 0); PG8_STAGE(PG8_SA(1, 1), a1 + hstep, voffA);
            PG8_WAIT_V(8); PG8_WAIT_L(0); PG8_BAR; PG8_MMA(0, 0, At, B0); PG8_MMA(0, 1, At, B1); PG8_BAR; PG8_SCHED;
            PG8_LDA(At, 0, 1); PG8_STAGE(PG8_SB(0, 0), b2, voffB); PG8_STAGE(PG8_SB(0, 1), b2 + hstep, voffB); PG8_STAGE(PG8_SA(0, 0), a2, voffA);
            PG8_WAIT_V(8); PG8_WAIT_L(0); PG8_BAR; PG8_MMA(1, 0, At, B0); PG8_MMA(1, 1, At, B1); PG8_BAR; PG8_SCHED;
            PG8_LDB(B0, 1, 0); PG8_LDB(B1, 1, 1); PG8_SCHED; PG8_LDA(At, 1, 0); PG8_STAGE(PG8_SA(0, 1), a2 + hstep, voffA);
            PG8_WAIT_V(8); PG8_WAIT_L(0); PG8_BAR; PG8_MMA(0, 0, At, B0); PG8_MMA(0, 1, At, B1); PG8_BAR; PG8_SCHED;
            PG8_LDA(At, 1, 1); PG8_STAGE(PG8_SB(1, 0), b3, voffB); PG8_STAGE(PG8_SB(1, 1), b3 + hstep, voffB); PG8_STAGE(PG8_SA(1, 0), a3, voffA);
            PG8_WAIT_V(8); PG8_WAIT_L(0); PG8_BAR; PG8_MMA(1, 0, At, B0); PG8_MMA(1, 1, At, B1); PG8_BAR; PG8_SCHED;
            } else {
            PG8_LDB(B0, 0, 0); PG8_SCHED; PG8_LDA(At, 0, 0); PG8_STAGE(PG8_SA(1, 1), a1 + hstep, voffA);
            PG8_WAIT_L(8); PG8_BAR; PG8_WAIT_L(0); PG8_MMA(0, 0, At, B0); PG8_BAR; PG8_SCHED;
            PG8_LDB(B1, 0, 1); PG8_STAGE(PG8_SB(0, 0), b2, voffB);
            PG8_BAR; PG8_WAIT_L(0); PG8_MMA(0, 1, At, B1); PG8_BAR;
            PG8_LDA(At, 0, 1); PG8_STAGE(PG8_SA(0, 0), a2, voffA);
            PG8_BAR; PG8_WAIT_L(0); PG8_MMA(1, 0, At, B0); PG8_BAR; PG8_SCHED;
            PG8_STAGE(PG8_SB(0, 1), b2 + hstep, voffB);
            PG8_WAIT_V(6); PG8_BAR; PG8_MMA(1, 1, At, B1); PG8_BAR;
            PG8_LDB(B0, 1, 0); PG8_SCHED; PG8_LDA(At, 1, 0); PG8_STAGE(PG8_SA(0, 1), a2 + hstep, voffA);
            PG8_WAIT_L(8); PG8_BAR; PG8_WAIT_L(0); PG8_MMA(0, 0, At, B0); PG8_BAR; PG8_SCHED;
            PG8_LDB(B1, 1, 1); PG8_STAGE(PG8_SB(1, 0), b3, voffB);
            PG8_BAR; PG8_WAIT_L(0); PG8_MMA(0, 1, At, B1); PG8_BAR;
            PG8_LDA(At, 1, 1); PG8_STAGE(PG8_SA(1, 0), a3, voffA);
            PG8_BAR; PG8_WAIT_L(0); PG8_MMA(1, 0, At, B0); PG8_BAR; PG8_SCHED;
            PG8_STAGE(PG8_SB(1, 1), b3 + hstep, voffB);
            PG8_WAIT_V(6); PG8_BAR; PG8_MMA(1, 1, At, B1); PG8_BAR;
            }
        }
        if constexpr (ALIGN_EPI) { if (wr == 0) PG8_BAR; }
        if constexpr (!Epi::AFTER_DRAIN) { E(acc, cur, wr, wc, fr, fq); S.done(cur); }
        if (!has_next) break;
#pragma unroll
        for (int a = 0; a < 2; ++a)
#pragma unroll
            for (int b = 0; b < 2; ++b)
#pragma unroll
                for (int m = 0; m < 4; ++m)
#pragma unroll
                    for (int n = 0; n < 2; ++n) acc[a][b][m][n] = (f32x4){0.f, 0.f, 0.f, 0.f};
        cur = nxt; cA = nA; cB = nB; ++ui;
        if constexpr (ALIGN_EPI) { if (wr == 1) PG8_BAR; }
    }
    PG8_WAIT_V(0);
    if constexpr (!ALIGN_EPI) { if (wr == 0) PG8_BAR; }
    PG8_BAR;
    if constexpr (Epi::AFTER_DRAIN) { E.fused(acc, cur, wr, wc, fr, fq, lds, wid, lane); S.done(cur); }
#undef PG8_SA
#undef PG8_SB
#undef PG8_STAGE
#undef PG8_LDA
#undef PG8_LDB
#undef PG8_MMA
#undef PG8_WAIT_V
#undef PG8_WAIT_L
#undef PG8_BAR
#undef PG8_SCHED
}
}
#define GAS __attribute__((address_space(1)))
#define LAS __attribute__((address_space(3)))
typedef unsigned short bf16;
typedef unsigned v4u __attribute__((ext_vector_type(4)));
typedef float f32x4 __attribute__((ext_vector_type(4)));
typedef short bf16x8 __attribute__((ext_vector_type(8)));
typedef GAS unsigned gu32;
typedef GAS unsigned long long gu64;
#define RLX_AGENT __ATOMIC_RELAXED, __HIP_MEMORY_SCOPE_AGENT
#define LDS_WAIT() asm volatile("s_waitcnt lgkmcnt(0)" ::: "memory")
#define VM_WAIT() asm volatile("s_waitcnt vmcnt(0)" ::: "memory")
__device__ __forceinline__ unsigned long long rt() { return __builtin_amdgcn_s_memrealtime(); }
__device__ __forceinline__ unsigned f2bf(float f) { unsigned u = __builtin_bit_cast(unsigned, f); return (u + 0x7fffu + ((u >> 16) & 1u)) >> 16; }
__device__ __forceinline__ unsigned pk2(float lo, float hi) { return f2bf(lo) | (f2bf(hi) << 16); }

#define XB_TMO      128
#define XB_XCNT(j)  (256  + 64 * (j))
#define XB_XSUB(j)  (1280 + 64 * (j))
#define XB_XGEN(j)  (2304 + 64 * (j))
#define XB_TOP      3328
#define XB_TOPGEN   3392
#define XCD_BAR_WORDS 3456
#define XB_SPIN_CAP (1u << 18)

__device__ __forceinline__ unsigned xb_ld(unsigned* p)              { return __hip_atomic_load(p, __ATOMIC_RELAXED, __HIP_MEMORY_SCOPE_AGENT); }
__device__ __forceinline__ unsigned xb_add(unsigned* p, unsigned v) { return __hip_atomic_fetch_add(p, v, __ATOMIC_RELAXED, __HIP_MEMORY_SCOPE_AGENT); }
__device__ __forceinline__ unsigned xb_xcc_id() { return (unsigned)__builtin_amdgcn_s_getreg((3 << 11) | 20) & 0xFu; }
#define XB_SPIN(cond, bar) do { unsigned _sp = 0; while (cond) { __builtin_amdgcn_s_sleep(1); \
    if ((++_sp & 255u) == 0u) { if (xb_ld(&(bar)[XB_TMO])) break; if (_sp > XB_SPIN_CAP) { atomicAdd(&(bar)[XB_TMO], 1u); break; } } } } while (0)

struct XcdBarrier {
    unsigned* bar; unsigned x; int wv;
    volatile LAS unsigned* st;
};

__device__ __forceinline__ XcdBarrier xcd_barrier_post(unsigned* bar, volatile LAS unsigned* st) {
    XcdBarrier b; b.bar = bar; b.x = xb_xcc_id(); b.st = st;
    if (threadIdx.x == 0) (void)xb_add(&bar[XB_XCNT(b.x)], 1u);
    return b;
}
__device__ __forceinline__ void xcd_barrier_complete(unsigned* bar, unsigned x, unsigned& nloc, unsigned& nx) {
    const unsigned G = gridDim.x * gridDim.y * gridDim.z;
    unsigned sum, cnt, mine, sp = 0u;
    for (;;) {
        sum = 0u; cnt = 0u; mine = 0u;
#pragma unroll
        for (unsigned j = 0; j < 16; ++j) { const unsigned c = xb_ld(&bar[XB_XCNT(j)]); sum += c; cnt += (c > 0u) ? 1u : 0u; mine = (j == x) ? c : mine; }
        if (sum == G) break;
        __builtin_amdgcn_s_sleep(1);
        if ((++sp & 255u) == 0u) { if (xb_ld(&bar[XB_TMO])) break; if (sp > XB_SPIN_CAP) { atomicAdd(&bar[XB_TMO], 1u); break; } }
    }
    nloc = mine > 0u ? mine : 1u; nx = cnt > 0u ? cnt : 1u;
}

__device__ __forceinline__ void xcd_barrier(const XcdBarrier& b) {
    asm volatile("s_waitcnt vmcnt(0)" ::: "memory");
    __syncthreads();
    if (b.wv == 0 && lane_id_v() == 0) {
        unsigned* bar = b.bar; asm volatile("" : "+s"(bar));
        __builtin_amdgcn_s_waitcnt(0);
        unsigned nloc = b.st[0], nx = b.st[1];
        if (nloc == 0u) { xcd_barrier_complete(bar, b.x, nloc, nx); b.st[0] = nloc; b.st[1] = nx; }
        const unsigned old = xb_add(&bar[XB_XSUB(b.x)], 1u);
        const unsigned gen = old / nloc;
        if (old + 1u == (gen + 1u) * nloc) {
            __builtin_amdgcn_fence(__ATOMIC_RELEASE, "agent");
            asm volatile("s_waitcnt vmcnt(0)" ::: "memory");
            const unsigned og = xb_add(&bar[XB_TOP], 1u);
            const unsigned tg = og / nx;
            if (og + 1u == (tg + 1u) * nx) xb_add(&bar[XB_TOPGEN], 1u);
            else XB_SPIN(xb_ld(&bar[XB_TOPGEN]) == tg, bar);
            __builtin_amdgcn_fence(__ATOMIC_ACQUIRE, "agent");
            xb_add(&bar[XB_XGEN(b.x)], 1u);
            asm volatile("s_waitcnt vmcnt(0)" ::: "memory");
        } else {
            XB_SPIN(xb_ld(&bar[XB_XGEN(b.x)]) == gen, bar);
            __builtin_amdgcn_fence(__ATOMIC_ACQUIRE, "agent");
            asm volatile("s_waitcnt vmcnt(0)" ::: "memory");
        }
    }
    __syncthreads();
}

using pg8::Unit;
constexpr float LOG2E = 1.4426950408889634f, QSCALE = 0.125f * LOG2E;
#define ROW_FENCE() asm volatile("" ::: "memory")
#define LDS_BARRIER() do { asm volatile("s_waitcnt lgkmcnt(0)" ::: "memory"); __builtin_amdgcn_s_barrier(); asm volatile("" ::: "memory"); } while (0)
__device__ __forceinline__ float row_rs(const float* ssq, int row) {
    const f32x4* p = (const f32x4*)(ssq + (size_t)row * 16);
    const f32x4 a = p[0], b = p[1], c = p[2], d = p[3];
    const float s = (((a[0] + a[1]) + (a[2] + a[3])) + ((b[0] + b[1]) + (b[2] + b[3]))) + (((c[0] + c[1]) + (c[2] + c[3])) + ((d[0] + d[1]) + (d[2] + d[3])));
    return rsqrtf(s * (1.0f / DM) + EPS);
}
__device__ __forceinline__ float row_rs4(const float* ssq, int row, int fq) {
    const f32x4 a = *(const f32x4*)(ssq + (size_t)row * 16 + 4 * fq);
    float s = (a[0] + a[1]) + (a[2] + a[3]);
    s += __shfl_xor(s, 16); s += __shfl_xor(s, 32);
    return rsqrtf(s * (1.0f / DM) + EPS);
}
typedef float f32x2_t __attribute__((ext_vector_type(2))); typedef __bf16 bf16x2_t __attribute__((ext_vector_type(2)));
__device__ __forceinline__ unsigned pkbf(float lo, float hi) { const f32x2_t v = {lo, hi}; const bf16x2_t b = __builtin_convertvector(v, bf16x2_t); return __builtin_bit_cast(unsigned, b); }
__device__ __forceinline__ u32x4 pack8(const f32x4 a, const f32x4 b) { u32x4 w; w.x = pkbf(a[0], a[1]); w.y = pkbf(a[2], a[3]); w.z = pkbf(b[0], b[1]); w.w = pkbf(b[2], b[3]); return w; }
__device__ __forceinline__ float bflo(unsigned w) { return __uint_as_float(w << 16); }
__device__ __forceinline__ float bfhi(unsigned w) { return __uint_as_float(w & 0xffff0000u); }

struct Epi1 {
    static constexpr bool PERM = true, AFTER_DRAIN = false, HAS_MID = false;
    int mid_t; Ptrs P; int l;
    __device__ __forceinline__ void operator()(const f32x4 (&acc)[2][2][4][2], const Unit& u, int wr, int wc, int fr0, int fq) const {
        int fr = fr0; asm volatile("" : "+v"(fr));
        const float* ssq = (const float*)(P.ws + WS_SSQ);
        const int pn = u.pn, c8 = wc * 32 + 8 * fq, row0 = u.pm * 256 + wr * 64 + fr;
        if (pn < 8) {
            bf16_t* dst = (bf16_t*)(P.ws + (pn < 4 ? WS_LX : WS_GG));
            const int colb = (pn & 3) * 256 + c8;
#pragma unroll
            for (int ai = 0; ai < 2; ++ai)
#pragma unroll
                for (int m = 0; m < 4; ++m) {
                    const int row = row0 + ai * 128 + m * 16; const float rs = row_rs4(ssq, row, fq);
#pragma unroll
                    for (int bj = 0; bj < 2; ++bj) {
                        f32x4 v0 = acc[ai][bj][m][0] * rs, v1 = acc[ai][bj][m][1] * rs; const int col = colb + bj * 128;
                        if (pn >= 4) {
#pragma unroll
                            for (int e = 0; e < 4; ++e) { v0[e] = gelu_tanh(v0[e]); v1[e] = gelu_tanh(v1[e]); }
                        }
                        *(u32x4*)(dst + (size_t)row * DR + col) = pack8(v0, v1);
                        if (pn < 4) {
                            if (row < MP) { const int t = row & (SEQ - 1); if (t >= SEQ - 3) { const int b = row >> 13; float* o = P.out + O_CONVP + ((size_t)(l * NB + b) * 3 + (t - (SEQ - 3))) * DR + col; *(f32x4*)o = v0; *(f32x4*)(o + 4) = v1; } }
                            else if (row < MT) { const int b = row - MP; float* cs = P.out + O_CONVS + (size_t)(l * SB + b) * 3 * DR + col; const float* sc = P.state_conv + (size_t)(l * SB + b) * 3 * DR + col;
                                *(f32x4*)cs = *(const f32x4*)(sc + DR); *(f32x4*)(cs + 4) = *(const f32x4*)(sc + DR + 4); *(f32x4*)(cs + DR) = *(const f32x4*)(sc + 2 * DR); *(f32x4*)(cs + DR + 4) = *(const f32x4*)(sc + 2 * DR + 4);
                                *(f32x4*)(cs + 2 * DR) = v0; *(f32x4*)(cs + 2 * DR + 4) = v1; }
                        }
                    }
                    ROW_FENCE();
                }
        } else if (pn < 26) {
            const int tq = pn - 8, type = tq / 6, head = 4 * (tq % 6) + wc, g = head >> 3, hh = head & 7;
            bf16_t* dst = (bf16_t*)(P.ws + (type == 0 ? WS_Q : (type == 1 ? WS_K : WS_V)));
            f32x4 gn[2][2];
#pragma unroll
            for (int bj = 0; bj < 2; ++bj)
#pragma unroll
                for (int n = 0; n < 2; ++n) gn[bj][n] = (f32x4){1.f, 1.f, 1.f, 1.f};
            if (type < 2) { const float* gp = (type == 0 ? P.q_gain : P.k_gain) + l * HD;
#pragma unroll
                for (int bj = 0; bj < 2; ++bj)
#pragma unroll
                    for (int n = 0; n < 2; ++n) gn[bj][n] = *(const f32x4*)(gp + 32 * bj + 8 * fq + 4 * n); }
            const int W = g_win(g);
#pragma unroll
            for (int ai = 0; ai < 2; ++ai)
#pragma unroll
                for (int m = 0; m < 4; ++m) {
                    const int row = row0 + ai * 128 + m * 16; const float rs = row_rs4(ssq, row, fq);
                    f32x4 v[2][2]; float ss = 0.f;
#pragma unroll
                    for (int bj = 0; bj < 2; ++bj)
#pragma unroll
                        for (int n = 0; n < 2; ++n) { v[bj][n] = acc[ai][bj][m][n] * rs; const f32x4 q = v[bj][n] * v[bj][n]; ss += (q[0] + q[1]) + (q[2] + q[3]); }
                    ss += __shfl_xor(ss, 16); ss += __shfl_xor(ss, 32);
                    const float inv = (type < 2) ? rsqrtf(ss * (1.0f / HD) + EPS) * (type == 0 ? QSCALE : 1.0f) : 1.0f;
#pragma unroll
                    for (int bj = 0; bj < 2; ++bj) {
                        v[bj][0] = v[bj][0] * inv * gn[bj][0]; v[bj][1] = v[bj][1] * inv * gn[bj][1];
                        *(u32x4*)(dst + (size_t)row * AW + head * HD + 32 * bj + 8 * fq) = pack8(v[bj][0], v[bj][1]);
                    }
                    if (type >= 1) {
                        float* o = nullptr;
                        if (row < MP) { const int t = row & (SEQ - 1), b = row >> 13; if (t >= SEQ - W) o = P.out + o_kvp(g) + ((((size_t)(l * NB + b) * W + (t - (SEQ - W))) * 2 + (type - 1)) * HPG + hh) * HD + 8 * fq; }
                        else if (row < MT) { const int b = row - MP; o = P.out + o_kvs(g) + (((size_t)(l * SB + b) * 2 + (type - 1)) * HPG + hh) * HD + 8 * fq; }
                        if (o) {
#pragma unroll
                            for (int bj = 0; bj < 2; ++bj) { *(f32x4*)(o + 32 * bj) = v[bj][0]; *(f32x4*)(o + 32 * bj + 4) = v[bj][1]; } }
                    }
                    ROW_FENCE();
                }
        } else {
            bf16_t* GM = (bf16_t*)(P.ws + WS_GM); const float* bm = P.b_merge + (size_t)l * 2048;
            const int colb = (pn - 26) * 128 + c8;
            f32x4 bv[2][2];
#pragma unroll
            for (int bj = 0; bj < 2; ++bj)
#pragma unroll
                for (int n = 0; n < 2; ++n) bv[bj][n] = *(const f32x4*)(bm + bj * 1024 + colb + 4 * n);
#pragma unroll
            for (int ai = 0; ai < 2; ++ai)
#pragma unroll
                for (int m = 0; m < 4; ++m) {
                    const int row = row0 + ai * 128 + m * 16; const float rs = row_rs4(ssq, row, fq);
                    f32x4 rho[2], gav[2];
#pragma unroll
                    for (int n = 0; n < 2; ++n) {
                        const f32x4 xl = acc[ai][0][m][n] * rs + bv[0][n], xa = acc[ai][1][m][n] * rs + bv[1][n];
#pragma unroll
                        for (int e = 0; e < 4; ++e) { const float el = __expf(-xl[e]), ea = fminf(__expf(-xa[e]), 1e30f); gav[n][e] = __builtin_amdgcn_rcpf(1.0f + ea); rho[n][e] = (1.0f + ea) * __builtin_amdgcn_rcpf(1.0f + el); }
                    }
                    *(u32x4*)(GM + (size_t)row * 2048 + colb) = pack8(rho[0], rho[1]);
                    *(u32x4*)(GM + (size_t)row * 2048 + 1024 + colb) = pack8(gav[0], gav[1]);
                    ROW_FENCE();
                }
        }
    }
};

struct Epi3 {
    static constexpr bool PERM = true, AFTER_DRAIN = false, HAS_MID = true;
    int mid_t; Ptrs P;
    __device__ __forceinline__ void mid(f32x4 (&acc)[2][2][4][2], const Unit& u, int wr, int wc, int fr, int fq) const {
        const bf16_t* GM = (const bf16_t*)(P.ws + WS_GM);
        int fr_ = fr; asm volatile("" : "+v"(fr_));
        const int colb = u.pn * 256 + wc * 32 + 8 * fq, row0 = u.pm * 256 + wr * 64 + fr_;
#pragma unroll
        for (int ai = 0; ai < 2; ++ai)
#pragma unroll
            for (int m = 0; m < 4; ++m) {
                const int row = row0 + ai * 128 + m * 16;
#pragma unroll
                for (int bj = 0; bj < 2; ++bj) {
                    const u32x4 gl = *(const u32x4*)(GM + (size_t)row * 2048 + colb + bj * 128);
                    const f32x4 r0 = (f32x4){bflo(gl.x), bfhi(gl.x), bflo(gl.y), bfhi(gl.y)}, r1 = (f32x4){bflo(gl.z), bfhi(gl.z), bflo(gl.w), bfhi(gl.w)};
                    acc[ai][bj][m][0] = acc[ai][bj][m][0] * r0; acc[ai][bj][m][1] = acc[ai][bj][m][1] * r1;
                }
                ROW_FENCE();
            }
    }
    __device__ __forceinline__ void operator()(const f32x4 (&acc)[2][2][4][2], const Unit& u, int wr, int wc, int fr0, int fq) const {
        int fr = fr0; asm volatile("" : "+v"(fr));
        const bf16_t* GM = (const bf16_t*)(P.ws + WS_GM); bf16_t* MRG = (bf16_t*)(P.ws + WS_MRG);
        const int colb = u.pn * 256 + wc * 32 + 8 * fq, row0 = u.pm * 256 + wr * 64 + fr;
#pragma unroll
        for (int ai = 0; ai < 2; ++ai)
#pragma unroll
            for (int m = 0; m < 4; ++m) {
                const int row = row0 + ai * 128 + m * 16;
#pragma unroll
                for (int bj = 0; bj < 2; ++bj) {
                    const u32x4 ga = *(const u32x4*)(GM + (size_t)row * 2048 + 1024 + colb + bj * 128);
                    const f32x4 g0 = (f32x4){bflo(ga.x), bfhi(ga.x), bflo(ga.y), bfhi(ga.y)}, g1 = (f32x4){bflo(ga.z), bfhi(ga.z), bflo(ga.w), bfhi(ga.w)};
                    *(u32x4*)(MRG + (size_t)row * DM + colb + bj * 128) = pack8(acc[ai][bj][m][0] * g0, acc[ai][bj][m][1] * g1);
                }
                ROW_FENCE();
            }
    }
};

struct EpiRes {
    static constexpr bool PERM = false, AFTER_DRAIN = false, HAS_MID = false;
    int mid_t; Ptrs P; int first; int dry;
    __device__ __forceinline__ void operator()(const f32x4 (&acc)[2][2][4][2], const Unit& u, int wr, int wc, int fr0, int fq) const {
        int fr = fr0; asm volatile("" : "+v"(fr));
        float* Y = P.out + O_Y; float* Yo = dry ? (float*)(P.ws + WS_DUMMY) : Y; bf16_t* XB = (bf16_t*)(P.ws + (dry ? WS_DUMMY + 80 * MiB : WS_XB)); float* ssq = (float*)(P.ws + (dry ? WS_DUMMY + 120 * MiB : WS_SSQ));
        const int colb = u.pn * 256 + wc * 32 + 4 * fq, row0 = u.pm * 256 + wr * 64 + fr;
#pragma unroll
        for (int ai = 0; ai < 2; ++ai)
#pragma unroll
            for (int m = 0; m < 4; ++m) {
                const int row = row0 + ai * 128 + m * 16; const bool live = row < MT;
                const float* base = first ? xin_row(P, live ? row : 0) : Y + (size_t)(live ? row : 0) * DM;
                float ss = 0.f;
#pragma unroll
                for (int bj = 0; bj < 2; ++bj)
#pragma unroll
                    for (int n = 0; n < 2; ++n) {
                        const int col = colb + bj * 128 + n * 16;
                        f32x4 v = acc[ai][bj][m][n];
                        if (live) { v = v + *(const f32x4*)(base + col); *(f32x4*)(Yo + (size_t)row * DM + col) = v; }
                        u32x2 w; w.x = pkbf(v[0], v[1]); w.y = pkbf(v[2], v[3]);
                        *(u32x2*)(XB + (size_t)row * DM + col) = w;
                        ss += (v[0] * v[0] + v[1] * v[1]) + (v[2] * v[2] + v[3] * v[3]);
                    }
                ss += __shfl_xor(ss, 16); ss += __shfl_xor(ss, 32);
                if (fq == 0) ssq[(size_t)row * 16 + u.pn * 4 + wc] = ss;
                ROW_FENCE();
            }
    }
};

struct Epi5 {
    static constexpr bool PERM = true, AFTER_DRAIN = false, HAS_MID = false;
    int mid_t; Ptrs P;
    __device__ __forceinline__ void operator()(const f32x4 (&acc)[2][2][4][2], const Unit& u, int wr, int wc, int fr0, int fq) const {
        int fr = fr0; asm volatile("" : "+v"(fr));
        const float* ssq = (const float*)(P.ws + WS_SSQ); bf16_t* H = (bf16_t*)(P.ws + WS_H);
        const int colb = u.pn * 128 + wc * 32 + 8 * fq, row0 = u.pm * 256 + wr * 64 + fr;
#pragma unroll
        for (int ai = 0; ai < 2; ++ai)
#pragma unroll
            for (int m = 0; m < 4; ++m) {
                const int row = row0 + ai * 128 + m * 16; const float rs = row_rs4(ssq, row, fq);
                f32x4 h[2];
#pragma unroll
                for (int n = 0; n < 2; ++n)
#pragma unroll
                    for (int e = 0; e < 4; ++e) { const float gt = acc[ai][0][m][n][e] * rs, up = acc[ai][1][m][n][e] * rs; h[n][e] = gt * sigmoidf_(gt) * up; }
                *(u32x4*)(H + (size_t)row * DFF + colb) = pack8(h[0], h[1]);
                ROW_FENCE();
            }
    }
};

__device__ __forceinline__ void tr_item(const float* W, int N, int s0, int k0, const float* gain, bf16_t* WT, int K, int r0, int kofs, LAS float* scr, int lane) {
    {
        f32x4 v[8]; const int kr = lane >> 3, c4 = 4 * (lane & 7);
#pragma unroll
        for (int i = 0; i < 8; ++i) v[i] = *(const f32x4*)(W + (size_t)(k0 + 8 * i + kr) * N + s0 + c4);
#pragma unroll
        for (int i = 0; i < 8; ++i) { const int kk = 8 * i + kr; const float gsc = gain ? gain[k0 + kk] : 1.0f; LAS float* d = scr + kk * 33 + c4;
            d[0] = v[i][0] * gsc; d[1] = v[i][1] * gsc; d[2] = v[i][2] * gsc; d[3] = v[i][3] * gsc; }
    }
    asm volatile("s_waitcnt lgkmcnt(0)" ::: "memory");
    const int c = lane & 7;
#pragma unroll
    for (int j = 0; j < 4; ++j) { const int n = (lane >> 3) + 8 * j; const LAS float* s = scr + (8 * c) * 33 + n;
        u32x4 o; o.x = pkbf(s[0 * 33], s[1 * 33]); o.y = pkbf(s[2 * 33], s[3 * 33]); o.z = pkbf(s[4 * 33], s[5 * 33]); o.w = pkbf(s[6 * 33], s[7 * 33]);
        *(u32x4*)(WT + (size_t)(r0 + n) * K + kofs + k0 + 8 * c) = o; }
    asm volatile("s_waitcnt lgkmcnt(0)" ::: "memory");
}
constexpr int IT_W1 = (N1 / 32) * (DM / 64), IT_W3A = (DM / 32) * (DR / 64), IT_W3B = (DM / 32) * (AO / 64), IT_W4 = (DM / 32) * (DM / 64), IT_W5 = (2 * DFF / 32) * (DM / 64), IT_W6 = (DM / 32) * (DFF / 64);
constexpr int IT_L = IT_W1 + IT_W3A + IT_W3B + IT_W4 + IT_W5 + IT_W6;
__device__ __forceinline__ void p0_prologue(const Ptrs& P, LAS unsigned char* lds, int gw, int ngw, int wv, int lane) {
    LAS float* scr = (LAS float*)(lds + wv * 16384);
    for (int it = gw; it < DEPTH * IT_L; it += ngw) {
        const int l = it / IT_L; int r = it % IT_L;
        unsigned char* wb = P.ws + WS_W + l * LW_BYTES;
        if (r < IT_W1) { const int kb = r & 15, nb = r >> 4, nt0 = 32 * nb, c = w1_src_col(nt0);
            if (c < 6656) tr_item(P.w_in + (size_t)l * DM * 6656, 6656, c, 64 * kb, P.norm_mix + l * DM, (bf16_t*)(wb + LW_W1), DM, nt0, 0, scr, lane);
            else tr_item(P.w_merge + (size_t)l * DM * 2048, 2048, c - 6656, 64 * kb, P.norm_mix + l * DM, (bf16_t*)(wb + LW_W1), DM, nt0, 0, scr, lane);
            continue; }
        r -= IT_W1;
        if (r < IT_W3A) { const int kb = r & 15, nb = r >> 4; tr_item(P.w_branch_lru + (size_t)l * DR * DM, DM, 32 * nb, 64 * kb, nullptr, (bf16_t*)(wb + LW_W3), K3, 32 * nb, 0, scr, lane); continue; }
        r -= IT_W3A;
        if (r < IT_W3B) { const int kb = r & 7, nb = r >> 3; tr_item(P.w_branch_att + (size_t)l * AO * DM, DM, 32 * nb, 64 * kb, nullptr, (bf16_t*)(wb + LW_W3), K3, 32 * nb, DR, scr, lane); continue; }
        r -= IT_W3B;
        if (r < IT_W4) { const int kb = r & 15, nb = r >> 4; tr_item(P.w_o + (size_t)l * DM * DM, DM, 32 * nb, 64 * kb, nullptr, (bf16_t*)(wb + LW_W4), DM, 32 * nb, 0, scr, lane); continue; }
        r -= IT_W4;
        if (r < IT_W5) { const int kb = r & 15, nb = r >> 4, nt0 = 32 * nb; tr_item(P.w_ffn_in + (size_t)l * DM * 2 * DFF, 2 * DFF, w5_src_col(nt0), 64 * kb, P.norm_ffn + l * DM, (bf16_t*)(wb + LW_W5), DM, nt0, 0, scr, lane); continue; }
        r -= IT_W5;
        { const int kb = r % 44, nb = r / 44; tr_item(P.w_ffn_out + (size_t)l * DFF * DM, DM, 32 * nb, 64 * kb, nullptr, (bf16_t*)(wb + LW_W6), DFF, 32 * nb, 0, scr, lane); }
    }
    float* BIAS = (float*)(P.ws + WS_BIAS);
    for (int e = gw * 64 + lane; e < NG * HPG * NKEY; e += ngw * 64) {
        const int kk = e % NKEY, hh = (e / NKEY) % HPG, g = e / (NKEY * HPG);
        const int d = kk * g_dil(g); int bkt;
        if (d < 16) bkt = d; else { const float df = (float)d; int lg = 16 + (int)(logf(df / 16.0f) / logf(128.0f) * 16.0f); bkt = lg < 31 ? lg : 31; }
        BIAS[e] = P.rel_bias[bkt * NH + 8 * g + hh] * LOG2E;
    }
    for (int row = gw; row < MT; row += ngw) {
        const f32x4* xr = (const f32x4*)xin_row(P, row) + lane; bf16_t* xb = (bf16_t*)(P.ws + WS_XB) + (size_t)row * DM; float* ssq = (float*)(P.ws + WS_SSQ) + (size_t)row * 16;
        float s = 0.f;
#pragma unroll
        for (int j = 0; j < 4; ++j) { const f32x4 v = xr[64 * j]; s += (v[0] * v[0] + v[1] * v[1]) + (v[2] * v[2] + v[3] * v[3]);
            u32x2 w; w.x = pkbf(v[0], v[1]); w.y = pkbf(v[2], v[3]); *(u32x2*)(xb + 4 * lane + 256 * j) = w; }
        s = wave_sum(s);
        if (lane < 16) ssq[lane] = (lane == 0) ? s : 0.f;
    }
}

__device__ __forceinline__ void ph_combine(const Ptrs& P, size_t gtid, size_t nth) {
    const bf16_t* OG = (const bf16_t*)(P.ws + WS_OG); const float* ML = (const float*)(P.ws + WS_ML); bf16_t* A3 = (bf16_t*)(P.ws + WS_A3);
    for (size_t e = gtid; e < (size_t)MT * 64; e += nth) {
        const size_t row = e >> 6; const int hh = (int)(e >> 3) & 7, ch = (int)e & 7;
        f32x2 q[3]; u32x4 og[3];
#pragma unroll
        for (int g = 0; g < 3; ++g) { q[g] = *(const f32x2*)(ML + (((size_t)g * MT + row) * HPG + hh) * 2); og[g] = *(const u32x4*)(OG + ((size_t)g * MT + row) * AO + hh * HD + 8 * ch); }
        const float mm = fmaxf(fmaxf(q[0].x, q[1].x), q[2].x);
        float z[3], den = 0.f;
#pragma unroll
        for (int g = 0; g < 3; ++g) { z[g] = q[g].y * __builtin_amdgcn_exp2f(q[g].x - mm); den += z[g]; }
        const float inv = 1.0f / den;
        f32x4 o0 = (f32x4){0.f, 0.f, 0.f, 0.f}, o1 = (f32x4){0.f, 0.f, 0.f, 0.f};
#pragma unroll
        for (int g = 0; g < 3; ++g) { const float w = z[g] * inv; const u32x4 v = og[g];
            o0 = o0 + (f32x4){bflo(v.x), bfhi(v.x), bflo(v.y), bfhi(v.y)} * w; o1 = o1 + (f32x4){bflo(v.z), bfhi(v.z), bflo(v.w), bfhi(v.w)} * w; }
        *(u32x4*)(A3 + row * K3 + DR + hh * HD + 8 * ch) = pack8(o0, o1);
    }
}

constexpr int SC_XCF = 0;
constexpr int SC_HSF = 34816;
constexpr int SC_XCB = 69632;
constexpr int SC_WTA = 88064;
constexpr int SC_WTX = 97280;
constexpr int SC_WTOT = 106496;
constexpr int SC_WC = 110592;
constexpr int SC_END = 111872;

template <int MODE>
__device__ __forceinline__ void scan_item(const Ptrs& P, int l, LAS unsigned char* lds, int wv, int tid_, int b, int n, int span) {
    int tid = tid_; asm volatile("" : "+v"(tid));
    const int lane = tid & 63, fr = lane & 15, fq = lane >> 4;
    LAS float* XCF = (LAS float*)(lds + SC_XCF); LAS float* HSF = (LAS float*)(lds + SC_HSF); LAS bf16_t* XCB = (LAS bf16_t*)(lds + SC_XCB);
    LAS bf16_t* WTA = (LAS bf16_t*)(lds + SC_WTA); LAS bf16_t* WTX = (LAS bf16_t*)(lds + SC_WTX);
    LAS f32x2* WTOT = (LAS f32x2*)(lds + SC_WTOT); LAS float* WC = (LAS float*)(lds + SC_WC);
    const bf16_t* LX = (const bf16_t*)(P.ws + WS_LX); const bf16_t* GG = (const bf16_t*)(P.ws + WS_GG); bf16_t* A3 = (bf16_t*)(P.ws + WS_A3);
    float* SUM = (float*)(P.ws + WS_SUM);
    __syncthreads();
    {
        const float* wa = P.w_rg_a + (size_t)(l * NBLK + n) * 4096; const float* wx = P.w_rg_x + (size_t)(l * NBLK + n) * 4096;
        for (int e = tid; e < 4096; e += 512) { const int i = e >> 6, j = e & 63; WTA[j * 72 + i] = f2b(wa[e]); WTX[j * 72 + i] = f2b(wx[e]); }
        if (tid < 320) { const int k = tid >> 6, c = tid & 63; WC[tid] = (k < 4) ? P.w_conv[(size_t)(l * CW + k) * DR + 64 * n + c] : P.b_conv[l * DR + 64 * n + c]; }
    }
    __syncthreads();
    bf16x8 wfa[4][2], wfx[4][2];
#pragma unroll
    for (int nt = 0; nt < 4; ++nt)
#pragma unroll
        for (int ks = 0; ks < 2; ++ks) { wfa[nt][ks] = *(const LAS bf16x8*)(WTA + (16 * nt + fr) * 72 + 32 * ks + 8 * fq); wfx[nt][ks] = *(const LAS bf16x8*)(WTX + (16 * nt + fr) * 72 + 32 * ks + 8 * fq); }
    float cba[4], cbx[4], csp[4], hc[4], pc[4];
#pragma unroll
    for (int nt = 0; nt < 4; ++nt) { const int ch = 64 * n + 16 * nt + fr;
        cba[nt] = P.b_rg_a[l * DR + ch]; cbx[nt] = P.b_rg_x[l * DR + ch]; csp[nt] = 8.0f * log1pf(expf(-P.lru_lambda[l * DR + ch]));
        float h = 0.f;
        if (MODE == 1) { for (int s = 0; s < span; ++s) { const f32x2 q = *(const f32x2*)(SUM + (((size_t)b * 8 + s) * DR + ch) * 2); h = q.x * h + q.y; } }
        hc[nt] = h; pc[nt] = 1.f; }
    u32x4 xr[2][4], gg[2];
#define SCAN_LOAD(C8) do { const int t0n = span * 1024 + (C8) * 128; _Pragma("unroll") for (int rep = 0; rep < 2; ++rep) { const int idx = tid + 512 * rep, tok = idx >> 3, cg = idx & 7, t = t0n + tok; const size_t rowg = (size_t)b * SEQ + t; \
        _Pragma("unroll") for (int k = 0; k < 4; ++k) { const int tt = t + k - 3; xr[rep][k] = *(const u32x4*)(LX + (rowg + (tt >= 0 ? k - 3 : -t)) * DR + 64 * n + 8 * cg); } \
        if (MODE == 1) gg[rep] = *(const u32x4*)(GG + rowg * DR + 64 * n + 8 * cg); } } while (0)
    SCAN_LOAD(0);
    for (int c8 = 0; c8 < 8; ++c8) {
        const int t0 = span * 1024 + c8 * 128;
        u32x4 gcur[2];
#pragma unroll
        for (int rep = 0; rep < 2; ++rep) {
            const int idx = tid + 512 * rep, tok = idx >> 3, cg = idx & 7, t = t0 + tok;
            float acc[8];
#pragma unroll
            for (int j = 0; j < 8; ++j) acc[j] = WC[4 * 64 + 8 * cg + j];
#pragma unroll
            for (int k = 0; k < 4; ++k) { const int tt = t + k - 3; const u32x4 x = xr[rep][k]; const float z = (tt >= 0) ? 1.0f : 0.0f;
                const LAS float* w = WC + k * 64 + 8 * cg;
                acc[0] += z * w[0] * bflo(x.x); acc[1] += z * w[1] * bfhi(x.x); acc[2] += z * w[2] * bflo(x.y); acc[3] += z * w[3] * bfhi(x.y);
                acc[4] += z * w[4] * bflo(x.z); acc[5] += z * w[5] * bfhi(x.z); acc[6] += z * w[6] * bflo(x.w); acc[7] += z * w[7] * bfhi(x.w); }
            *(LAS f32x4*)(XCF + tok * 68 + 8 * cg) = (f32x4){acc[0], acc[1], acc[2], acc[3]}; *(LAS f32x4*)(XCF + tok * 68 + 8 * cg + 4) = (f32x4){acc[4], acc[5], acc[6], acc[7]};
            *(LAS u32x4*)(XCB + tok * 72 + 8 * cg) = pack8((f32x4){acc[0], acc[1], acc[2], acc[3]}, (f32x4){acc[4], acc[5], acc[6], acc[7]});
            if (MODE == 1) gcur[rep] = gg[rep];
        }
        asm volatile("" ::: "memory");
        if (c8 + 1 < 8) SCAN_LOAD(c8 + 1);
        LDS_BARRIER();
        bf16x8 af[2];
#pragma unroll
        for (int ks = 0; ks < 2; ++ks) af[ks] = *(const LAS bf16x8*)(XCB + (16 * wv + fr) * 72 + 32 * ks + 8 * fq);
        float hl[4][4], ac[4][4], Ae[4], He[4];
#pragma unroll
        for (int nt = 0; nt < 4; ++nt) {
            f32x4 da = (f32x4){0.f, 0.f, 0.f, 0.f}, dx = (f32x4){0.f, 0.f, 0.f, 0.f};
#pragma unroll
            for (int ks = 0; ks < 2; ++ks) { da = __builtin_amdgcn_mfma_f32_16x16x32_bf16(af[ks], wfa[nt][ks], da, 0, 0, 0); dx = __builtin_amdgcn_mfma_f32_16x16x32_bf16(af[ks], wfx[nt][ks], dx, 0, 0, 0); }
            float A = 1.f, H = 0.f;
#pragma unroll
            for (int r = 0; r < 4; ++r) {
                const int tok = 16 * wv + 4 * fq + r;
                const float rr = sigmoidf_(da[r] + cba[nt]), ii = sigmoidf_(dx[r] + cbx[nt]);
                const float av = __expf(-rr * csp[nt]);
                float mult = sqrtf(fmaxf(fmaf(-av, av, 1.0f), 0.f)); if (t0 + tok == 0) mult = 1.0f;
                const float u = mult * ii * XCF[tok * 68 + 16 * nt + fr];
                H = av * H + u; A = A * av; hl[nt][r] = H; ac[nt][r] = A;
            }
            { const float A1 = __shfl(A, lane - 16), H1 = __shfl(H, lane - 16); if (fq >= 1) { H = A * H1 + H; A = A * A1; } }
            { const float A2 = __shfl(A, lane - 32), H2 = __shfl(H, lane - 32); if (fq >= 2) { H = A * H2 + H; A = A * A2; } }
            { const float A3_ = __shfl(A, lane - 16), H3 = __shfl(H, lane - 16); Ae[nt] = (fq >= 1) ? A3_ : 1.f; He[nt] = (fq >= 1) ? H3 : 0.f; }
            if (fq == 3) WTOT[wv * 64 + 16 * nt + fr] = (f32x2){A, H};
        }
        LDS_BARRIER();
#pragma unroll
        for (int nt = 0; nt < 4; ++nt) {
            float hrun = hc[nt], prun = pc[nt], hin = 0.f;
#pragma unroll
            for (int w = 0; w < 8; ++w) { const f32x2 q = WTOT[w * 64 + 16 * nt + fr]; if (w == wv) hin = hrun; hrun = q.x * hrun + q.y; prun = prun * q.x; }
            hc[nt] = hrun; pc[nt] = prun;
            if (MODE == 1) {
#pragma unroll
                for (int r = 0; r < 4; ++r) { const int tok = 16 * wv + 4 * fq + r; HSF[tok * 68 + 16 * nt + fr] = (ac[nt][r] * Ae[nt]) * hin + (ac[nt][r] * He[nt] + hl[nt][r]); }
            }
        }
        if (MODE == 1) {
            LDS_BARRIER();
#pragma unroll
            for (int rep = 0; rep < 2; ++rep) {
                const int idx = tid + 512 * rep, tok = idx >> 3, cg = idx & 7; const size_t rowg = (size_t)b * SEQ + t0 + tok;
                const f32x4 h0 = *(const LAS f32x4*)(HSF + tok * 68 + 8 * cg), h1 = *(const LAS f32x4*)(HSF + tok * 68 + 8 * cg + 4);
                const u32x4 g = gcur[rep];
                const f32x4 o0 = (f32x4){h0[0] * bflo(g.x), h0[1] * bfhi(g.x), h0[2] * bflo(g.y), h0[3] * bfhi(g.y)}, o1 = (f32x4){h1[0] * bflo(g.z), h1[1] * bfhi(g.z), h1[2] * bflo(g.w), h1[3] * bfhi(g.w)};
                *(u32x4*)(A3 + rowg * K3 + 64 * n + 8 * cg) = pack8(o0, o1);
            }
        }
    }
#undef SCAN_LOAD
    if (wv == 0 && fq == 0) {
#pragma unroll
        for (int nt = 0; nt < 4; ++nt) { const int ch = 64 * n + 16 * nt + fr;
            if (MODE == 0) *(f32x2*)(SUM + (((size_t)b * 8 + span) * DR + ch) * 2) = (f32x2){pc[nt], hc[nt]};
            else if (span == 7) P.out[O_HP + (size_t)(l * NB + b) * DR + ch] = hc[nt]; }
    }
}
__device__ __forceinline__ void scan_sample(const Ptrs& P, int l, LAS unsigned char* lds, int tid, int rg, int n) {
    LAS float* XS = (LAS float*)lds;
    const int r = tid >> 6, j = tid & 63, b = 8 * rg + r, ch = 64 * n + j; const size_t row = (size_t)MP + b;
    const bf16_t* LX = (const bf16_t*)(P.ws + WS_LX); const bf16_t* GG = (const bf16_t*)(P.ws + WS_GG); bf16_t* A3 = (bf16_t*)(P.ws + WS_A3);
    const float* wc = P.w_conv + (size_t)l * CW * DR; const float* sc = P.state_conv + (size_t)(l * SB + b) * 3 * DR;
    const float xc = P.b_conv[l * DR + ch] + wc[ch] * sc[ch] + wc[DR + ch] * sc[DR + ch] + wc[2 * DR + ch] * sc[2 * DR + ch] + wc[3 * DR + ch] * bf2f(LX[row * DR + ch]);
    __syncthreads();
    XS[r * 64 + j] = xc;
    __syncthreads();
    const float* wa = P.w_rg_a + (size_t)(l * NBLK + n) * 4096 + j; const float* wx = P.w_rg_x + (size_t)(l * NBLK + n) * 4096 + j;
    float ga = P.b_rg_a[l * DR + ch], gx = P.b_rg_x[l * DR + ch];
#pragma unroll 1
    for (int i0 = 0; i0 < 64; i0 += 16) {
        float wa_[16], wx_[16];
#pragma unroll
        for (int i = 0; i < 16; ++i) { wa_[i] = wa[(i0 + i) * 64]; wx_[i] = wx[(i0 + i) * 64]; }
#pragma unroll
        for (int i = 0; i < 16; ++i) { const float x = XS[r * 64 + i0 + i]; ga += x * wa_[i]; gx += x * wx_[i]; }
    }
    const float rr = sigmoidf_(ga), ii = sigmoidf_(gx);
    const float log_a = -8.0f * rr * log1pf(expf(-P.lru_lambda[l * DR + ch])); const float av = expf(log_a);
    const float mult = sqrtf(-expm1f(2.0f * log_a));
    const float h = av * P.state_h[(size_t)(l * SB + b) * DR + ch] + mult * ii * xc;
    P.out[O_HS + (size_t)(l * SB + b) * DR + ch] = h;
    A3[row * K3 + ch] = f2b(h * bf2f(GG[row * DR + ch]));
}

constexpr int AT_K = 0, AT_V = 49152, AT_B = 98304, AT_W = 99328, AT_O = 101376, AT_END = 134144;
typedef float f32x16 __attribute__((ext_vector_type(16)));
typedef short s16x4 __attribute__((ext_vector_type(4)));
__device__ __forceinline__ int crow(int r, int hi) { return (r & 3) + 8 * (r >> 2) + 4 * hi; }
__device__ __forceinline__ s16x4 ds_tr16(const LAS unsigned char* p) { return __builtin_bit_cast(s16x4, __builtin_amdgcn_ds_read_tr16_b64_v4i16((LAS s16x4*)p)); }
struct AttnUnit { int g, b, hh, d, rho, u, head, j0; size_t rowbase; };
__device__ __forceinline__ AttnUnit attn_decode(int unit) {
    AttnUnit a; a.g = unit >> 9; const int rem = unit & 511; a.b = rem >> 8; a.hh = (rem >> 5) & 7; const int ru = rem & 31;
    a.d = g_dil(a.g); const int nub = 32 / a.d; a.rho = ru / nub; a.u = ru % nub; a.head = 8 * a.g + a.hh; a.j0 = 256 * a.u; a.rowbase = (size_t)a.b * SEQ + a.rho; return a;
}
__device__ __forceinline__ void attn_load(const Ptrs& P, const AttnUnit& a, int tid, u32x4 (&kq)[6], u32x4 (&vq)[6]) {
    const bf16_t* K = (const bf16_t*)(P.ws + WS_K); const bf16_t* V = (const bf16_t*)(P.ws + WS_V);
#pragma unroll
    for (int i = 0; i < 6; ++i) {
        const int idx = tid + 512 * i, key = idx >> 3, ch = idx & 7, j = a.j0 - 128 + key;
        const size_t off = (a.rowbase + (size_t)a.d * (j < 0 ? 0 : j)) * AW + a.head * HD + 8 * ch;
        kq[i] = *(const u32x4*)(K + off); vq[i] = *(const u32x4*)(V + off);
    }
}
__device__ __forceinline__ void attn_loadq(const Ptrs& P, const AttnUnit& a, int wv, int tid, bf16x8 (&qf)[4]) {
    const bf16_t* Q = (const bf16_t*)(P.ws + WS_Q);
    const int lane = tid & 63, l31 = lane & 31, hi = lane >> 5;
    const size_t rq = (a.rowbase + (size_t)a.d * (a.j0 + 32 * wv + l31)) * AW + a.head * HD + 8 * hi;
#pragma unroll
    for (int ks = 0; ks < 4; ++ks) qf[ks] = *(const bf16x8*)(Q + rq + 16 * ks);
}
__device__ __forceinline__ void attn_phase(const Ptrs& P, int l, LAS unsigned char* lds, int wv, int tid, int bid, int G) {
    const int lane = tid & 63, l31 = lane & 31, hi = lane >> 5;
    LAS float* BL = (LAS float*)(lds + AT_B); LAS float* LW = (LAS float*)(lds + AT_W) + wv * 64; LAS bf16_t* OS = (LAS bf16_t*)(lds + AT_O) + wv * 2048;
    u32x4 kq[6], vq[6]; float bl = 0.f;
    int unit = bid;
    if (unit >= 1536) return;
    AttnUnit a = attn_decode(unit);
    attn_load(P, a, tid, kq, vq); if (tid < NKEY) bl = ((const float*)(P.ws + WS_BIAS))[(size_t)(a.g * HPG + a.hh) * NKEY + tid];
    bf16x8 qn[4];
    attn_loadq(P, a, wv, tid, qn);
    for (; unit < 1536; unit += G) {
        LDS_BARRIER();
        int tl = tid; asm volatile("" : "+v"(tl));
#pragma unroll
        for (int i = 0; i < 6; ++i) {
            const int idx = tl + 512 * i, key = idx >> 3, ch = idx & 7; const unsigned msk = (a.j0 - 128 + key >= 0) ? 0xffffffffu : 0u;
            *(LAS u32x4*)(lds + AT_K + key * 128 + ((ch ^ ((key >> 1) & 7)) << 4)) = kq[i] & msk;
            *(LAS u32x4*)(lds + AT_V + key * 128 + (ch << 4)) = vq[i] & msk;
        }
        if (tl < NKEY) BL[tl] = bl;
        const AttnUnit cur = a;
        bf16x8 qf[4];
#pragma unroll
        for (int ks = 0; ks < 4; ++ks) qf[ks] = qn[ks];
        LDS_BARRIER();
        f32x16 S[5];
#pragma unroll
        for (int c = 0; c < 5; ++c) {
            const int key = 32 * (wv + c) + l31;
            f32x16 acc = {};
#pragma unroll
            for (int ks = 0; ks < 4; ++ks) {
                const bf16x8 kf = *(const LAS bf16x8*)(lds + AT_K + key * 128 + (((2 * ks + hi) ^ ((key >> 1) & 7)) << 4));
                acc = __builtin_amdgcn_mfma_f32_32x32x16_bf16(kf, qf[ks], acc, 0, 0, 0);
            }
            S[c] = acc;
            if (c & 1) asm volatile("" ::: "memory");
        }
        asm volatile("" ::: "memory");
        if (unit + G < 1536) { a = attn_decode(unit + G); attn_load(P, a, tid, kq, vq); attn_loadq(P, a, wv, tid, qn); if (tid < NKEY) bl = ((const float*)(P.ws + WS_BIAS))[(size_t)(a.g * HPG + a.hh) * NKEY + tid]; }
        float mx = -INFINITY;
#pragma unroll
        for (int c = 0; c < 5; ++c) {
            const bool tile_ok = (cur.u > 0) || (wv + c >= 4);
#pragma unroll
            for (int r = 0; r < 16; ++r) {
                const int dist = 128 - 32 * c + l31 - crow(r, hi);
                const int dcl = (c == 0) ? (dist > 128 ? 128 : dist) : ((c == 4) ? (dist < 0 ? 0 : dist) : dist);
                const float bv = BL[dcl];
                float s = S[c][r] + bv;
                if (c == 0) s = (dist > 128) ? -INFINITY : s;
                if (c == 4) s = (dist < 0) ? -INFINITY : s;
                s = tile_ok ? s : -INFINITY;
                S[c][r] = s; mx = fmaxf(mx, s);
            }
        }
        mx = fmaxf(mx, __shfl_xor(mx, 32));
        float lsum = 0.f;
        u32x4 pw[5][2];
#pragma unroll
        for (int c = 0; c < 5; ++c)
#pragma unroll
            for (int s = 0; s < 2; ++s) {
                float p[8];
#pragma unroll
                for (int j = 0; j < 8; ++j) { p[j] = __builtin_amdgcn_exp2f(S[c][8 * s + j] - mx); lsum += p[j]; }
                pw[c][s].x = pkbf(p[0], p[1]); pw[c][s].y = pkbf(p[2], p[3]); pw[c][s].z = pkbf(p[4], p[5]); pw[c][s].w = pkbf(p[6], p[7]);
            }
        lsum += __shfl_xor(lsum, 32);
        if (hi == 0) { LW[l31] = lsum;
            float* ML = (float*)(P.ws + WS_ML) + (((size_t)cur.g * MT + cur.rowbase + (size_t)cur.d * (cur.j0 + 32 * wv + l31)) * HPG + cur.hh) * 2; *(f32x2*)ML = (f32x2){mx, lsum}; }
        f32x16 o[2]; o[0] = (f32x16){}; o[1] = (f32x16){};
        const int g16 = lane >> 4, i16 = lane & 15;
        const LAS unsigned char* vb = lds + AT_V + (4 * hi + (i16 >> 2)) * 128 + (16 * (g16 & 1) + 4 * (i16 & 3)) * 2;
#pragma unroll
        for (int c = 0; c < 5; ++c)
#pragma unroll
            for (int s = 0; s < 2; ++s) {
                const bf16x8 pa = __builtin_bit_cast(bf16x8, pw[c][s]);
                const LAS unsigned char* vp = vb + (32 * (wv + c) + 16 * s) * 128;
#pragma unroll
                for (int db = 0; db < 2; ++db) {
                    const s16x4 lo = ds_tr16(vp + 64 * db), hi4 = ds_tr16(vp + 64 * db + 8 * 128);
                    const bf16x8 vf = (bf16x8){lo[0], lo[1], lo[2], lo[3], hi4[0], hi4[1], hi4[2], hi4[3]};
                    o[db] = __builtin_amdgcn_mfma_f32_32x32x16_bf16(pa, vf, o[db], 0, 0, 0);
                }
            }
        int lo_ = lane; asm volatile("" : "+v"(lo_)); const int l31o = lo_ & 31, hio = lo_ >> 5;
#pragma unroll
        for (int r = 0; r < 16; ++r) {
            const int q = crow(r, hio); const float inv = __builtin_amdgcn_rcpf(LW[q]);
            const unsigned w = pkbf(o[0][r] * inv, o[1][r] * inv);
            OS[q * 64 + l31o] = (bf16_t)(w & 0xffffu); OS[q * 64 + 32 + l31o] = (bf16_t)(w >> 16);
        }
        asm volatile("s_waitcnt lgkmcnt(0)" ::: "memory");
        bf16_t* OG = (bf16_t*)(P.ws + WS_OG) + (size_t)cur.g * MT * AO;
#pragma unroll
        for (int i = 0; i < 4; ++i) {
            const int q = 8 * i + (lo_ >> 3), ch = lo_ & 7;
            const u32x4 v = *(const LAS u32x4*)(OS + q * 64 + 8 * ch);
            *(u32x4*)(OG + (cur.rowbase + (size_t)cur.d * (cur.j0 + 32 * wv + q)) * AO + cur.hh * HD + 8 * ch) = v;
        }
    }
}
__device__ __forceinline__ void attn_sample(const Ptrs& P, int l, LAS unsigned char* lds, int wv, int lane, int item) {
    const int b = item / NH, head = item % NH, g = head >> 3, hh = head & 7, dil = g_dil(g), Lc = g_win(g);
    const bf16_t* Q = (const bf16_t*)(P.ws + WS_Q); const bf16_t* K = (const bf16_t*)(P.ws + WS_K); const bf16_t* V = (const bf16_t*)(P.ws + WS_V);
    const float* BIAS = (const float*)(P.ws + WS_BIAS) + (size_t)(g * HPG + hh) * NKEY;
    const float* cache = P.cache[g] + (size_t)(l * SB + b) * Lc * 1024;
    const size_t row = (size_t)MP + b;
    LAS float* qw = (LAS float*)(lds + AT_W) + wv * 64;
    qw[lane] = bf2f(Q[row * AW + head * HD + lane]);
    asm volatile("s_waitcnt lgkmcnt(0)" ::: "memory");
    float s[3];
#pragma unroll
    for (int j = 0; j < 3; ++j) { const int kk = lane + 64 * j; float acc = -INFINITY;
        if (kk <= 128) { acc = 0.f;
            if (kk == 0) { const bf16_t* kr = K + row * AW + head * HD; for (int dd = 0; dd < HD; ++dd) acc += qw[dd] * bf2f(kr[dd]); }
            else { const f32x4* kr = (const f32x4*)(cache + ((size_t)(Lc - kk * dil) * 2 + 0) * 512 + hh * HD);
#pragma unroll
                for (int dd = 0; dd < 16; ++dd) { const f32x4 kv = kr[dd]; const f32x4 qv = *(const LAS f32x4*)(qw + 4 * dd); acc += (kv[0] * qv[0] + kv[1] * qv[1]) + (kv[2] * qv[2] + kv[3] * qv[3]); } }
            acc = acc + BIAS[kk]; }
        s[j] = acc; }
    const float m = wave_max(fmaxf(fmaxf(s[0], s[1]), s[2]));
    float p[3]; float lsum = 0.f;
#pragma unroll
    for (int j = 0; j < 3; ++j) { p[j] = (lane + 64 * j <= 128) ? __builtin_amdgcn_exp2f(s[j] - m) : 0.f; lsum += p[j]; }
    lsum = wave_sum(lsum);
    float o = __shfl(p[0], 0) * bf2f(V[row * AW + head * HD + lane]);
#pragma unroll 1
    for (int k0 = 1; k0 <= 128; k0 += 32) {
        float vv[32];
#pragma unroll
        for (int i = 0; i < 32; ++i) vv[i] = cache[((size_t)(Lc - (k0 + i) * dil) * 2 + 1) * 512 + hh * HD + lane];
#pragma unroll
        for (int i = 0; i < 32; ++i) { const int kk = k0 + i; const float pk = __shfl(kk < 64 ? p[0] : (kk < 128 ? p[1] : p[2]), kk & 63); o += pk * vv[i]; }
    }
    bf16_t* OG = (bf16_t*)(P.ws + WS_OG) + ((size_t)g * MT + row) * AO; OG[hh * HD + lane] = f2b(o / lsum);
    if (lane == 0) { float* ML = (float*)(P.ws + WS_ML) + (((size_t)g * MT + row) * HPG + hh) * 2; ML[0] = m; ML[1] = lsum; }
}

template <int NSTEP>
__device__ __forceinline__ void sg_part(const bf16_t* A, int lda, const bf16_t* Bt, int ldb, int k0, int colbase, LAS float* TLP, int wv, int lane) {
    const int l31 = lane & 31, hi = lane >> 5, cb = wv & 1, kq = wv >> 1;
    const bf16_t* ap = A + (size_t)l31 * lda + k0 + kq * (NSTEP * 16) + 8 * hi;
    const bf16_t* bp = Bt + (size_t)(colbase + 128 * cb + l31) * ldb + k0 + kq * (NSTEP * 16) + 8 * hi;
    f32x16 acc = {};
    int s = 0;
#pragma unroll 1
    for (; s + 8 <= NSTEP; s += 8) {
        bf16x8 a[8], b[8];
#pragma unroll
        for (int i = 0; i < 8; ++i) { a[i] = *(const bf16x8*)(ap + 16 * (s + i)); b[i] = *(const bf16x8*)(bp + 16 * (s + i)); }
#pragma unroll
        for (int i = 0; i < 8; ++i) acc = __builtin_amdgcn_mfma_f32_32x32x16_bf16(a[i], b[i], acc, 0, 0, 0);
    }
    if (NSTEP & 4) {
        bf16x8 a[4], b[4];
#pragma unroll
        for (int i = 0; i < 4; ++i) { a[i] = *(const bf16x8*)(ap + 16 * (s + i)); b[i] = *(const bf16x8*)(bp + 16 * (s + i)); }
#pragma unroll
        for (int i = 0; i < 4; ++i) acc = __builtin_amdgcn_mfma_f32_32x32x16_bf16(a[i], b[i], acc, 0, 0, 0);
    }
    LAS float* t = TLP + kq * 2048 + 32 * cb + l31;
#pragma unroll
    for (int r = 0; r < 16; ++r) t[crow(r, hi) * 64] = acc[r];
}
__device__ __forceinline__ f32x4 sg_sum(const LAS float* TLP, int r, int q) {
    const LAS f32x4* p = (const LAS f32x4*)(TLP + r * 64 + 4 * q);
    return (p[0] + p[512]) + (p[1024] + p[1536]);
}
__device__ __forceinline__ float red16(float v) { v += __shfl_xor(v, 1); v += __shfl_xor(v, 2); v += __shfl_xor(v, 4); v += __shfl_xor(v, 8); return v; }

template <int WHICH>
__device__ __forceinline__ void sample_strip(const Ptrs& P, int l, LAS unsigned char* lds, int wv, int tid, int s, int first) {
    const int lane = tid & 63, pn = s >> 2, wc = s & 3, colbase = 256 * pn + 32 * wc;
    unsigned char* ws = P.ws; unsigned char* wb = ws + WS_W + l * LW_BYTES;
    LAS float* TLP = (LAS float*)lds; LAS float* TLP2 = TLP + 8192;
    __syncthreads();
    if (WHICH == 1) sg_part<16>((const bf16_t*)(ws + WS_XB) + (size_t)MP * DM, DM, (const bf16_t*)(wb + LW_W1), DM, 0, colbase, TLP, wv, lane);
    if (WHICH == 3) { sg_part<16>((const bf16_t*)(ws + WS_A3) + (size_t)MP * K3, K3, (const bf16_t*)(wb + LW_W3), K3, 0, colbase, TLP, wv, lane);
                      sg_part<8>((const bf16_t*)(ws + WS_A3) + (size_t)MP * K3, K3, (const bf16_t*)(wb + LW_W3), K3, DR, colbase, TLP2, wv, lane); }
    if (WHICH == 4) sg_part<16>((const bf16_t*)(ws + WS_MRG) + (size_t)MP * DM, DM, (const bf16_t*)(wb + LW_W4), DM, 0, colbase, TLP, wv, lane);
    if (WHICH == 5) sg_part<16>((const bf16_t*)(ws + WS_XB) + (size_t)MP * DM, DM, (const bf16_t*)(wb + LW_W5), DM, 0, colbase, TLP, wv, lane);
    if (WHICH == 6) sg_part<44>((const bf16_t*)(ws + WS_H) + (size_t)MP * DFF, DFF, (const bf16_t*)(wb + LW_W6), DFF, 0, colbase, TLP, wv, lane);
    __syncthreads();
    const int r = tid >> 4, q = tid & 15, c0 = 4 * q, cb = q >> 3, i0 = c0 & 31;
    const size_t row = (size_t)MP + r;
    f32x4 y = sg_sum(TLP, r, q);
    const float* ssq = (const float*)(ws + WS_SSQ);
    if (WHICH == 1) {
        const float rs = row_rs(ssq, (int)row);
        const f32x4 v = y * rs;
        if (pn < 8) {
            const int col = (pn & 3) * 256 + 128 * cb + 32 * wc + i0;
            if (pn < 4) {
                u32x2 w; w.x = pkbf(v[0], v[1]); w.y = pkbf(v[2], v[3]); *(u32x2*)((bf16_t*)(ws + WS_LX) + row * DR + col) = w;
                float* cs = P.out + O_CONVS + (size_t)(l * SB + r) * 3 * DR + col; const float* sc = P.state_conv + (size_t)(l * SB + r) * 3 * DR + col;
                *(f32x4*)cs = *(const f32x4*)(sc + DR); *(f32x4*)(cs + DR) = *(const f32x4*)(sc + 2 * DR); *(f32x4*)(cs + 2 * DR) = v;
            } else {
                u32x2 w; w.x = pkbf(gelu_tanh(v[0]), gelu_tanh(v[1])); w.y = pkbf(gelu_tanh(v[2]), gelu_tanh(v[3])); *(u32x2*)((bf16_t*)(ws + WS_GG) + row * DR + col) = w;
            }
        } else if (pn < 26) {
            const int tq = pn - 8, type = tq / 6, head = 4 * (tq % 6) + wc, g = head >> 3, hh = head & 7;
            f32x4 o = v;
            const float ss = red16((v[0] * v[0] + v[1] * v[1]) + (v[2] * v[2] + v[3] * v[3]));
            if (type < 2) { const float inv = rsqrtf(ss * (1.0f / HD) + EPS) * (type == 0 ? QSCALE : 1.0f); const f32x4 gn = *(const f32x4*)((type == 0 ? P.q_gain : P.k_gain) + l * HD + c0); o = v * inv * gn; }
            bf16_t* dst = (bf16_t*)(ws + (type == 0 ? WS_Q : (type == 1 ? WS_K : WS_V)));
            u32x2 w; w.x = pkbf(o[0], o[1]); w.y = pkbf(o[2], o[3]); *(u32x2*)(dst + row * AW + head * HD + c0) = w;
            if (type >= 1) *(f32x4*)(P.out + o_kvs(g) + (((size_t)(l * SB + r) * 2 + (type - 1)) * HPG + hh) * HD + c0) = o;
        } else if (q < 8) {
            const f32x4 ya = sg_sum(TLP, r, q + 8);
            const float* bm = P.b_merge + (size_t)l * 2048; const int col = (pn - 26) * 128 + 32 * wc + i0;
            const f32x4 xl = v + *(const f32x4*)(bm + col), xa = ya * rs + *(const f32x4*)(bm + 1024 + col);
            f32x4 rho, gav;
#pragma unroll
            for (int e = 0; e < 4; ++e) { const float el = __expf(-xl[e]), ea = fminf(__expf(-xa[e]), 1e30f); gav[e] = __builtin_amdgcn_rcpf(1.0f + ea); rho[e] = (1.0f + ea) * __builtin_amdgcn_rcpf(1.0f + el); }
            bf16_t* GM = (bf16_t*)(ws + WS_GM) + row * 2048;
            u32x2 w; w.x = pkbf(rho[0], rho[1]); w.y = pkbf(rho[2], rho[3]); *(u32x2*)(GM + col) = w;
            w.x = pkbf(gav[0], gav[1]); w.y = pkbf(gav[2], gav[3]); *(u32x2*)(GM + 1024 + col) = w;
        }
    } else if (WHICH == 3) {
        const f32x4 y2 = sg_sum(TLP2, r, q);
        const int col = 256 * pn + 128 * cb + 32 * wc + i0;
        const bf16_t* GM = (const bf16_t*)(ws + WS_GM) + row * 2048;
        const u32x2 gl = *(const u32x2*)(GM + col), ga = *(const u32x2*)(GM + 1024 + col);
        const f32x4 rho = (f32x4){bflo(gl.x), bfhi(gl.x), bflo(gl.y), bfhi(gl.y)}, gav = (f32x4){bflo(ga.x), bfhi(ga.x), bflo(ga.y), bfhi(ga.y)};
        const f32x4 mg = gav * (rho * y + y2);
        u32x2 w; w.x = pkbf(mg[0], mg[1]); w.y = pkbf(mg[2], mg[3]); *(u32x2*)((bf16_t*)(ws + WS_MRG) + row * DM + col) = w;
    } else if (WHICH == 4 || WHICH == 6) {
        const int col = 256 * pn + 128 * cb + 32 * wc + i0;
        float* Y = P.out + O_Y + row * DM + col;
        const f32x4 base = first ? *(const f32x4*)(P.x_sample + (size_t)r * DM + col) : *(const f32x4*)Y;
        const f32x4 v = base + y;
        *(f32x4*)Y = v;
        u32x2 w; w.x = pkbf(v[0], v[1]); w.y = pkbf(v[2], v[3]); *(u32x2*)((bf16_t*)(ws + WS_XB) + row * DM + col) = w;
        const float ss = red16((v[0] * v[0] + v[1] * v[1]) + (v[2] * v[2] + v[3] * v[3]));
        if (q == 0) ((float*)(ws + WS_SSQ))[row * 16 + pn * 4 + wc] = ss;
    } else if (WHICH == 5) {
        if (q < 8) {
            const float rs = row_rs(ssq, (int)row);
            const f32x4 yu = sg_sum(TLP, r, q + 8);
            f32x4 h;
#pragma unroll
            for (int e = 0; e < 4; ++e) { const float gt = y[e] * rs, up = yu[e] * rs; h[e] = gt * sigmoidf_(gt) * up; }
            u32x2 w; w.x = pkbf(h[0], h[1]); w.y = pkbf(h[2], h[3]); *(u32x2*)((bf16_t*)(ws + WS_H) + row * DFF + pn * 128 + 32 * wc + i0) = w;
        }
    }
}

constexpr int RING_BYTES = 131072, LDS_BYTES = 147456, LDSCTL_OFF = LDS_BYTES - 1024, MISC_OFF = LDSCTL_OFF + 320;
static_assert(AT_END <= LDSCTL_OFF && SC_END <= LDSCTL_OFF && RING_BYTES <= LDSCTL_OFF, "LDS map");
constexpr int CW_BAR = 4096;
constexpr int NPH = 1 + 8 * DEPTH;
#ifndef PHMASK
#define PHMASK 63
#endif
struct Args { Ptrs P; int ph_lo, ph_hi, pad0, pad1; };

__global__ void __launch_bounds__(512, 2) mega(Args a) {
    extern __shared__ __attribute__((aligned(16))) unsigned char lds_raw[];
    LAS unsigned char* lds = (LAS unsigned char*)lds_raw;
    const int wv = __builtin_amdgcn_readfirstlane(threadIdx.x >> 6);
#define TID() ((wv << 6) | lane_id_v())
    { const int tid = TID(); for (int u = tid; u < (LDS_BYTES - LDSCTL_OFF) / 4; u += 512) ((LAS unsigned*)(lds + LDSCTL_OFF))[u] = 0u; }
    __syncthreads();
    unsigned char* ws0 = a.P.ws;
    XcdBarrier bar; bar.bar = (unsigned*)(ws0 + WS_CTL) + CW_BAR; bar.x = 0; bar.st = nullptr; bar.wv = wv;
    if (a.ph_hi - a.ph_lo > 1) bar = xcd_barrier_post((unsigned*)(ws0 + WS_CTL) + CW_BAR, (volatile LAS unsigned*)(lds + MISC_OFF) + 8);
    bar.wv = wv;
    const int G = gridDim.x;
#ifndef PROBE_REPEAT
#define PROBE_REPEAT -1
#endif
    for (int ph2_ = a.ph_lo * 2; ph2_ < a.ph_hi * 2; ph2_ = __builtin_amdgcn_readfirstlane(ph2_ + 1)) {
        const int ph2 = __builtin_amdgcn_readfirstlane(ph2_), ph = ph2 >> 1;
        const bool isrep = (PROBE_REPEAT == 8) ? (ph == 0) : (PROBE_REPEAT == 9 ? true : (ph > 0 && ((ph - 1) & 7) == PROBE_REPEAT));
        if (!isrep && (ph2 & 1) == 0) continue;
        const int dry = (isrep && (ph2 & 1) == 0) ? 1 : 0;
        if (PROBE_REPEAT == 9 && dry) { xcd_barrier(bar); continue; }
        const Ptrs& P = a.P;
        int bid = blockIdx.x; asm volatile("" : "+s"(bid));
        unsigned char* ws = P.ws;
        if (ph == 0 && (PHMASK & 32)) {
            int t_ = TID(); asm volatile("" : "+v"(t_));
            p0_prologue(P, lds, bid * 8 + wv, G * 8, wv, t_ & 63);
        } else {
            const int l = __builtin_amdgcn_readfirstlane((ph - 1) >> 3), p = __builtin_amdgcn_readfirstlane((ph - 1) & 7);
            unsigned char* wb = ws + WS_W + l * LW_BYTES;
            if (p == 0 && (PHMASK & 1)) {
                pg8::Gemm g{(const bf16_t*)(ws + WS_XB), (const bf16_t*)(wb + LW_W1), MP, N1, DM, wv}; pg8::StaticOrder S; S.init(MP, N1, G, bid);
                Epi1 E{0, P, l}; pg8::gemm_phase<Epi1, pg8::StaticOrder, true, true>(lds, g, S, E);
                { int t_ = TID(); asm volatile("" : "+v"(t_)); for (int s = G - 1 - bid; s < N1 / 64; s += G) sample_strip<1>(P, l, lds, wv, t_, s, 0); }
            } else if (p == 4 && (PHMASK & 2)) {
                pg8::Gemm g{(const bf16_t*)(ws + WS_A3), (const bf16_t*)(wb + LW_W3), MP, DM, K3, wv}; pg8::StaticOrder S; S.init(MP, DM, G, bid);
                Epi3 E{DR / 64, P}; pg8::gemm_phase<Epi3, pg8::StaticOrder, true, true>(lds, g, S, E);
                { int t_ = TID(); asm volatile("" : "+v"(t_)); for (int s = G - 1 - bid; s < DM / 64; s += G) sample_strip<3>(P, l, lds, wv, t_, s, 0); }
            } else if (p == 5 && (PHMASK & 4)) {
                pg8::Gemm g{(const bf16_t*)(ws + WS_MRG), (const bf16_t*)(wb + LW_W4), MP, DM, DM, wv}; pg8::StaticOrder S; S.init(MP, DM, G, bid);
                EpiRes E{0, P, l == 0 ? 1 : 0, dry}; pg8::gemm_phase<EpiRes, pg8::StaticOrder, true, true>(lds, g, S, E);
                { int t_ = TID(); asm volatile("" : "+v"(t_)); for (int s = G - 1 - bid; s < DM / 64; s += G) if (!dry) sample_strip<4>(P, l, lds, wv, t_, s, l == 0 ? 1 : 0); }
            } else if (p == 6 && (PHMASK & 8)) {
                pg8::Gemm g{(const bf16_t*)(ws + WS_XB), (const bf16_t*)(wb + LW_W5), MP, 2 * DFF, DM, wv}; pg8::StaticOrder S; S.init(MP, 2 * DFF, G, bid);
                Epi5 E{0, P}; pg8::gemm_phase<Epi5, pg8::StaticOrder, true, true>(lds, g, S, E);
                { int t_ = TID(); asm volatile("" : "+v"(t_)); for (int s = G - 1 - bid; s < 2 * DFF / 64; s += G) sample_strip<5>(P, l, lds, wv, t_, s, 0); }
            } else if (p == 7 && (PHMASK & 16)) {
                pg8::Gemm g{(const bf16_t*)(ws + WS_H), (const bf16_t*)(wb + LW_W6), MP, DM, DFF, wv}; pg8::StaticOrder S; S.init(MP, DM, G, bid);
                EpiRes E{0, P, 0, dry}; pg8::gemm_phase<EpiRes, pg8::StaticOrder, true, true>(lds, g, S, E);
                { int t_ = TID(); asm volatile("" : "+v"(t_)); for (int s = G - 1 - bid; s < DM / 64; s += G) if (!dry) sample_strip<6>(P, l, lds, wv, t_, s, 0); }
            } else if (p >= 1 && p <= 3) {
                int t_ = TID(); asm volatile("" : "+v"(t_));
                const size_t gtid = (size_t)bid * 512 + t_, nth = (size_t)G * 512;
                if (p == 1) {
                    for (int rp = 0; rp < (PROBE_REPEAT == 10 ? 2 : 1); ++rp)
                    for (int it = bid; it < 256; it += G) scan_item<0>(P, l, lds, wv, t_, it >> 7, (it >> 3) & 15, it & 7);
                    for (int rp = 0; rp < (PROBE_REPEAT == 11 ? 2 : 1); ++rp)
                    attn_phase(P, l, lds, wv, t_, bid, G);
                    __syncthreads();
                    for (int it = bid * 8 + wv; it < SB * NH; it += G * 8) attn_sample(P, l, lds, wv, t_ & 63, it);
                } else if (p == 2) {
                    for (int rp = 0; rp < (PROBE_REPEAT == 12 ? 2 : 1); ++rp)
                    for (int it = bid; it < 256; it += G) scan_item<1>(P, l, lds, wv, t_, it >> 7, (it >> 3) & 15, it & 7);
                    for (int rp = 0; rp < (PROBE_REPEAT == 13 ? 2 : 1); ++rp) {
                    for (int it = bid; it < 64; it += G) scan_sample(P, l, lds, t_, it >> 4, it & 15);
                    ph_combine(P, gtid, nth); }
                }
            }
        }
        if (ph2 + 1 < a.ph_hi * 2) xcd_barrier(bar);
    }
}

extern "C" void kernel_launch(void* const* d_in, const int* in_sizes, int n_in, void* d_out, int out_size, void* d_ws, size_t ws_size, hipStream_t stream) {
    static int grid = 0;
    if (grid == 0) {
        if (n_in != 27 || (size_t)out_size != O_END || ws_size < WS_END) { fprintf(stderr, "kernel_launch: unexpected sizes n_in %d out %d (want %zu) ws %zu (want %zu)\n", n_in, out_size, (size_t)O_END, ws_size, (size_t)WS_END); grid = -1; return; }
        int dev = 0, cus = 0;
        if (hipGetDevice(&dev) != hipSuccess || hipDeviceGetAttribute(&cus, hipDeviceAttributeMultiprocessorCount, dev) != hipSuccess) { grid = -1; return; }
        if (hipFuncSetAttribute((const void*)mega, hipFuncAttributeMaxDynamicSharedMemorySize, LDS_BYTES) != hipSuccess) { fprintf(stderr, "kernel_launch: hipFuncSetAttribute failed\n"); grid = -1; return; }
        grid = cus;
    }
    if (grid < 0) return;
    Args a{};
    Ptrs& P = a.P;
    const float* const* in = (const float* const*)d_in;
    P.x_prompt = in[0]; P.x_sample = in[1]; P.cache[0] = in[2]; P.cache[1] = in[3]; P.cache[2] = in[4]; P.state_conv = in[5]; P.state_h = in[6]; P.rel_bias = in[7];
    P.norm_mix = in[8]; P.w_in = in[9]; P.w_conv = in[10]; P.b_conv = in[11]; P.w_rg_a = in[12]; P.b_rg_a = in[13]; P.w_rg_x = in[14]; P.b_rg_x = in[15];
    P.lru_lambda = in[16]; P.q_gain = in[17]; P.k_gain = in[18]; P.w_merge = in[19]; P.b_merge = in[20]; P.w_branch_lru = in[21]; P.w_branch_att = in[22];
    P.w_o = in[23]; P.norm_ffn = in[24]; P.w_ffn_in = in[25]; P.w_ffn_out = in[26];
    P.out = (float*)d_out; P.ws = (unsigned char*)d_ws;
    (void)hipMemsetAsync((char*)d_ws + WS_CTL, 0, CTL_ZERO_BYTES, stream);
    a.ph_lo = 0; a.ph_hi = NPH;
    hipLaunchKernelGGL(mega, dim3(grid), dim3(512), LDS_BYTES, stream, a);
}
```

```cpp
#include <hip/hip_runtime.h>
#include <stdint.h>
#include <stdio.h>

typedef unsigned short bf16_t;
typedef short bf16x8 __attribute__((ext_vector_type(8)));
typedef float f32x4 __attribute__((ext_vector_type(4)));
typedef unsigned u32x4 __attribute__((ext_vector_type(4)));
typedef unsigned u32x2 __attribute__((ext_vector_type(2)));
typedef float f32x2 __attribute__((ext_vector_type(2)));

constexpr int DM = 1024, NB = 2, SEQ = 8192, DEPTH = 2, SB = 32, PAST = 8192;
constexpr int MP = NB * SEQ;
constexpr int MT = MP + SB;
constexpr int MPAD = 16640;
constexpr int DR = 1024, NBLK = 16, CW = 4;
constexpr int HD = 64, HPG = 8, NG = 3, NH = 24, AW = 1536, AO = 512;
constexpr int DFF = 2816;
constexpr int N1 = 2 * DR + 3 * AW + 2 * DM;
constexpr int K3 = DR + AO;
constexpr float EPS = 1e-6f;
constexpr int NKEY = 129;

__host__ __device__ constexpr int g_dil(int g) { return g == 0 ? 1 : (g == 1 ? 4 : 16); }
__host__ __device__ constexpr int g_win(int g) { return g == 0 ? 128 : (g == 1 ? 512 : 2048); }

constexpr size_t O_Y = 0;
constexpr size_t O_KVP0 = (size_t)MT * DM;
constexpr size_t O_KVP1 = O_KVP0 + (size_t)DEPTH * NB * 128 * 1024;
constexpr size_t O_KVP2 = O_KVP1 + (size_t)DEPTH * NB * 512 * 1024;
constexpr size_t O_CONVP = O_KVP2 + (size_t)DEPTH * NB * 2048 * 1024;
constexpr size_t O_HP = O_CONVP + (size_t)DEPTH * NB * 3 * DR;
constexpr size_t O_KVS0 = O_HP + (size_t)DEPTH * NB * DR;
constexpr size_t O_KVS1 = O_KVS0 + (size_t)DEPTH * SB * 1024;
constexpr size_t O_KVS2 = O_KVS1 + (size_t)DEPTH * SB * 1024;
constexpr size_t O_CONVS = O_KVS2 + (size_t)DEPTH * SB * 1024;
constexpr size_t O_HS = O_CONVS + (size_t)DEPTH * SB * 3 * DR;
constexpr size_t O_END = O_HS + (size_t)DEPTH * SB * DR;
__host__ __device__ constexpr size_t o_kvp(int g) { return g == 0 ? O_KVP0 : (g == 1 ? O_KVP1 : O_KVP2); }
__host__ __device__ constexpr size_t o_kvs(int g) { return g == 0 ? O_KVS0 : (g == 1 ? O_KVS1 : O_KVS2); }

constexpr size_t MiB = 1u << 20;
constexpr size_t rup(size_t x) { return (x + MiB - 1) / MiB * MiB; }
constexpr size_t WS_CTL = 0, CTL_ZERO_BYTES = 1 * MiB;
constexpr size_t WS_BIAS = 1 * MiB;
constexpr size_t WS_SSQ = 2 * MiB;
constexpr size_t WS_SUM = 4 * MiB;
constexpr size_t WS_W = 8 * MiB;
constexpr size_t LW_W1 = 0;
constexpr size_t LW_W3 = LW_W1 + (size_t)N1 * DM * 2;
constexpr size_t LW_W4 = LW_W3 + (size_t)DM * K3 * 2;
constexpr size_t LW_W5 = LW_W4 + (size_t)DM * DM * 2;
constexpr size_t LW_W6 = LW_W5 + (size_t)2 * DFF * DM * 2;
constexpr size_t LW_BYTES = rup(LW_W6 + (size_t)DM * DFF * 2);
constexpr size_t WS_XB = WS_W + DEPTH * LW_BYTES;
constexpr size_t WS_LX = WS_XB + rup((size_t)MPAD * DM * 2);
constexpr size_t WS_GG = WS_LX + rup((size_t)MPAD * DM * 2);
constexpr size_t WS_Q = WS_GG + rup((size_t)MPAD * DM * 2);
constexpr size_t WS_K = WS_Q + rup((size_t)MPAD * AW * 2);
constexpr size_t WS_V = WS_K + rup((size_t)MPAD * AW * 2);
constexpr size_t WS_GM = WS_V + rup((size_t)MPAD * AW * 2);
constexpr size_t WS_OG = WS_GM + rup((size_t)MPAD * 2048 * 2);
constexpr size_t WS_ML = WS_OG + rup((size_t)3 * MPAD * AO * 2);
constexpr size_t WS_A3 = WS_ML + rup((size_t)3 * MPAD * 16 * 4);
constexpr size_t WS_MRG = WS_A3 + rup((size_t)MPAD * K3 * 2);
constexpr size_t WS_H = WS_MRG + rup((size_t)MPAD * DM * 2);
constexpr size_t WS_SIMPLE = WS_H + rup((size_t)MPAD * DFF * 2);
constexpr size_t WS_XC = WS_SIMPLE;
constexpr size_t WS_AA = WS_XC + rup((size_t)MPAD * DM * 4);
constexpr size_t WS_UU = WS_AA + rup((size_t)MPAD * DM * 4);
constexpr size_t WS_DUMMY = WS_UU + rup((size_t)MPAD * DM * 4);
constexpr size_t WS_END = WS_DUMMY + 160 * MiB;

__device__ __forceinline__ int lane_id_v() { int x; asm volatile("v_mbcnt_lo_u32_b32 %0, -1, 0\n\tv_mbcnt_hi_u32_b32 %0, -1, %0" : "=v"(x)); return x; }
__device__ __forceinline__ float bf2f(bf16_t v) { return __uint_as_float(((unsigned)v) << 16); }
__device__ __forceinline__ bf16_t f2b(float f) { unsigned u = __float_as_uint(f); u += 0x7fffu + ((u >> 16) & 1u); return (bf16_t)(u >> 16); }
__device__ __forceinline__ float wave_sum(float v) {
#pragma unroll
    for (int o = 1; o < 64; o <<= 1) v += __shfl_xor(v, o);
    return v;
}
__device__ __forceinline__ float wave_max(float v) {
#pragma unroll
    for (int o = 1; o < 64; o <<= 1) v = fmaxf(v, __shfl_xor(v, o));
    return v;
}
__device__ __forceinline__ float sigmoidf_(float x) { return __builtin_amdgcn_rcpf(1.0f + __builtin_amdgcn_exp2f(-1.4426950408889634f * x)); }
__device__ __forceinline__ float gelu_tanh(float x) { const float u2 = x * (1.5957691216057308f + 0.07135481627159831f * x * x); return x * __builtin_amdgcn_rcpf(1.0f + __builtin_amdgcn_exp2f(-1.4426950408889634f * u2)); }

__host__ __device__ __forceinline__ int w1_src_col(int nt) {
    if (nt < 2048) return nt;
    const int pn = nt >> 8, tc = nt & 255, bj = tc >> 7;
    if (nt >= 6656) return 6656 + bj * 1024 + (pn - 26) * 128 + (tc & 127);
    const int wc = (tc >> 5) & 3, i = tc & 31;
    return 2048 + (pn - 8) * 256 + wc * 64 + bj * 32 + i;
}
__host__ __device__ __forceinline__ int w5_src_col(int nt) { const int pn = nt >> 8, tc = nt & 255, bj = tc >> 7, j = tc & 127; return bj * DFF + pn * 128 + j; }

struct Ptrs {
    const float* x_prompt; const float* x_sample; const float* cache[3]; const float* state_conv; const float* state_h; const float* rel_bias;
    const float* norm_mix; const float* w_in; const float* w_conv; const float* b_conv; const float* w_rg_a; const float* b_rg_a; const float* w_rg_x; const float* b_rg_x;
    const float* lru_lambda; const float* q_gain; const float* k_gain; const float* w_merge; const float* b_merge; const float* w_branch_lru; const float* w_branch_att;
    const float* w_o; const float* norm_ffn; const float* w_ffn_in; const float* w_ffn_out;
    float* out; unsigned char* ws;
};
__device__ __forceinline__ const float* xin_row(const Ptrs& P, int row) { return row < MP ? P.x_prompt + (size_t)row * DM : P.x_sample + (size_t)(row - MP) * DM; }

namespace pg8 {
#define PG8_LAS __attribute__((address_space(3)))
typedef unsigned short bf16_t;
typedef short bf16x8 __attribute__((ext_vector_type(8)));
typedef float f32x4 __attribute__((ext_vector_type(4)));
typedef unsigned u32x4 __attribute__((ext_vector_type(4)));
constexpr int BM = 256, BK = 64, HALF = 128, HTB = HALF * BK * 2  , STAGE_BYTES = 8 * HTB, NXCD = 8, WGM = 8;

__host__ __device__ __forceinline__ int lds_byte(int r, int c) { const int st = (r >> 4) * 2 + (c >> 5), rr = r & 15, cc = c & 31, ob = rr * 64 + cc * 2; return st * 1024 + (ob ^ (((ob >> 9) & 1) << 5)); }
__host__ __device__ __forceinline__ void stage_rc(int b, int& R, int& C) { const int st = b / 1024, sb = b % 1024, swz = sb ^ (((sb >> 9) & 1) << 5); R = (st >> 1) * 16 + swz / 64; C = (st & 1) * 32 + (swz % 64) / 2; }
__host__ __device__ __forceinline__ int perm32(int rho) { const int n = rho >> 4, i = rho & 15; return 8 * (i >> 2) + 4 * n + (i & 3); }

struct Unit { int pm, pn; };
struct Gemm { const bf16_t* A; const bf16_t* Bt; int M, N, K; int wv; };

struct StaticOrder {
    int nM, nN, nwg, G, c;
    __host__ __device__ void init(int M, int N, int G_, int c_) { nM = M / BM; nN = N / BM; nwg = nM * nN; G = G_; c = c_; }
    __host__ __device__ bool next(int i, Unit& u) const {
        const long L = (long)i * G + c; if (L >= nwg) return false;
        int wgid = (int)L; { const int q = nwg / NXCD, r = nwg % NXCD, xcd = wgid % NXCD, off = wgid / NXCD; wgid = (xcd < r ? xcd * (q + 1) : r * (q + 1) + (xcd - r) * q) + off; }
        const int nig = WGM * nN, gid = wgid / nig, fm = gid * WGM, gsz = (nM - fm) < WGM ? (nM - fm) : WGM;
        u.pm = fm + ((wgid % nig) % gsz); u.pn = (wgid % nig) / gsz; return true;
    }
    __device__ __forceinline__ void a_ready(const Unit&) const {}
    __device__ __forceinline__ void done(const Unit&) const {}
};

template <class Epi, class Sched, bool ALIGN_EPI = false, bool SP2 = false>
__device__ __forceinline__ void gemm_phase(PG8_LAS unsigned char* lds, const Gemm g, const Sched& S, const Epi& E) {
    int tid_ = (g.wv << 6) | lane_id_v(); asm volatile("" : "+v"(tid_));
    const int tid = tid_, wid = __builtin_amdgcn_readfirstlane(tid >> 6), lane = tid & 63, wr = wid >> 2, wc = wid & 3, fr = lane & 15, fq = lane >> 4;
    const int K = g.K, nt = K / BK;
    unsigned voffA[2], voffB[2];
#pragma unroll
    for (int i = 0; i < 2; ++i) { int R, C; stage_rc(tid * 16 + i * 8192, R, C); const int Rb = Epi::PERM ? ((R & ~31) + perm32(R & 31)) : R;
        voffA[i] = (unsigned)(R * K + C) * 2u; voffB[i] = (unsigned)(Rb * K + C) * 2u; }
    const size_t kstep = (size_t)(BK * 2);
    const size_t hstep = (size_t)HALF * K * 2;
    const size_t tstep = 2 * hstep;
    const unsigned ldsw = (unsigned)wid * 1024u;
    const int aoff = lds_byte(wr * 64 + fr, fq * 8), boff = lds_byte(wc * 32 + fr, fq * 8);
#define PG8_SA(b, h) (((b) * 2 + (h)) * HTB)
#define PG8_SB(b, h) ((4 + (b) * 2 + (h)) * HTB)
#define PG8_STAGE(bufoff, gbase, voff) do { _Pragma("unroll") for (int _i = 0; _i < 2; ++_i) \
        __builtin_amdgcn_global_load_lds((const unsigned*)((const char*)(gbase) + (voff)[_i]), (PG8_LAS unsigned*)(lds + (bufoff) + ldsw + _i * 8192), 16, 0, 0); } while (0)
#define PG8_LDA(dst, b, h) do { _Pragma("unroll") for (int m = 0; m < 4; ++m) _Pragma("unroll") for (int k = 0; k < 2; ++k) dst[m][k] = *(const PG8_LAS bf16x8*)(lds + PG8_SA(b, h) + aoff + m * 2048 + k * 1024); } while (0)
#define PG8_LDB(dst, b, h) do { _Pragma("unroll") for (int n = 0; n < 2; ++n) _Pragma("unroll") for (int k = 0; k < 2; ++k) dst[n][k] = *(const PG8_LAS bf16x8*)(lds + PG8_SB(b, h) + boff + n * 2048 + k * 1024); } while (0)
#define PG8_MMA(ai, bj, At, Bt) do { __builtin_amdgcn_s_setprio(1); _Pragma("unroll") for (int m = 0; m < 4; ++m) _Pragma("unroll") for (int n = 0; n < 2; ++n) _Pragma("unroll") for (int k = 0; k < 2; ++k) \
        acc[ai][bj][m][n] = __builtin_amdgcn_mfma_f32_16x16x32_bf16(Bt[n][k], At[m][k], acc[ai][bj][m][n], 0, 0, 0); __builtin_amdgcn_s_setprio(0); } while (0)
#define PG8_WAIT_V(n) asm volatile("s_waitcnt vmcnt(" #n ")" ::: "memory")
#define PG8_WAIT_L(n) asm volatile("s_waitcnt lgkmcnt(" #n ")" ::: "memory")
#define PG8_BAR __builtin_amdgcn_s_barrier()
#define PG8_SCHED __builtin_amdgcn_sched_barrier(0)
    Unit cur, nxt; int ui = 0;
    if (!S.next(0, cur)) return;
    f32x4 acc[2][2][4][2];
#pragma unroll
    for (int a = 0; a < 2; ++a)
#pragma unroll
        for (int b = 0; b < 2; ++b)
#pragma unroll
            for (int m = 0; m < 4; ++m)
#pragma unroll
                for (int n = 0; n < 2; ++n) acc[a][b][m][n] = (f32x4){0.f, 0.f, 0.f, 0.f};
    bf16x8 At[4][2], B0[2][2], B1[2][2];
    const char* cA = (const char*)g.A + (size_t)cur.pm * tstep; const char* cB = (const char*)g.Bt + (size_t)cur.pn * tstep;
    S.a_ready(cur);
    if constexpr (SP2) {
        PG8_STAGE(PG8_SB(0, 0), cB, voffB); PG8_STAGE(PG8_SB(0, 1), cB + hstep, voffB); PG8_STAGE(PG8_SA(0, 0), cA, voffA); PG8_STAGE(PG8_SA(0, 1), cA + hstep, voffA);
        if (wr == 1) PG8_BAR;
        PG8_WAIT_V(2); PG8_BAR;
        PG8_STAGE(PG8_SB(1, 0), cB + kstep, voffB); PG8_STAGE(PG8_SA(1, 0), cA + kstep, voffA); PG8_STAGE(PG8_SB(1, 1), cB + hstep + kstep, voffB);
        PG8_WAIT_V(6); PG8_BAR;
    } else {
        PG8_STAGE(PG8_SB(0, 0), cB, voffB); PG8_STAGE(PG8_SA(0, 0), cA, voffA); PG8_STAGE(PG8_SB(0, 1), cB + hstep, voffB); PG8_STAGE(PG8_SA(0, 1), cA + hstep, voffA);
        if (wr == 1) PG8_BAR;
        PG8_WAIT_V(4); PG8_BAR;
        PG8_STAGE(PG8_SB(1, 0), cB + kstep, voffB); PG8_STAGE(PG8_SA(1, 0), cA + kstep, voffA); PG8_STAGE(PG8_SB(1, 1), cB + hstep + kstep, voffB);
        PG8_WAIT_V(6); PG8_BAR;
    }
    for (;;) {
        const bool has_next = S.next(ui + 1, nxt);
        const char* nA = has_next ? (const char*)g.A + (size_t)nxt.pm * tstep : cA; const char* nB = has_next ? (const char*)g.Bt + (size_t)nxt.pn * tstep : cB;
        for (int t = 0; t < nt; t += 2) {
            if constexpr (Epi::HAS_MID) { if (t == E.mid_t) E.mid(acc, cur, wr, wc, fr, fq); }
            const bool last = (t == nt - 2);
            const char* a1 = cA + (size_t)(t + 1) * kstep;
            const char* a2 = last ? nA : cA + (size_t)(t + 2) * kstep; const char* b2 = last ? nB : cB + (size_t)(t + 2) * kstep;
            const char* a3 = a2 + kstep; const char* b3 = b2 + kstep;
            if (last && has_next) S.a_ready(nxt);
            if constexpr (SP2) {
            PG8_LDB(B0, 0, 0); PG8_LDB(B1, 0, 1); PG8_SCHED; PG8_LDA(At, 0, 0); PG8_STAGE(PG8_SA(1, 1), a1 + hstep, voffA);
            PG8_WAIT_V(8); PG8_WAIT_L(0); PG8_BAR; PG8_MMA(0, 0, At, B0); PG8_MMA(0, 1, At, B1); PG8_BAR; PG8_SCHED;
            PG8_LDA(At, 0, 1); PG8_STAGE(PG8_SB(0, 0), b2, voffB); PG8_STAGE(PG8_SB(0, 1), b2 + hstep, voffB); PG8_STAGE(PG8_SA(0, 0), a2, voffA);
            PG8_WAIT_V(8); PG8_WAIT_L(0); PG8_BAR; PG8_MMA(1, 0, At, B0); PG8_MMA(1, 1, At, B1); PG8_BAR; PG8_SCHED;
            PG8_LDB(B0, 1, 0); PG8_LDB(B1, 1, 1); PG8_SCHED; PG8_LDA(At, 1, 0); PG8_STAGE(PG8_SA(0, 1), a2 + hstep, voffA);
            PG8_WAIT_V(8); PG8_WAIT_L(0); PG8_BAR; PG8_MMA(0, 0, At, B0); PG8_MMA(0, 1, At, B1); PG8_BAR; PG8_SCHED;
            PG8_LDA(At, 1, 1); PG8_STAGE(PG8_SB(1, 0), b3, voffB); PG8_STAGE(PG8_SB(1, 1), b3 + hstep, voffB); PG8_STAGE(PG8_SA(1, 0), a3, voffA);
            PG8_WAIT_V(8); PG8_WAIT_L(0); PG8_BAR; PG8_MMA(1, 0, At, B0); PG8_MMA(1, 1, At, B1); PG8_BAR; PG8_SCHED;
            } else {
            PG8_LDB(B0, 0, 0); PG8_SCHED; PG8_LDA(At, 0, 0); PG8_STAGE(PG8_SA(1, 1), a1 + hstep, voffA);
            PG8_WAIT_L(8); PG8_BAR; PG8_WAIT_L(0); PG8_MMA(0, 0, At, B0); PG8_BAR; PG8_SCHED;
            PG8_LDB(B1, 0, 1); PG8_STAGE(PG8_SB(0, 0), b2, voffB);
            PG8_BAR; PG8_WAIT_L(0); PG8_MMA(0, 1, At, B1); PG8_BAR;
            PG8_LDA(At, 0, 1); PG8_STAGE(PG8_SA(0, 0), a2, voffA);
            PG8_BAR; PG8_WAIT_L(0); PG8_MMA(1, 0, At, B0); PG8_BAR; PG8_SCHED;
            PG8_STAGE(PG8_SB(0, 1), b2 + hstep, voffB);
            PG8_WAIT_V(6); PG8_BAR; PG8_MMA(1, 1, At, B1); PG8_BAR;
            PG8_LDB(B0, 1, 0); PG8_SCHED; PG8_LDA(At, 1, 0); PG8_STAGE(PG8_SA(0, 1), a2 + hstep, voffA);
            PG8_WAIT_L(8); PG8_BAR; PG8_WAIT_L(0); PG8_MMA(0, 0, At, B0); PG8_BAR; PG8_SCHED;
            PG8_LDB(B1, 1, 1); PG8_STAGE(PG8_SB(1, 0), b3, voffB);
            PG8_BAR; PG8_WAIT_L(0); PG8_MMA(0, 1, At, B1); PG8_BAR;
            PG8_LDA(At, 1, 1); PG8_STAGE(PG8_SA(1, 0), a3, voffA);
            PG8_BAR; PG8_WAIT_L(0); PG8_MMA(1, 0, At, B0); PG8_BAR; PG8_SCHED;
            PG8_STAGE(PG8_SB(1, 1), b3 + hstep, voffB);
            PG8_WAIT_V(6); PG8_BAR; PG8_MMA(1, 1, At, B1); PG8_BAR;
            }
        }
        if constexpr (ALIGN_EPI) { if (wr == 0) PG8_BAR; }
        if constexpr (!Epi::AFTER_DRAIN) { E(acc, cur, wr, wc, fr, fq); S.done(cur); }
        if (!has_next) break;
#pragma unroll
        for (int a = 0; a < 2; ++a)
#pragma unroll
            for (int b = 0; b < 2; ++b)
#pragma unroll
                for (int m = 0; m < 4; ++m)
#pragma unroll
                    for (int n = 0; n < 2; ++n) acc[a][b][m][n] = (f32x4){0.f, 0.f, 0.f, 0.f};
        cur = nxt; cA = nA; cB = nB; ++ui;
        if constexpr (ALIGN_EPI) { if (wr == 1) PG8_BAR; }
    }
    PG8_WAIT_V(0);
    if constexpr (!ALIGN_EPI) { if (wr == 0) PG8_BAR; }
    PG8_BAR;
    if constexpr (Epi::AFTER_DRAIN) { E.fused(acc, cur, wr, wc, fr, fq, lds, wid, lane); S.done(cur); }
#undef PG8_SA
#undef PG8_SB
#undef PG8_STAGE
#undef PG8_LDA
#undef PG8_LDB
#undef PG8_MMA
#undef PG8_WAIT_V
#undef PG8_WAIT_L
#undef PG8_BAR
#undef PG8_SCHED
}
}
#define GAS __attribute__((address_space(1)))
#define LAS __attribute__((address_space(3)))
typedef unsigned short bf16;
typedef unsigned v4u __attribute__((ext_vector_type(4)));
typedef float f32x4 __attribute__((ext_vector_type(4)));
typedef short bf16x8 __attribute__((ext_vector_type(8)));
typedef GAS unsigned gu32;
typedef GAS unsigned long long gu64;
#define RLX_AGENT __ATOMIC_RELAXED, __HIP_MEMORY_SCOPE_AGENT
#define LDS_WAIT() asm volatile("s_waitcnt lgkmcnt(0)" ::: "memory")
#define VM_WAIT() asm volatile("s_waitcnt vmcnt(0)" ::: "memory")
__device__ __forceinline__ unsigned long long rt() { return __builtin_amdgcn_s_memrealtime(); }
__device__ __forceinline__ unsigned f2bf(float f) { unsigned u = __builtin_bit_cast(unsigned, f); return (u + 0x7fffu + ((u >> 16) & 1u)) >> 16; }
__device__ __forceinline__ unsigned pk2(float lo, float hi) { return f2bf(lo) | (f2bf(hi) << 16); }

#define XB_TMO      128
#define XB_XCNT(j)  (256  + 64 * (j))
#define XB_XSUB(j)  (1280 + 64 * (j))
#define XB_XGEN(j)  (2304 + 64 * (j))
#define XB_TOP      3328
#define XB_TOPGEN   3392
#define XCD_BAR_WORDS 3456
#define XB_SPIN_CAP (1u << 18)

__device__ __forceinline__ unsigned xb_ld(unsigned* p)              { return __hip_atomic_load(p, __ATOMIC_RELAXED, __HIP_MEMORY_SCOPE_AGENT); }
__device__ __forceinline__ unsigned xb_add(unsigned* p, unsigned v) { return __hip_atomic_fetch_add(p, v, __ATOMIC_RELAXED, __HIP_MEMORY_SCOPE_AGENT); }
__device__ __forceinline__ unsigned xb_xcc_id() { return (unsigned)__builtin_amdgcn_s_getreg((3 << 11) | 20) & 0xFu; }
#define XB_SPIN(cond, bar) do { unsigned _sp = 0; while (cond) { __builtin_amdgcn_s_sleep(1); \
    if ((++_sp & 255u) == 0u) { if (xb_ld(&(bar)[XB_TMO])) break; if (_sp > XB_SPIN_CAP) { atomicAdd(&(bar)[XB_TMO], 1u); break; } } } } while (0)

struct XcdBarrier {
    unsigned* bar; unsigned x; int wv;
    volatile LAS unsigned* st;
};

__device__ __forceinline__ XcdBarrier xcd_barrier_post(unsigned* bar, volatile LAS unsigned* st) {
    XcdBarrier b; b.bar = bar; b.x = xb_xcc_id(); b.st = st;
    if (threadIdx.x == 0) (void)xb_add(&bar[XB_XCNT(b.x)], 1u);
    return b;
}
__device__ __forceinline__ void xcd_barrier_complete(unsigned* bar, unsigned x, unsigned& nloc, unsigned& nx) {
    const unsigned G = gridDim.x * gridDim.y * gridDim.z;
    unsigned sum, cnt, mine, sp = 0u;
    for (;;) {
        sum = 0u; cnt = 0u; mine = 0u;
#pragma unroll
        for (unsigned j = 0; j < 16; ++j) { const unsigned c = xb_ld(&bar[XB_XCNT(j)]); sum += c; cnt += (c > 0u) ? 1u : 0u; mine = (j == x) ? c : mine; }
        if (sum == G) break;
        __builtin_amdgcn_s_sleep(1);
        if ((++sp & 255u) == 0u) { if (xb_ld(&bar[XB_TMO])) break; if (sp > XB_SPIN_CAP) { atomicAdd(&bar[XB_TMO], 1u); break; } }
    }
    nloc = mine > 0u ? mine : 1u; nx = cnt > 0u ? cnt : 1u;
}

__device__ __forceinline__ void xcd_barrier(const XcdBarrier& b) {
    asm volatile("s_waitcnt vmcnt(0)" ::: "memory");
    __syncthreads();
    if (b.wv == 0 && lane_id_v() == 0) {
        unsigned* bar = b.bar; asm volatile("" : "+s"(bar));
        __builtin_amdgcn_s_waitcnt(0);
        unsigned nloc = b.st[0], nx = b.st[1];
        if (nloc == 0u) { xcd_barrier_complete(bar, b.x, nloc, nx); b.st[0] = nloc; b.st[1] = nx; }
        const unsigned old = xb_add(&bar[XB_XSUB(b.x)], 1u);
        const unsigned gen = old / nloc;
        if (old + 1u == (gen + 1u) * nloc) {
            __builtin_amdgcn_fence(__ATOMIC_RELEASE, "agent");
            asm volatile("s_waitcnt vmcnt(0)" ::: "memory");
            const unsigned og = xb_add(&bar[XB_TOP], 1u);
            const unsigned tg = og / nx;
            if (og + 1u == (tg + 1u) * nx) xb_add(&bar[XB_TOPGEN], 1u);
            else XB_SPIN(xb_ld(&bar[XB_TOPGEN]) == tg, bar);
            __builtin_amdgcn_fence(__ATOMIC_ACQUIRE, "agent");
            xb_add(&bar[XB_XGEN(b.x)], 1u);
            asm volatile("s_waitcnt vmcnt(0)" ::: "memory");
        } else {
            XB_SPIN(xb_ld(&bar[XB_XGEN(b.x)]) == gen, bar);
            __builtin_amdgcn_fence(__ATOMIC_ACQUIRE, "agent");
            asm volatile("s_waitcnt vmcnt(0)" ::: "memory");
        }
    }
    __syncthreads();
}

using pg8::Unit;
constexpr float LOG2E = 1.4426950408889634f, QSCALE = 0.125f * LOG2E;
#define ROW_FENCE() asm volatile("" ::: "memory")
#define LDS_BARRIER() do { asm volatile("s_waitcnt lgkmcnt(0)" ::: "memory"); __builtin_amdgcn_s_barrier(); asm volatile("" ::: "memory"); } while (0)
__device__ __forceinline__ float row_rs(const float* ssq, int row) {
    const f32x4* p = (const f32x4*)(ssq + (size_t)row * 16);
    const f32x4 a = p[0], b = p[1], c = p[2], d = p[3];
    const float s = (((a[0] + a[1]) + (a[2] + a[3])) + ((b[0] + b[1]) + (b[2] + b[3]))) + (((c[0] + c[1]) + (c[2] + c[3])) + ((d[0] + d[1]) + (d[2] + d[3])));
    return rsqrtf(s * (1.0f / DM) + EPS);
}
__device__ __forceinline__ float row_rs4(const float* ssq, int row, int fq) {
    const f32x4 a = *(const f32x4*)(ssq + (size_t)row * 16 + 4 * fq);
    float s = (a[0] + a[1]) + (a[2] + a[3]);
    s += __shfl_xor(s, 16); s += __shfl_xor(s, 32);
    return rsqrtf(s * (1.0f / DM) + EPS);
}
typedef float f32x2_t __attribute__((ext_vector_type(2))); typedef __bf16 bf16x2_t __attribute__((ext_vector_type(2)));
__device__ __forceinline__ unsigned pkbf(float lo, float hi) { const f32x2_t v = {lo, hi}; const bf16x2_t b = __builtin_convertvector(v, bf16x2_t); return __builtin_bit_cast(unsigned, b); }
__device__ __forceinline__ u32x4 pack8(const f32x4 a, const f32x4 b) { u32x4 w; w.x = pkbf(a[0], a[1]); w.y = pkbf(a[2], a[3]); w.z = pkbf(b[0], b[1]); w.w = pkbf(b[2], b[3]); return w; }
__device__ __forceinline__ float bflo(unsigned w) { return __uint_as_float(w << 16); }
__device__ __forceinline__ float bfhi(unsigned w) { return __uint_as_float(w & 0xffff0000u); }

struct Epi1 {
    static constexpr bool PERM = true, AFTER_DRAIN = false, HAS_MID = false;
    int mid_t; Ptrs P; int l;
    __device__ __forceinline__ void operator()(const f32x4 (&acc)[2][2][4][2], const Unit& u, int wr, int wc, int fr0, int fq) const {
        int fr = fr0; asm volatile("" : "+v"(fr));
        const float* ssq = (const float*)(P.ws + WS_SSQ);
        const int pn = u.pn, c8 = wc * 32 + 8 * fq, row0 = u.pm * 256 + wr * 64 + fr;
        if (pn < 8) {
            bf16_t* dst = (bf16_t*)(P.ws + (pn < 4 ? WS_LX : WS_GG));
            const int colb = (pn & 3) * 256 + c8;
#pragma unroll
            for (int ai = 0; ai < 2; ++ai)
#pragma unroll
                for (int m = 0; m < 4; ++m) {
                    const int row = row0 + ai * 128 + m * 16; const float rs = row_rs4(ssq, row, fq);
#pragma unroll
                    for (int bj = 0; bj < 2; ++bj) {
                        f32x4 v0 = acc[ai][bj][m][0] * rs, v1 = acc[ai][bj][m][1] * rs; const int col = colb + bj * 128;
                        if (pn >= 4) {
#pragma unroll
                            for (int e = 0; e < 4; ++e) { v0[e] = gelu_tanh(v0[e]); v1[e] = gelu_tanh(v1[e]); }
                        }
                        *(u32x4*)(dst + (size_t)row * DR + col) = pack8(v0, v1);
                        if (pn < 4) {
                            if (row < MP) { const int t = row & (SEQ - 1); if (t >= SEQ - 3) { const int b = row >> 13; float* o = P.out + O_CONVP + ((size_t)(l * NB + b) * 3 + (t - (SEQ - 3))) * DR + col; *(f32x4*)o = v0; *(f32x4*)(o + 4) = v1; } }
                            else if (row < MT) { const int b = row - MP; float* cs = P.out + O_CONVS + (size_t)(l * SB + b) * 3 * DR + col; const float* sc = P.state_conv + (size_t)(l * SB + b) * 3 * DR + col;
                                *(f32x4*)cs = *(const f32x4*)(sc + DR); *(f32x4*)(cs + 4) = *(const f32x4*)(sc + DR + 4); *(f32x4*)(cs + DR) = *(const f32x4*)(sc + 2 * DR); *(f32x4*)(cs + DR + 4) = *(const f32x4*)(sc + 2 * DR + 4);
                                *(f32x4*)(cs + 2 * DR) = v0; *(f32x4*)(cs + 2 * DR + 4) = v1; }
                        }
                    }
                    ROW_FENCE();
                }
        } else if (pn < 26) {
            const int tq = pn - 8, type = tq / 6, head = 4 * (tq % 6) + wc, g = head >> 3, hh = head & 7;
            bf16_t* dst = (bf16_t*)(P.ws + (type == 0 ? WS_Q : (type == 1 ? WS_K : WS_V)));
            f32x4 gn[2][2];
#pragma unroll
            for (int bj = 0; bj < 2; ++bj)
#pragma unroll
                for (int n = 0; n < 2; ++n) gn[bj][n] = (f32x4){1.f, 1.f, 1.f, 1.f};
            if (type < 2) { const float* gp = (type == 0 ? P.q_gain : P.k_gain) + l * HD;
#pragma unroll
                for (int bj = 0; bj < 2; ++bj)
#pragma unroll
                    for (int n = 0; n < 2; ++n) gn[bj][n] = *(const f32x4*)(gp + 32 * bj + 8 * fq + 4 * n); }
            const int W = g_win(g);
#pragma unroll
            for (int ai = 0; ai < 2; ++ai)
#pragma unroll
                for (int m = 0; m < 4; ++m) {
                    const int row = row0 + ai * 128 + m * 16; const float rs = row_rs4(ssq, row, fq);
                    f32x4 v[2][2]; float ss = 0.f;
#pragma unroll
                    for (int bj = 0; bj < 2; ++bj)
#pragma unroll
                        for (int n = 0; n < 2; ++n) { v[bj][n] = acc[ai][bj][m][n] * rs; const f32x4 q = v[bj][n] * v[bj][n]; ss += (q[0] + q[1]) + (q[2] + q[3]); }
                    ss += __shfl_xor(ss, 16); ss += __shfl_xor(ss, 32);
                    const float inv = (type < 2) ? rsqrtf(ss * (1.0f / HD) + EPS) * (type == 0 ? QSCALE : 1.0f) : 1.0f;
#pragma unroll
                    for (int bj = 0; bj < 2; ++bj) {
                        v[bj][0] = v[bj][0] * inv * gn[bj][0]; v[bj][1] = v[bj][1] * inv * gn[bj][1];
                        *(u32x4*)(dst + (size_t)row * AW + head * HD + 32 * bj + 8 * fq) = pack8(v[bj][0], v[bj][1]);
                    }
                    if (type >= 1) {
                        float* o = nullptr;
                        if (row < MP) { const int t = row & (SEQ - 1), b = row >> 13; if (t >= SEQ - W) o = P.out + o_kvp(g) + ((((size_t)(l * NB + b) * W + (t - (SEQ - W))) * 2 + (type - 1)) * HPG + hh) * HD + 8 * fq; }
                        else if (row < MT) { const int b = row - MP; o = P.out + o_kvs(g) + (((size_t)(l * SB + b) * 2 + (type - 1)) * HPG + hh) * HD + 8 * fq; }
                        if (o) {
#pragma unroll
                            for (int bj = 0; bj < 2; ++bj) { *(f32x4*)(o + 32 * bj) = v[bj][0]; *(f32x4*)(o + 32 * bj + 4) = v[bj][1]; } }
                    }
                    ROW_FENCE();
                }
        } else {
            bf16_t* GM = (bf16_t*)(P.ws + WS_GM); const float* bm = P.b_merge + (size_t)l * 2048;
            const int colb = (pn - 26) * 128 + c8;
            f32x4 bv[2][2];
#pragma unroll
            for (int bj = 0; bj < 2; ++bj)
#pragma unroll
                for (int n = 0; n < 2; ++n) bv[bj][n] = *(const f32x4*)(bm + bj * 1024 + colb + 4 * n);
#pragma unroll
            for (int ai = 0; ai < 2; ++ai)
#pragma unroll
                for (int m = 0; m < 4; ++m) {
                    const int row = row0 + ai * 128 + m * 16; const float rs = row_rs4(ssq, row, fq);
                    f32x4 rho[2], gav[2];
#pragma unroll
                    for (int n = 0; n < 2; ++n) {
                        const f32x4 xl = acc[ai][0][m][n] * rs + bv[0][n], xa = acc[ai][1][m][n] * rs + bv[1][n];
#pragma unroll
                        for (int e = 0; e < 4; ++e) { const float el = __expf(-xl[e]), ea = fminf(__expf(-xa[e]), 1e30f); gav[n][e] = __builtin_amdgcn_rcpf(1.0f + ea); rho[n][e] = (1.0f + ea) * __builtin_amdgcn_rcpf(1.0f + el); }
                    }
                    *(u32x4*)(GM + (size_t)row * 2048 + colb) = pack8(rho[0], rho[1]);
                    *(u32x4*)(GM + (size_t)row * 2048 + 1024 + colb) = pack8(gav[0], gav[1]);
                    ROW_FENCE();
                }
        }
    }
};

struct Epi3 {
    static constexpr bool PERM = true, AFTER_DRAIN = false, HAS_MID = true;
    int mid_t; Ptrs P;
    __device__ __forceinline__ void mid(f32x4 (&acc)[2][2][4][2], const Unit& u, int wr, int wc, int fr, int fq) const {
        const bf16_t* GM = (const bf16_t*)(P.ws + WS_GM);
        int fr_ = fr; asm volatile("" : "+v"(fr_));
        const int colb = u.pn * 256 + wc * 32 + 8 * fq, row0 = u.pm * 256 + wr * 64 + fr_;
#pragma unroll
        for (int ai = 0; ai < 2; ++ai)
#pragma unroll
            for (int m = 0; m < 4; ++m) {
                const int row = row0 + ai * 128 + m * 16;
#pragma unroll
                for (int bj = 0; bj < 2; ++bj) {
                    const u32x4 gl = *(const u32x4*)(GM + (size_t)row * 2048 + colb + bj * 128);
                    const f32x4 r0 = (f32x4){bflo(gl.x), bfhi(gl.x), bflo(gl.y), bfhi(gl.y)}, r1 = (f32x4){bflo(gl.z), bfhi(gl.z), bflo(gl.w), bfhi(gl.w)};
                    acc[ai][bj][m][0] = acc[ai][bj][m][0] * r0; acc[ai][bj][m][1] = acc[ai][bj][m][1] * r1;
                }
                ROW_FENCE();
            }
    }
    __device__ __forceinline__ void operator()(const f32x4 (&acc)[2][2][4][2], const Unit& u, int wr, int wc, int fr0, int fq) const {
        int fr = fr0; asm volatile("" : "+v"(fr));
        const bf16_t* GM = (const bf16_t*)(P.ws + WS_GM); bf16_t* MRG = (bf16_t*)(P.ws + WS_MRG);
        const int colb = u.pn * 256 + wc * 32 + 8 * fq, row0 = u.pm * 256 + wr * 64 + fr;
#pragma unroll
        for (int ai = 0; ai < 2; ++ai)
#pragma unroll
            for (int m = 0; m < 4; ++m) {
                const int row = row0 + ai * 128 + m * 16;
#pragma unroll
                for (int bj = 0; bj < 2; ++bj) {
                    const u32x4 ga = *(const u32x4*)(GM + (size_t)row * 2048 + 1024 + colb + bj * 128);
                    const f32x4 g0 = (f32x4){bflo(ga.x), bfhi(ga.x), bflo(ga.y), bfhi(ga.y)}, g1 = (f32x4){bflo(ga.z), bfhi(ga.z), bflo(ga.w), bfhi(ga.w)};
                    *(u32x4*)(MRG + (size_t)row * DM + colb + bj * 128) = pack8(acc[ai][bj][m][0] * g0, acc[ai][bj][m][1] * g1);
                }
                ROW_FENCE();
            }
    }
};

struct EpiRes {
    static constexpr bool PERM = true, AFTER_DRAIN = false, HAS_MID = false;
    int mid_t; Ptrs P; int first; int last; int dry;
    __device__ __forceinline__ void operator()(const f32x4 (&acc)[2][2][4][2], const Unit& u, int wr, int wc, int fr0, int fq) const {
        int fr = fr0; asm volatile("" : "+v"(fr));
        const bf16_t* XBi = (const bf16_t*)(P.ws + WS_XB); bf16_t* XBo = (bf16_t*)(P.ws + (dry ? WS_DUMMY + 80 * MiB : WS_XB));
        float* Y = dry ? (float*)(P.ws + WS_DUMMY) : P.out + O_Y; float* ssq = (float*)(P.ws + (dry ? WS_DUMMY + 120 * MiB : WS_SSQ));
        const int colb = u.pn * 256 + wc * 32 + 8 * fq, row0 = u.pm * 256 + wr * 64 + fr;
#pragma unroll
        for (int ai = 0; ai < 2; ++ai)
#pragma unroll
            for (int m = 0; m < 4; ++m) {
                const int row = row0 + ai * 128 + m * 16;
                float ss = 0.f;
#pragma unroll
                for (int bj = 0; bj < 2; ++bj) {
                    const size_t off = (size_t)row * DM + colb + bj * 128;
                    f32x4 b0, b1;
                    if (first) { b0 = *(const f32x4*)(P.x_prompt + off); b1 = *(const f32x4*)(P.x_prompt + off + 4); }
                    else { const u32x4 w = *(const u32x4*)(XBi + off); b0 = (f32x4){bflo(w.x), bfhi(w.x), bflo(w.y), bfhi(w.y)}; b1 = (f32x4){bflo(w.z), bfhi(w.z), bflo(w.w), bfhi(w.w)}; }
                    const f32x4 v0 = acc[ai][bj][m][0] + b0, v1 = acc[ai][bj][m][1] + b1;
                    if (last) { *(f32x4*)(Y + off) = v0; *(f32x4*)(Y + off + 4) = v1; }
                    else *(u32x4*)(XBo + off) = pack8(v0, v1);
                    ss += ((v0[0] * v0[0] + v0[1] * v0[1]) + (v0[2] * v0[2] + v0[3] * v0[3])) + ((v1[0] * v1[0] + v1[1] * v1[1]) + (v1[2] * v1[2] + v1[3] * v1[3]));
                }
                ss += __shfl_xor(ss, 16); ss += __shfl_xor(ss, 32);
                if (fq == 0 && !last) ssq[(size_t)row * 16 + u.pn * 4 + wc] = ss;
                ROW_FENCE();
            }
    }
};

struct Epi5 {
    static constexpr bool PERM = true, AFTER_DRAIN = false, HAS_MID = false;
    int mid_t; Ptrs P;
    __device__ __forceinline__ void operator()(const f32x4 (&acc)[2][2][4][2], const Unit& u, int wr, int wc, int fr0, int fq) const {
        int fr = fr0; asm volatile("" : "+v"(fr));
        const float* ssq = (const float*)(P.ws + WS_SSQ); bf16_t* H = (bf16_t*)(P.ws + WS_H);
        const int colb = u.pn * 128 + wc * 32 + 8 * fq, row0 = u.pm * 256 + wr * 64 + fr;
#pragma unroll
        for (int ai = 0; ai < 2; ++ai)
#pragma unroll
            for (int m = 0; m < 4; ++m) {
                const int row = row0 + ai * 128 + m * 16; const float rs = row_rs4(ssq, row, fq);
                f32x4 h[2];
#pragma unroll
                for (int n = 0; n < 2; ++n)
#pragma unroll
                    for (int e = 0; e < 4; ++e) { const float gt = acc[ai][0][m][n][e] * rs, up = acc[ai][1][m][n][e] * rs; h[n][e] = gt * sigmoidf_(gt) * up; }
                *(u32x4*)(H + (size_t)row * DFF + colb) = pack8(h[0], h[1]);
                ROW_FENCE();
            }
    }
};

__device__ __forceinline__ void tr_item(const float* W, int N, int s0, int k0, const float* gain, bf16_t* WT, int K, int r0, int kofs, LAS float* scr, int lane) {
    {
        f32x4 v[8]; const int kr = lane >> 3, c4 = 4 * (lane & 7);
#pragma unroll
        for (int i = 0; i < 8; ++i) v[i] = *(const f32x4*)(W + (size_t)(k0 + 8 * i + kr) * N + s0 + c4);
#pragma unroll
        for (int i = 0; i < 8; ++i) { const int kk = 8 * i + kr; const float gsc = gain ? gain[k0 + kk] : 1.0f; LAS float* d = scr + kk * 33 + c4;
            d[0] = v[i][0] * gsc; d[1] = v[i][1] * gsc; d[2] = v[i][2] * gsc; d[3] = v[i][3] * gsc; }
    }
    asm volatile("s_waitcnt lgkmcnt(0)" ::: "memory");
    const int c = lane & 7;
#pragma unroll
    for (int j = 0; j < 4; ++j) { const int n = (lane >> 3) + 8 * j; const LAS float* s = scr + (8 * c) * 33 + n;
        u32x4 o; o.x = pkbf(s[0 * 33], s[1 * 33]); o.y = pkbf(s[2 * 33], s[3 * 33]); o.z = pkbf(s[4 * 33], s[5 * 33]); o.w = pkbf(s[6 * 33], s[7 * 33]);
        *(u32x4*)(WT + (size_t)(r0 + n) * K + kofs + k0 + 8 * c) = o; }
    asm volatile("s_waitcnt lgkmcnt(0)" ::: "memory");
}
constexpr int IT_W1 = (N1 / 32) * (DM / 64), IT_W3A = (DM / 32) * (DR / 64), IT_W3B = (DM / 32) * (AO / 64), IT_W4 = (DM / 32) * (DM / 64), IT_W5 = (2 * DFF / 32) * (DM / 64), IT_W6 = (DM / 32) * (DFF / 64);
constexpr int IT_L = IT_W1 + IT_W3A + IT_W3B + IT_W4 + IT_W5 + IT_W6;
__device__ __forceinline__ void p0_prologue(const Ptrs& P, LAS unsigned char* lds, int gw, int ngw, int wv, int lane) {
    LAS float* scr = (LAS float*)(lds + wv * 16384);
    for (int it = gw; it < DEPTH * IT_L; it += ngw) {
        const int l = it / IT_L; int r = it % IT_L;
        unsigned char* wb = P.ws + WS_W + l * LW_BYTES;
        if (r < IT_W1) { const int kb = r & 15, nb = r >> 4, nt0 = 32 * nb, c = w1_src_col(nt0);
            if (c < 6656) tr_item(P.w_in + (size_t)l * DM * 6656, 6656, c, 64 * kb, P.norm_mix + l * DM, (bf16_t*)(wb + LW_W1), DM, nt0, 0, scr, lane);
            else tr_item(P.w_merge + (size_t)l * DM * 2048, 2048, c - 6656, 64 * kb, P.norm_mix + l * DM, (bf16_t*)(wb + LW_W1), DM, nt0, 0, scr, lane);
            continue; }
        r -= IT_W1;
        if (r < IT_W3A) { const int kb = r & 15, nb = r >> 4; tr_item(P.w_branch_lru + (size_t)l * DR * DM, DM, 32 * nb, 64 * kb, nullptr, (bf16_t*)(wb + LW_W3), K3, 32 * nb, 0, scr, lane); continue; }
        r -= IT_W3A;
        if (r < IT_W3B) { const int kb = r & 7, nb = r >> 3; tr_item(P.w_branch_att + (size_t)l * AO * DM, DM, 32 * nb, 64 * kb, nullptr, (bf16_t*)(wb + LW_W3), K3, 32 * nb, DR, scr, lane); continue; }
        r -= IT_W3B;
        if (r < IT_W4) { const int kb = r & 15, nb = r >> 4; tr_item(P.w_o + (size_t)l * DM * DM, DM, 32 * nb, 64 * kb, nullptr, (bf16_t*)(wb + LW_W4), DM, 32 * nb, 0, scr, lane); continue; }
        r -= IT_W4;
        if (r < IT_W5) { const int kb = r & 15, nb = r >> 4, nt0 = 32 * nb; tr_item(P.w_ffn_in + (size_t)l * DM * 2 * DFF, 2 * DFF, w5_src_col(nt0), 64 * kb, P.norm_ffn + l * DM, (bf16_t*)(wb + LW_W5), DM, nt0, 0, scr, lane); continue; }
        r -= IT_W5;
        { const int kb = r % 44, nb = r / 44; tr_item(P.w_ffn_out + (size_t)l * DFF * DM, DM, 32 * nb, 64 * kb, nullptr, (bf16_t*)(wb + LW_W6), DFF, 32 * nb, 0, scr, lane); }
    }
    float* BIAS = (float*)(P.ws + WS_BIAS);
    for (int e = gw * 64 + lane; e < NG * HPG * NKEY; e += ngw * 64) {
        const int kk = e % NKEY, hh = (e / NKEY) % HPG, g = e / (NKEY * HPG);
        const int d = kk * g_dil(g); int bkt;
        if (d < 16) bkt = d; else { const float df = (float)d; int lg = 16 + (int)(logf(df / 16.0f) / logf(128.0f) * 16.0f); bkt = lg < 31 ? lg : 31; }
        BIAS[e] = P.rel_bias[bkt * NH + 8 * g + hh] * LOG2E;
    }
    for (int row = gw; row < MT; row += ngw) {
        const f32x4* xr = (const f32x4*)xin_row(P, row) + lane; bf16_t* xb = (bf16_t*)(P.ws + WS_XB) + (size_t)row * DM; float* ssq = (float*)(P.ws + WS_SSQ) + (size_t)row * 16;
        float s = 0.f;
#pragma unroll
        for (int j = 0; j < 4; ++j) { const f32x4 v = xr[64 * j]; s += (v[0] * v[0] + v[1] * v[1]) + (v[2] * v[2] + v[3] * v[3]);
            u32x2 w; w.x = pkbf(v[0], v[1]); w.y = pkbf(v[2], v[3]); *(u32x2*)(xb + 4 * lane + 256 * j) = w; }
        s = wave_sum(s);
        if (lane < 16) ssq[lane] = (lane == 0) ? s : 0.f;
    }
}

__device__ __forceinline__ void ph_combine(const Ptrs& P, size_t gtid, size_t nth) {
    const bf16_t* OG = (const bf16_t*)(P.ws + WS_OG); const float* ML = (const float*)(P.ws + WS_ML); bf16_t* A3 = (bf16_t*)(P.ws + WS_A3);
    for (size_t e = gtid; e < (size_t)MT * 64; e += nth) {
        const size_t row = e >> 6; const int hh = (int)(e >> 3) & 7, ch = (int)e & 7;
        f32x2 q[3]; u32x4 og[3];
#pragma unroll
        for (int g = 0; g < 3; ++g) { q[g] = *(const f32x2*)(ML + (((size_t)g * MT + row) * HPG + hh) * 2); og[g] = *(const u32x4*)(OG + ((size_t)g * MT + row) * AO + hh * HD + 8 * ch); }
        const float mm = fmaxf(fmaxf(q[0].x, q[1].x), q[2].x);
        float z[3], den = 0.f;
#pragma unroll
        for (int g = 0; g < 3; ++g) { z[g] = q[g].y * __builtin_amdgcn_exp2f(q[g].x - mm); den += z[g]; }
        const float inv = 1.0f / den;
        f32x4 o0 = (f32x4){0.f, 0.f, 0.f, 0.f}, o1 = (f32x4){0.f, 0.f, 0.f, 0.f};
#pragma unroll
        for (int g = 0; g < 3; ++g) { const float w = z[g] * inv; const u32x4 v = og[g];
            o0 = o0 + (f32x4){bflo(v.x), bfhi(v.x), bflo(v.y), bfhi(v.y)} * w; o1 = o1 + (f32x4){bflo(v.z), bfhi(v.z), bflo(v.w), bfhi(v.w)} * w; }
        *(u32x4*)(A3 + row * K3 + DR + hh * HD + 8 * ch) = pack8(o0, o1);
    }
}

constexpr int SC_XCF = 0;
constexpr int SC_HSF = 34816;
constexpr int SC_XCB = 69632;
constexpr int SC_WTA = 88064;
constexpr int SC_WTX = 97280;
constexpr int SC_WTOT = 106496;
constexpr int SC_WC = 110592;
constexpr int SC_END = 111872;

template <int MODE>
__device__ __forceinline__ void scan_item(const Ptrs& P, int l, LAS unsigned char* lds, int wv, int tid_, int b, int n, int span) {
    int tid = tid_; asm volatile("" : "+v"(tid));
    const int lane = tid & 63, fr = lane & 15, fq = lane >> 4;
    LAS float* XCF = (LAS float*)(lds + SC_XCF); LAS float* HSF = (LAS float*)(lds + SC_HSF); LAS bf16_t* XCB = (LAS bf16_t*)(lds + SC_XCB);
    LAS bf16_t* WTA = (LAS bf16_t*)(lds + SC_WTA); LAS bf16_t* WTX = (LAS bf16_t*)(lds + SC_WTX);
    LAS f32x2* WTOT = (LAS f32x2*)(lds + SC_WTOT); LAS float* WC = (LAS float*)(lds + SC_WC);
    const bf16_t* LX = (const bf16_t*)(P.ws + WS_LX); const bf16_t* GG = (const bf16_t*)(P.ws + WS_GG); bf16_t* A3 = (bf16_t*)(P.ws + WS_A3);
    float* SUM = (float*)(P.ws + WS_SUM);
    __syncthreads();
    {
        const float* wa = P.w_rg_a + (size_t)(l * NBLK + n) * 4096; const float* wx = P.w_rg_x + (size_t)(l * NBLK + n) * 4096;
        for (int e = tid; e < 4096; e += 512) { const int i = e >> 6, j = e & 63; WTA[j * 72 + i] = f2b(wa[e]); WTX[j * 72 + i] = f2b(wx[e]); }
        if (tid < 320) { const int k = tid >> 6, c = tid & 63; WC[tid] = (k < 4) ? P.w_conv[(size_t)(l * CW + k) * DR + 64 * n + c] : P.b_conv[l * DR + 64 * n + c]; }
    }
    __syncthreads();
    bf16x8 wfa[4][2], wfx[4][2];
#pragma unroll
    for (int nt = 0; nt < 4; ++nt)
#pragma unroll
        for (int ks = 0; ks < 2; ++ks) { wfa[nt][ks] = *(const LAS bf16x8*)(WTA + (16 * nt + fr) * 72 + 32 * ks + 8 * fq); wfx[nt][ks] = *(const LAS bf16x8*)(WTX + (16 * nt + fr) * 72 + 32 * ks + 8 * fq); }
    float cba[4], cbx[4], csp[4], hc[4], pc[4];
#pragma unroll
    for (int nt = 0; nt < 4; ++nt) { const int ch = 64 * n + 16 * nt + fr;
        cba[nt] = P.b_rg_a[l * DR + ch]; cbx[nt] = P.b_rg_x[l * DR + ch]; csp[nt] = 8.0f * log1pf(expf(-P.lru_lambda[l * DR + ch]));
        float h = 0.f;
        if (MODE == 1) { for (int s = 0; s < span; ++s) { const f32x2 q = *(const f32x2*)(SUM + (((size_t)b * 8 + s) * DR + ch) * 2); h = q.x * h + q.y; } }
        hc[nt] = h; pc[nt] = 1.f; }
    u32x4 xr[2][4], gg[2];
#define SCAN_LOAD(C8) do { const int t0n = span * 1024 + (C8) * 128; _Pragma("unroll") for (int rep = 0; rep < 2; ++rep) { const int idx = tid + 512 * rep, tok = idx >> 3, cg = idx & 7, t = t0n + tok; const size_t rowg = (size_t)b * SEQ + t; \
        _Pragma("unroll") for (int k = 0; k < 4; ++k) { const int tt = t + k - 3; xr[rep][k] = *(const u32x4*)(LX + (rowg + (tt >= 0 ? k - 3 : -t)) * DR + 64 * n + 8 * cg); } \
        if (MODE == 1) gg[rep] = *(const u32x4*)(GG + rowg * DR + 64 * n + 8 * cg); } } while (0)
    SCAN_LOAD(0);
    for (int c8 = 0; c8 < 8; ++c8) {
        const int t0 = span * 1024 + c8 * 128;
        u32x4 gcur[2];
#pragma unroll
        for (int rep = 0; rep < 2; ++rep) {
            const int idx = tid + 512 * rep, tok = idx >> 3, cg = idx & 7, t = t0 + tok;
            float acc[8];
#pragma unroll
            for (int j = 0; j < 8; ++j) acc[j] = WC[4 * 64 + 8 * cg + j];
#pragma unroll
            for (int k = 0; k < 4; ++k) { const int tt = t + k - 3; const u32x4 x = xr[rep][k]; const float z = (tt >= 0) ? 1.0f : 0.0f;
                const LAS float* w = WC + k * 64 + 8 * cg;
                acc[0] += z * w[0] * bflo(x.x); acc[1] += z * w[1] * bfhi(x.x); acc[2] += z * w[2] * bflo(x.y); acc[3] += z * w[3] * bfhi(x.y);
                acc[4] += z * w[4] * bflo(x.z); acc[5] += z * w[5] * bfhi(x.z); acc[6] += z * w[6] * bflo(x.w); acc[7] += z * w[7] * bfhi(x.w); }
            *(LAS f32x4*)(XCF + tok * 68 + 8 * cg) = (f32x4){acc[0], acc[1], acc[2], acc[3]}; *(LAS f32x4*)(XCF + tok * 68 + 8 * cg + 4) = (f32x4){acc[4], acc[5], acc[6], acc[7]};
            *(LAS u32x4*)(XCB + tok * 72 + 8 * cg) = pack8((f32x4){acc[0], acc[1], acc[2], acc[3]}, (f32x4){acc[4], acc[5], acc[6], acc[7]});
            if (MODE == 1) gcur[rep] = gg[rep];
        }
        asm volatile("" ::: "memory");
        if (c8 + 1 < 8) SCAN_LOAD(c8 + 1);
        LDS_BARRIER();
        bf16x8 af[2];
#pragma unroll
        for (int ks = 0; ks < 2; ++ks) af[ks] = *(const LAS bf16x8*)(XCB + (16 * wv + fr) * 72 + 32 * ks + 8 * fq);
        float hl[4][4], ac[4][4], Ae[4], He[4];
#pragma unroll
        for (int nt = 0; nt < 4; ++nt) {
            f32x4 da = (f32x4){0.f, 0.f, 0.f, 0.f}, dx = (f32x4){0.f, 0.f, 0.f, 0.f};
#pragma unroll
            for (int ks = 0; ks < 2; ++ks) { da = __builtin_amdgcn_mfma_f32_16x16x32_bf16(af[ks], wfa[nt][ks], da, 0, 0, 0); dx = __builtin_amdgcn_mfma_f32_16x16x32_bf16(af[ks], wfx[nt][ks], dx, 0, 0, 0); }
            float A = 1.f, H = 0.f;
#pragma unroll
            for (int r = 0; r < 4; ++r) {
                const int tok = 16 * wv + 4 * fq + r;
                const float rr = sigmoidf_(da[r] + cba[nt]), ii = sigmoidf_(dx[r] + cbx[nt]);
                const float av = __expf(-rr * csp[nt]);
                float mult = sqrtf(fmaxf(fmaf(-av, av, 1.0f), 0.f)); if (t0 + tok == 0) mult = 1.0f;
                const float u = mult * ii * XCF[tok * 68 + 16 * nt + fr];
                H = av * H + u; A = A * av; hl[nt][r] = H; ac[nt][r] = A;
            }
            { const float A1 = __shfl(A, lane - 16), H1 = __shfl(H, lane - 16); if (fq >= 1) { H = A * H1 + H; A = A * A1; } }
            { const float A2 = __shfl(A, lane - 32), H2 = __shfl(H, lane - 32); if (fq >= 2) { H = A * H2 + H; A = A * A2; } }
            { const float A3_ = __shfl(A, lane - 16), H3 = __shfl(H, lane - 16); Ae[nt] = (fq >= 1) ? A3_ : 1.f; He[nt] = (fq >= 1) ? H3 : 0.f; }
            if (fq == 3) WTOT[wv * 64 + 16 * nt + fr] = (f32x2){A, H};
        }
        LDS_BARRIER();
#pragma unroll
        for (int nt = 0; nt < 4; ++nt) {
            float hrun = hc[nt], prun = pc[nt], hin = 0.f;
#pragma unroll
            for (int w = 0; w < 8; ++w) { const f32x2 q = WTOT[w * 64 + 16 * nt + fr]; if (w == wv) hin = hrun; hrun = q.x * hrun + q.y; prun = prun * q.x; }
            hc[nt] = hrun; pc[nt] = prun;
            if (MODE == 1) {
#pragma unroll
                for (int r = 0; r < 4; ++r) { const int tok = 16 * wv + 4 * fq + r; HSF[tok * 68 + 16 * nt + fr] = (ac[nt][r] * Ae[nt]) * hin + (ac[nt][r] * He[nt] + hl[nt][r]); }
            }
        }
        if (MODE == 1) {
            LDS_BARRIER();
#pragma unroll
            for (int rep = 0; rep < 2; ++rep) {
                const int idx = tid + 512 * rep, tok = idx >> 3, cg = idx & 7; const size_t rowg = (size_t)b * SEQ + t0 + tok;
                const f32x4 h0 = *(const LAS f32x4*)(HSF + tok * 68 + 8 * cg), h1 = *(const LAS f32x4*)(HSF + tok * 68 + 8 * cg + 4);
                const u32x4 g = gcur[rep];
                const f32x4 o0 = (f32x4){h0[0] * bflo(g.x), h0[1] * bfhi(g.x), h0[2] * bflo(g.y), h0[3] * bfhi(g.y)}, o1 = (f32x4){h1[0] * bflo(g.z), h1[1] * bfhi(g.z), h1[2] * bflo(g.w), h1[3] * bfhi(g.w)};
                *(u32x4*)(A3 + rowg * K3 + 64 * n + 8 * cg) = pack8(o0, o1);
            }
        }
    }
#undef SCAN_LOAD
    if (wv == 0 && fq == 0) {
#pragma unroll
        for (int nt = 0; nt < 4; ++nt) { const int ch = 64 * n + 16 * nt + fr;
            if (MODE == 0) *(f32x2*)(SUM + (((size_t)b * 8 + span) * DR + ch) * 2) = (f32x2){pc[nt], hc[nt]};
            else if (span == 7) P.out[O_HP + (size_t)(l * NB + b) * DR + ch] = hc[nt]; }
    }
}
__device__ __forceinline__ void scan_sample(const Ptrs& P, int l, LAS unsigned char* lds, int tid, int rg, int n) {
    LAS float* XS = (LAS float*)lds;
    const int r = tid >> 6, j = tid & 63, b = 8 * rg + r, ch = 64 * n + j; const size_t row = (size_t)MP + b;
    const bf16_t* LX = (const bf16_t*)(P.ws + WS_LX); const bf16_t* GG = (const bf16_t*)(P.ws + WS_GG); bf16_t* A3 = (bf16_t*)(P.ws + WS_A3);
    const float* wc = P.w_conv + (size_t)l * CW * DR; const float* sc = P.state_conv + (size_t)(l * SB + b) * 3 * DR;
    const float xc = P.b_conv[l * DR + ch] + wc[ch] * sc[ch] + wc[DR + ch] * sc[DR + ch] + wc[2 * DR + ch] * sc[2 * DR + ch] + wc[3 * DR + ch] * bf2f(LX[row * DR + ch]);
    __syncthreads();
    XS[r * 64 + j] = xc;
    __syncthreads();
    const float* wa = P.w_rg_a + (size_t)(l * NBLK + n) * 4096 + j; const float* wx = P.w_rg_x + (size_t)(l * NBLK + n) * 4096 + j;
    float ga = P.b_rg_a[l * DR + ch], gx = P.b_rg_x[l * DR + ch];
#pragma unroll 1
    for (int i0 = 0; i0 < 64; i0 += 16) {
        float wa_[16], wx_[16];
#pragma unroll
        for (int i = 0; i < 16; ++i) { wa_[i] = wa[(i0 + i) * 64]; wx_[i] = wx[(i0 + i) * 64]; }
#pragma unroll
        for (int i = 0; i < 16; ++i) { const float x = XS[r * 64 + i0 + i]; ga += x * wa_[i]; gx += x * wx_[i]; }
    }
    const float rr = sigmoidf_(ga), ii = sigmoidf_(gx);
    const float log_a = -8.0f * rr * log1pf(expf(-P.lru_lambda[l * DR + ch])); const float av = expf(log_a);
    const float mult = sqrtf(-expm1f(2.0f * log_a));
    const float h = av * P.state_h[(size_t)(l * SB + b) * DR + ch] + mult * ii * xc;
    P.out[O_HS + (size_t)(l * SB + b) * DR + ch] = h;
    A3[row * K3 + ch] = f2b(h * bf2f(GG[row * DR + ch]));
}

constexpr int AT_K = 0, AT_V = 49152, AT_B = 98304, AT_W = 99328, AT_O = 101376, AT_END = 134144;
typedef float f32x16 __attribute__((ext_vector_type(16)));
typedef short s16x4 __attribute__((ext_vector_type(4)));
__device__ __forceinline__ int crow(int r, int hi) { return (r & 3) + 8 * (r >> 2) + 4 * hi; }
__device__ __forceinline__ s16x4 ds_tr16(const LAS unsigned char* p) { return __builtin_bit_cast(s16x4, __builtin_amdgcn_ds_read_tr16_b64_v4i16((LAS s16x4*)p)); }
struct AttnUnit { int g, b, hh, d, rho, u, head, j0; size_t rowbase; };
__device__ __forceinline__ AttnUnit attn_decode(int unit) {
    AttnUnit a; a.g = unit >> 9; const int rem = unit & 511; a.b = rem >> 8; a.hh = (rem >> 5) & 7; const int ru = rem & 31;
    a.d = g_dil(a.g); const int nub = 32 / a.d; a.rho = ru / nub; a.u = ru % nub; a.head = 8 * a.g + a.hh; a.j0 = 256 * a.u; a.rowbase = (size_t)a.b * SEQ + a.rho; return a;
}
__device__ __forceinline__ void attn_load(const Ptrs& P, const AttnUnit& a, int tid, u32x4 (&kq)[6], u32x4 (&vq)[6]) {
    const bf16_t* K = (const bf16_t*)(P.ws + WS_K); const bf16_t* V = (const bf16_t*)(P.ws + WS_V);
#pragma unroll
    for (int i = 0; i < 6; ++i) {
        const int idx = tid + 512 * i, key = idx >> 3, ch = idx & 7, j = a.j0 - 128 + key;
        const size_t off = (a.rowbase + (size_t)a.d * (j < 0 ? 0 : j)) * AW + a.head * HD + 8 * ch;
        kq[i] = *(const u32x4*)(K + off); vq[i] = *(const u32x4*)(V + off);
    }
}
__device__ __forceinline__ void attn_loadq(const Ptrs& P, const AttnUnit& a, int wv, int tid, bf16x8 (&qf)[4]) {
    const bf16_t* Q = (const bf16_t*)(P.ws + WS_Q);
    const int lane = tid & 63, l31 = lane & 31, hi = lane >> 5;
    const size_t rq = (a.rowbase + (size_t)a.d * (a.j0 + 32 * wv + l31)) * AW + a.head * HD + 8 * hi;
#pragma unroll
    for (int ks = 0; ks < 4; ++ks) qf[ks] = *(const bf16x8*)(Q + rq + 16 * ks);
}
__device__ __forceinline__ void attn_phase(const Ptrs& P, int l, LAS unsigned char* lds, int wv, int tid, int bid, int G) {
    const int lane = tid & 63, l31 = lane & 31, hi = lane >> 5;
    LAS float* BL = (LAS float*)(lds + AT_B); LAS float* LW = (LAS float*)(lds + AT_W) + wv * 64; LAS bf16_t* OS = (LAS bf16_t*)(lds + AT_O) + wv * 2048;
    u32x4 kq[6], vq[6]; float bl = 0.f;
    int unit = bid;
    if (unit >= 1536) return;
    AttnUnit a = attn_decode(unit);
    attn_load(P, a, tid, kq, vq); if (tid < NKEY) bl = ((const float*)(P.ws + WS_BIAS))[(size_t)(a.g * HPG + a.hh) * NKEY + tid];
    bf16x8 qn[4];
    attn_loadq(P, a, wv, tid, qn);
    for (; unit < 1536; unit += G) {
        LDS_BARRIER();
        int tl = tid; asm volatile("" : "+v"(tl));
#pragma unroll
        for (int i = 0; i < 6; ++i) {
            const int idx = tl + 512 * i, key = idx >> 3, ch = idx & 7; const unsigned msk = (a.j0 - 128 + key >= 0) ? 0xffffffffu : 0u;
            *(LAS u32x4*)(lds + AT_K + key * 128 + ((ch ^ ((key >> 1) & 7)) << 4)) = kq[i] & msk;
            *(LAS u32x4*)(lds + AT_V + key * 128 + (ch << 4)) = vq[i] & msk;
        }
        if (tl < NKEY) BL[tl] = bl;
        const AttnUnit cur = a;
        bf16x8 qf[4];
#pragma unroll
        for (int ks = 0; ks < 4; ++ks) qf[ks] = qn[ks];
        LDS_BARRIER();
        f32x16 S[5];
#pragma unroll
        for (int c = 0; c < 5; ++c) {
            const int key = 32 * (wv + c) + l31;
            f32x16 acc = {};
#pragma unroll
            for (int ks = 0; ks < 4; ++ks) {
                const bf16x8 kf = *(const LAS bf16x8*)(lds + AT_K + key * 128 + (((2 * ks + hi) ^ ((key >> 1) & 7)) << 4));
                acc = __builtin_amdgcn_mfma_f32_32x32x16_bf16(kf, qf[ks], acc, 0, 0, 0);
            }
            S[c] = acc;
            if (c & 1) asm volatile("" ::: "memory");
        }
        asm volatile("" ::: "memory");
        if (unit + G < 1536) { a = attn_decode(unit + G); attn_load(P, a, tid, kq, vq); attn_loadq(P, a, wv, tid, qn); if (tid < NKEY) bl = ((const float*)(P.ws + WS_BIAS))[(size_t)(a.g * HPG + a.hh) * NKEY + tid]; }
        float mx = -INFINITY;
#pragma unroll
        for (int c = 0; c < 5; ++c) {
            const bool tile_ok = (cur.u > 0) || (wv + c >= 4);
#pragma unroll
            for (int r = 0; r < 16; ++r) {
                const int dist = 128 - 32 * c + l31 - crow(r, hi);
                const int dcl = (c == 0) ? (dist > 128 ? 128 : dist) : ((c == 4) ? (dist < 0 ? 0 : dist) : dist);
                const float bv = BL[dcl];
                float s = S[c][r] + bv;
                if (c == 0) s = (dist > 128) ? -INFINITY : s;
                if (c == 4) s = (dist < 0) ? -INFINITY : s;
                s = tile_ok ? s : -INFINITY;
                S[c][r] = s; mx = fmaxf(mx, s);
            }
        }
        mx = fmaxf(mx, __shfl_xor(mx, 32));
        float lsum = 0.f;
        u32x4 pw[5][2];
#pragma unroll
        for (int c = 0; c < 5; ++c)
#pragma unroll
            for (int s = 0; s < 2; ++s) {
                float p[8];
#pragma unroll
                for (int j = 0; j < 8; ++j) { p[j] = __builtin_amdgcn_exp2f(S[c][8 * s + j] - mx); lsum += p[j]; }
                pw[c][s].x = pkbf(p[0], p[1]); pw[c][s].y = pkbf(p[2], p[3]); pw[c][s].z = pkbf(p[4], p[5]); pw[c][s].w = pkbf(p[6], p[7]);
            }
        lsum += __shfl_xor(lsum, 32);
        if (hi == 0) { LW[l31] = lsum;
            float* ML = (float*)(P.ws + WS_ML) + (((size_t)cur.g * MT + cur.rowbase + (size_t)cur.d * (cur.j0 + 32 * wv + l31)) * HPG + cur.hh) * 2; *(f32x2*)ML = (f32x2){mx, lsum}; }
        f32x16 o[2]; o[0] = (f32x16){}; o[1] = (f32x16){};
        const int g16 = lane >> 4, i16 = lane & 15;
        const LAS unsigned char* vb = lds + AT_V + (4 * hi + (i16 >> 2)) * 128 + (16 * (g16 & 1) + 4 * (i16 & 3)) * 2;
#pragma unroll
        for (int c = 0; c < 5; ++c)
#pragma unroll
            for (int s = 0; s < 2; ++s) {
                const bf16x8 pa = __builtin_bit_cast(bf16x8, pw[c][s]);
                const LAS unsigned char* vp = vb + (32 * (wv + c) + 16 * s) * 128;
#pragma unroll
                for (int db = 0; db < 2; ++db) {
                    const s16x4 lo = ds_tr16(vp + 64 * db), hi4 = ds_tr16(vp + 64 * db + 8 * 128);
                    const bf16x8 vf = (bf16x8){lo[0], lo[1], lo[2], lo[3], hi4[0], hi4[1], hi4[2], hi4[3]};
                    o[db] = __builtin_amdgcn_mfma_f32_32x32x16_bf16(pa, vf, o[db], 0, 0, 0);
                }
            }
        int lo_ = lane; asm volatile("" : "+v"(lo_)); const int l31o = lo_ & 31, hio = lo_ >> 5;
#pragma unroll
        for (int r = 0; r < 16; ++r) {
            const int q = crow(r, hio); const float inv = __builtin_amdgcn_rcpf(LW[q]);
            const unsigned w = pkbf(o[0][r] * inv, o[1][r] * inv);
            OS[q * 64 + l31o] = (bf16_t)(w & 0xffffu); OS[q * 64 + 32 + l31o] = (bf16_t)(w >> 16);
        }
        asm volatile("s_waitcnt lgkmcnt(0)" ::: "memory");
        bf16_t* OG = (bf16_t*)(P.ws + WS_OG) + (size_t)cur.g * MT * AO;
#pragma unroll
        for (int i = 0; i < 4; ++i) {
            const int q = 8 * i + (lo_ >> 3), ch = lo_ & 7;
            const u32x4 v = *(const LAS u32x4*)(OS + q * 64 + 8 * ch);
            *(u32x4*)(OG + (cur.rowbase + (size_t)cur.d * (cur.j0 + 32 * wv + q)) * AO + cur.hh * HD + 8 * ch) = v;
        }
    }
}
__device__ __forceinline__ void attn_sample(const Ptrs& P, int l, LAS unsigned char* lds, int wv, int lane, int item) {
    const int b = item / NH, head = item % NH, g = head >> 3, hh = head & 7, dil = g_dil(g), Lc = g_win(g);
    const bf16_t* Q = (const bf16_t*)(P.ws + WS_Q); const bf16_t* K = (const bf16_t*)(P.ws + WS_K); const bf16_t* V = (const bf16_t*)(P.ws + WS_V);
    const float* BIAS = (const float*)(P.ws + WS_BIAS) + (size_t)(g * HPG + hh) * NKEY;
    const float* cache = P.cache[g] + (size_t)(l * SB + b) * Lc * 1024;
    const size_t row = (size_t)MP + b;
    LAS float* qw = (LAS float*)(lds + AT_W) + wv * 64;
    qw[lane] = bf2f(Q[row * AW + head * HD + lane]);
    asm volatile("s_waitcnt lgkmcnt(0)" ::: "memory");
    float s[3];
#pragma unroll
    for (int j = 0; j < 3; ++j) { const int kk = lane + 64 * j; float acc = -INFINITY;
        if (kk <= 128) { acc = 0.f;
            if (kk == 0) { const bf16_t* kr = K + row * AW + head * HD; for (int dd = 0; dd < HD; ++dd) acc += qw[dd] * bf2f(kr[dd]); }
            else { const f32x4* kr = (const f32x4*)(cache + ((size_t)(Lc - kk * dil) * 2 + 0) * 512 + hh * HD);
#pragma unroll
                for (int dd = 0; dd < 16; ++dd) { const f32x4 kv = kr[dd]; const f32x4 qv = *(const LAS f32x4*)(qw + 4 * dd); acc += (kv[0] * qv[0] + kv[1] * qv[1]) + (kv[2] * qv[2] + kv[3] * qv[3]); } }
            acc = acc + BIAS[kk]; }
        s[j] = acc; }
    const float m = wave_max(fmaxf(fmaxf(s[0], s[1]), s[2]));
    float p[3]; float lsum = 0.f;
#pragma unroll
    for (int j = 0; j < 3; ++j) { p[j] = (lane + 64 * j <= 128) ? __builtin_amdgcn_exp2f(s[j] - m) : 0.f; lsum += p[j]; }
    lsum = wave_sum(lsum);
    float o = __shfl(p[0], 0) * bf2f(V[row * AW + head * HD + lane]);
#pragma unroll 1
    for (int k0 = 1; k0 <= 128; k0 += 32) {
        float vv[32];
#pragma unroll
        for (int i = 0; i < 32; ++i) vv[i] = cache[((size_t)(Lc - (k0 + i) * dil) * 2 + 1) * 512 + hh * HD + lane];
#pragma unroll
        for (int i = 0; i < 32; ++i) { const int kk = k0 + i; const float pk = __shfl(kk < 64 ? p[0] : (kk < 128 ? p[1] : p[2]), kk & 63); o += pk * vv[i]; }
    }
    bf16_t* OG = (bf16_t*)(P.ws + WS_OG) + ((size_t)g * MT + row) * AO; OG[hh * HD + lane] = f2b(o / lsum);
    if (lane == 0) { float* ML = (float*)(P.ws + WS_ML) + (((size_t)g * MT + row) * HPG + hh) * 2; ML[0] = m; ML[1] = lsum; }
}

template <int NSTEP>
__device__ __forceinline__ void sg_part(const bf16_t* A, int lda, const bf16_t* Bt, int ldb, int k0, int colbase, LAS float* TLP, int wv, int lane) {
    const int l31 = lane & 31, hi = lane >> 5, cb = wv & 1, kq = wv >> 1;
    const bf16_t* ap = A + (size_t)l31 * lda + k0 + kq * (NSTEP * 16) + 8 * hi;
    const bf16_t* bp = Bt + (size_t)(colbase + 128 * cb + l31) * ldb + k0 + kq * (NSTEP * 16) + 8 * hi;
    f32x16 acc = {};
    int s = 0;
#pragma unroll 1
    for (; s + 8 <= NSTEP; s += 8) {
        bf16x8 a[8], b[8];
#pragma unroll
        for (int i = 0; i < 8; ++i) { a[i] = *(const bf16x8*)(ap + 16 * (s + i)); b[i] = *(const bf16x8*)(bp + 16 * (s + i)); }
#pragma unroll
        for (int i = 0; i < 8; ++i) acc = __builtin_amdgcn_mfma_f32_32x32x16_bf16(a[i], b[i], acc, 0, 0, 0);
    }
    if (NSTEP & 4) {
        bf16x8 a[4], b[4];
#pragma unroll
        for (int i = 0; i < 4; ++i) { a[i] = *(const bf16x8*)(ap + 16 * (s + i)); b[i] = *(const bf16x8*)(bp + 16 * (s + i)); }
#pragma unroll
        for (int i = 0; i < 4; ++i) acc = __builtin_amdgcn_mfma_f32_32x32x16_bf16(a[i], b[i], acc, 0, 0, 0);
    }
    LAS float* t = TLP + kq * 2048 + 32 * cb + l31;
#pragma unroll
    for (int r = 0; r < 16; ++r) t[crow(r, hi) * 64] = acc[r];
}
__device__ __forceinline__ f32x4 sg_sum(const LAS float* TLP, int r, int q) {
    const LAS f32x4* p = (const LAS f32x4*)(TLP + r * 64 + 4 * q);
    return (p[0] + p[512]) + (p[1024] + p[1536]);
}
__device__ __forceinline__ float red16(float v) { v += __shfl_xor(v, 1); v += __shfl_xor(v, 2); v += __shfl_xor(v, 4); v += __shfl_xor(v, 8); return v; }

template <int WHICH>
__device__ __forceinline__ void sample_strip(const Ptrs& P, int l, LAS unsigned char* lds, int wv, int tid, int s, int first) {
    const int lane = tid & 63, pn = s >> 2, wc = s & 3, colbase = 256 * pn + 32 * wc;
    unsigned char* ws = P.ws; unsigned char* wb = ws + WS_W + l * LW_BYTES;
    LAS float* TLP = (LAS float*)lds; LAS float* TLP2 = TLP + 8192;
    __syncthreads();
    if (WHICH == 1) sg_part<16>((const bf16_t*)(ws + WS_XB) + (size_t)MP * DM, DM, (const bf16_t*)(wb + LW_W1), DM, 0, colbase, TLP, wv, lane);
    if (WHICH == 3) { sg_part<16>((const bf16_t*)(ws + WS_A3) + (size_t)MP * K3, K3, (const bf16_t*)(wb + LW_W3), K3, 0, colbase, TLP, wv, lane);
                      sg_part<8>((const bf16_t*)(ws + WS_A3) + (size_t)MP * K3, K3, (const bf16_t*)(wb + LW_W3), K3, DR, colbase, TLP2, wv, lane); }
    if (WHICH == 4) sg_part<16>((const bf16_t*)(ws + WS_MRG) + (size_t)MP * DM, DM, (const bf16_t*)(wb + LW_W4), DM, 0, colbase, TLP, wv, lane);
    if (WHICH == 5) sg_part<16>((const bf16_t*)(ws + WS_XB) + (size_t)MP * DM, DM, (const bf16_t*)(wb + LW_W5), DM, 0, colbase, TLP, wv, lane);
    if (WHICH == 6) sg_part<44>((const bf16_t*)(ws + WS_H) + (size_t)MP * DFF, DFF, (const bf16_t*)(wb + LW_W6), DFF, 0, colbase, TLP, wv, lane);
    __syncthreads();
    const int r = tid >> 4, q = tid & 15, c0 = 4 * q, cb = q >> 3, i0 = c0 & 31;
    const size_t row = (size_t)MP + r;
    f32x4 y = sg_sum(TLP, r, q);
    const float* ssq = (const float*)(ws + WS_SSQ);
    if (WHICH == 1) {
        const float rs = row_rs(ssq, (int)row);
        const f32x4 v = y * rs;
        if (pn < 8) {
            const int col = (pn & 3) * 256 + 128 * cb + 32 * wc + i0;
            if (pn < 4) {
                u32x2 w; w.x = pkbf(v[0], v[1]); w.y = pkbf(v[2], v[3]); *(u32x2*)((bf16_t*)(ws + WS_LX) + row * DR + col) = w;
                float* cs = P.out + O_CONVS + (size_t)(l * SB + r) * 3 * DR + col; const float* sc = P.state_conv + (size_t)(l * SB + r) * 3 * DR + col;
                *(f32x4*)cs = *(const f32x4*)(sc + DR); *(f32x4*)(cs + DR) = *(const f32x4*)(sc + 2 * DR); *(f32x4*)(cs + 2 * DR) = v;
            } else {
                u32x2 w; w.x = pkbf(gelu_tanh(v[0]), gelu_tanh(v[1])); w.y = pkbf(gelu_tanh(v[2]), gelu_tanh(v[3])); *(u32x2*)((bf16_t*)(ws + WS_GG) + row * DR + col) = w;
            }
        } else if (pn < 26) {
            const int tq = pn - 8, type = tq / 6, head = 4 * (tq % 6) + wc, g = head >> 3, hh = head & 7;
            f32x4 o = v;
            const float ss = red16((v[0] * v[0] + v[1] * v[1]) + (v[2] * v[2] + v[3] * v[3]));
            if (type < 2) { const float inv = rsqrtf(ss * (1.0f / HD) + EPS) * (type == 0 ? QSCALE : 1.0f); const f32x4 gn = *(const f32x4*)((type == 0 ? P.q_gain : P.k_gain) + l * HD + c0); o = v * inv * gn; }
            bf16_t* dst = (bf16_t*)(ws + (type == 0 ? WS_Q : (type == 1 ? WS_K : WS_V)));
            u32x2 w; w.x = pkbf(o[0], o[1]); w.y = pkbf(o[2], o[3]); *(u32x2*)(dst + row * AW + head * HD + c0) = w;
            if (type >= 1) *(f32x4*)(P.out + o_kvs(g) + (((size_t)(l * SB + r) * 2 + (type - 1)) * HPG + hh) * HD + c0) = o;
        } else if (q < 8) {
            const f32x4 ya = sg_sum(TLP, r, q + 8);
            const float* bm = P.b_merge + (size_t)l * 2048; const int col = (pn - 26) * 128 + 32 * wc + i0;
            const f32x4 xl = v + *(const f32x4*)(bm + col), xa = ya * rs + *(const f32x4*)(bm + 1024 + col);
            f32x4 rho, gav;
#pragma unroll
            for (int e = 0; e < 4; ++e) { const float el = __expf(-xl[e]), ea = fminf(__expf(-xa[e]), 1e30f); gav[e] = __builtin_amdgcn_rcpf(1.0f + ea); rho[e] = (1.0f + ea) * __builtin_amdgcn_rcpf(1.0f + el); }
            bf16_t* GM = (bf16_t*)(ws + WS_GM) + row * 2048;
            u32x2 w; w.x = pkbf(rho[0], rho[1]); w.y = pkbf(rho[2], rho[3]); *(u32x2*)(GM + col) = w;
            w.x = pkbf(gav[0], gav[1]); w.y = pkbf(gav[2], gav[3]); *(u32x2*)(GM + 1024 + col) = w;
        }
    } else if (WHICH == 3) {
        const f32x4 y2 = sg_sum(TLP2, r, q);
        const int col = 256 * pn + 128 * cb + 32 * wc + i0;
        const bf16_t* GM = (const bf16_t*)(ws + WS_GM) + row * 2048;
        const u32x2 gl = *(const u32x2*)(GM + col), ga = *(const u32x2*)(GM + 1024 + col);
        const f32x4 rho = (f32x4){bflo(gl.x), bfhi(gl.x), bflo(gl.y), bfhi(gl.y)}, gav = (f32x4){bflo(ga.x), bfhi(ga.x), bflo(ga.y), bfhi(ga.y)};
        const f32x4 mg = gav * (rho * y + y2);
        u32x2 w; w.x = pkbf(mg[0], mg[1]); w.y = pkbf(mg[2], mg[3]); *(u32x2*)((bf16_t*)(ws + WS_MRG) + row * DM + col) = w;
    } else if (WHICH == 4 || WHICH == 6) {
        const int col = 256 * pn + 128 * cb + 32 * wc + i0;
        bf16_t* xb = (bf16_t*)(ws + WS_XB) + row * DM + col;
        f32x4 base;
        if (first & 1) base = *(const f32x4*)(P.x_sample + (size_t)r * DM + col);
        else { const u32x2 wq = *(const u32x2*)xb; base = (f32x4){bflo(wq.x), bfhi(wq.x), bflo(wq.y), bfhi(wq.y)}; }
        const f32x4 v = base + y;
        if (first & 2) *(f32x4*)(P.out + O_Y + row * DM + col) = v;
        else { u32x2 w; w.x = pkbf(v[0], v[1]); w.y = pkbf(v[2], v[3]); *(u32x2*)xb = w; }
        const float ss = red16((v[0] * v[0] + v[1] * v[1]) + (v[2] * v[2] + v[3] * v[3]));
        if (q == 0) ((float*)(ws + WS_SSQ))[row * 16 + pn * 4 + wc] = ss;
    } else if (WHICH == 5) {
        if (q < 8) {
            const float rs = row_rs(ssq, (int)row);
            const f32x4 yu = sg_sum(TLP, r, q + 8);
            f32x4 h;
#pragma unroll
            for (int e = 0; e < 4; ++e) { const float gt = y[e] * rs, up = yu[e] * rs; h[e] = gt * sigmoidf_(gt) * up; }
            u32x2 w; w.x = pkbf(h[0], h[1]); w.y = pkbf(h[2], h[3]); *(u32x2*)((bf16_t*)(ws + WS_H) + row * DFF + pn * 128 + 32 * wc + i0) = w;
        }
    }
}

constexpr int RING_BYTES = 131072, LDS_BYTES = 147456, LDSCTL_OFF = LDS_BYTES - 1024, MISC_OFF = LDSCTL_OFF + 320;
static_assert(AT_END <= LDSCTL_OFF && SC_END <= LDSCTL_OFF && RING_BYTES <= LDSCTL_OFF, "LDS map");
constexpr int CW_BAR = 4096;
constexpr int NPH = 1 + 8 * DEPTH;
#ifndef PHMASK
#define PHMASK 63
#endif
struct Args { Ptrs P; int ph_lo, ph_hi, pad0, pad1; };

__global__ void __launch_bounds__(512, 2) mega(Args a) {
    extern __shared__ __attribute__((aligned(16))) unsigned char lds_raw[];
    LAS unsigned char* lds = (LAS unsigned char*)lds_raw;
    const int wv = __builtin_amdgcn_readfirstlane(threadIdx.x >> 6);
#define TID() ((wv << 6) | lane_id_v())
    { const int tid = TID(); for (int u = tid; u < (LDS_BYTES - LDSCTL_OFF) / 4; u += 512) ((LAS unsigned*)(lds + LDSCTL_OFF))[u] = 0u; }
    __syncthreads();
    unsigned char* ws0 = a.P.ws;
    XcdBarrier bar; bar.bar = (unsigned*)(ws0 + WS_CTL) + CW_BAR; bar.x = 0; bar.st = nullptr; bar.wv = wv;
    if (a.ph_hi - a.ph_lo > 1) bar = xcd_barrier_post((unsigned*)(ws0 + WS_CTL) + CW_BAR, (volatile LAS unsigned*)(lds + MISC_OFF) + 8);
    bar.wv = wv;
    const int G = gridDim.x;
#ifndef PROBE_REPEAT
#define PROBE_REPEAT -1
#endif
    for (int ph2_ = a.ph_lo * 2; ph2_ < a.ph_hi * 2; ph2_ = __builtin_amdgcn_readfirstlane(ph2_ + 1)) {
        const int ph2 = __builtin_amdgcn_readfirstlane(ph2_), ph = ph2 >> 1;
        const bool isrep = (PROBE_REPEAT == 8) ? (ph == 0) : (PROBE_REPEAT == 9 ? true : (ph > 0 && ((ph - 1) & 7) == PROBE_REPEAT));
        if (!isrep && (ph2 & 1) == 0) continue;
        const int dry = (isrep && (ph2 & 1) == 0) ? 1 : 0;
        if (PROBE_REPEAT == 9 && dry) { xcd_barrier(bar); continue; }
        const Ptrs& P = a.P;
        int bid = blockIdx.x; asm volatile("" : "+s"(bid));
        unsigned char* ws = P.ws;
        if (ph == 0 && (PHMASK & 32)) {
            int t_ = TID(); asm volatile("" : "+v"(t_));
            p0_prologue(P, lds, bid * 8 + wv, G * 8, wv, t_ & 63);
        } else {
            const int l = __builtin_amdgcn_readfirstlane((ph - 1) >> 3), p = __builtin_amdgcn_readfirstlane((ph - 1) & 7);
            unsigned char* wb = ws + WS_W + l * LW_BYTES;
            if (p == 0 && (PHMASK & 1)) {
                pg8::Gemm g{(const bf16_t*)(ws + WS_XB), (const bf16_t*)(wb + LW_W1), MP, N1, DM, wv}; pg8::StaticOrder S; S.init(MP, N1, G, bid);
                Epi1 E{0, P, l}; pg8::gemm_phase<Epi1, pg8::StaticOrder, true, true>(lds, g, S, E);
                { int t_ = TID(); asm volatile("" : "+v"(t_)); for (int s = G - 1 - bid; s < N1 / 64; s += G) sample_strip<1>(P, l, lds, wv, t_, s, 0); }
            } else if (p == 4 && (PHMASK & 2)) {
                pg8::Gemm g{(const bf16_t*)(ws + WS_A3), (const bf16_t*)(wb + LW_W3), MP, DM, K3, wv}; pg8::StaticOrder S; S.init(MP, DM, G, bid);
                Epi3 E{DR / 64, P}; pg8::gemm_phase<Epi3, pg8::StaticOrder, true, true>(lds, g, S, E);
                { int t_ = TID(); asm volatile("" : "+v"(t_)); for (int s = G - 1 - bid; s < DM / 64; s += G) sample_strip<3>(P, l, lds, wv, t_, s, 0); }
            } else if (p == 5 && (PHMASK & 4)) {
                pg8::Gemm g{(const bf16_t*)(ws + WS_MRG), (const bf16_t*)(wb + LW_W4), MP, DM, DM, wv}; pg8::StaticOrder S; S.init(MP, DM, G, bid);
                EpiRes E{0, P, l == 0 ? 1 : 0, 0, dry}; pg8::gemm_phase<EpiRes, pg8::StaticOrder, true, true>(lds, g, S, E);
                { int t_ = TID(); asm volatile("" : "+v"(t_)); for (int s = G - 1 - bid; s < DM / 64; s += G) if (!dry) sample_strip<4>(P, l, lds, wv, t_, s, l == 0 ? 1 : 0); }
            } else if (p == 6 && (PHMASK & 8)) {
                pg8::Gemm g{(const bf16_t*)(ws + WS_XB), (const bf16_t*)(wb + LW_W5), MP, 2 * DFF, DM, wv}; pg8::StaticOrder S; S.init(MP, 2 * DFF, G, bid);
                Epi5 E{0, P}; pg8::gemm_phase<Epi5, pg8::StaticOrder, true, true>(lds, g, S, E);
                { int t_ = TID(); asm volatile("" : "+v"(t_)); for (int s = G - 1 - bid; s < 2 * DFF / 64; s += G) sample_strip<5>(P, l, lds, wv, t_, s, 0); }
            } else if (p == 7 && (PHMASK & 16)) {
                pg8::Gemm g{(const bf16_t*)(ws + WS_H), (const bf16_t*)(wb + LW_W6), MP, DM, DFF, wv}; pg8::StaticOrder S; S.init(MP, DM, G, bid);
                EpiRes E{0, P, 0, l == DEPTH - 1 ? 1 : 0, dry}; pg8::gemm_phase<EpiRes, pg8::StaticOrder, true, true>(lds, g, S, E);
                { int t_ = TID(); asm volatile("" : "+v"(t_)); for (int s = G - 1 - bid; s < DM / 64; s += G) if (!dry) sample_strip<6>(P, l, lds, wv, t_, s, l == DEPTH - 1 ? 2 : 0); }
            } else if (p >= 1 && p <= 3) {
                int t_ = TID(); asm volatile("" : "+v"(t_));
                const size_t gtid = (size_t)bid * 512 + t_, nth = (size_t)G * 512;
                if (p == 1) {
                    for (int rp = 0; rp < (PROBE_REPEAT == 10 ? 2 : 1); ++rp)
                    for (int it = bid; it < 256; it += G) scan_item<0>(P, l, lds, wv, t_, it >> 7, (it >> 3) & 15, it & 7);
                    for (int rp = 0; rp < (PROBE_REPEAT == 11 ? 2 : 1); ++rp)
                    attn_phase(P, l, lds, wv, t_, bid, G);
                    __syncthreads();
                    for (int it = bid * 8 + wv; it < SB * NH; it += G * 8) attn_sample(P, l, lds, wv, t_ & 63, it);
                } else if (p == 2) {
                    for (int rp = 0; rp < (PROBE_REPEAT == 12 ? 2 : 1); ++rp)
                    for (int it = bid; it < 256; it += G) scan_item<1>(P, l, lds, wv, t_, it >> 7, (it >> 3) & 15, it & 7);
                    for (int rp = 0; rp < (PROBE_REPEAT == 13 ? 2 : 1); ++rp) {
                    for (int it = bid; it < 64; it += G) scan_sample(P, l, lds, t_, it >> 4, it & 15);
                    ph_combine(P, gtid, nth); }
                }
            }
        }
        if (ph2 + 1 < a.ph_hi * 2) xcd_barrier(bar);
    }
}

extern "C" void kernel_launch(void* const* d_in, const int* in_sizes, int n_in, void* d_out, int out_size, void* d_ws, size_t ws_size, hipStream_t stream) {
    static int grid = 0;
    if (grid == 0) {
        if (n_in != 27 || (size_t)out_size != O_END || ws_size < WS_END) { fprintf(stderr, "kernel_launch: unexpected sizes n_in %d out %d (want %zu) ws %zu (want %zu)\n", n_in, out_size, (size_t)O_END, ws_size, (size_t)WS_END); grid = -1; return; }
        int dev = 0, cus = 0;
        if (hipGetDevice(&dev) != hipSuccess || hipDeviceGetAttribute(&cus, hipDeviceAttributeMultiprocessorCount, dev) != hipSuccess) { grid = -1; return; }
        if (hipFuncSetAttribute((const void*)mega, hipFuncAttributeMaxDynamicSharedMemorySize, LDS_BYTES) != hipSuccess) { fprintf(stderr, "kernel_launch: hipFuncSetAttribute failed\n"); grid = -1; return; }
        grid = cus;
    }
    if (grid < 0) return;
    Args a{};
    Ptrs& P = a.P;
    const float* const* in = (const float* const*)d_in;
    P.x_prompt = in[0]; P.x_sample = in[1]; P.cache[0] = in[2]; P.cache[1] = in[3]; P.cache[2] = in[4]; P.state_conv = in[5]; P.state_h = in[6]; P.rel_bias = in[7];
    P.norm_mix = in[8]; P.w_in = in[9]; P.w_conv = in[10]; P.b_conv = in[11]; P.w_rg_a = in[12]; P.b_rg_a = in[13]; P.w_rg_x = in[14]; P.b_rg_x = in[15];
    P.lru_lambda = in[16]; P.q_gain = in[17]; P.k_gain = in[18]; P.w_merge = in[19]; P.b_merge = in[20]; P.w_branch_lru = in[21]; P.w_branch_att = in[22];
    P.w_o = in[23]; P.norm_ffn = in[24]; P.w_ffn_in = in[25]; P.w_ffn_out = in[26];
    P.out = (float*)d_out; P.ws = (unsigned char*)d_ws;
    (void)hipMemsetAsync((char*)d_ws + WS_CTL, 0, CTL_ZERO_BYTES, stream);
    a.ph_lo = 0; a.ph_hi = NPH;
    hipLaunchKernelGGL(mega, dim3(grid), dim3(512), LDS_BYTES, stream, a);
}
```
